# Optimizing an MI355X kernel written in HIP

```python
import math
import jax
import jax.numpy as jnp
from jax import lax
import numpy as np

D_MODEL = 1024
BATCH = 2
SEQ = 8192
DEPTH = 1

MEM_LEN = 256
RMS_EPS = 1e-5

SSM_HEADS = 8
SSM_HEAD_DIM = 64
SSM_WIDTH = SSM_HEADS * SSM_HEAD_DIM
SSM_STATE = 128
SSM_GROUPS = 2
CONV_WIDTH = 4
CHUNK = 128
CONV_CH = SSM_WIDTH + 2 * SSM_GROUPS * SSM_STATE

ATTN_HEADS = 8
KV_HEADS = 2
Q_PER_KV = ATTN_HEADS // KV_HEADS
HEAD_DIM = 64
ATTN_WIDTH = ATTN_HEADS * HEAD_DIM
KV_WIDTH = KV_HEADS * HEAD_DIM
WINDOW = 128
BLOCK = WINDOW
QKV_COLS = ATTN_WIDTH + 2 * KV_WIDTH

MIX_WIDTH = SSM_WIDTH + ATTN_WIDTH
IN_COLS = SSM_WIDTH + CONV_CH + SSM_HEADS + QKV_COLS

REL_BUCKETS = 32
REL_MAX_DIST = 128

CROSS_HEADS = 4
CROSS_HEAD_DIM = 128
CROSS_WIDTH = CROSS_HEADS * CROSS_HEAD_DIM

N_EXPERTS = 32
TOP_K = 4
D_FF = D_MODEL
SWIGLU_ALPHA = 1.702
SWIGLU_LIMIT = 7.0
MOE_BLOCK = 128

kernel_name = "hybrid_ssd_swa_sink_t5_memxattn_moe"


def rmsnorm(x, g):
    xf = x.astype(jnp.float32)
    y = xf * lax.rsqrt(jnp.mean(xf * xf, axis=-1, keepdims=True) + RMS_EPS)
    return (y * g.astype(jnp.float32)).astype(x.dtype)


def causal_depthwise_conv(u, w, b):
    c = u.shape[-1]
    out = lax.conv_general_dilated(
        u, w[:, None, :].astype(u.dtype), window_strides=(1,),
        padding=[(CONV_WIDTH - 1, 0)], dimension_numbers=("NWC", "WIO", "NWC"),
        feature_group_count=c)
    return out + b.astype(u.dtype)


def segsum(a):
    t = a.shape[-1]
    cs = jnp.cumsum(a, axis=-1)
    diff = cs[..., :, None] - cs[..., None, :]
    mask = jnp.tril(jnp.ones((t, t), dtype=bool))
    return jnp.where(mask, diff, -jnp.inf)


def ssd_chunked(xh, dt, a_head, bm, cm):
    b, l, nh, p = xh.shape
    g, n = bm.shape[-2], bm.shape[-1]
    r = nh // g
    c = l // CHUNK
    xdt = (xh * dt[..., None]).reshape(b, c, CHUNK, g, r, p)
    a = (dt * a_head).reshape(b, c, CHUNK, g, r).transpose(0, 3, 4, 1, 2)
    bc = bm.reshape(b, c, CHUNK, g, n)
    cc = cm.reshape(b, c, CHUNK, g, n)
    a_cs = jnp.cumsum(a, axis=-1)
    decay = jnp.exp(segsum(a))
    cb = jnp.einsum("bclgn,bcsgn->bgcls", cc, bc)
    y_diag = jnp.einsum("bgrcls,bcsgrp->bclgrp", cb[:, :, None] * decay, xdt)
    to_end = jnp.exp(a_cs[..., -1:] - a_cs)
    states = jnp.einsum("bcsgn,bgrcs,bcsgrp->cbgrpn", bc, to_end, xdt)
    chunk_decay = jnp.exp(a_cs[..., -1]).transpose(3, 0, 1, 2)

    def step(h_state, inp):
        st, dec = inp
        return h_state * dec[..., None, None] + st, h_state

    h0 = jnp.zeros((b, g, r, p, n), jnp.float32)
    _, h_in = lax.scan(step, h0, (states, chunk_decay))
    y_off = jnp.einsum("bclgn,cbgrpn,bgrcl->bclgrp", cc, h_in, jnp.exp(a_cs))
    return (y_diag + y_off).reshape(b, l, nh, p)


def ssd_mixer(z, xbc, dt_raw, conv_w, conv_b, dt_bias, a_log, d_skip, g_ssm_out):
    b, l, _ = xbc.shape
    xbc = jax.nn.silu(causal_depthwise_conv(xbc, conv_w, conv_b))
    xs, bm, cm = jnp.split(xbc, [SSM_WIDTH, SSM_WIDTH + SSM_GROUPS * SSM_STATE], axis=-1)
    f32 = jnp.float32
    dt = jax.nn.softplus(dt_raw.astype(f32) + dt_bias.astype(f32))
    a_head = -jnp.exp(a_log.astype(f32))
    xh = xs.astype(f32).reshape(b, l, SSM_HEADS, SSM_HEAD_DIM)
    y = ssd_chunked(xh, dt, a_head,
                    bm.astype(f32).reshape(b, l, SSM_GROUPS, SSM_STATE),
                    cm.astype(f32).reshape(b, l, SSM_GROUPS, SSM_STATE))
    y = y + d_skip.astype(f32)[:, None] * xh
    y = y.reshape(b, l, SSM_WIDTH) * jax.nn.silu(z.astype(f32))
    yg = y.reshape(b, l, SSM_GROUPS, SSM_WIDTH // SSM_GROUPS)
    yg = yg * lax.rsqrt(jnp.mean(yg * yg, axis=-1, keepdims=True) + RMS_EPS)
    return (yg.reshape(b, l, SSM_WIDTH) * g_ssm_out.astype(f32)).astype(z.dtype)


def t5_bucket(dist):
    d = jnp.maximum(dist, 0)
    max_exact = REL_BUCKETS // 2
    ratio = jnp.maximum(d, max_exact).astype(jnp.float32) / max_exact
    large = max_exact + (jnp.log(ratio) / math.log(REL_MAX_DIST / max_exact)
                         * (REL_BUCKETS - max_exact)).astype(jnp.int32)
    large = jnp.minimum(large, REL_BUCKETS - 1)
    return jnp.where(d < max_exact, d, large)


def swa_mixer(qkv, sinks, rel_bias):
    b, l, _ = qkv.shape
    nb = l // BLOCK
    q, k, v = jnp.split(qkv, [ATTN_WIDTH, ATTN_WIDTH + KV_WIDTH], axis=-1)
    q = q.reshape(b, nb, BLOCK, KV_HEADS, Q_PER_KV, HEAD_DIM)
    k = k.reshape(b, nb, BLOCK, KV_HEADS, HEAD_DIM)
    v = v.reshape(b, nb, BLOCK, KV_HEADS, HEAD_DIM)

    def with_prev(t):
        prev = jnp.pad(t, ((0, 0), (1, 0), (0, 0), (0, 0), (0, 0)))[:, :-1]
        return jnp.concatenate([prev, t], axis=2)

    k2, v2 = with_prev(k), with_prev(v)
    s = jnp.einsum("bnqkgd,bnskd->bnkgqs", q, k2).astype(jnp.float32) * (HEAD_DIM ** -0.5)
    q_pos = jnp.arange(BLOCK)[:, None]
    k_pos = jnp.arange(2 * BLOCK)[None, :] - BLOCK
    dist = q_pos - k_pos
    bias = rel_bias.astype(jnp.float32)[t5_bucket(dist)]
    bias = bias.reshape(BLOCK, 2 * BLOCK, KV_HEADS, Q_PER_KV).transpose(2, 3, 0, 1)
    in_window = (dist >= 0) & (dist < WINDOW)
    k_abs = jnp.arange(nb)[:, None] * BLOCK + k_pos
    mask = in_window[None] & (k_abs >= 0)[:, None, :]
    s = jnp.where(mask[None, :, None, None], s + bias, -jnp.inf)
    sink = jnp.broadcast_to(
        sinks.astype(jnp.float32).reshape(KV_HEADS, Q_PER_KV)[None, None, :, :, None, None],
        s.shape[:-1] + (1,))
    p = jax.nn.softmax(jnp.concatenate([s, sink], axis=-1), axis=-1)[..., :-1]
    o = jnp.einsum("bnkgqs,bnskd->bnqkgd", p.astype(v.dtype), v2)
    return o.reshape(b, l, ATTN_WIDTH)


def hybrid_mixer(u, w_in, b_qkv, conv_w, conv_b, dt_bias, a_log, d_skip, g_ssm_out,
                 attn_sinks, rel_bias, w_out, b_out):
    proj = u @ w_in
    z, xbc, dt_raw, qkv = jnp.split(
        proj, [SSM_WIDTH, SSM_WIDTH + CONV_CH, SSM_WIDTH + CONV_CH + SSM_HEADS], axis=-1)
    y_ssm = ssd_mixer(z, xbc, dt_raw, conv_w, conv_b, dt_bias, a_log, d_skip, g_ssm_out)
    y_attn = swa_mixer(qkv + b_qkv.astype(qkv.dtype), attn_sinks, rel_bias).astype(y_ssm.dtype)
    return jnp.concatenate([y_ssm, y_attn], axis=-1) @ w_out + b_out


def cross_attention(u, m, w_q, w_kv, w_o):
    b, l, _ = u.shape
    n_mem = m.shape[1]
    q = (u @ w_q).reshape(b, l, CROSS_HEADS, CROSS_HEAD_DIM)
    k, v = jnp.split(m @ w_kv, 2, axis=-1)
    k = k.reshape(b, n_mem, CROSS_HEADS, CROSS_HEAD_DIM)
    v = v.reshape(b, n_mem, CROSS_HEADS, CROSS_HEAD_DIM)
    s = jnp.einsum("blhd,bmhd->bhlm", q, k).astype(jnp.float32) * (CROSS_HEAD_DIM ** -0.5)
    p = jax.nn.softmax(s, axis=-1).astype(v.dtype)
    o = jnp.einsum("bhlm,bmhd->blhd", p, v).reshape(b, l, CROSS_WIDTH)
    return o @ w_o


def clamped_swiglu(h):
    x_glu, x_lin = h[..., ::2], h[..., 1::2]
    x_glu = jnp.minimum(x_glu, SWIGLU_LIMIT)
    x_lin = jnp.clip(x_lin, -SWIGLU_LIMIT, SWIGLU_LIMIT)
    return x_glu * jax.nn.sigmoid(SWIGLU_ALPHA * x_glu) * (x_lin + 1.0)


def moe(u, w_router, b_router, w1, b1, w2, b2):
    b, l, d = u.shape
    n_tok = b * l
    n_assign = n_tok * TOP_K
    xt = u.reshape(n_tok, d)
    logits = xt @ w_router + b_router
    top_vals, top_idx = lax.top_k(logits, TOP_K)
    gates = jax.nn.softmax(top_vals.astype(jnp.float32), axis=-1).astype(xt.dtype)
    e_flat = top_idx.reshape(-1).astype(jnp.int32)
    tok_flat = jnp.arange(n_assign, dtype=jnp.int32) // TOP_K
    g_flat = gates.reshape(-1)
    counts = jnp.bincount(e_flat, length=N_EXPERTS).astype(jnp.int32)
    padded = (counts + MOE_BLOCK - 1) // MOE_BLOCK * MOE_BLOCK
    padded_end = jnp.cumsum(padded)
    padded_start = padded_end - padded
    count_start = jnp.cumsum(counts) - counts
    order = jnp.argsort(e_flat, stable=True)
    se = e_flat[order]
    rank = jnp.arange(n_assign, dtype=jnp.int32) - count_start[se]
    dest = padded_start[se] + rank
    n_blocks = (n_assign + MOE_BLOCK - 1) // MOE_BLOCK + N_EXPERTS
    n_rows = n_blocks * MOE_BLOCK
    row_tok = jnp.zeros((n_rows,), jnp.int32).at[dest].set(tok_flat[order])
    row_gate = jnp.zeros((n_rows,), xt.dtype).at[dest].set(g_flat[order])
    block_start = jnp.arange(n_blocks, dtype=jnp.int32) * MOE_BLOCK
    block_exp = jnp.minimum(jnp.searchsorted(padded_end, block_start, side="right"),
                            N_EXPERTS - 1).astype(jnp.int32)

    def expert_block(args):
        toks, e = args
        hdn = xt[toks] @ w1[e] + b1[e]
        return clamped_swiglu(hdn) @ w2[e] + b2[e]

    y_rows = lax.map(expert_block, (row_tok.reshape(n_blocks, MOE_BLOCK), block_exp))
    y_rows = y_rows.reshape(n_rows, d) * row_gate[:, None]
    out = jnp.zeros((n_tok, d), xt.dtype).at[row_tok].add(y_rows)
    return out.reshape(b, l, d)


def setup_inputs(seed: int = 0) -> dict:
    key = jax.random.key(seed)
    ks = iter(jax.random.split(key, 40))
    L = DEPTH
    f32 = jnp.float32

    def nrm(shape, scale):
        return jax.random.normal(next(ks), shape, f32) * scale

    def gain(shape):
        return 1.0 + nrm(shape, 0.05)

    dt0 = jnp.exp(jax.random.uniform(next(ks), (L, SSM_HEADS), f32)
                  * (math.log(0.1) - math.log(0.001)) + math.log(0.001))
    dt_bias = dt0 + jnp.log(-jnp.expm1(-dt0))
    a_log = jnp.log(jax.random.uniform(next(ks), (L, SSM_HEADS), f32, minval=1.0, maxval=16.0))
    return {
        "x": nrm((BATCH, SEQ, D_MODEL), 1.0),
        "mem": nrm((BATCH, MEM_LEN, D_MODEL), 1.0),
        "g_mix": gain((L, D_MODEL)),
        "w_in": nrm((L, D_MODEL, IN_COLS), D_MODEL ** -0.5),
        "b_qkv": nrm((L, QKV_COLS), 0.02),
        "conv_w": nrm((L, CONV_WIDTH, CONV_CH), CONV_WIDTH ** -0.5),
        "conv_b": nrm((L, CONV_CH), 0.02),
        "dt_bias": dt_bias,
        "a_log": a_log,
        "d_skip": gain((L, SSM_HEADS)),
        "g_ssm_out": gain((L, SSM_WIDTH)),
        "attn_sinks": nrm((L, ATTN_HEADS), 0.5),
        "rel_bias": nrm((REL_BUCKETS, ATTN_HEADS), 0.5),
        "w_out": nrm((L, MIX_WIDTH, D_MODEL), MIX_WIDTH ** -0.5),
        "b_out": nrm((L, D_MODEL), 0.02),
        "g_cross": gain((L, D_MODEL)),
        "g_mem": gain((L, D_MODEL)),
        "w_q_cross": nrm((L, D_MODEL, CROSS_WIDTH), D_MODEL ** -0.5),
        "w_kv_cross": nrm((L, D_MODEL, 2 * CROSS_WIDTH), D_MODEL ** -0.5),
        "w_o_cross": nrm((L, CROSS_WIDTH, D_MODEL), CROSS_WIDTH ** -0.5),
        "g_ffn": gain((L, D_MODEL)),
        "w_router": nrm((L, D_MODEL, N_EXPERTS), D_MODEL ** -0.5),
        "b_router": nrm((L, N_EXPERTS), 0.01),
        "w1": nrm((L, N_EXPERTS, D_MODEL, 2 * D_FF), D_MODEL ** -0.5),
        "b1": nrm((L, N_EXPERTS, 2 * D_FF), 0.01),
        "w2": nrm((L, N_EXPERTS, D_FF, D_MODEL), D_FF ** -0.5),
        "b2": nrm((L, N_EXPERTS, D_MODEL), 0.01),
        "g_final": gain((D_MODEL,)),
    }


def reference(x, mem, g_mix, w_in, b_qkv, conv_w, conv_b, dt_bias, a_log, d_skip, g_ssm_out,
              attn_sinks, rel_bias, w_out, b_out, g_cross, g_mem, w_q_cross, w_kv_cross,
              w_o_cross, g_ffn, w_router, b_router, w1, b1, w2, b2, g_final):
    h = x
    for i in range(DEPTH):
        h = h + hybrid_mixer(rmsnorm(h, g_mix[i]), w_in[i], b_qkv[i], conv_w[i], conv_b[i],
                             dt_bias[i], a_log[i], d_skip[i], g_ssm_out[i], attn_sinks[i],
                             rel_bias, w_out[i], b_out[i]).astype(h.dtype)
        h = h + cross_attention(rmsnorm(h, g_cross[i]), rmsnorm(mem, g_mem[i]),
                                w_q_cross[i], w_kv_cross[i], w_o_cross[i]).astype(h.dtype)
        h = h + moe(rmsnorm(h, g_ffn[i]), w_router[i], b_router[i], w1[i], b1[i],
                    w2[i], b2[i]).astype(h.dtype)
    return rmsnorm(h, g_final)
```

```cpp
#include <hip/hip_runtime.h>
#include <hip/hip_cooperative_groups.h>
#include <cstdio>
#include <cstdint>
namespace cg = cooperative_groups;

#define DEVI __device__ __forceinline__

constexpr int BATCH = 2, SEQ = 8192, NTOK = BATCH * SEQ, DM = 1024, MEMLEN = 256, NMEM = BATCH * MEMLEN;
constexpr int SSM_H = 8, SSM_P = 64, SSM_W = 512, SSM_N = 128, CONVCH = 1024;
constexpr int IN_COLS = 2312, COL_Z = 0, COL_XBC = 512, COL_DT = 1536, COL_Q = 1544, COL_K = 2056, COL_V = 2184;
constexpr int NEXP = 32, TOPK = 4, DFF = 1024, NASSIGN = NTOK * TOPK;
constexpr float EPS = 1e-5f;

enum { I_X = 0, I_MEM, I_GMIX, I_WIN, I_BQKV, I_CONVW, I_CONVB, I_DTB, I_ALOG, I_DSKIP, I_GSSM, I_SINK, I_RELB, I_WOUT, I_BOUT,
       I_GCROSS, I_GMEM, I_WQ, I_WKV, I_WO, I_GFFN, I_WR, I_BR, I_W1, I_B1, I_W2, I_B2, I_GFIN, N_IN };

constexpr size_t MiB = 1u << 20;
constexpr size_t WS_CTL = 0;
constexpr size_t WS_U = 1 * MiB;
constexpr size_t WS_BIG = WS_U + 64 * MiB;
constexpr size_t WS_XBC = WS_BIG + 256 * MiB;
constexpr size_t WS_MIX = WS_XBC + 64 * MiB;
constexpr size_t WS_H1 = WS_MIX + 64 * MiB;
constexpr size_t WS_H2 = WS_H1 + 64 * MiB;
constexpr size_t WS_YSSM = WS_H2 + 64 * MiB;
constexpr size_t WS_QC = WS_YSSM + 32 * MiB;
constexpr size_t WS_OC = WS_QC + 32 * MiB;
constexpr size_t WS_Y = WS_OC + 32 * MiB;
constexpr size_t WS_SMALL = WS_Y + 256 * MiB;
constexpr size_t WS_DT = WS_SMALL;
constexpr size_t WS_KVM = WS_DT + 1 * MiB;
constexpr size_t WS_MEMN = WS_KVM + 2 * MiB;
constexpr size_t WS_GATE = WS_MEMN + 2 * MiB;
constexpr size_t WS_LIST = WS_GATE + 1 * MiB;
constexpr size_t WS_END = WS_LIST + 2 * MiB;
constexpr int CW_CNT = 64;

struct Params { const float* in[N_IN]; float* out; unsigned char* ws; };

DEVI float wave_sum(float v) {
#pragma unroll
    for (int o = 32; o > 0; o >>= 1) v += __shfl_xor(v, o);
    return v;
}
DEVI float wave_max(float v) {
#pragma unroll
    for (int o = 32; o > 0; o >>= 1) v = fmaxf(v, __shfl_xor(v, o));
    return v;
}
DEVI float silu_f(float x) { return x / (1.f + __expf(-x)); }
DEVI float softplus_f(float x) { return fmaxf(x, 0.f) + log1pf(__expf(-fabsf(x))); }
DEVI float4 ld4(const float* p) { return *(const float4*)p; }
DEVI void st4(float* p, float4 v) { *(float4*)p = v; }

DEVI void rms_row(const float* xrow, const float* g, float* orow, int lane) {
    float4 v[4]; float s = 0.f;
#pragma unroll
    for (int j = 0; j < 4; ++j) { v[j] = ld4(xrow + 4 * (lane + 64 * j)); s += v[j].x * v[j].x + v[j].y * v[j].y + v[j].z * v[j].z + v[j].w * v[j].w; }
    const float rs = rsqrtf(wave_sum(s) * (1.f / 1024.f) + EPS);
#pragma unroll
    for (int j = 0; j < 4; ++j) { const float4 gv = ld4(g + 4 * (lane + 64 * j));
        st4(orow + 4 * (lane + 64 * j), make_float4(v[j].x * rs * gv.x, v[j].y * rs * gv.y, v[j].z * rs * gv.z, v[j].w * rs * gv.w)); }
}

template <int NC>
DEVI void ng_core(const float* const (&ar)[8], const float* B, int ldb, int col, int K, float (&acc)[8][NC]) {
#pragma unroll
    for (int r = 0; r < 8; ++r)
#pragma unroll
        for (int c = 0; c < NC; ++c) acc[r][c] = 0.f;
    for (int k = 0; k < K; k += 4) {
        float b[4][NC];
#pragma unroll
        for (int kk = 0; kk < 4; ++kk)
#pragma unroll
            for (int c = 0; c < NC; ++c) b[kk][c] = B[(size_t)(k + kk) * ldb + col + c];
#pragma unroll
        for (int r = 0; r < 8; ++r) {
            const float4 a = ld4(ar[r] + k);
#pragma unroll
            for (int c = 0; c < NC; ++c) acc[r][c] += a.x * b[0][c] + a.y * b[1][c] + a.z * b[2][c] + a.w * b[3][c];
        }
    }
}

template <class Epi>
DEVI void ngemm_dense(const float* A, int lda, const float* B, int ldb, int M, int N, int K, const Epi& epi) {
    const int nct = (N + 511) / 512, nrt = M / 8;
    for (int tile = blockIdx.x; tile < nct * nrt; tile += gridDim.x) {
        const int ct = tile % nct, rt = tile / nct;
        const int col = ct * 512 + threadIdx.x; const bool cv = col < N; const int colc = cv ? col : N - 1;
        const float* ar[8];
#pragma unroll
        for (int r = 0; r < 8; ++r) ar[r] = A + (size_t)(rt * 8 + r) * lda;
        float acc[8][1];
        ng_core<1>(ar, B, ldb, colc, K, acc);
        if (cv) {
#pragma unroll
            for (int r = 0; r < 8; ++r) epi(rt * 8 + r, col, acc[r][0]);
        }
    }
}

struct EpiStore { float* C; int ldc; DEVI void operator()(int r, int c, float v) const { C[(size_t)r * ldc + c] = v; } };
struct EpiBiasRes { float* C; const float* bias; const float* res; DEVI void operator()(int r, int c, float v) const { C[(size_t)r * 1024 + c] = v + (bias ? bias[c] : 0.f) + res[(size_t)r * 1024 + c]; } };

__global__ void __launch_bounds__(512, 2) mk_fwd(Params p) {
    extern __shared__ __attribute__((aligned(16))) unsigned char lds[];
    cg::grid_group grid = cg::this_grid();
    const int tid = threadIdx.x, lane = tid & 63, wave = __builtin_amdgcn_readfirstlane(tid >> 6);
    const int gw = blockIdx.x * 8 + wave, NGW = gridDim.x * 8;
    const int gtid = blockIdx.x * 512 + tid, NGT = gridDim.x * 512;
    unsigned char* ws = p.ws;
    unsigned* ctl = (unsigned*)(ws + WS_CTL);
    float* U = (float*)(ws + WS_U); float* PROJ = (float*)(ws + WS_BIG); float* ACT = (float*)(ws + WS_BIG);
    float* XBC = (float*)(ws + WS_XBC); float* MIX = (float*)(ws + WS_MIX); float* H1 = (float*)(ws + WS_H1); float* H2 = (float*)(ws + WS_H2);
    float* YSSM = (float*)(ws + WS_YSSM); float* QC = (float*)(ws + WS_QC); float* OC = (float*)(ws + WS_OC); float* Y = (float*)(ws + WS_Y);
    float* DT = (float*)(ws + WS_DT); float* KVM = (float*)(ws + WS_KVM); float* MEMN = (float*)(ws + WS_MEMN); float* GATE = (float*)(ws + WS_GATE);
    int* LIST = (int*)(ws + WS_LIST);
    const float* x = p.in[I_X];

    for (int r = gw; r < NTOK + NMEM; r += NGW) {
        if (r < NTOK) rms_row(x + (size_t)r * DM, p.in[I_GMIX], U + (size_t)r * DM, lane);
        else rms_row(p.in[I_MEM] + (size_t)(r - NTOK) * DM, p.in[I_GMEM], MEMN + (size_t)(r - NTOK) * DM, lane);
    }
    grid.sync();
    ngemm_dense(U, DM, p.in[I_WIN], IN_COLS, NTOK, IN_COLS, DM, EpiStore{PROJ, IN_COLS});
    ngemm_dense(MEMN, DM, p.in[I_WKV], 1024, NMEM, 1024, DM, EpiStore{KVM, 1024});
    grid.sync();
    for (int idx = gtid; idx < NTOK * 256; idx += NGT) {
        const int row = idx >> 8, c4 = (idx & 255) * 4, t = row & (SEQ - 1);
        float4 a = ld4(p.in[I_CONVB] + c4);
#pragma unroll
        for (int k = 0; k < 4; ++k) if (t - 3 + k >= 0) {
            const float4 w = ld4(p.in[I_CONVW] + k * CONVCH + c4), v = ld4(PROJ + (size_t)(row - 3 + k) * IN_COLS + COL_XBC + c4);
            a.x += w.x * v.x; a.y += w.y * v.y; a.z += w.z * v.z; a.w += w.w * v.w; }
        st4(XBC + (size_t)row * 1024 + c4, make_float4(silu_f(a.x), silu_f(a.y), silu_f(a.z), silu_f(a.w)));
    }
    for (int idx = gtid; idx < NTOK * 8; idx += NGT) {
        const int row = idx >> 3, h = idx & 7;
        DT[idx] = softplus_f(PROJ[(size_t)row * IN_COLS + COL_DT + h] + p.in[I_DTB][h]);
    }
    grid.sync();
    for (int item = gw; item < BATCH * SSM_H * SSM_P; item += NGW) {
        const int b = item >> 9, h = (item >> 6) & 7, pp = item & 63, g = h >> 2;
        const float ah = -__expf(p.in[I_ALOG][h]), dsk = p.in[I_DSKIP][h];
        float h0 = 0.f, h1 = 0.f;
        const float* xb = XBC + (size_t)b * SEQ * 1024; const float* dtb = DT + (size_t)b * SEQ * 8 + h;
#pragma unroll 4
        for (int t = 0; t < SEQ; ++t) {
            const float* xr = xb + (size_t)t * 1024;
            const float dtv = dtb[(size_t)t * 8], xv = xr[h * 64 + pp];
            const float B0 = xr[512 + g * 128 + lane], B1 = xr[512 + g * 128 + 64 + lane];
            const float C0 = xr[768 + g * 128 + lane], C1 = xr[768 + g * 128 + 64 + lane];
            const float dec = __expf(dtv * ah), dx = dtv * xv;
            h0 = h0 * dec + dx * B0; h1 = h1 * dec + dx * B1;
            const float y = wave_sum(C0 * h0 + C1 * h1) + dsk * xv;
            if (lane == 0) YSSM[(size_t)(b * SEQ + t) * 512 + h * 64 + pp] = y;
        }
    }
    for (int item = gw; item < NTOK * 8; item += NGW) {
        const int row = item >> 3, hq = item & 7, kv = hq >> 2, t = row & (SEQ - 1);
        const float* bq = p.in[I_BQKV];
        const float qv = PROJ[(size_t)row * IN_COLS + COL_Q + hq * 64 + lane] + bq[hq * 64 + lane];
        float s0 = 0.f, s1 = 0.f;
        const int j0 = lane, j1 = lane + 64; const bool v0 = (t - j0) >= 0, v1 = (t - j1) >= 0;
        const float* k0p = PROJ + (size_t)(row - (v0 ? j0 : 0)) * IN_COLS + COL_K + kv * 64;
        const float* k1p = PROJ + (size_t)(row - (v1 ? j1 : 0)) * IN_COLS + COL_K + kv * 64;
        for (int d = 0; d < 64; ++d) {
            const float qd = __shfl(qv, d), kb = bq[512 + kv * 64 + d];
            s0 += qd * (k0p[d] + kb); s1 += qd * (k1p[d] + kb);
        }
        int bk0 = j0 < 16 ? j0 : min(31, 16 + (int)(log2f((float)j0 * 0.0625f) * (16.f / 3.f)));
        int bk1 = min(31, 16 + (int)(log2f((float)j1 * 0.0625f) * (16.f / 3.f)));
        s0 = v0 ? s0 * 0.125f + p.in[I_RELB][bk0 * 8 + hq] : -INFINITY;
        s1 = v1 ? s1 * 0.125f + p.in[I_RELB][bk1 * 8 + hq] : -INFINITY;
        const float sink = p.in[I_SINK][hq];
        const float m = fmaxf(wave_max(fmaxf(s0, s1)), sink);
        const float e0 = v0 ? __expf(s0 - m) : 0.f, e1 = v1 ? __expf(s1 - m) : 0.f;
        const float den = wave_sum(e0 + e1) + __expf(sink - m);
        const float p0 = e0 / den, p1 = e1 / den;
        float o = 0.f; const float vb = bq[640 + kv * 64 + lane];
        const int jmax = min(127, t);
        for (int j = 0; j <= jmax; ++j) {
            const float pj = __shfl(j < 64 ? p0 : p1, j & 63);
            o += pj * (PROJ[(size_t)(row - j) * IN_COLS + COL_V + kv * 64 + lane] + vb);
        }
        MIX[(size_t)row * 1024 + 512 + hq * 64 + lane] = o;
    }
    grid.sync();
    for (int row = gw; row < NTOK; row += NGW) {
        const int c = lane * 8;
        float v[8]; float s = 0.f;
#pragma unroll
        for (int i = 0; i < 8; ++i) { v[i] = YSSM[(size_t)row * 512 + c + i] * silu_f(PROJ[(size_t)row * IN_COLS + COL_Z + c + i]); s += v[i] * v[i]; }
#pragma unroll
        for (int o = 16; o > 0; o >>= 1) s += __shfl_xor(s, o);
        const float rs = rsqrtf(s * (1.f / 256.f) + EPS);
#pragma unroll
        for (int i = 0; i < 8; ++i) MIX[(size_t)row * 1024 + c + i] = v[i] * rs * p.in[I_GSSM][c + i];
    }
    grid.sync();
    ngemm_dense(MIX, 1024, p.in[I_WOUT], 1024, NTOK, 1024, 1024, EpiBiasRes{H1, p.in[I_BOUT], x});
    grid.sync();
    for (int r = gw; r < NTOK; r += NGW) rms_row(H1 + (size_t)r * DM, p.in[I_GCROSS], U + (size_t)r * DM, lane);
    grid.sync();
    ngemm_dense(U, DM, p.in[I_WQ], 512, NTOK, 512, DM, EpiStore{QC, 512});
    grid.sync();
    for (int item = gw; item < NTOK * 4; item += NGW) {
        const int row = item >> 2, hd = item & 3, b = row >> 13;
        const float q0 = QC[(size_t)row * 512 + hd * 128 + lane], q1 = QC[(size_t)row * 512 + hd * 128 + 64 + lane];
        const float* kb = KVM + (size_t)b * MEMLEN * 1024 + hd * 128;
        float s[4] = {0.f, 0.f, 0.f, 0.f};
        for (int d = 0; d < 128; ++d) {
            const float qd = __shfl(d < 64 ? q0 : q1, d & 63);
#pragma unroll
            for (int i = 0; i < 4; ++i) s[i] += qd * kb[(size_t)(lane + 64 * i) * 1024 + d];
        }
        const float sc = 0.08838834764831845f;
        float m = -INFINITY;
#pragma unroll
        for (int i = 0; i < 4; ++i) { s[i] *= sc; m = fmaxf(m, s[i]); }
        m = wave_max(m);
        float den = 0.f;
#pragma unroll
        for (int i = 0; i < 4; ++i) { s[i] = __expf(s[i] - m); den += s[i]; }
        den = wave_sum(den);
        const float inv = 1.f / den;
        float o0 = 0.f, o1 = 0.f; const float* vb = kb + 512;
#pragma unroll
        for (int i = 0; i < 4; ++i)
            for (int jj = 0; jj < 64; ++jj) {
                const float pj = __shfl(s[i], jj) * inv; const float* vr = vb + (size_t)(jj + 64 * i) * 1024;
                o0 += pj * vr[lane]; o1 += pj * vr[64 + lane];
            }
        OC[(size_t)row * 512 + hd * 128 + lane] = o0; OC[(size_t)row * 512 + hd * 128 + 64 + lane] = o1;
    }
    grid.sync();
    ngemm_dense(OC, 512, p.in[I_WO], 1024, NTOK, 1024, 512, EpiBiasRes{H2, nullptr, H1});
    grid.sync();
    for (int row = gw; row < NTOK; row += NGW) {
        float4 un[4];
        {
            float s = 0.f;
#pragma unroll
            for (int j = 0; j < 4; ++j) { un[j] = ld4(H2 + (size_t)row * DM + 4 * (lane + 64 * j)); s += un[j].x * un[j].x + un[j].y * un[j].y + un[j].z * un[j].z + un[j].w * un[j].w; }
            const float rs = rsqrtf(wave_sum(s) * (1.f / 1024.f) + EPS);
#pragma unroll
            for (int j = 0; j < 4; ++j) { const float4 gv = ld4(p.in[I_GFFN] + 4 * (lane + 64 * j));
                un[j] = make_float4(un[j].x * rs * gv.x, un[j].y * rs * gv.y, un[j].z * rs * gv.z, un[j].w * rs * gv.w);
                st4(U + (size_t)row * DM + 4 * (lane + 64 * j), un[j]); }
        }
        float l[32];
#pragma unroll
        for (int e = 0; e < 32; ++e) l[e] = 0.f;
#pragma unroll
        for (int j = 0; j < 4; ++j) {
            const float uu[4] = {un[j].x, un[j].y, un[j].z, un[j].w};
#pragma unroll
            for (int c = 0; c < 4; ++c) {
                const float* wr = p.in[I_WR] + (size_t)(4 * (lane + 64 * j) + c) * 32;
#pragma unroll
                for (int e4 = 0; e4 < 8; ++e4) { const float4 w = ld4(wr + 4 * e4);
                    l[4 * e4] += uu[c] * w.x; l[4 * e4 + 1] += uu[c] * w.y; l[4 * e4 + 2] += uu[c] * w.z; l[4 * e4 + 3] += uu[c] * w.w; }
            }
        }
#pragma unroll
        for (int e = 0; e < 32; ++e) l[e] = wave_sum(l[e]) + p.in[I_BR][e];
        int sel[4]; float val[4];
#pragma unroll
        for (int k = 0; k < 4; ++k) {
            float best = -INFINITY; int bi = 0;
#pragma unroll
            for (int e = 0; e < 32; ++e) if (l[e] > best) { best = l[e]; bi = e; }
            sel[k] = bi; val[k] = best;
#pragma unroll
            for (int e = 0; e < 32; ++e) l[e] = (e == bi) ? -INFINITY : l[e];
        }
        float ex[4], den = 0.f;
#pragma unroll
        for (int k = 0; k < 4; ++k) { ex[k] = __expf(val[k] - val[0]); den += ex[k]; }
        if (lane == 0) {
#pragma unroll
            for (int k = 0; k < 4; ++k) {
                const int a = row * 4 + k;
                const unsigned slot = atomicAdd(&ctl[CW_CNT + sel[k]], 1u);
                LIST[sel[k] * NTOK + slot] = a;
                GATE[a] = ex[k] / den;
            }
        }
    }
    grid.sync();
    for (int tile = blockIdx.x; tile < NEXP * 2048 * 2; tile += gridDim.x) {
        const int ct = tile & 1, rg = (tile >> 1) & 2047, e = tile >> 12;
        const int cnt = (int)__hip_atomic_load(&ctl[CW_CNT + e], __ATOMIC_RELAXED, __HIP_MEMORY_SCOPE_AGENT);
        if (rg * 8 >= cnt) continue;
        int as[8]; const float* ar[8];
#pragma unroll
        for (int r = 0; r < 8; ++r) { const int i = min(rg * 8 + r, cnt - 1); as[r] = __builtin_amdgcn_readfirstlane(LIST[e * NTOK + i]); ar[r] = U + (size_t)(as[r] >> 2) * DM; }
        const int j = ct * 512 + tid;
        float acc[8][2];
        ng_core<2>(ar, p.in[I_W1] + (size_t)e * 1024 * 2048, 2048, 2 * j, 1024, acc);
        const float b0 = p.in[I_B1][e * 2048 + 2 * j], b1 = p.in[I_B1][e * 2048 + 2 * j + 1];
#pragma unroll
        for (int r = 0; r < 8; ++r) if (rg * 8 + r < cnt) {
            const float xg = fminf(acc[r][0] + b0, 7.f), xl = fminf(fmaxf(acc[r][1] + b1, -7.f), 7.f);
            ACT[(size_t)as[r] * 1024 + j] = xg / (1.f + __expf(-1.702f * xg)) * (xl + 1.f);
        }
    }
    grid.sync();
    for (int tile = blockIdx.x; tile < NEXP * 2048 * 2; tile += gridDim.x) {
        const int ct = tile & 1, rg = (tile >> 1) & 2047, e = tile >> 12;
        const int cnt = (int)__hip_atomic_load(&ctl[CW_CNT + e], __ATOMIC_RELAXED, __HIP_MEMORY_SCOPE_AGENT);
        if (rg * 8 >= cnt) continue;
        int as[8]; const float* ar[8];
#pragma unroll
        for (int r = 0; r < 8; ++r) { const int i = min(rg * 8 + r, cnt - 1); as[r] = __builtin_amdgcn_readfirstlane(LIST[e * NTOK + i]); ar[r] = ACT + (size_t)as[r] * 1024; }
        const int col = ct * 512 + tid;
        float acc[8][1];
        ng_core<1>(ar, p.in[I_W2] + (size_t)e * 1024 * 1024, 1024, col, 1024, acc);
        const float bb = p.in[I_B2][e * 1024 + col];
#pragma unroll
        for (int r = 0; r < 8; ++r) if (rg * 8 + r < cnt) Y[(size_t)as[r] * 1024 + col] = acc[r][0] + bb;
    }
    grid.sync();
    for (int row = gw; row < NTOK; row += NGW) {
        float4 v[4]; float s = 0.f;
#pragma unroll
        for (int j = 0; j < 4; ++j) {
            const int c = 4 * (lane + 64 * j);
            float4 a = ld4(H2 + (size_t)row * DM + c);
#pragma unroll
            for (int k = 0; k < 4; ++k) { const float gk = GATE[row * 4 + k]; const float4 y = ld4(Y + (size_t)(row * 4 + k) * 1024 + c);
                a.x += gk * y.x; a.y += gk * y.y; a.z += gk * y.z; a.w += gk * y.w; }
            v[j] = a; s += a.x * a.x + a.y * a.y + a.z * a.z + a.w * a.w;
        }
        const float rs = rsqrtf(wave_sum(s) * (1.f / 1024.f) + EPS);
#pragma unroll
        for (int j = 0; j < 4; ++j) { const int c = 4 * (lane + 64 * j); const float4 gv = ld4(p.in[I_GFIN] + c);
            st4(p.out + (size_t)row * DM + c, make_float4(v[j].x * rs * gv.x, v[j].y * rs * gv.y, v[j].z * rs * gv.z, v[j].w * rs * gv.w)); }
    }
}

constexpr int LDS_BYTES = 147456;

extern "C" void kernel_launch(void* const* d_in, const int* in_sizes, int n_in, void* d_out, int out_size, void* d_ws, size_t ws_size, hipStream_t stream) {
    static int grid = 0;
    if (grid == 0) {
        if (n_in != N_IN || ws_size < WS_END) { fprintf(stderr, "kernel_launch: unexpected n_in %d / ws_size %zu (need %zu)\n", n_in, ws_size, (size_t)WS_END); grid = -1; return; }
        int dev = 0, cus = 0, per_cu = 0;
        hipGetDevice(&dev);
        hipDeviceGetAttribute(&cus, hipDeviceAttributeMultiprocessorCount, dev);
        hipFuncSetAttribute((const void*)mk_fwd, hipFuncAttributeMaxDynamicSharedMemorySize, LDS_BYTES);
        hipOccupancyMaxActiveBlocksPerMultiprocessor(&per_cu, (const void*)mk_fwd, 512, LDS_BYTES);
        if (per_cu < 1) { fprintf(stderr, "kernel_launch: occupancy query says %d blocks per CU\n", per_cu); per_cu = 1; }
        if (per_cu > 1) per_cu = 1;
        grid = cus * per_cu;
    }
    if (grid < 0) return;
    hipMemsetAsync((char*)d_ws + WS_CTL, 0, 1 * MiB, stream);
    Params p{};
    for (int i = 0; i < N_IN; ++i) p.in[i] = (const float*)d_in[i];
    p.out = (float*)d_out; p.ws = (unsigned char*)d_ws;
    void* args[] = {&p};
    hipError_t e = hipLaunchCooperativeKernel((const void*)mk_fwd, dim3(grid), dim3(512), args, LDS_BYTES, stream);
    if (e != hipSuccess) fprintf(stderr, "cooperative launch failed: %s (grid %d)\n", hipGetErrorString(e), grid);
}
```

```cpp
#include <hip/hip_runtime.h>
#include <hip/hip_cooperative_groups.h>
#include <cstdio>
#include <cstdint>
namespace cg = cooperative_groups;

#define DEVI __device__ __forceinline__

constexpr int BATCH = 2, SEQ = 8192, NTOK = BATCH * SEQ, DM = 1024, MEMLEN = 256, NMEM = BATCH * MEMLEN;
constexpr int SSM_H = 8, SSM_P = 64, SSM_W = 512, SSM_N = 128, CONVCH = 1024;
constexpr int IN_COLS = 2312, COL_Z = 0, COL_XBC = 512, COL_DT = 1536, COL_Q = 1544, COL_K = 2056, COL_V = 2184;
constexpr int NEXP = 32, TOPK = 4, DFF = 1024, NASSIGN = NTOK * TOPK;
constexpr float EPS = 1e-5f;

enum { I_X = 0, I_MEM, I_GMIX, I_WIN, I_BQKV, I_CONVW, I_CONVB, I_DTB, I_ALOG, I_DSKIP, I_GSSM, I_SINK, I_RELB, I_WOUT, I_BOUT,
       I_GCROSS, I_GMEM, I_WQ, I_WKV, I_WO, I_GFFN, I_WR, I_BR, I_W1, I_B1, I_W2, I_B2, I_GFIN, N_IN };

constexpr size_t MiB = 1u << 20;
constexpr size_t WS_CTL = 0;
constexpr size_t WS_U = 1 * MiB;
constexpr size_t WS_BIG = WS_U + 64 * MiB;
constexpr size_t WS_XBC = WS_BIG + 256 * MiB;
constexpr size_t WS_MIX = WS_XBC + 64 * MiB;
constexpr size_t WS_H1 = WS_MIX + 64 * MiB;
constexpr size_t WS_H2 = WS_H1 + 64 * MiB;
constexpr size_t WS_YSSM = WS_H2 + 64 * MiB;
constexpr size_t WS_QC = WS_YSSM + 32 * MiB;
constexpr size_t WS_OC = WS_QC + 32 * MiB;
constexpr size_t WS_ACTB = WS_OC + 32 * MiB;
constexpr size_t WS_W1T = WS_ACTB + 144 * MiB;
constexpr size_t WS_W2T = WS_W1T + 128 * MiB;
constexpr size_t WS_SMALL = WS_W2T + 64 * MiB;
constexpr size_t WS_DT = WS_SMALL;
constexpr size_t WS_KVM = WS_DT + 1 * MiB;
constexpr size_t WS_MEMN = WS_KVM + 2 * MiB;
constexpr size_t WS_GATE = WS_MEMN + 2 * MiB;
constexpr size_t WS_SLOT = WS_GATE + 512 * 1024;
constexpr size_t WS_LIST = WS_GATE + 1 * MiB;
constexpr size_t WS_END = WS_LIST + 2 * MiB;
constexpr size_t WS_XN = WS_XBC;
constexpr size_t WS_YB = WS_BIG;
constexpr int NROWS_MAX = NASSIGN + NEXP * 256;
constexpr int CW_CNT = 64;

struct Params { const float* in[N_IN]; float* out; unsigned char* ws; };

DEVI float wave_sum(float v) {
#pragma unroll
    for (int o = 32; o > 0; o >>= 1) v += __shfl_xor(v, o);
    return v;
}
DEVI float wave_max(float v) {
#pragma unroll
    for (int o = 32; o > 0; o >>= 1) v = fmaxf(v, __shfl_xor(v, o));
    return v;
}
DEVI float silu_f(float x) { return x / (1.f + __expf(-x)); }
DEVI float softplus_f(float x) { return fmaxf(x, 0.f) + log1pf(__expf(-fabsf(x))); }
DEVI float4 ld4(const float* p) { return *(const float4*)p; }
DEVI void st4(float* p, float4 v) { *(float4*)p = v; }

DEVI void rms_row(const float* xrow, const float* g, float* orow, int lane) {
    float4 v[4]; float s = 0.f;
#pragma unroll
    for (int j = 0; j < 4; ++j) { v[j] = ld4(xrow + 4 * (lane + 64 * j)); s += v[j].x * v[j].x + v[j].y * v[j].y + v[j].z * v[j].z + v[j].w * v[j].w; }
    const float rs = rsqrtf(wave_sum(s) * (1.f / 1024.f) + EPS);
#pragma unroll
    for (int j = 0; j < 4; ++j) { const float4 gv = ld4(g + 4 * (lane + 64 * j));
        st4(orow + 4 * (lane + 64 * j), make_float4(v[j].x * rs * gv.x, v[j].y * rs * gv.y, v[j].z * rs * gv.z, v[j].w * rs * gv.w)); }
}

template <int NC>
DEVI void ng_core(const float* const (&ar)[8], const float* B, int ldb, int col, int K, float (&acc)[8][NC]) {
#pragma unroll
    for (int r = 0; r < 8; ++r)
#pragma unroll
        for (int c = 0; c < NC; ++c) acc[r][c] = 0.f;
    for (int k = 0; k < K; k += 4) {
        float b[4][NC];
#pragma unroll
        for (int kk = 0; kk < 4; ++kk)
#pragma unroll
            for (int c = 0; c < NC; ++c) b[kk][c] = B[(size_t)(k + kk) * ldb + col + c];
#pragma unroll
        for (int r = 0; r < 8; ++r) {
            const float4 a = ld4(ar[r] + k);
#pragma unroll
            for (int c = 0; c < NC; ++c) acc[r][c] += a.x * b[0][c] + a.y * b[1][c] + a.z * b[2][c] + a.w * b[3][c];
        }
    }
}

template <class Epi>
DEVI void ngemm_dense(const float* A, int lda, const float* B, int ldb, int M, int N, int K, const Epi& epi) {
    const int nct = (N + 511) / 512, nrt = M / 8;
    for (int tile = blockIdx.x; tile < nct * nrt; tile += gridDim.x) {
        const int ct = tile % nct, rt = tile / nct;
        const int col = ct * 512 + threadIdx.x; const bool cv = col < N; const int colc = cv ? col : N - 1;
        const float* ar[8];
#pragma unroll
        for (int r = 0; r < 8; ++r) ar[r] = A + (size_t)(rt * 8 + r) * lda;
        float acc[8][1];
        ng_core<1>(ar, B, ldb, colc, K, acc);
        if (cv) {
#pragma unroll
            for (int r = 0; r < 8; ++r) epi(rt * 8 + r, col, acc[r][0]);
        }
    }
}

struct EpiStore { float* C; int ldc; DEVI void operator()(int r, int c, float v) const { C[(size_t)r * ldc + c] = v; } };
struct EpiBiasRes { float* C; const float* bias; const float* res; DEVI void operator()(int r, int c, float v) const { C[(size_t)r * 1024 + c] = v + (bias ? bias[c] : 0.f) + res[(size_t)r * 1024 + c]; } };


namespace g8 {
#define G8_LAS __attribute__((address_space(3)))
typedef unsigned short bf16_t;
typedef short bf16x8 __attribute__((ext_vector_type(8)));
typedef float f32x4 __attribute__((ext_vector_type(4)));
typedef float f32x2 __attribute__((ext_vector_type(2)));
typedef unsigned u32x4 __attribute__((ext_vector_type(4)));
typedef unsigned u32x2 __attribute__((ext_vector_type(2)));
constexpr int BM = 256, BK = 64, HALF = 128, HTB = HALF * BK * 2, STAGE_BYTES = 8 * HTB;

DEVI int lds_byte(int r, int c) { const int st = (r >> 4) * 2 + (c >> 5), rr = r & 15, cc = c & 31, ob = rr * 64 + cc * 2; return st * 1024 + (ob ^ (((ob >> 9) & 1) << 5)); }
DEVI void stage_rc(int b, int& R, int& C) { const int st = b / 1024, sb = b % 1024, swz = sb ^ (((sb >> 9) & 1) << 5); R = (st >> 1) * 16 + swz / 64; C = (st & 1) * 32 + (swz % 64) / 2; }
DEVI int perm32(int rho) { const int n = rho >> 4, i = rho & 15; return 8 * (i >> 2) + 4 * n + (i & 3); }
DEVI unsigned cvt_pk_bf16(float lo, float hi) { unsigned r; asm volatile("v_cvt_pk_bf16_f32 %0, %1, %2" : "=v"(r) : "v"(lo), "v"(hi)); return r; }

struct Unit {
    const int* alist;
    int acnt;
    int arow0;
    const char* bt;
    int orow0, ocol0;
    int e;
};


struct EpiSwiglu {
    static constexpr bool PERM = true;
    bf16_t* O; const float* bias;
    DEVI void operator()(const f32x4 (&acc)[2][2][4][2], const Unit& u, int wr, int wc, int fr, int fq) const {
        const int row0 = u.orow0 + wr * 64 + fr, col0 = u.ocol0 + wc * 32 + 8 * fq;
        const float* bp = bias + (size_t)u.e * 2048 + col0;
        f32x4 bv[2][2];
#pragma unroll
        for (int bj = 0; bj < 2; ++bj)
#pragma unroll
            for (int n = 0; n < 2; ++n) bv[bj][n] = *(const f32x4*)(bp + bj * HALF + 4 * n);
#pragma unroll
        for (int ai = 0; ai < 2; ++ai)
#pragma unroll
            for (int m = 0; m < 4; ++m) { bf16_t* rowp = O + (size_t)(row0 + ai * HALF + m * 16) * 1024 + (col0 >> 1);
#pragma unroll
                for (int bj = 0; bj < 2; ++bj) { const f32x4 v0 = acc[ai][bj][m][0] + bv[bj][0], v1 = acc[ai][bj][m][1] + bv[bj][1];
                    float o[4];
                    const float gl[4] = {v0[0], v0[2], v1[0], v1[2]}, li[4] = {v0[1], v0[3], v1[1], v1[3]};
#pragma unroll
                    for (int q = 0; q < 4; ++q) { const float xg = fminf(gl[q], 7.f), xl = fminf(fmaxf(li[q], -7.f), 7.f);
                        o[q] = xg * __builtin_amdgcn_rcpf(1.f + __expf(-1.702f * xg)) * (xl + 1.f); }
                    u32x2 w; w.x = cvt_pk_bf16(o[0], o[1]); w.y = cvt_pk_bf16(o[2], o[3]);
                    *(u32x2*)(rowp + bj * (HALF / 2)) = w; } }
    }
};
struct EpiBf16 {
    static constexpr bool PERM = true;
    bf16_t* O; int ldc; const float* bias; int bias_stride;
    DEVI void operator()(const f32x4 (&acc)[2][2][4][2], const Unit& u, int wr, int wc, int fr, int fq) const {
        const int row0 = u.orow0 + wr * 64 + fr, col0 = u.ocol0 + wc * 32 + 8 * fq;
        f32x4 bv[2][2];
#pragma unroll
        for (int bj = 0; bj < 2; ++bj)
#pragma unroll
            for (int n = 0; n < 2; ++n) bv[bj][n] = bias ? *(const f32x4*)(bias + (size_t)u.e * bias_stride + col0 + bj * HALF + 4 * n) : (f32x4){0.f, 0.f, 0.f, 0.f};
#pragma unroll
        for (int ai = 0; ai < 2; ++ai)
#pragma unroll
            for (int m = 0; m < 4; ++m) { bf16_t* rowp = O + (size_t)(row0 + ai * HALF + m * 16) * ldc + col0;
#pragma unroll
                for (int bj = 0; bj < 2; ++bj) { const f32x4 v0 = acc[ai][bj][m][0] + bv[bj][0], v1 = acc[ai][bj][m][1] + bv[bj][1];
                    u32x4 w; w.x = cvt_pk_bf16(v0[0], v0[1]); w.y = cvt_pk_bf16(v0[2], v0[3]); w.z = cvt_pk_bf16(v1[0], v1[1]); w.w = cvt_pk_bf16(v1[2], v1[3]);
                    *(u32x4*)(rowp + bj * HALF) = w; } }
    }
};

template <class Epi, class Sched>
DEVI void gemm_phase(G8_LAS unsigned char* lds, const bf16_t* A, int K, int ashift, const Sched& S, const Epi& E) {
    const int tid = threadIdx.x, wid = __builtin_amdgcn_readfirstlane(tid >> 6), lane = tid & 63, wr = wid >> 2, wc = wid & 3, fr = lane & 15, fq = lane >> 4;
    const int nt = K / BK;
    int Rl[2], Cl[2]; unsigned voffB[2];
#pragma unroll
    for (int i = 0; i < 2; ++i) { stage_rc(tid * 16 + i * 8192, Rl[i], Cl[i]); const int Rb = Epi::PERM ? ((Rl[i] & ~31) + perm32(Rl[i] & 31)) : Rl[i];
        voffB[i] = (unsigned)(Rb * K + Cl[i]) * 2u; }
    const size_t kstep = (size_t)(BK * 2);
    const size_t hstep = (size_t)HALF * K * 2;
    const unsigned ldsw = (unsigned)wid * 1024u;
    const int aoff = lds_byte(wr * 64 + fr, fq * 8), boff = lds_byte(wc * 32 + fr, fq * 8);
    const char* Ab = (const char*)A;
#define G8_AOFF(dst, u) do { _Pragma("unroll") for (int _h = 0; _h < 2; ++_h) _Pragma("unroll") for (int _i = 0; _i < 2; ++_i) { const int _row = _h * HALF + Rl[_i]; int _ar; \
        if ((u).alist) { const int _idx = _row < (u).acnt ? _row : 0; _ar = (u).alist[_idx] >> ashift; } else _ar = (u).arow0 + _row; \
        dst[_h][_i] = (unsigned)(_ar * K + Cl[_i]) * 2u; } } while (0)
#define G8_SA(b, h) (((b) * 2 + (h)) * HTB)
#define G8_SB(b, h) ((4 + (b) * 2 + (h)) * HTB)
#define G8_STAGE(bufoff, gbase, voff) do { _Pragma("unroll") for (int _i = 0; _i < 2; ++_i) \
        __builtin_amdgcn_global_load_lds((const unsigned*)((const char*)(gbase) + (voff)[_i]), (G8_LAS unsigned*)(lds + (bufoff) + ldsw + _i * 8192), 16, 0, 0); } while (0)
#define G8_LDA(dst, b, h) do { _Pragma("unroll") for (int m = 0; m < 4; ++m) _Pragma("unroll") for (int k = 0; k < 2; ++k) dst[m][k] = *(const G8_LAS bf16x8*)(lds + G8_SA(b, h) + aoff + m * 2048 + k * 1024); } while (0)
#define G8_LDB(dst, b, h) do { _Pragma("unroll") for (int n = 0; n < 2; ++n) _Pragma("unroll") for (int k = 0; k < 2; ++k) dst[n][k] = *(const G8_LAS bf16x8*)(lds + G8_SB(b, h) + boff + n * 2048 + k * 1024); } while (0)
#define G8_MMA(ai, bj, At, Bt) do { __builtin_amdgcn_s_setprio(1); _Pragma("unroll") for (int m = 0; m < 4; ++m) _Pragma("unroll") for (int n = 0; n < 2; ++n) _Pragma("unroll") for (int k = 0; k < 2; ++k) \
        acc[ai][bj][m][n] = __builtin_amdgcn_mfma_f32_16x16x32_bf16(Bt[n][k], At[m][k], acc[ai][bj][m][n], 0, 0, 0); __builtin_amdgcn_s_setprio(0); } while (0)
#define G8_WAIT_V(n) asm volatile("s_waitcnt vmcnt(" #n ")" ::: "memory")
#define G8_WAIT_L(n) asm volatile("s_waitcnt lgkmcnt(" #n ")" ::: "memory")
#define G8_BAR __builtin_amdgcn_s_barrier()
#define G8_SCHED __builtin_amdgcn_sched_barrier(0)
    Unit cur, nxt, nn; int ui = 0;
    if (!S.next(0, cur)) return;
    f32x4 acc[2][2][4][2];
#pragma unroll
    for (int a = 0; a < 2; ++a)
#pragma unroll
        for (int b = 0; b < 2; ++b)
#pragma unroll
            for (int m = 0; m < 4; ++m)
#pragma unroll
                for (int n = 0; n < 2; ++n) acc[a][b][m][n] = (f32x4){0.f, 0.f, 0.f, 0.f};
    bf16x8 At[4][2], B0[2][2], B1[2][2];
    unsigned cv[2][2], nv[2][2], fv[2][2];
    G8_AOFF(cv, cur);
    bool has_next = S.next(1, nxt);
    if (has_next) { G8_AOFF(nv, nxt); } else {
#pragma unroll
        for (int h = 0; h < 2; ++h)
#pragma unroll
            for (int i = 0; i < 2; ++i) nv[h][i] = cv[h][i]; }
    const char* cB = cur.bt; const char* nB = has_next ? nxt.bt : cB;
    G8_STAGE(G8_SB(0, 0), cB, voffB); G8_STAGE(G8_SB(0, 1), cB + hstep, voffB); G8_STAGE(G8_SA(0, 0), Ab, cv[0]); G8_STAGE(G8_SA(0, 1), Ab, cv[1]);
    if (wr == 1) G8_BAR;
    G8_WAIT_V(2); G8_BAR;
    G8_STAGE(G8_SB(1, 0), cB + kstep, voffB); G8_STAGE(G8_SA(1, 0), Ab + kstep, cv[0]); G8_STAGE(G8_SB(1, 1), cB + hstep + kstep, voffB);
    G8_WAIT_V(6); G8_BAR;
    for (;;) {
        for (int t = 0; t < nt; t += 2) {
            const bool last = (t == nt - 2);
            const size_t k1 = (size_t)(t + 1) * kstep;
            const size_t k2 = last ? 0 : (size_t)(t + 2) * kstep;
            const char* b2 = last ? nB : cB + (size_t)(t + 2) * kstep; const char* b3 = b2 + kstep;
            unsigned sv[2][2];
#pragma unroll
            for (int h = 0; h < 2; ++h)
#pragma unroll
                for (int i = 0; i < 2; ++i) sv[h][i] = last ? nv[h][i] : cv[h][i];
            G8_LDB(B0, 0, 0); G8_LDB(B1, 0, 1); G8_SCHED; G8_LDA(At, 0, 0); G8_STAGE(G8_SA(1, 1), Ab + k1, cv[1]);
            G8_WAIT_V(8); G8_WAIT_L(0); G8_BAR; G8_MMA(0, 0, At, B0); G8_MMA(0, 1, At, B1); G8_BAR; G8_SCHED;
            G8_LDA(At, 0, 1); G8_STAGE(G8_SB(0, 0), b2, voffB); G8_STAGE(G8_SB(0, 1), b2 + hstep, voffB); G8_STAGE(G8_SA(0, 0), Ab + k2, sv[0]);
            G8_WAIT_V(8); G8_WAIT_L(0); G8_BAR; G8_MMA(1, 0, At, B0); G8_MMA(1, 1, At, B1); G8_BAR; G8_SCHED;
            G8_LDB(B0, 1, 0); G8_LDB(B1, 1, 1); G8_SCHED; G8_LDA(At, 1, 0); G8_STAGE(G8_SA(0, 1), Ab + k2, sv[1]);
            G8_WAIT_V(8); G8_WAIT_L(0); G8_BAR; G8_MMA(0, 0, At, B0); G8_MMA(0, 1, At, B1); G8_BAR; G8_SCHED;
            G8_LDA(At, 1, 1); G8_STAGE(G8_SB(1, 0), b3, voffB); G8_STAGE(G8_SB(1, 1), b3 + hstep, voffB); G8_STAGE(G8_SA(1, 0), Ab + k2 + kstep, sv[0]);
            G8_WAIT_V(8); G8_WAIT_L(0); G8_BAR; G8_MMA(1, 0, At, B0); G8_MMA(1, 1, At, B1); G8_BAR; G8_SCHED;
        }
        if (wr == 0) G8_BAR;
        const bool has_nn = has_next && S.next(ui + 2, nn);
        if (has_nn) { G8_AOFF(fv, nn); }
        E(acc, cur, wr, wc, fr, fq);
        if (!has_next) break;
#pragma unroll
        for (int a = 0; a < 2; ++a)
#pragma unroll
            for (int b = 0; b < 2; ++b)
#pragma unroll
                for (int m = 0; m < 4; ++m)
#pragma unroll
                    for (int n = 0; n < 2; ++n) acc[a][b][m][n] = (f32x4){0.f, 0.f, 0.f, 0.f};
        cur = nxt; cB = nB; ++ui;
#pragma unroll
        for (int h = 0; h < 2; ++h)
#pragma unroll
            for (int i = 0; i < 2; ++i) { cv[h][i] = nv[h][i]; nv[h][i] = has_nn ? fv[h][i] : nv[h][i]; }
        has_next = has_nn; if (has_nn) { nxt = nn; nB = nn.bt; }
        if (wr == 1) G8_BAR;
    }
    G8_WAIT_V(0);
    G8_BAR;
#undef G8_AOFF
#undef G8_SA
#undef G8_SB
#undef G8_STAGE
#undef G8_LDA
#undef G8_LDB
#undef G8_MMA
#undef G8_WAIT_V
#undef G8_WAIT_L
#undef G8_BAR
#undef G8_SCHED
}

struct MoeSched {
    int G, vcu, nct, K;
    const G8_LAS int* tp; const G8_LAS int* cnt;
    const int* list;
    const char* Bt; size_t bt_estride;
    DEVI bool next(int i, Unit& u) const {
        const int L = i * G + vcu, total = tp[32] * nct;
        if (L >= total) return false;
        const int rtg = L / nct, ct = L - rtg * nct;
        int e = 0;
#pragma unroll
        for (int k = 1; k < 32; ++k) e += (rtg >= tp[k]) ? 1 : 0;
        const int rt = rtg - tp[e];
        u.e = e; u.orow0 = rtg * 256; u.ocol0 = ct * 256;
        u.bt = Bt + (size_t)e * bt_estride + (size_t)ct * 256 * K * 2;
        if (list) { u.alist = list + e * NTOK + rt * 256; u.acnt = min(256, cnt[e] - rt * 256); u.arow0 = 0; }
        else { u.alist = nullptr; u.acnt = 0; u.arow0 = rtg * 256; }
        return true;
    }
};
}

DEVI unsigned f2bf(float f) { unsigned u = __builtin_bit_cast(unsigned, f); return (u + 0x7fffu + ((u >> 16) & 1u)) >> 16; }
DEVI unsigned pk2(float lo, float hi) { return f2bf(lo) | (f2bf(hi) << 16); }
typedef unsigned v4u __attribute__((ext_vector_type(4)));
DEVI void transpose_item(const float* W, int K, int N, unsigned short* WT, __attribute__((address_space(3))) float* scr, int item, int lane) {
    const int nblk = N / 32, kb = item / nblk, nb = item % nblk, k0 = 64 * kb, n0 = 32 * nb;
#pragma unroll 8
    for (int i = 0; i < 32; ++i) { const int kk = 2 * i + (lane >> 5); scr[kk * 33 + (lane & 31)] = W[(size_t)(k0 + kk) * N + n0 + (lane & 31)]; }
    asm volatile("s_waitcnt lgkmcnt(0)" ::: "memory");
    const int c = lane & 7;
#pragma unroll
    for (int j = 0; j < 4; ++j) { const int n = (lane >> 3) + 8 * j; const __attribute__((address_space(3))) float* s = scr + (8 * c) * 33 + n;
        v4u o; o.x = pk2(s[0 * 33], s[1 * 33]); o.y = pk2(s[2 * 33], s[3 * 33]); o.z = pk2(s[4 * 33], s[5 * 33]); o.w = pk2(s[6 * 33], s[7 * 33]);
        *(v4u*)(WT + (size_t)(n0 + n) * K + k0 + 8 * c) = o; }
    asm volatile("s_waitcnt lgkmcnt(0)" ::: "memory");
}

__global__ void __launch_bounds__(512, 2) mk_fwd(Params p) {
    extern __shared__ __attribute__((aligned(16))) unsigned char lds[];
    cg::grid_group grid = cg::this_grid();
    const int tid = threadIdx.x, lane = tid & 63, wave = __builtin_amdgcn_readfirstlane(tid >> 6);
    const int gw = blockIdx.x * 8 + wave, NGW = gridDim.x * 8;
    const int gtid = blockIdx.x * 512 + tid, NGT = gridDim.x * 512;
    unsigned char* ws = p.ws;
    unsigned* ctl = (unsigned*)(ws + WS_CTL);
    float* U = (float*)(ws + WS_U); float* PROJ = (float*)(ws + WS_BIG);
    float* XBC = (float*)(ws + WS_XBC); float* MIX = (float*)(ws + WS_MIX); float* H1 = (float*)(ws + WS_H1); float* H2 = (float*)(ws + WS_H2);
    float* YSSM = (float*)(ws + WS_YSSM); float* QC = (float*)(ws + WS_QC); float* OC = (float*)(ws + WS_OC);
    unsigned short* ACTB = (unsigned short*)(ws + WS_ACTB); unsigned short* YB = (unsigned short*)(ws + WS_YB); unsigned short* XN = (unsigned short*)(ws + WS_XN);
    unsigned short* W1T = (unsigned short*)(ws + WS_W1T); unsigned short* W2T = (unsigned short*)(ws + WS_W2T); int* SLOT = (int*)(ws + WS_SLOT);
    __attribute__((address_space(3))) unsigned char* ldsp = (__attribute__((address_space(3))) unsigned char*)lds;
    __attribute__((address_space(3))) int* TP = (__attribute__((address_space(3))) int*)(ldsp + 131072); __attribute__((address_space(3))) int* CNTL = TP + 64;
    float* DT = (float*)(ws + WS_DT); float* KVM = (float*)(ws + WS_KVM); float* MEMN = (float*)(ws + WS_MEMN); float* GATE = (float*)(ws + WS_GATE);
    int* LIST = (int*)(ws + WS_LIST);
    const float* x = p.in[I_X];

    for (int r = gw; r < NTOK + NMEM; r += NGW) {
        if (r < NTOK) rms_row(x + (size_t)r * DM, p.in[I_GMIX], U + (size_t)r * DM, lane);
        else rms_row(p.in[I_MEM] + (size_t)(r - NTOK) * DM, p.in[I_GMEM], MEMN + (size_t)(r - NTOK) * DM, lane);
    }
    {
        __attribute__((address_space(3))) float* scr = (__attribute__((address_space(3))) float*)(ldsp + wave * 16384);
        constexpr int IT1 = (1024 / 64) * (2048 / 32), IT2 = (1024 / 64) * (1024 / 32);
        for (int it = gw; it < NEXP * (IT1 + IT2); it += NGW) {
            if (it < NEXP * IT1) { const int e = it / IT1, r = it - e * IT1; transpose_item(p.in[I_W1] + (size_t)e * 1024 * 2048, 1024, 2048, W1T + (size_t)e * 2048 * 1024, scr, r, lane); }
            else { const int i2 = it - NEXP * IT1, e = i2 / IT2, r = i2 - e * IT2; transpose_item(p.in[I_W2] + (size_t)e * 1024 * 1024, 1024, 1024, W2T + (size_t)e * 1024 * 1024, scr, r, lane); }
        }
    }
    grid.sync();
    ngemm_dense(U, DM, p.in[I_WIN], IN_COLS, NTOK, IN_COLS, DM, EpiStore{PROJ, IN_COLS});
    ngemm_dense(MEMN, DM, p.in[I_WKV], 1024, NMEM, 1024, DM, EpiStore{KVM, 1024});
    grid.sync();
    for (int idx = gtid; idx < NTOK * 256; idx += NGT) {
        const int row = idx >> 8, c4 = (idx & 255) * 4, t = row & (SEQ - 1);
        float4 a = ld4(p.in[I_CONVB] + c4);
#pragma unroll
        for (int k = 0; k < 4; ++k) if (t - 3 + k >= 0) {
            const float4 w = ld4(p.in[I_CONVW] + k * CONVCH + c4), v = ld4(PROJ + (size_t)(row - 3 + k) * IN_COLS + COL_XBC + c4);
            a.x += w.x * v.x; a.y += w.y * v.y; a.z += w.z * v.z; a.w += w.w * v.w; }
        st4(XBC + (size_t)row * 1024 + c4, make_float4(silu_f(a.x), silu_f(a.y), silu_f(a.z), silu_f(a.w)));
    }
    for (int idx = gtid; idx < NTOK * 8; idx += NGT) {
        const int row = idx >> 3, h = idx & 7;
        DT[idx] = softplus_f(PROJ[(size_t)row * IN_COLS + COL_DT + h] + p.in[I_DTB][h]);
    }
    grid.sync();
    for (int item = gw; item < BATCH * SSM_H * SSM_P; item += NGW) {
        const int b = item >> 9, h = (item >> 6) & 7, pp = item & 63, g = h >> 2;
        const float ah = -__expf(p.in[I_ALOG][h]), dsk = p.in[I_DSKIP][h];
        float h0 = 0.f, h1 = 0.f;
        const float* xb = XBC + (size_t)b * SEQ * 1024; const float* dtb = DT + (size_t)b * SEQ * 8 + h;
#pragma unroll 4
        for (int t = 0; t < SEQ; ++t) {
            const float* xr = xb + (size_t)t * 1024;
            const float dtv = dtb[(size_t)t * 8], xv = xr[h * 64 + pp];
            const float B0 = xr[512 + g * 128 + lane], B1 = xr[512 + g * 128 + 64 + lane];
            const float C0 = xr[768 + g * 128 + lane], C1 = xr[768 + g * 128 + 64 + lane];
            const float dec = __expf(dtv * ah), dx = dtv * xv;
            h0 = h0 * dec + dx * B0; h1 = h1 * dec + dx * B1;
            const float y = wave_sum(C0 * h0 + C1 * h1) + dsk * xv;
            if (lane == 0) YSSM[(size_t)(b * SEQ + t) * 512 + h * 64 + pp] = y;
        }
    }
    for (int item = gw; item < NTOK * 8; item += NGW) {
        const int row = item >> 3, hq = item & 7, kv = hq >> 2, t = row & (SEQ - 1);
        const float* bq = p.in[I_BQKV];
        const float qv = PROJ[(size_t)row * IN_COLS + COL_Q + hq * 64 + lane] + bq[hq * 64 + lane];
        float s0 = 0.f, s1 = 0.f;
        const int j0 = lane, j1 = lane + 64; const bool v0 = (t - j0) >= 0, v1 = (t - j1) >= 0;
        const float* k0p = PROJ + (size_t)(row - (v0 ? j0 : 0)) * IN_COLS + COL_K + kv * 64;
        const float* k1p = PROJ + (size_t)(row - (v1 ? j1 : 0)) * IN_COLS + COL_K + kv * 64;
        for (int d = 0; d < 64; ++d) {
            const float qd = __shfl(qv, d), kb = bq[512 + kv * 64 + d];
            s0 += qd * (k0p[d] + kb); s1 += qd * (k1p[d] + kb);
        }
        int bk0 = j0 < 16 ? j0 : min(31, 16 + (int)(log2f((float)j0 * 0.0625f) * (16.f / 3.f)));
        int bk1 = min(31, 16 + (int)(log2f((float)j1 * 0.0625f) * (16.f / 3.f)));
        s0 = v0 ? s0 * 0.125f + p.in[I_RELB][bk0 * 8 + hq] : -INFINITY;
        s1 = v1 ? s1 * 0.125f + p.in[I_RELB][bk1 * 8 + hq] : -INFINITY;
        const float sink = p.in[I_SINK][hq];
        const float m = fmaxf(wave_max(fmaxf(s0, s1)), sink);
        const float e0 = v0 ? __expf(s0 - m) : 0.f, e1 = v1 ? __expf(s1 - m) : 0.f;
        const float den = wave_sum(e0 + e1) + __expf(sink - m);
        const float p0 = e0 / den, p1 = e1 / den;
        float o = 0.f; const float vb = bq[640 + kv * 64 + lane];
        const int jmax = min(127, t);
        for (int j = 0; j <= jmax; ++j) {
            const float pj = __shfl(j < 64 ? p0 : p1, j & 63);
            o += pj * (PROJ[(size_t)(row - j) * IN_COLS + COL_V + kv * 64 + lane] + vb);
        }
        MIX[(size_t)row * 1024 + 512 + hq * 64 + lane] = o;
    }
    grid.sync();
    for (int row = gw; row < NTOK; row += NGW) {
        const int c = lane * 8;
        float v[8]; float s = 0.f;
#pragma unroll
        for (int i = 0; i < 8; ++i) { v[i] = YSSM[(size_t)row * 512 + c + i] * silu_f(PROJ[(size_t)row * IN_COLS + COL_Z + c + i]); s += v[i] * v[i]; }
#pragma unroll
        for (int o = 16; o > 0; o >>= 1) s += __shfl_xor(s, o);
        const float rs = rsqrtf(s * (1.f / 256.f) + EPS);
#pragma unroll
        for (int i = 0; i < 8; ++i) MIX[(size_t)row * 1024 + c + i] = v[i] * rs * p.in[I_GSSM][c + i];
    }
    grid.sync();
    ngemm_dense(MIX, 1024, p.in[I_WOUT], 1024, NTOK, 1024, 1024, EpiBiasRes{H1, p.in[I_BOUT], x});
    grid.sync();
    for (int r = gw; r < NTOK; r += NGW) rms_row(H1 + (size_t)r * DM, p.in[I_GCROSS], U + (size_t)r * DM, lane);
    grid.sync();
    ngemm_dense(U, DM, p.in[I_WQ], 512, NTOK, 512, DM, EpiStore{QC, 512});
    grid.sync();
    for (int item = gw; item < NTOK * 4; item += NGW) {
        const int row = item >> 2, hd = item & 3, b = row >> 13;
        const float q0 = QC[(size_t)row * 512 + hd * 128 + lane], q1 = QC[(size_t)row * 512 + hd * 128 + 64 + lane];
        const float* kb = KVM + (size_t)b * MEMLEN * 1024 + hd * 128;
        float s[4] = {0.f, 0.f, 0.f, 0.f};
        for (int d = 0; d < 128; ++d) {
            const float qd = __shfl(d < 64 ? q0 : q1, d & 63);
#pragma unroll
            for (int i = 0; i < 4; ++i) s[i] += qd * kb[(size_t)(lane + 64 * i) * 1024 + d];
        }
        const float sc = 0.08838834764831845f;
        float m = -INFINITY;
#pragma unroll
        for (int i = 0; i < 4; ++i) { s[i] *= sc; m = fmaxf(m, s[i]); }
        m = wave_max(m);
        float den = 0.f;
#pragma unroll
        for (int i = 0; i < 4; ++i) { s[i] = __expf(s[i] - m); den += s[i]; }
        den = wave_sum(den);
        const float inv = 1.f / den;
        float o0 = 0.f, o1 = 0.f; const float* vb = kb + 512;
#pragma unroll
        for (int i = 0; i < 4; ++i)
            for (int jj = 0; jj < 64; ++jj) {
                const float pj = __shfl(s[i], jj) * inv; const float* vr = vb + (size_t)(jj + 64 * i) * 1024;
                o0 += pj * vr[lane]; o1 += pj * vr[64 + lane];
            }
        OC[(size_t)row * 512 + hd * 128 + lane] = o0; OC[(size_t)row * 512 + hd * 128 + 64 + lane] = o1;
    }
    grid.sync();
    ngemm_dense(OC, 512, p.in[I_WO], 1024, NTOK, 1024, 512, EpiBiasRes{H2, nullptr, H1});
    grid.sync();
    for (int row = gw; row < NTOK; row += NGW) {
        float4 un[4];
        {
            float s = 0.f;
#pragma unroll
            for (int j = 0; j < 4; ++j) { un[j] = ld4(H2 + (size_t)row * DM + 4 * (lane + 64 * j)); s += un[j].x * un[j].x + un[j].y * un[j].y + un[j].z * un[j].z + un[j].w * un[j].w; }
            const float rs = rsqrtf(wave_sum(s) * (1.f / 1024.f) + EPS);
#pragma unroll
            for (int j = 0; j < 4; ++j) { const float4 gv = ld4(p.in[I_GFFN] + 4 * (lane + 64 * j));
                un[j] = make_float4(un[j].x * rs * gv.x, un[j].y * rs * gv.y, un[j].z * rs * gv.z, un[j].w * rs * gv.w);
                st4(U + (size_t)row * DM + 4 * (lane + 64 * j), un[j]);
                *(uint2*)(XN + (size_t)row * DM + 4 * (lane + 64 * j)) = make_uint2(pk2(un[j].x, un[j].y), pk2(un[j].z, un[j].w)); }
        }
        float l[32];
#pragma unroll
        for (int e = 0; e < 32; ++e) l[e] = 0.f;
#pragma unroll
        for (int j = 0; j < 4; ++j) {
            const float uu[4] = {un[j].x, un[j].y, un[j].z, un[j].w};
#pragma unroll
            for (int c = 0; c < 4; ++c) {
                const float* wr = p.in[I_WR] + (size_t)(4 * (lane + 64 * j) + c) * 32;
#pragma unroll
                for (int e4 = 0; e4 < 8; ++e4) { const float4 w = ld4(wr + 4 * e4);
                    l[4 * e4] += uu[c] * w.x; l[4 * e4 + 1] += uu[c] * w.y; l[4 * e4 + 2] += uu[c] * w.z; l[4 * e4 + 3] += uu[c] * w.w; }
            }
        }
#pragma unroll
        for (int e = 0; e < 32; ++e) l[e] = wave_sum(l[e]) + p.in[I_BR][e];
        int sel[4]; float val[4];
#pragma unroll
        for (int k = 0; k < 4; ++k) {
            float best = -INFINITY; int bi = 0;
#pragma unroll
            for (int e = 0; e < 32; ++e) if (l[e] > best) { best = l[e]; bi = e; }
            sel[k] = bi; val[k] = best;
#pragma unroll
            for (int e = 0; e < 32; ++e) l[e] = (e == bi) ? -INFINITY : l[e];
        }
        float ex[4], den = 0.f;
#pragma unroll
        for (int k = 0; k < 4; ++k) { ex[k] = __expf(val[k] - val[0]); den += ex[k]; }
        if (lane == 0) {
#pragma unroll
            for (int k = 0; k < 4; ++k) {
                const int a = row * 4 + k;
                const unsigned slot = atomicAdd(&ctl[CW_CNT + sel[k]], 1u);
                LIST[sel[k] * NTOK + slot] = a;
                SLOT[a] = (sel[k] << 16) | (int)slot;
                GATE[a] = ex[k] / den;
            }
        }
    }
    grid.sync();
    if (tid < 64) {
        const int c = tid < 32 ? (int)__hip_atomic_load(&ctl[CW_CNT + (tid & 31)], __ATOMIC_RELAXED, __HIP_MEMORY_SCOPE_AGENT) : 0;
        int tl = (c + 255) >> 8, incl = tl;
#pragma unroll
        for (int o = 1; o < 32; o <<= 1) { const int v = __shfl_up(incl, o); if ((tid & 63) >= o) incl += v; }
        if (tid < 32) { CNTL[tid] = c; TP[tid] = incl - tl; }
        if (tid == 31) TP[32] = incl;
    }
    __syncthreads();
    const int vcu = (gridDim.x % 8 == 0) ? (blockIdx.x % 8) * (gridDim.x / 8) + blockIdx.x / 8 : blockIdx.x;
    {
        g8::MoeSched S{(int)gridDim.x, vcu, 8, 1024, TP, CNTL, LIST, (const char*)W1T, (size_t)2048 * 1024 * 2};
        g8::EpiSwiglu E{ACTB, p.in[I_B1]};
        g8::gemm_phase(ldsp, XN, 1024, 2, S, E);
    }
    grid.sync();
    {
        g8::MoeSched S{(int)gridDim.x, vcu, 4, 1024, TP, CNTL, nullptr, (const char*)W2T, (size_t)1024 * 1024 * 2};
        g8::EpiBf16 E{YB, 1024, p.in[I_B2], 1024};
        g8::gemm_phase(ldsp, ACTB, 1024, 0, S, E);
    }
    grid.sync();
    for (int row = gw; row < NTOK; row += NGW) {
        float4 v[4]; float s = 0.f;
        int yrow[4]; float gk[4];
#pragma unroll
        for (int k = 0; k < 4; ++k) { const int sl = SLOT[row * 4 + k]; yrow[k] = TP[sl >> 16] * 256 + (sl & 0xffff); gk[k] = GATE[row * 4 + k]; }
#pragma unroll
        for (int j = 0; j < 4; ++j) {
            const int c = 4 * (lane + 64 * j);
            float4 a = ld4(H2 + (size_t)row * DM + c);
#pragma unroll
            for (int k = 0; k < 4; ++k) { const uint2 y = *(const uint2*)(YB + (size_t)yrow[k] * 1024 + c);
                a.x += gk[k] * __uint_as_float(y.x << 16); a.y += gk[k] * __uint_as_float(y.x & 0xffff0000u);
                a.z += gk[k] * __uint_as_float(y.y << 16); a.w += gk[k] * __uint_as_float(y.y & 0xffff0000u); }
            v[j] = a; s += a.x * a.x + a.y * a.y + a.z * a.z + a.w * a.w;
        }
        const float rs = rsqrtf(wave_sum(s) * (1.f / 1024.f) + EPS);
#pragma unroll
        for (int j = 0; j < 4; ++j) { const int c = 4 * (lane + 64 * j); const float4 gv = ld4(p.in[I_GFIN] + c);
            st4(p.out + (size_t)row * DM + c, make_float4(v[j].x * rs * gv.x, v[j].y * rs * gv.y, v[j].z * rs * gv.z, v[j].w * rs * gv.w)); }
    }
}

constexpr int LDS_BYTES = 147456;

extern "C" void kernel_launch(void* const* d_in, const int* in_sizes, int n_in, void* d_out, int out_size, void* d_ws, size_t ws_size, hipStream_t stream) {
    static int grid = 0;
    if (grid == 0) {
        if (n_in != N_IN || ws_size < WS_END) { fprintf(stderr, "kernel_launch: unexpected n_in %d / ws_size %zu (need %zu)\n", n_in, ws_size, (size_t)WS_END); grid = -1; return; }
        int dev = 0, cus = 0, per_cu = 0;
        (void)hipGetDevice(&dev);
        (void)hipDeviceGetAttribute(&cus, hipDeviceAttributeMultiprocessorCount, dev);
        (void)hipFuncSetAttribute((const void*)mk_fwd, hipFuncAttributeMaxDynamicSharedMemorySize, LDS_BYTES);
        (void)hipOccupancyMaxActiveBlocksPerMultiprocessor(&per_cu, (const void*)mk_fwd, 512, LDS_BYTES);
        if (per_cu < 1) { fprintf(stderr, "kernel_launch: occupancy query says %d blocks per CU\n", per_cu); per_cu = 1; }
        if (per_cu > 1) per_cu = 1;
        grid = cus * per_cu;
    }
    if (grid < 0) return;
    (void)hipMemsetAsync((char*)d_ws + WS_CTL, 0, 1 * MiB, stream);
    Params p{};
    for (int i = 0; i < N_IN; ++i) p.in[i] = (const float*)d_in[i];
    p.out = (float*)d_out; p.ws = (unsigned char*)d_ws;
    void* args[] = {&p};
    hipError_t e = hipLaunchCooperativeKernel((const void*)mk_fwd, dim3(grid), dim3(512), args, LDS_BYTES, stream);
    if (e != hipSuccess) fprintf(stderr, "cooperative launch failed: %s (grid %d)\n", hipGetErrorString(e), grid);
}
```

```cpp
#include <hip/hip_runtime.h>
#include <hip/hip_cooperative_groups.h>
#include <cstdio>
#include <cstdint>
namespace cg = cooperative_groups;

#define DEVI __device__ __forceinline__

constexpr int BATCH = 2, SEQ = 8192, NTOK = BATCH * SEQ, DM = 1024, MEMLEN = 256, NMEM = BATCH * MEMLEN;
constexpr int SSM_H = 8, SSM_P = 64, SSM_W = 512, SSM_N = 128, CONVCH = 1024;
constexpr int IN_COLS = 2312, COL_Z = 0, COL_XBC = 512, COL_DT = 1536, COL_Q = 1544, COL_K = 2056, COL_V = 2184;
constexpr int NEXP = 32, TOPK = 4, DFF = 1024, NASSIGN = NTOK * TOPK;
constexpr float EPS = 1e-5f;

enum { I_X = 0, I_MEM, I_GMIX, I_WIN, I_BQKV, I_CONVW, I_CONVB, I_DTB, I_ALOG, I_DSKIP, I_GSSM, I_SINK, I_RELB, I_WOUT, I_BOUT,
       I_GCROSS, I_GMEM, I_WQ, I_WKV, I_WO, I_GFFN, I_WR, I_BR, I_W1, I_B1, I_W2, I_B2, I_GFIN, N_IN };

constexpr size_t MiB = 1u << 20;
constexpr size_t WS_CTL = 0;
constexpr size_t WS_XN = 1 * MiB;
constexpr size_t WS_BIG = WS_XN + 34 * MiB;
constexpr size_t WS_XBC = WS_BIG + 144 * MiB;
constexpr size_t WS_MIXB = WS_XBC + 64 * MiB;
constexpr size_t WS_H1 = WS_MIXB + 32 * MiB;
constexpr size_t WS_H2 = WS_H1 + 64 * MiB;
constexpr size_t WS_YSSM = WS_H2 + 64 * MiB;
constexpr size_t WS_QCB = WS_YSSM + 32 * MiB;
constexpr size_t WS_OCB = WS_QCB + 16 * MiB;
constexpr size_t WS_ACTB = WS_OCB + 16 * MiB;
constexpr size_t WS_W1T = WS_ACTB + 144 * MiB;
constexpr size_t WS_W2T = WS_W1T + 128 * MiB;
constexpr size_t WS_WINT = WS_W2T + 64 * MiB;
constexpr size_t WS_WOUTT = WS_WINT + 5 * MiB;
constexpr size_t WS_WQT = WS_WOUTT + 2 * MiB;
constexpr size_t WS_WKVT = WS_WQT + 1 * MiB;
constexpr size_t WS_WOT = WS_WKVT + 2 * MiB;
constexpr size_t WS_SMALL = WS_WOT + 1 * MiB;
constexpr size_t WS_DT = WS_SMALL;
constexpr size_t WS_DTRAW = WS_DT + 512 * 1024;
constexpr size_t WS_KVMB = WS_DTRAW + 512 * 1024;
constexpr size_t WS_GATE = WS_KVMB + 1 * MiB;
constexpr size_t WS_SLOT = WS_GATE + 512 * 1024;
constexpr size_t WS_BIASP = WS_SLOT + 256 * 1024;
constexpr size_t WS_LIST = WS_GATE + 1 * MiB;
constexpr size_t WS_END = WS_LIST + 2 * MiB;
constexpr size_t WS_YB = WS_BIG;
constexpr int NROWS_MAX = NASSIGN + NEXP * 256;
constexpr int PJ = 2304, PJ_Z = 0, PJ_XBC = 512, PJ_Q = 1536, PJ_K = 2048, PJ_V = 2176;
constexpr int CW_CNT = 64;

struct Params { const float* in[N_IN]; float* out; unsigned char* ws; };

DEVI float wave_sum(float v) {
#pragma unroll
    for (int o = 32; o > 0; o >>= 1) v += __shfl_xor(v, o);
    return v;
}
DEVI float wave_max(float v) {
#pragma unroll
    for (int o = 32; o > 0; o >>= 1) v = fmaxf(v, __shfl_xor(v, o));
    return v;
}
DEVI float silu_f(float x) { return x / (1.f + __expf(-x)); }
DEVI float softplus_f(float x) { return fmaxf(x, 0.f) + log1pf(__expf(-fabsf(x))); }
DEVI float4 ld4(const float* p) { return *(const float4*)p; }
DEVI void st4(float* p, float4 v) { *(float4*)p = v; }

DEVI void rms_row(const float* xrow, const float* g, float* orow, int lane) {
    float4 v[4]; float s = 0.f;
#pragma unroll
    for (int j = 0; j < 4; ++j) { v[j] = ld4(xrow + 4 * (lane + 64 * j)); s += v[j].x * v[j].x + v[j].y * v[j].y + v[j].z * v[j].z + v[j].w * v[j].w; }
    const float rs = rsqrtf(wave_sum(s) * (1.f / 1024.f) + EPS);
#pragma unroll
    for (int j = 0; j < 4; ++j) { const float4 gv = ld4(g + 4 * (lane + 64 * j));
        st4(orow + 4 * (lane + 64 * j), make_float4(v[j].x * rs * gv.x, v[j].y * rs * gv.y, v[j].z * rs * gv.z, v[j].w * rs * gv.w)); }
}

struct TI { int tid, lane, wave, gw, gtid; };
DEVI TI fresh_ti() { int t = threadIdx.x; asm volatile("" : "+v"(t)); TI r; r.tid = t; r.lane = t & 63; r.wave = __builtin_amdgcn_readfirstlane(t >> 6); r.gw = blockIdx.x * 8 + r.wave; r.gtid = blockIdx.x * 512 + t; return r; }
#define PHASE_IDS() const TI ti_ = fresh_ti(); const int tid = ti_.tid, lane = ti_.lane, wave = ti_.wave, gw = ti_.gw, gtid = ti_.gtid; (void)tid; (void)lane; (void)wave; (void)gw; (void)gtid
DEVI float bf2f(unsigned short v) { return __uint_as_float((unsigned)v << 16); }
namespace g8 {
#define G8_LAS __attribute__((address_space(3)))
typedef unsigned short bf16_t;
typedef short bf16x8 __attribute__((ext_vector_type(8)));
typedef float f32x4 __attribute__((ext_vector_type(4)));
typedef float f32x2 __attribute__((ext_vector_type(2)));
typedef unsigned u32x4 __attribute__((ext_vector_type(4)));
typedef unsigned u32x2 __attribute__((ext_vector_type(2)));
constexpr int BM = 256, BK = 64, HALF = 128, HTB = HALF * BK * 2, STAGE_BYTES = 8 * HTB;

DEVI int lds_byte(int r, int c) { const int st = (r >> 4) * 2 + (c >> 5), rr = r & 15, cc = c & 31, ob = rr * 64 + cc * 2; return st * 1024 + (ob ^ (((ob >> 9) & 1) << 5)); }
DEVI void stage_rc(int b, int& R, int& C) { const int st = b / 1024, sb = b % 1024, swz = sb ^ (((sb >> 9) & 1) << 5); R = (st >> 1) * 16 + swz / 64; C = (st & 1) * 32 + (swz % 64) / 2; }
DEVI int perm32(int rho) { const int n = rho >> 4, i = rho & 15; return 8 * (i >> 2) + 4 * n + (i & 3); }
DEVI unsigned cvt_pk_bf16(float lo, float hi) { unsigned r; asm volatile("v_cvt_pk_bf16_f32 %0, %1, %2" : "=v"(r) : "v"(lo), "v"(hi)); return r; }

struct Unit {
    const int* alist;
    int acnt;
    int arow0;
    const char* bt;
    int orow0, ocol0;
    int e;
};


struct EpiSwiglu {
    static constexpr bool PERM = true;
    bf16_t* O; const float* bias;
    DEVI void operator()(const f32x4 (&acc)[2][2][4][2], const Unit& u, int wr, int wc, int fr, int fq) const {
        const int row0 = u.orow0 + wr * 64 + fr, col0 = u.ocol0 + wc * 32 + 8 * fq;
        const float* bp = bias + (size_t)u.e * 2048 + col0;
        f32x4 bv[2][2];
#pragma unroll
        for (int bj = 0; bj < 2; ++bj)
#pragma unroll
            for (int n = 0; n < 2; ++n) bv[bj][n] = *(const f32x4*)(bp + bj * HALF + 4 * n);
#pragma unroll
        for (int ai = 0; ai < 2; ++ai)
#pragma unroll
            for (int m = 0; m < 4; ++m) { bf16_t* rowp = O + (size_t)(row0 + ai * HALF + m * 16) * 1024 + (col0 >> 1);
#pragma unroll
                for (int bj = 0; bj < 2; ++bj) { const f32x4 v0 = acc[ai][bj][m][0] + bv[bj][0], v1 = acc[ai][bj][m][1] + bv[bj][1];
                    float o[4];
                    const float gl[4] = {v0[0], v0[2], v1[0], v1[2]}, li[4] = {v0[1], v0[3], v1[1], v1[3]};
#pragma unroll
                    for (int q = 0; q < 4; ++q) { const float xg = fminf(gl[q], 7.f), xl = fminf(fmaxf(li[q], -7.f), 7.f);
                        o[q] = xg * __builtin_amdgcn_rcpf(1.f + __expf(-1.702f * xg)) * (xl + 1.f); }
                    u32x2 w; w.x = cvt_pk_bf16(o[0], o[1]); w.y = cvt_pk_bf16(o[2], o[3]);
                    *(u32x2*)(rowp + bj * (HALF / 2)) = w; } }
    }
};
struct EpiBf16 {
    static constexpr bool PERM = true;
    bf16_t* O; int ldc; const float* bias; int bias_stride;
    DEVI void operator()(const f32x4 (&acc)[2][2][4][2], const Unit& u, int wr, int wc, int fr, int fq) const {
        const int row0 = u.orow0 + wr * 64 + fr, col0 = u.ocol0 + wc * 32 + 8 * fq;
        f32x4 bv[2][2];
#pragma unroll
        for (int bj = 0; bj < 2; ++bj)
#pragma unroll
            for (int n = 0; n < 2; ++n) bv[bj][n] = bias ? *(const f32x4*)(bias + (size_t)u.e * bias_stride + col0 + bj * HALF + 4 * n) : (f32x4){0.f, 0.f, 0.f, 0.f};
#pragma unroll
        for (int ai = 0; ai < 2; ++ai)
#pragma unroll
            for (int m = 0; m < 4; ++m) { bf16_t* rowp = O + (size_t)(row0 + ai * HALF + m * 16) * ldc + col0;
#pragma unroll
                for (int bj = 0; bj < 2; ++bj) { const f32x4 v0 = acc[ai][bj][m][0] + bv[bj][0], v1 = acc[ai][bj][m][1] + bv[bj][1];
                    u32x4 w; w.x = cvt_pk_bf16(v0[0], v0[1]); w.y = cvt_pk_bf16(v0[2], v0[3]); w.z = cvt_pk_bf16(v1[0], v1[1]); w.w = cvt_pk_bf16(v1[2], v1[3]);
                    *(u32x4*)(rowp + bj * HALF) = w; } }
    }
};

struct EpiBf16Dual {
    static constexpr bool PERM = true;
    bf16_t* O0; int ldc0; const float* bias0; bf16_t* O1; int ldc1;
    DEVI void operator()(const f32x4 (&acc)[2][2][4][2], const Unit& u, int wr, int wc, int fr, int fq) const {
        const int row0 = u.orow0 + wr * 64 + fr, col0 = u.ocol0 + wc * 32 + 8 * fq;
        bf16_t* O = u.e ? O1 : O0; const int ldc = u.e ? ldc1 : ldc0; const float* bias = u.e ? nullptr : bias0;
        f32x4 bv[2][2];
#pragma unroll
        for (int bj = 0; bj < 2; ++bj)
#pragma unroll
            for (int n = 0; n < 2; ++n) bv[bj][n] = bias ? *(const f32x4*)(bias + col0 + bj * HALF + 4 * n) : (f32x4){0.f, 0.f, 0.f, 0.f};
#pragma unroll
        for (int ai = 0; ai < 2; ++ai)
#pragma unroll
            for (int m = 0; m < 4; ++m) { bf16_t* rowp = O + (size_t)(row0 + ai * HALF + m * 16) * ldc + col0;
#pragma unroll
                for (int bj = 0; bj < 2; ++bj) { const f32x4 v0 = acc[ai][bj][m][0] + bv[bj][0], v1 = acc[ai][bj][m][1] + bv[bj][1];
                    u32x4 w; w.x = cvt_pk_bf16(v0[0], v0[1]); w.y = cvt_pk_bf16(v0[2], v0[3]); w.z = cvt_pk_bf16(v1[0], v1[1]); w.w = cvt_pk_bf16(v1[2], v1[3]);
                    *(u32x4*)(rowp + bj * HALF) = w; } }
    }
};
struct EpiF32Res {
    static constexpr bool PERM = false;
    float* C; const float* bias; const float* res;
    DEVI void operator()(const f32x4 (&acc)[2][2][4][2], const Unit& u, int wr, int wc, int fr, int fq) const {
        const int row0 = u.orow0 + wr * 64 + fr, col0 = u.ocol0 + wc * 32 + 4 * fq;
        f32x4 bv[2][2];
#pragma unroll
        for (int bj = 0; bj < 2; ++bj)
#pragma unroll
            for (int n = 0; n < 2; ++n) bv[bj][n] = bias ? *(const f32x4*)(bias + col0 + bj * HALF + n * 16) : (f32x4){0.f, 0.f, 0.f, 0.f};
#pragma unroll
        for (int ai = 0; ai < 2; ++ai)
#pragma unroll
            for (int m = 0; m < 4; ++m) { const size_t off = (size_t)(row0 + ai * HALF + m * 16) * 1024 + col0;
#pragma unroll
                for (int bj = 0; bj < 2; ++bj)
#pragma unroll
                    for (int n = 0; n < 2; ++n) *(f32x4*)(C + off + bj * HALF + n * 16) = acc[ai][bj][m][n] + bv[bj][n] + *(const f32x4*)(res + off + bj * HALF + n * 16);
                if (m & 1) asm volatile("" ::: "memory"); }
    }
};

template <class Epi, class Sched>
DEVI void gemm_phase(G8_LAS unsigned char* lds, const bf16_t* A, int K, int ashift, const Sched& S, const Epi& E) {
    int tid = threadIdx.x; asm volatile("" : "+v"(tid));
    const int wid = __builtin_amdgcn_readfirstlane(tid >> 6), lane = tid & 63, wr = wid >> 2, wc = wid & 3, fr = lane & 15, fq = lane >> 4;
    const int nt = K / BK;
    int Rl[2], Cl[2]; unsigned voffB[2];
#pragma unroll
    for (int i = 0; i < 2; ++i) { stage_rc(tid * 16 + i * 8192, Rl[i], Cl[i]); const int Rb = Epi::PERM ? ((Rl[i] & ~31) + perm32(Rl[i] & 31)) : Rl[i];
        voffB[i] = (unsigned)(Rb * K + Cl[i]) * 2u; }
    const size_t kstep = (size_t)(BK * 2);
    const size_t hstep = (size_t)HALF * K * 2;
    const unsigned ldsw = (unsigned)wid * 1024u;
    const int aoff = lds_byte(wr * 64 + fr, fq * 8), boff = lds_byte(wc * 32 + fr, fq * 8);
    const char* Ab = (const char*)A;
#define G8_AOFF(dst, u) do { _Pragma("unroll") for (int _h = 0; _h < 2; ++_h) _Pragma("unroll") for (int _i = 0; _i < 2; ++_i) { const int _row = _h * HALF + Rl[_i]; int _ar; \
        if ((u).alist) { const int _idx = _row < (u).acnt ? _row : 0; _ar = (u).alist[_idx] >> ashift; } else _ar = (u).arow0 + _row; \
        dst[_h][_i] = (unsigned)(_ar * K + Cl[_i]) * 2u; } } while (0)
#define G8_SA(b, h) (((b) * 2 + (h)) * HTB)
#define G8_SB(b, h) ((4 + (b) * 2 + (h)) * HTB)
#define G8_STAGE(bufoff, gbase, voff) do { _Pragma("unroll") for (int _i = 0; _i < 2; ++_i) \
        __builtin_amdgcn_global_load_lds((const unsigned*)((const char*)(gbase) + (voff)[_i]), (G8_LAS unsigned*)(lds + (bufoff) + ldsw + _i * 8192), 16, 0, 0); } while (0)
#define G8_LDA(dst, b, h) do { _Pragma("unroll") for (int m = 0; m < 4; ++m) _Pragma("unroll") for (int k = 0; k < 2; ++k) dst[m][k] = *(const G8_LAS bf16x8*)(lds + G8_SA(b, h) + aoff + m * 2048 + k * 1024); } while (0)
#define G8_LDB(dst, b, h) do { _Pragma("unroll") for (int n = 0; n < 2; ++n) _Pragma("unroll") for (int k = 0; k < 2; ++k) dst[n][k] = *(const G8_LAS bf16x8*)(lds + G8_SB(b, h) + boff + n * 2048 + k * 1024); } while (0)
#define G8_MMA(ai, bj, At, Bt) do { __builtin_amdgcn_s_setprio(1); _Pragma("unroll") for (int m = 0; m < 4; ++m) _Pragma("unroll") for (int n = 0; n < 2; ++n) _Pragma("unroll") for (int k = 0; k < 2; ++k) \
        acc[ai][bj][m][n] = __builtin_amdgcn_mfma_f32_16x16x32_bf16(Bt[n][k], At[m][k], acc[ai][bj][m][n], 0, 0, 0); __builtin_amdgcn_s_setprio(0); } while (0)
#define G8_WAIT_V(n) asm volatile("s_waitcnt vmcnt(" #n ")" ::: "memory")
#define G8_WAIT_L(n) asm volatile("s_waitcnt lgkmcnt(" #n ")" ::: "memory")
#define G8_BAR __builtin_amdgcn_s_barrier()
#define G8_SCHED __builtin_amdgcn_sched_barrier(0)
    Unit cur, nxt, nn; int ui = 0;
    if (!S.next(0, cur)) return;
    f32x4 acc[2][2][4][2];
#pragma unroll
    for (int a = 0; a < 2; ++a)
#pragma unroll
        for (int b = 0; b < 2; ++b)
#pragma unroll
            for (int m = 0; m < 4; ++m)
#pragma unroll
                for (int n = 0; n < 2; ++n) acc[a][b][m][n] = (f32x4){0.f, 0.f, 0.f, 0.f};
    bf16x8 At[4][2], B0[2][2], B1[2][2];
    unsigned cv[2][2], nv[2][2], fv[2][2];
    G8_AOFF(cv, cur);
    bool has_next = S.next(1, nxt);
    if (has_next) { G8_AOFF(nv, nxt); } else {
#pragma unroll
        for (int h = 0; h < 2; ++h)
#pragma unroll
            for (int i = 0; i < 2; ++i) nv[h][i] = cv[h][i]; }
    const char* cB = cur.bt; const char* nB = has_next ? nxt.bt : cB;
    G8_STAGE(G8_SB(0, 0), cB, voffB); G8_STAGE(G8_SB(0, 1), cB + hstep, voffB); G8_STAGE(G8_SA(0, 0), Ab, cv[0]); G8_STAGE(G8_SA(0, 1), Ab, cv[1]);
    if (wr == 1) G8_BAR;
    G8_WAIT_V(2); G8_BAR;
    G8_STAGE(G8_SB(1, 0), cB + kstep, voffB); G8_STAGE(G8_SA(1, 0), Ab + kstep, cv[0]); G8_STAGE(G8_SB(1, 1), cB + hstep + kstep, voffB);
    G8_WAIT_V(6); G8_BAR;
    for (;;) {
#pragma unroll 1
        for (int t = 0; t < nt; t += 2) {
            const bool last = (t == nt - 2);
            const size_t k1 = (size_t)(t + 1) * kstep;
            const size_t k2 = last ? 0 : (size_t)(t + 2) * kstep;
            const char* b2 = last ? nB : cB + (size_t)(t + 2) * kstep; const char* b3 = b2 + kstep;
            unsigned sv[2][2];
#pragma unroll
            for (int h = 0; h < 2; ++h)
#pragma unroll
                for (int i = 0; i < 2; ++i) sv[h][i] = last ? nv[h][i] : cv[h][i];
            G8_LDB(B0, 0, 0); G8_LDB(B1, 0, 1); G8_SCHED; G8_LDA(At, 0, 0); G8_STAGE(G8_SA(1, 1), Ab + k1, cv[1]);
            G8_WAIT_V(8); G8_WAIT_L(0); G8_BAR; G8_MMA(0, 0, At, B0); G8_MMA(0, 1, At, B1); G8_BAR; G8_SCHED;
            G8_LDA(At, 0, 1); G8_STAGE(G8_SB(0, 0), b2, voffB); G8_STAGE(G8_SB(0, 1), b2 + hstep, voffB); G8_STAGE(G8_SA(0, 0), Ab + k2, sv[0]);
            G8_WAIT_V(8); G8_WAIT_L(0); G8_BAR; G8_MMA(1, 0, At, B0); G8_MMA(1, 1, At, B1); G8_BAR; G8_SCHED;
            G8_LDB(B0, 1, 0); G8_LDB(B1, 1, 1); G8_SCHED; G8_LDA(At, 1, 0); G8_STAGE(G8_SA(0, 1), Ab + k2, sv[1]);
            G8_WAIT_V(8); G8_WAIT_L(0); G8_BAR; G8_MMA(0, 0, At, B0); G8_MMA(0, 1, At, B1); G8_BAR; G8_SCHED;
            G8_LDA(At, 1, 1); G8_STAGE(G8_SB(1, 0), b3, voffB); G8_STAGE(G8_SB(1, 1), b3 + hstep, voffB); G8_STAGE(G8_SA(1, 0), Ab + k2 + kstep, sv[0]);
            G8_WAIT_V(8); G8_WAIT_L(0); G8_BAR; G8_MMA(1, 0, At, B0); G8_MMA(1, 1, At, B1); G8_BAR; G8_SCHED;
        }
        if (wr == 0) G8_BAR;
        const bool has_nn = has_next && S.next(ui + 2, nn);
        if (has_nn) { G8_AOFF(fv, nn); }
        E(acc, cur, wr, wc, fr, fq);
        if (!has_next) break;
#pragma unroll
        for (int a = 0; a < 2; ++a)
#pragma unroll
            for (int b = 0; b < 2; ++b)
#pragma unroll
                for (int m = 0; m < 4; ++m)
#pragma unroll
                    for (int n = 0; n < 2; ++n) acc[a][b][m][n] = (f32x4){0.f, 0.f, 0.f, 0.f};
        cur = nxt; cB = nB; ++ui;
#pragma unroll
        for (int h = 0; h < 2; ++h)
#pragma unroll
            for (int i = 0; i < 2; ++i) { cv[h][i] = nv[h][i]; nv[h][i] = has_nn ? fv[h][i] : nv[h][i]; }
        has_next = has_nn; if (has_nn) { nxt = nn; nB = nn.bt; }
        if (wr == 1) G8_BAR;
    }
    G8_WAIT_V(0);
    G8_BAR;
#undef G8_AOFF
#undef G8_SA
#undef G8_SB
#undef G8_STAGE
#undef G8_LDA
#undef G8_LDB
#undef G8_MMA
#undef G8_WAIT_V
#undef G8_WAIT_L
#undef G8_BAR
#undef G8_SCHED
}

struct MoeSched {
    int G, vcu, nct, K;
    const G8_LAS int* tp; const G8_LAS int* cnt;
    const int* list;
    const char* Bt; size_t bt_estride;
    DEVI bool next(int i, Unit& u) const {
        const int L = i * G + vcu, total = tp[32] * nct;
        if (L >= total) return false;
        const int rtg = L / nct, ct = L - rtg * nct;
        int e = 0;
#pragma unroll
        for (int k = 1; k < 32; ++k) e += (rtg >= tp[k]) ? 1 : 0;
        const int rt = rtg - tp[e];
        u.e = e; u.orow0 = rtg * 256; u.ocol0 = ct * 256;
        u.bt = Bt + (size_t)e * bt_estride + (size_t)ct * 256 * K * 2;
        if (list) { u.alist = list + e * NTOK + rt * 256; u.acnt = min(256, cnt[e] - rt * 256); u.arow0 = 0; }
        else { u.alist = nullptr; u.acnt = 0; u.arow0 = rtg * 256; }
        return true;
    }
};
struct DenseSched {
    int G, c, K, nM0, nN0; const char* Bt0; int nM1, nN1, arow1; const char* Bt1;
    DEVI bool next(int i, Unit& u) const {
        const int nwg = nM0 * nN0, L = i * G + c;
        u.alist = nullptr; u.acnt = 0;
        if (L < nwg) {
            int wgid = L; { const int q = nwg / 8, r = nwg % 8, xcd = wgid % 8, off = wgid / 8; wgid = (xcd < r ? xcd * (q + 1) : r * (q + 1) + (xcd - r) * q) + off; }
            const int nig = 8 * nN0, gid = wgid / nig, fm = gid * 8, gsz = (nM0 - fm) < 8 ? (nM0 - fm) : 8;
            const int pm = fm + ((wgid % nig) % gsz), pn = (wgid % nig) / gsz;
            u.e = 0; u.arow0 = pm * 256; u.orow0 = pm * 256; u.ocol0 = pn * 256; u.bt = Bt0 + (size_t)pn * 256 * K * 2; return true;
        }
        const int l = L - nwg; if (l >= nM1 * nN1) return false;
        const int pm = l / nN1, pn = l - pm * nN1;
        u.e = 1; u.arow0 = arow1 + pm * 256; u.orow0 = pm * 256; u.ocol0 = pn * 256; u.bt = Bt1 + (size_t)pn * 256 * K * 2; return true;
    }
};
}

DEVI unsigned f2bf(float f) { unsigned u = __builtin_bit_cast(unsigned, f); return (u + 0x7fffu + ((u >> 16) & 1u)) >> 16; }
DEVI unsigned pk2(float lo, float hi) { return f2bf(lo) | (f2bf(hi) << 16); }
typedef unsigned v4u __attribute__((ext_vector_type(4)));
DEVI void transpose_item(const float* W, int K, int N, unsigned short* WT, __attribute__((address_space(3))) float* scr, int item, int lane, int ncols = 0) {
    const int nblk = (ncols ? ncols : N) / 32, kb = item / nblk, nb = item % nblk, k0 = 64 * kb, n0 = 32 * nb;
#pragma unroll 8
    for (int i = 0; i < 32; ++i) { const int kk = 2 * i + (lane >> 5); scr[kk * 33 + (lane & 31)] = W[(size_t)(k0 + kk) * N + n0 + (lane & 31)]; }
    asm volatile("s_waitcnt lgkmcnt(0)" ::: "memory");
    const int c = lane & 7;
#pragma unroll
    for (int j = 0; j < 4; ++j) { const int n = (lane >> 3) + 8 * j; const __attribute__((address_space(3))) float* s = scr + (8 * c) * 33 + n;
        v4u o; o.x = pk2(s[0 * 33], s[1 * 33]); o.y = pk2(s[2 * 33], s[3 * 33]); o.z = pk2(s[4 * 33], s[5 * 33]); o.w = pk2(s[6 * 33], s[7 * 33]);
        *(v4u*)(WT + (size_t)(n0 + n) * K + k0 + 8 * c) = o; }
    asm volatile("s_waitcnt lgkmcnt(0)" ::: "memory");
}

#define LAS3 __attribute__((address_space(3)))
__global__ void __launch_bounds__(512, 2) mk_fwd(Params p) {
    extern __shared__ __attribute__((aligned(16))) unsigned char lds[];
    cg::grid_group grid = cg::this_grid();
    const int NGW = gridDim.x * 8, NGT = gridDim.x * 512, G = gridDim.x;
    unsigned char* ws = p.ws;
    unsigned* ctl = (unsigned*)(ws + WS_CTL);
    float* XBC = (float*)(ws + WS_XBC); float* H1 = (float*)(ws + WS_H1); float* H2 = (float*)(ws + WS_H2);
    float* YSSM = (float*)(ws + WS_YSSM); float* DT = (float*)(ws + WS_DT); float* DTRAW = (float*)(ws + WS_DTRAW); float* GATE = (float*)(ws + WS_GATE); float* BIASP = (float*)(ws + WS_BIASP);
    typedef unsigned short bf;
    bf* XN = (bf*)(ws + WS_XN); bf* PROJB = (bf*)(ws + WS_BIG); bf* YB = (bf*)(ws + WS_YB); bf* MIXB = (bf*)(ws + WS_MIXB); bf* QCB = (bf*)(ws + WS_QCB); bf* OCB = (bf*)(ws + WS_OCB);
    bf* ACTB = (bf*)(ws + WS_ACTB); bf* KVMB = (bf*)(ws + WS_KVMB);
    bf* W1T = (bf*)(ws + WS_W1T); bf* W2T = (bf*)(ws + WS_W2T); bf* WINT = (bf*)(ws + WS_WINT); bf* WOUTT = (bf*)(ws + WS_WOUTT); bf* WQT = (bf*)(ws + WS_WQT); bf* WKVT = (bf*)(ws + WS_WKVT); bf* WOT = (bf*)(ws + WS_WOT);
    int* LIST = (int*)(ws + WS_LIST); int* SLOT = (int*)(ws + WS_SLOT);
    LAS3 unsigned char* ldsp = (LAS3 unsigned char*)lds;
    LAS3 int* TP = (LAS3 int*)(ldsp + 131072); LAS3 int* CNTL = TP + 64;
    const float* x = p.in[I_X];
    const int vcu = (G % 8 == 0) ? (blockIdx.x % 8) * (G / 8) + blockIdx.x / 8 : blockIdx.x;

    {
        PHASE_IDS();
        LAS3 float* wdt = (LAS3 float*)ldsp;
        for (int i = tid; i < 1024 * 2; i += 512) { const int k = i >> 1, hh = (i & 1) * 4; { const float4 t4 = ld4(p.in[I_WIN] + (size_t)k * IN_COLS + COL_DT + hh); *(LAS3 g8::f32x4*)(wdt + k * 8 + hh) = (g8::f32x4){t4.x, t4.y, t4.z, t4.w}; } }
        for (int i = gtid; i < PJ; i += NGT) BIASP[i] = i < PJ_Q ? 0.f : p.in[I_BQKV][i - PJ_Q];
        __syncthreads();
        for (int r = gw; r < NTOK + NMEM; r += NGW) {
            const bool ismem = r >= NTOK;
            const float* xrow = ismem ? p.in[I_MEM] + (size_t)(r - NTOK) * DM : x + (size_t)r * DM;
            const float* g = ismem ? p.in[I_GMEM] : p.in[I_GMIX];
            float4 v[4]; float ss = 0.f;
#pragma unroll
            for (int j = 0; j < 4; ++j) { v[j] = ld4(xrow + 4 * (lane + 64 * j)); ss += v[j].x * v[j].x + v[j].y * v[j].y + v[j].z * v[j].z + v[j].w * v[j].w; }
            const float rs = rsqrtf(wave_sum(ss) * (1.f / 1024.f) + EPS);
            float dacc[8];
#pragma unroll
            for (int h = 0; h < 8; ++h) dacc[h] = 0.f;
#pragma unroll
            for (int j = 0; j < 4; ++j) { const int c = 4 * (lane + 64 * j); const float4 gv = ld4(g + c);
                v[j] = make_float4(v[j].x * rs * gv.x, v[j].y * rs * gv.y, v[j].z * rs * gv.z, v[j].w * rs * gv.w);
                *(uint2*)(XN + (size_t)r * DM + c) = make_uint2(pk2(v[j].x, v[j].y), pk2(v[j].z, v[j].w));
                if (!ismem) { const float uu[4] = {v[j].x, v[j].y, v[j].z, v[j].w};
#pragma unroll
                    for (int q = 0; q < 4; ++q) { const g8::f32x4 w0 = *(const LAS3 g8::f32x4*)(wdt + (c + q) * 8), w1 = *(const LAS3 g8::f32x4*)(wdt + (c + q) * 8 + 4);
                        dacc[0] += uu[q] * w0.x; dacc[1] += uu[q] * w0.y; dacc[2] += uu[q] * w0.z; dacc[3] += uu[q] * w0.w;
                        dacc[4] += uu[q] * w1.x; dacc[5] += uu[q] * w1.y; dacc[6] += uu[q] * w1.z; dacc[7] += uu[q] * w1.w; } }
            }
            if (!ismem) {
#pragma unroll
                for (int h = 0; h < 8; ++h) dacc[h] = wave_sum(dacc[h]);
                if (lane == 0) { st4(DTRAW + (size_t)r * 8, make_float4(dacc[0], dacc[1], dacc[2], dacc[3])); st4(DTRAW + (size_t)r * 8 + 4, make_float4(dacc[4], dacc[5], dacc[6], dacc[7])); }
            }
        }
        __syncthreads();
        LAS3 float* scr = (LAS3 float*)(ldsp + wave * 16384);
        constexpr int IT1 = 16 * (2048 / 32), IT2 = 16 * (1024 / 32);
        constexpr int IA = 16 * (1536 / 32), IB = 16 * (768 / 32), IO = 16 * 32, IQ = 16 * 16, IKV = 16 * 32, IWO = 8 * 32;
        constexpr int NSM = IA + IB + IO + IQ + IKV + IWO, NIT = NSM + NEXP * (IT1 + IT2);
        for (int it = gw; it < NIT; it += NGW) {
            int r = it;
            if (r < IA) { transpose_item(p.in[I_WIN], 1024, IN_COLS, WINT, scr, r, lane, 1536); continue; } r -= IA;
            if (r < IB) { transpose_item(p.in[I_WIN] + COL_Q, 1024, IN_COLS, WINT + (size_t)1536 * 1024, scr, r, lane, 768); continue; } r -= IB;
            if (r < IO) { transpose_item(p.in[I_WOUT], 1024, 1024, WOUTT, scr, r, lane); continue; } r -= IO;
            if (r < IQ) { transpose_item(p.in[I_WQ], 1024, 512, WQT, scr, r, lane); continue; } r -= IQ;
            if (r < IKV) { transpose_item(p.in[I_WKV], 1024, 1024, WKVT, scr, r, lane); continue; } r -= IKV;
            if (r < IWO) { transpose_item(p.in[I_WO], 512, 1024, WOT, scr, r, lane); continue; } r -= IWO;
            if (r < NEXP * IT1) { const int e = r / IT1, q = r - e * IT1; transpose_item(p.in[I_W1] + (size_t)e * 1024 * 2048, 1024, 2048, W1T + (size_t)e * 2048 * 1024, scr, q, lane); continue; } r -= NEXP * IT1;
            { const int e = r / IT2, q = r - e * IT2; transpose_item(p.in[I_W2] + (size_t)e * 1024 * 1024, 1024, 1024, W2T + (size_t)e * 1024 * 1024, scr, q, lane); }
        }
    }
    grid.sync();
    {
        g8::DenseSched S{G, (int)blockIdx.x, 1024, NTOK / 256, PJ / 256, (const char*)WINT, NMEM / 256, 4, NTOK, (const char*)WKVT};
        g8::EpiBf16Dual E{PROJB, PJ, BIASP, KVMB, 1024};
        g8::gemm_phase(ldsp, XN, 1024, 0, S, E);
    }
    grid.sync();
    {
    PHASE_IDS();
    for (int idx = gtid; idx < NTOK * 256; idx += NGT) {
        const int row = idx >> 8, c4 = (idx & 255) * 4, t = row & (SEQ - 1);
        float4 a = ld4(p.in[I_CONVB] + c4);
#pragma unroll
        for (int k = 0; k < 4; ++k) if (t - 3 + k >= 0) {
            const float4 w = ld4(p.in[I_CONVW] + k * CONVCH + c4); const uint2 pv = *(const uint2*)(PROJB + (size_t)(row - 3 + k) * PJ + PJ_XBC + c4);
            a.x += w.x * __uint_as_float(pv.x << 16); a.y += w.y * __uint_as_float(pv.x & 0xffff0000u); a.z += w.z * __uint_as_float(pv.y << 16); a.w += w.w * __uint_as_float(pv.y & 0xffff0000u); }
        st4(XBC + (size_t)row * 1024 + c4, make_float4(silu_f(a.x), silu_f(a.y), silu_f(a.z), silu_f(a.w)));
    }
    for (int idx = gtid; idx < NTOK * 8; idx += NGT) DT[idx] = softplus_f(DTRAW[idx] + p.in[I_DTB][idx & 7]);
    }
    grid.sync();
    {
    PHASE_IDS();
    for (int item = gw; item < BATCH * SSM_H * SSM_P; item += NGW) {
        const int b = item >> 9, h = (item >> 6) & 7, pp = item & 63, g = h >> 2;
        const float ah = -__expf(p.in[I_ALOG][h]), dsk = p.in[I_DSKIP][h];
        float h0 = 0.f, h1 = 0.f;
        const float* xb = XBC + (size_t)b * SEQ * 1024; const float* dtb = DT + (size_t)b * SEQ * 8 + h;
#pragma unroll 4
        for (int t = 0; t < SEQ; ++t) {
            const float* xr = xb + (size_t)t * 1024;
            const float dtv = dtb[(size_t)t * 8], xv = xr[h * 64 + pp];
            const float B0 = xr[512 + g * 128 + lane], B1 = xr[512 + g * 128 + 64 + lane];
            const float C0 = xr[768 + g * 128 + lane], C1 = xr[768 + g * 128 + 64 + lane];
            const float dec = __expf(dtv * ah), dx = dtv * xv;
            h0 = h0 * dec + dx * B0; h1 = h1 * dec + dx * B1;
            const float y = wave_sum(C0 * h0 + C1 * h1) + dsk * xv;
            if (lane == 0) YSSM[(size_t)(b * SEQ + t) * 512 + h * 64 + pp] = y;
        }
    }
    for (int item = gw; item < NTOK * 8; item += NGW) {
        const int row = item >> 3, hq = item & 7, kv = hq >> 2, t = row & (SEQ - 1);
        const float qv = bf2f(PROJB[(size_t)row * PJ + PJ_Q + hq * 64 + lane]);
        float s0 = 0.f, s1 = 0.f;
        const int j0 = lane, j1 = lane + 64; const bool v0 = (t - j0) >= 0, v1 = (t - j1) >= 0;
        const bf* k0p = PROJB + (size_t)(row - (v0 ? j0 : 0)) * PJ + PJ_K + kv * 64;
        const bf* k1p = PROJB + (size_t)(row - (v1 ? j1 : 0)) * PJ + PJ_K + kv * 64;
        for (int d = 0; d < 64; ++d) { const float qd = __shfl(qv, d); s0 += qd * bf2f(k0p[d]); s1 += qd * bf2f(k1p[d]); }
        const int bk0 = j0 < 16 ? j0 : min(31, 16 + (int)(log2f((float)j0 * 0.0625f) * (16.f / 3.f)));
        const int bk1 = min(31, 16 + (int)(log2f((float)j1 * 0.0625f) * (16.f / 3.f)));
        s0 = v0 ? s0 * 0.125f + p.in[I_RELB][bk0 * 8 + hq] : -INFINITY;
        s1 = v1 ? s1 * 0.125f + p.in[I_RELB][bk1 * 8 + hq] : -INFINITY;
        const float sink = p.in[I_SINK][hq];
        const float m = fmaxf(wave_max(fmaxf(s0, s1)), sink);
        const float e0 = v0 ? __expf(s0 - m) : 0.f, e1 = v1 ? __expf(s1 - m) : 0.f;
        const float den = wave_sum(e0 + e1) + __expf(sink - m);
        const float p0 = e0 / den, p1 = e1 / den;
        float o = 0.f;
        const int jmax = min(127, t);
        for (int j = 0; j <= jmax; ++j) { const float pj = __shfl(j < 64 ? p0 : p1, j & 63); o += pj * bf2f(PROJB[(size_t)(row - j) * PJ + PJ_V + kv * 64 + lane]); }
        MIXB[(size_t)row * 1024 + 512 + hq * 64 + lane] = (bf)f2bf(o);
    }
    }
    grid.sync();
    {
    PHASE_IDS();
    for (int row = gw; row < NTOK; row += NGW) {
        const int c = lane * 8;
        float v[8]; float ss = 0.f;
        const uint4 zz = *(const uint4*)(PROJB + (size_t)row * PJ + PJ_Z + c);
        const unsigned zw[4] = {zz.x, zz.y, zz.z, zz.w};
#pragma unroll
        for (int i = 0; i < 8; ++i) { const float z = __uint_as_float((i & 1) ? (zw[i >> 1] & 0xffff0000u) : (zw[i >> 1] << 16)); v[i] = YSSM[(size_t)row * 512 + c + i] * silu_f(z); ss += v[i] * v[i]; }
#pragma unroll
        for (int o = 16; o > 0; o >>= 1) ss += __shfl_xor(ss, o);
        const float rs = rsqrtf(ss * (1.f / 256.f) + EPS);
        uint4 ov; unsigned ow[4];
#pragma unroll
        for (int i = 0; i < 4; ++i) ow[i] = pk2(v[2 * i] * rs * p.in[I_GSSM][c + 2 * i], v[2 * i + 1] * rs * p.in[I_GSSM][c + 2 * i + 1]);
        ov.x = ow[0]; ov.y = ow[1]; ov.z = ow[2]; ov.w = ow[3];
        *(uint4*)(MIXB + (size_t)row * 1024 + c) = ov;
    }
    }
    grid.sync();
    {
        g8::DenseSched S{G, (int)blockIdx.x, 1024, NTOK / 256, 4, (const char*)WOUTT, 0, 1, 0, nullptr};
        g8::EpiF32Res E{H1, p.in[I_BOUT], x};
        g8::gemm_phase(ldsp, MIXB, 1024, 0, S, E);
    }
    grid.sync();
    {
    PHASE_IDS();
    for (int r = gw; r < NTOK; r += NGW) {
        float4 v[4]; float ss = 0.f;
#pragma unroll
        for (int j = 0; j < 4; ++j) { v[j] = ld4(H1 + (size_t)r * DM + 4 * (lane + 64 * j)); ss += v[j].x * v[j].x + v[j].y * v[j].y + v[j].z * v[j].z + v[j].w * v[j].w; }
        const float rs = rsqrtf(wave_sum(ss) * (1.f / 1024.f) + EPS);
#pragma unroll
        for (int j = 0; j < 4; ++j) { const int c = 4 * (lane + 64 * j); const float4 gv = ld4(p.in[I_GCROSS] + c);
            *(uint2*)(XN + (size_t)r * DM + c) = make_uint2(pk2(v[j].x * rs * gv.x, v[j].y * rs * gv.y), pk2(v[j].z * rs * gv.z, v[j].w * rs * gv.w)); }
    }
    }
    grid.sync();
    {
        g8::DenseSched S{G, (int)blockIdx.x, 1024, NTOK / 256, 2, (const char*)WQT, 0, 1, 0, nullptr};
        g8::EpiBf16Dual E{QCB, 512, nullptr, nullptr, 0};
        g8::gemm_phase(ldsp, XN, 1024, 0, S, E);
    }
    grid.sync();
    {
    PHASE_IDS();
    for (int item = gw; item < NTOK * 4; item += NGW) {
        const int row = item >> 2, hd = item & 3, b = row >> 13;
        const float q0 = bf2f(QCB[(size_t)row * 512 + hd * 128 + lane]), q1 = bf2f(QCB[(size_t)row * 512 + hd * 128 + 64 + lane]);
        const bf* kb = KVMB + (size_t)b * MEMLEN * 1024 + hd * 128;
        float sc4[4] = {0.f, 0.f, 0.f, 0.f};
        for (int d = 0; d < 128; ++d) {
            const float qd = __shfl(d < 64 ? q0 : q1, d & 63);
#pragma unroll
            for (int i = 0; i < 4; ++i) sc4[i] += qd * bf2f(kb[(size_t)(lane + 64 * i) * 1024 + d]);
        }
        const float sc = 0.08838834764831845f;
        float m = -INFINITY;
#pragma unroll
        for (int i = 0; i < 4; ++i) { sc4[i] *= sc; m = fmaxf(m, sc4[i]); }
        m = wave_max(m);
        float den = 0.f;
#pragma unroll
        for (int i = 0; i < 4; ++i) { sc4[i] = __expf(sc4[i] - m); den += sc4[i]; }
        den = wave_sum(den);
        const float inv = 1.f / den;
        float o0 = 0.f, o1 = 0.f; const bf* vb = kb + 512;
#pragma unroll
        for (int i = 0; i < 4; ++i)
            for (int jj = 0; jj < 64; ++jj) {
                const float pj = __shfl(sc4[i], jj) * inv; const bf* vr = vb + (size_t)(jj + 64 * i) * 1024;
                o0 += pj * bf2f(vr[lane]); o1 += pj * bf2f(vr[64 + lane]);
            }
        OCB[(size_t)row * 512 + hd * 128 + lane] = (bf)f2bf(o0); OCB[(size_t)row * 512 + hd * 128 + 64 + lane] = (bf)f2bf(o1);
    }
    }
    grid.sync();
    {
        g8::DenseSched S{G, (int)blockIdx.x, 512, NTOK / 256, 4, (const char*)WOT, 0, 1, 0, nullptr};
        g8::EpiF32Res E{H2, nullptr, H1};
        g8::gemm_phase(ldsp, OCB, 512, 0, S, E);
    }
    grid.sync();
    {
    PHASE_IDS();
    for (int row = gw; row < NTOK; row += NGW) {
        float4 un[4];
        {
            float ss = 0.f;
#pragma unroll
            for (int j = 0; j < 4; ++j) { un[j] = ld4(H2 + (size_t)row * DM + 16 * lane + 4 * j); ss += un[j].x * un[j].x + un[j].y * un[j].y + un[j].z * un[j].z + un[j].w * un[j].w; }
            const float rs = rsqrtf(wave_sum(ss) * (1.f / 1024.f) + EPS);
#pragma unroll
            for (int j = 0; j < 4; ++j) { const float4 gv = ld4(p.in[I_GFFN] + 16 * lane + 4 * j);
                un[j] = make_float4(un[j].x * rs * gv.x, un[j].y * rs * gv.y, un[j].z * rs * gv.z, un[j].w * rs * gv.w);
                *(uint2*)(XN + (size_t)row * DM + 16 * lane + 4 * j) = make_uint2(pk2(un[j].x, un[j].y), pk2(un[j].z, un[j].w)); }
        }
        float l[32];
#pragma unroll
        for (int e = 0; e < 32; ++e) l[e] = 0.f;
        const float* wrb = p.in[I_WR] + (size_t)(16 * lane) * 32;
        LAS3 float* us = (LAS3 float*)(ldsp + wave * 4096);
#pragma unroll
        for (int j = 0; j < 4; ++j) { us[(4 * j + 0) * 64 + lane] = un[j].x; us[(4 * j + 1) * 64 + lane] = un[j].y; us[(4 * j + 2) * 64 + lane] = un[j].z; us[(4 * j + 3) * 64 + lane] = un[j].w; }
#pragma unroll 2
        for (int q = 0; q < 16; ++q) {
            const float uq = us[q * 64 + lane]; const float* wr = wrb + q * 32;
#pragma unroll
            for (int e4 = 0; e4 < 8; ++e4) { const float4 w = ld4(wr + 4 * e4);
                l[4 * e4] += uq * w.x; l[4 * e4 + 1] += uq * w.y; l[4 * e4 + 2] += uq * w.z; l[4 * e4 + 3] += uq * w.w; }
        }
#pragma unroll
        for (int e = 0; e < 32; ++e) l[e] = wave_sum(l[e]) + p.in[I_BR][e];
        int sel[4]; float val[4];
#pragma unroll
        for (int k = 0; k < 4; ++k) {
            float best = -INFINITY; int bi = 0;
#pragma unroll
            for (int e = 0; e < 32; ++e) if (l[e] > best) { best = l[e]; bi = e; }
            sel[k] = bi; val[k] = best;
#pragma unroll
            for (int e = 0; e < 32; ++e) l[e] = (e == bi) ? -INFINITY : l[e];
        }
        float ex[4], den = 0.f;
#pragma unroll
        for (int k = 0; k < 4; ++k) { ex[k] = __expf(val[k] - val[0]); den += ex[k]; }
        if (lane == 0) {
#pragma unroll
            for (int k = 0; k < 4; ++k) {
                const int a = row * 4 + k;
                const unsigned slot = atomicAdd(&ctl[CW_CNT + sel[k]], 1u);
                LIST[sel[k] * NTOK + slot] = a;
                SLOT[a] = (sel[k] << 16) | (int)slot;
                GATE[a] = ex[k] / den;
            }
        }
    }
    }
    grid.sync();
    {
    PHASE_IDS();
    if (tid < 64) {
        const int c = tid < 32 ? (int)__hip_atomic_load(&ctl[CW_CNT + (tid & 31)], __ATOMIC_RELAXED, __HIP_MEMORY_SCOPE_AGENT) : 0;
        int tl = (c + 255) >> 8, incl = tl;
#pragma unroll
        for (int o = 1; o < 32; o <<= 1) { const int v = __shfl_up(incl, o); if ((tid & 63) >= o) incl += v; }
        if (tid < 32) { CNTL[tid] = c; TP[tid] = incl - tl; }
        if (tid == 31) TP[32] = incl;
    }
    }
    __syncthreads();
    {
        g8::MoeSched S{G, vcu, 8, 1024, TP, CNTL, LIST, (const char*)W1T, (size_t)2048 * 1024 * 2};
        g8::EpiSwiglu E{ACTB, p.in[I_B1]};
        g8::gemm_phase(ldsp, XN, 1024, 2, S, E);
    }
    grid.sync();
    {
        g8::MoeSched S{G, vcu, 4, 1024, TP, CNTL, nullptr, (const char*)W2T, (size_t)1024 * 1024 * 2};
        g8::EpiBf16 E{YB, 1024, p.in[I_B2], 1024};
        g8::gemm_phase(ldsp, ACTB, 1024, 0, S, E);
    }
    grid.sync();
    {
    PHASE_IDS();
    for (int row = gw; row < NTOK; row += NGW) {
        float4 v[4]; float ss = 0.f;
        int yrow[4]; float gk[4];
#pragma unroll
        for (int k = 0; k < 4; ++k) { const int sl = SLOT[row * 4 + k]; yrow[k] = TP[sl >> 16] * 256 + (sl & 0xffff); gk[k] = GATE[row * 4 + k]; }
#pragma unroll
        for (int j = 0; j < 4; ++j) {
            const int c = 4 * (lane + 64 * j);
            float4 a = ld4(H2 + (size_t)row * DM + c);
#pragma unroll
            for (int k = 0; k < 4; ++k) { const uint2 y = *(const uint2*)(YB + (size_t)yrow[k] * 1024 + c);
                a.x += gk[k] * __uint_as_float(y.x << 16); a.y += gk[k] * __uint_as_float(y.x & 0xffff0000u);
                a.z += gk[k] * __uint_as_float(y.y << 16); a.w += gk[k] * __uint_as_float(y.y & 0xffff0000u); }
            v[j] = a; ss += a.x * a.x + a.y * a.y + a.z * a.z + a.w * a.w;
        }
        const float rs = rsqrtf(wave_sum(ss) * (1.f / 1024.f) + EPS);
#pragma unroll
        for (int j = 0; j < 4; ++j) { const int c = 4 * (lane + 64 * j); const float4 gv = ld4(p.in[I_GFIN] + c);
            st4(p.out + (size_t)row * DM + c, make_float4(v[j].x * rs * gv.x, v[j].y * rs * gv.y, v[j].z * rs * gv.z, v[j].w * rs * gv.w)); }
    }
    }
}

constexpr int LDS_BYTES = 147456;

extern "C" void kernel_launch(void* const* d_in, const int* in_sizes, int n_in, void* d_out, int out_size, void* d_ws, size_t ws_size, hipStream_t stream) {
    static int grid = 0;
    if (grid == 0) {
        if (n_in != N_IN || ws_size < WS_END) { fprintf(stderr, "kernel_launch: unexpected n_in %d / ws_size %zu (need %zu)\n", n_in, ws_size, (size_t)WS_END); grid = -1; return; }
        int dev = 0, cus = 0, per_cu = 0;
        (void)hipGetDevice(&dev);
        (void)hipDeviceGetAttribute(&cus, hipDeviceAttributeMultiprocessorCount, dev);
        (void)hipFuncSetAttribute((const void*)mk_fwd, hipFuncAttributeMaxDynamicSharedMemorySize, LDS_BYTES);
        (void)hipOccupancyMaxActiveBlocksPerMultiprocessor(&per_cu, (const void*)mk_fwd, 512, LDS_BYTES);
        if (per_cu < 1) { fprintf(stderr, "kernel_launch: occupancy query says %d blocks per CU\n", per_cu); per_cu = 1; }
        if (per_cu > 1) per_cu = 1;
        grid = cus * per_cu;
    }
    if (grid < 0) return;
    (void)hipMemsetAsync((char*)d_ws + WS_CTL, 0, 1 * MiB, stream);
    Params p{};
    for (int i = 0; i < N_IN; ++i) p.in[i] = (const float*)d_in[i];
    p.out = (float*)d_out; p.ws = (unsigned char*)d_ws;
    void* args[] = {&p};
    hipError_t e = hipLaunchCooperativeKernel((const void*)mk_fwd, dim3(grid), dim3(512), args, LDS_BYTES, stream);
    if (e != hipSuccess) fprintf(stderr, "cooperative launch failed: %s (grid %d)\n", hipGetErrorString(e), grid);
}
```

```cpp
#include <hip/hip_runtime.h>
#include <hip/hip_cooperative_groups.h>
#include <cstdio>
#include <cstdint>
namespace cg = cooperative_groups;

#define DEVI __device__ __forceinline__

constexpr int BATCH = 2, SEQ = 8192, NTOK = BATCH * SEQ, DM = 1024, MEMLEN = 256, NMEM = BATCH * MEMLEN;
constexpr int SSM_H = 8, SSM_P = 64, SSM_W = 512, SSM_N = 128, CONVCH = 1024;
constexpr int IN_COLS = 2312, COL_Z = 0, COL_XBC = 512, COL_DT = 1536, COL_Q = 1544, COL_K = 2056, COL_V = 2184;
constexpr int NEXP = 32, TOPK = 4, DFF = 1024, NASSIGN = NTOK * TOPK;
constexpr float EPS = 1e-5f;

enum { I_X = 0, I_MEM, I_GMIX, I_WIN, I_BQKV, I_CONVW, I_CONVB, I_DTB, I_ALOG, I_DSKIP, I_GSSM, I_SINK, I_RELB, I_WOUT, I_BOUT,
       I_GCROSS, I_GMEM, I_WQ, I_WKV, I_WO, I_GFFN, I_WR, I_BR, I_W1, I_B1, I_W2, I_B2, I_GFIN, N_IN };

constexpr size_t MiB = 1u << 20;
constexpr size_t WS_CTL = 0;
constexpr size_t WS_XN = 1 * MiB;
constexpr size_t WS_BIG = WS_XN + 34 * MiB;
constexpr size_t WS_XBC = WS_BIG + 144 * MiB;
constexpr size_t WS_MIXB = WS_XBC + 64 * MiB;
constexpr size_t WS_H1 = WS_MIXB + 32 * MiB;
constexpr size_t WS_H2 = WS_H1 + 64 * MiB;
constexpr size_t WS_YSSM = WS_H2 + 64 * MiB;
constexpr size_t WS_QCB = WS_YSSM + 32 * MiB;
constexpr size_t WS_OCB = WS_QCB + 16 * MiB;
constexpr size_t WS_ACTB = WS_OCB + 16 * MiB;
constexpr size_t WS_W1T = WS_ACTB + 144 * MiB;
constexpr size_t WS_W2T = WS_W1T + 128 * MiB;
constexpr size_t WS_WINT = WS_W2T + 64 * MiB;
constexpr size_t WS_WOUTT = WS_WINT + 5 * MiB;
constexpr size_t WS_WQT = WS_WOUTT + 2 * MiB;
constexpr size_t WS_WKVT = WS_WQT + 1 * MiB;
constexpr size_t WS_WOT = WS_WKVT + 2 * MiB;
constexpr size_t WS_SMALL = WS_WOT + 1 * MiB;
constexpr size_t WS_DT = WS_SMALL;
constexpr size_t WS_DTRAW = WS_DT + 512 * 1024;
constexpr size_t WS_KVMB = WS_DTRAW + 512 * 1024;
constexpr size_t WS_GATE = WS_KVMB + 1 * MiB;
constexpr size_t WS_SLOT = WS_GATE + 512 * 1024;
constexpr size_t WS_BIASP = WS_SLOT + 256 * 1024;
constexpr size_t WS_LIST = WS_GATE + 1 * MiB;
constexpr size_t WS_END = WS_LIST + 2 * MiB;
constexpr size_t WS_YB = WS_BIG;
constexpr int NROWS_MAX = NASSIGN + NEXP * 256;
constexpr int PJ = 2304, PJ_Z = 0, PJ_XBC = 512, PJ_Q = 1536, PJ_K = 2048, PJ_V = 2176;
constexpr int CW_CNT = 64;
constexpr int CW_ERR = 128;
#ifndef CHECK_ATTN
#define CHECK_ATTN 0
#endif

struct Params { const float* in[N_IN]; float* out; unsigned char* ws; };

DEVI float wave_sum(float v) {
#pragma unroll
    for (int o = 32; o > 0; o >>= 1) v += __shfl_xor(v, o);
    return v;
}
DEVI float wave_max(float v) {
#pragma unroll
    for (int o = 32; o > 0; o >>= 1) v = fmaxf(v, __shfl_xor(v, o));
    return v;
}
DEVI float silu_f(float x) { return x / (1.f + __expf(-x)); }
DEVI float softplus_f(float x) { return fmaxf(x, 0.f) + log1pf(__expf(-fabsf(x))); }
DEVI float4 ld4(const float* p) { return *(const float4*)p; }
DEVI void st4(float* p, float4 v) { *(float4*)p = v; }

DEVI void rms_row(const float* xrow, const float* g, float* orow, int lane) {
    float4 v[4]; float s = 0.f;
#pragma unroll
    for (int j = 0; j < 4; ++j) { v[j] = ld4(xrow + 4 * (lane + 64 * j)); s += v[j].x * v[j].x + v[j].y * v[j].y + v[j].z * v[j].z + v[j].w * v[j].w; }
    const float rs = rsqrtf(wave_sum(s) * (1.f / 1024.f) + EPS);
#pragma unroll
    for (int j = 0; j < 4; ++j) { const float4 gv = ld4(g + 4 * (lane + 64 * j));
        st4(orow + 4 * (lane + 64 * j), make_float4(v[j].x * rs * gv.x, v[j].y * rs * gv.y, v[j].z * rs * gv.z, v[j].w * rs * gv.w)); }
}

struct TI { int tid, lane, wave, gw, gtid; };
DEVI TI fresh_ti() { int t = threadIdx.x; asm volatile("" : "+v"(t)); TI r; r.tid = t; r.lane = t & 63; r.wave = __builtin_amdgcn_readfirstlane(t >> 6); r.gw = blockIdx.x * 8 + r.wave; r.gtid = blockIdx.x * 512 + t; return r; }
#define PHASE_IDS() const TI ti_ = fresh_ti(); const int tid = ti_.tid, lane = ti_.lane, wave = ti_.wave, gw = ti_.gw, gtid = ti_.gtid; (void)tid; (void)lane; (void)wave; (void)gw; (void)gtid
DEVI float bf2f(unsigned short v) { return __uint_as_float((unsigned)v << 16); }
namespace g8 {
#define G8_LAS __attribute__((address_space(3)))
typedef unsigned short bf16_t;
typedef short bf16x8 __attribute__((ext_vector_type(8)));
typedef float f32x4 __attribute__((ext_vector_type(4)));
typedef float f32x2 __attribute__((ext_vector_type(2)));
typedef unsigned u32x4 __attribute__((ext_vector_type(4)));
typedef unsigned u32x2 __attribute__((ext_vector_type(2)));
constexpr int BM = 256, BK = 64, HALF = 128, HTB = HALF * BK * 2, STAGE_BYTES = 8 * HTB;

DEVI int lds_byte(int r, int c) { const int st = (r >> 4) * 2 + (c >> 5), rr = r & 15, cc = c & 31, ob = rr * 64 + cc * 2; return st * 1024 + (ob ^ (((ob >> 9) & 1) << 5)); }
DEVI void stage_rc(int b, int& R, int& C) { const int st = b / 1024, sb = b % 1024, swz = sb ^ (((sb >> 9) & 1) << 5); R = (st >> 1) * 16 + swz / 64; C = (st & 1) * 32 + (swz % 64) / 2; }
DEVI int perm32(int rho) { const int n = rho >> 4, i = rho & 15; return 8 * (i >> 2) + 4 * n + (i & 3); }
DEVI unsigned cvt_pk_bf16(float lo, float hi) { unsigned r; asm volatile("v_cvt_pk_bf16_f32 %0, %1, %2" : "=v"(r) : "v"(lo), "v"(hi)); return r; }

struct Unit {
    const int* alist;
    int acnt;
    int arow0;
    const char* bt;
    int orow0, ocol0;
    int e;
};


struct EpiSwiglu {
    static constexpr bool PERM = true;
    bf16_t* O; const float* bias;
    DEVI void operator()(const f32x4 (&acc)[2][2][4][2], const Unit& u, int wr, int wc, int fr, int fq) const {
        const int row0 = u.orow0 + wr * 64 + fr, col0 = u.ocol0 + wc * 32 + 8 * fq;
        const float* bp = bias + (size_t)u.e * 2048 + col0;
        f32x4 bv[2][2];
#pragma unroll
        for (int bj = 0; bj < 2; ++bj)
#pragma unroll
            for (int n = 0; n < 2; ++n) bv[bj][n] = *(const f32x4*)(bp + bj * HALF + 4 * n);
#pragma unroll
        for (int ai = 0; ai < 2; ++ai)
#pragma unroll
            for (int m = 0; m < 4; ++m) { bf16_t* rowp = O + (size_t)(row0 + ai * HALF + m * 16) * 1024 + (col0 >> 1);
#pragma unroll
                for (int bj = 0; bj < 2; ++bj) { const f32x4 v0 = acc[ai][bj][m][0] + bv[bj][0], v1 = acc[ai][bj][m][1] + bv[bj][1];
                    float o[4];
                    const float gl[4] = {v0[0], v0[2], v1[0], v1[2]}, li[4] = {v0[1], v0[3], v1[1], v1[3]};
#pragma unroll
                    for (int q = 0; q < 4; ++q) { const float xg = fminf(gl[q], 7.f), xl = fminf(fmaxf(li[q], -7.f), 7.f);
                        o[q] = xg * __builtin_amdgcn_rcpf(1.f + __expf(-1.702f * xg)) * (xl + 1.f); }
                    u32x2 w; w.x = cvt_pk_bf16(o[0], o[1]); w.y = cvt_pk_bf16(o[2], o[3]);
                    *(u32x2*)(rowp + bj * (HALF / 2)) = w; } }
    }
};
struct EpiBf16 {
    static constexpr bool PERM = true;
    bf16_t* O; int ldc; const float* bias; int bias_stride;
    DEVI void operator()(const f32x4 (&acc)[2][2][4][2], const Unit& u, int wr, int wc, int fr, int fq) const {
        const int row0 = u.orow0 + wr * 64 + fr, col0 = u.ocol0 + wc * 32 + 8 * fq;
        f32x4 bv[2][2];
#pragma unroll
        for (int bj = 0; bj < 2; ++bj)
#pragma unroll
            for (int n = 0; n < 2; ++n) bv[bj][n] = bias ? *(const f32x4*)(bias + (size_t)u.e * bias_stride + col0 + bj * HALF + 4 * n) : (f32x4){0.f, 0.f, 0.f, 0.f};
#pragma unroll
        for (int ai = 0; ai < 2; ++ai)
#pragma unroll
            for (int m = 0; m < 4; ++m) { bf16_t* rowp = O + (size_t)(row0 + ai * HALF + m * 16) * ldc + col0;
#pragma unroll
                for (int bj = 0; bj < 2; ++bj) { const f32x4 v0 = acc[ai][bj][m][0] + bv[bj][0], v1 = acc[ai][bj][m][1] + bv[bj][1];
                    u32x4 w; w.x = cvt_pk_bf16(v0[0], v0[1]); w.y = cvt_pk_bf16(v0[2], v0[3]); w.z = cvt_pk_bf16(v1[0], v1[1]); w.w = cvt_pk_bf16(v1[2], v1[3]);
                    *(u32x4*)(rowp + bj * HALF) = w; } }
    }
};

struct EpiBf16Dual {
    static constexpr bool PERM = true;
    bf16_t* O0; int ldc0; const float* bias0; bf16_t* O1; int ldc1;
    DEVI void operator()(const f32x4 (&acc)[2][2][4][2], const Unit& u, int wr, int wc, int fr, int fq) const {
        const int row0 = u.orow0 + wr * 64 + fr, col0 = u.ocol0 + wc * 32 + 8 * fq;
        bf16_t* O = u.e ? O1 : O0; const int ldc = u.e ? ldc1 : ldc0; const float* bias = u.e ? nullptr : bias0;
        f32x4 bv[2][2];
#pragma unroll
        for (int bj = 0; bj < 2; ++bj)
#pragma unroll
            for (int n = 0; n < 2; ++n) bv[bj][n] = bias ? *(const f32x4*)(bias + col0 + bj * HALF + 4 * n) : (f32x4){0.f, 0.f, 0.f, 0.f};
#pragma unroll
        for (int ai = 0; ai < 2; ++ai)
#pragma unroll
            for (int m = 0; m < 4; ++m) { bf16_t* rowp = O + (size_t)(row0 + ai * HALF + m * 16) * ldc + col0;
#pragma unroll
                for (int bj = 0; bj < 2; ++bj) { const f32x4 v0 = acc[ai][bj][m][0] + bv[bj][0], v1 = acc[ai][bj][m][1] + bv[bj][1];
                    u32x4 w; w.x = cvt_pk_bf16(v0[0], v0[1]); w.y = cvt_pk_bf16(v0[2], v0[3]); w.z = cvt_pk_bf16(v1[0], v1[1]); w.w = cvt_pk_bf16(v1[2], v1[3]);
                    *(u32x4*)(rowp + bj * HALF) = w; } }
    }
};
struct EpiF32Res {
    static constexpr bool PERM = false;
    float* C; const float* bias; const float* res;
    DEVI void operator()(const f32x4 (&acc)[2][2][4][2], const Unit& u, int wr, int wc, int fr, int fq) const {
        const int row0 = u.orow0 + wr * 64 + fr, col0 = u.ocol0 + wc * 32 + 4 * fq;
        f32x4 bv[2][2];
#pragma unroll
        for (int bj = 0; bj < 2; ++bj)
#pragma unroll
            for (int n = 0; n < 2; ++n) bv[bj][n] = bias ? *(const f32x4*)(bias + col0 + bj * HALF + n * 16) : (f32x4){0.f, 0.f, 0.f, 0.f};
#pragma unroll
        for (int ai = 0; ai < 2; ++ai)
#pragma unroll
            for (int m = 0; m < 4; ++m) { const size_t off = (size_t)(row0 + ai * HALF + m * 16) * 1024 + col0;
#pragma unroll
                for (int bj = 0; bj < 2; ++bj)
#pragma unroll
                    for (int n = 0; n < 2; ++n) *(f32x4*)(C + off + bj * HALF + n * 16) = acc[ai][bj][m][n] + bv[bj][n] + *(const f32x4*)(res + off + bj * HALF + n * 16);
                if (m & 1) asm volatile("" ::: "memory"); }
    }
};

template <class Epi, class Sched>
DEVI void gemm_phase(G8_LAS unsigned char* lds, const bf16_t* A, int K, int ashift, const Sched& S, const Epi& E) {
    int tid = threadIdx.x; asm volatile("" : "+v"(tid));
    const int wid = __builtin_amdgcn_readfirstlane(tid >> 6), lane = tid & 63, wr = wid >> 2, wc = wid & 3, fr = lane & 15, fq = lane >> 4;
    const int nt = K / BK;
    int Rl[2], Cl[2]; unsigned voffB[2];
#pragma unroll
    for (int i = 0; i < 2; ++i) { stage_rc(tid * 16 + i * 8192, Rl[i], Cl[i]); const int Rb = Epi::PERM ? ((Rl[i] & ~31) + perm32(Rl[i] & 31)) : Rl[i];
        voffB[i] = (unsigned)(Rb * K + Cl[i]) * 2u; }
    const size_t kstep = (size_t)(BK * 2);
    const size_t hstep = (size_t)HALF * K * 2;
    const unsigned ldsw = (unsigned)wid * 1024u;
    const int aoff = lds_byte(wr * 64 + fr, fq * 8), boff = lds_byte(wc * 32 + fr, fq * 8);
    const char* Ab = (const char*)A;
#define G8_AOFF(dst, u) do { _Pragma("unroll") for (int _h = 0; _h < 2; ++_h) _Pragma("unroll") for (int _i = 0; _i < 2; ++_i) { const int _row = _h * HALF + Rl[_i]; int _ar; \
        if ((u).alist) { const int _idx = _row < (u).acnt ? _row : 0; _ar = (u).alist[_idx] >> ashift; } else _ar = (u).arow0 + _row; \
        dst[_h][_i] = (unsigned)(_ar * K + Cl[_i]) * 2u; } } while (0)
#define G8_SA(b, h) (((b) * 2 + (h)) * HTB)
#define G8_SB(b, h) ((4 + (b) * 2 + (h)) * HTB)
#define G8_STAGE(bufoff, gbase, voff) do { _Pragma("unroll") for (int _i = 0; _i < 2; ++_i) \
        __builtin_amdgcn_global_load_lds((const unsigned*)((const char*)(gbase) + (voff)[_i]), (G8_LAS unsigned*)(lds + (bufoff) + ldsw + _i * 8192), 16, 0, 0); } while (0)
#define G8_LDA(dst, b, h) do { _Pragma("unroll") for (int m = 0; m < 4; ++m) _Pragma("unroll") for (int k = 0; k < 2; ++k) dst[m][k] = *(const G8_LAS bf16x8*)(lds + G8_SA(b, h) + aoff + m * 2048 + k * 1024); } while (0)
#define G8_LDB(dst, b, h) do { _Pragma("unroll") for (int n = 0; n < 2; ++n) _Pragma("unroll") for (int k = 0; k < 2; ++k) dst[n][k] = *(const G8_LAS bf16x8*)(lds + G8_SB(b, h) + boff + n * 2048 + k * 1024); } while (0)
#define G8_MMA(ai, bj, At, Bt) do { __builtin_amdgcn_s_setprio(1); _Pragma("unroll") for (int m = 0; m < 4; ++m) _Pragma("unroll") for (int n = 0; n < 2; ++n) _Pragma("unroll") for (int k = 0; k < 2; ++k) \
        acc[ai][bj][m][n] = __builtin_amdgcn_mfma_f32_16x16x32_bf16(Bt[n][k], At[m][k], acc[ai][bj][m][n], 0, 0, 0); __builtin_amdgcn_s_setprio(0); } while (0)
#define G8_WAIT_V(n) asm volatile("s_waitcnt vmcnt(" #n ")" ::: "memory")
#define G8_WAIT_L(n) asm volatile("s_waitcnt lgkmcnt(" #n ")" ::: "memory")
#define G8_BAR __builtin_amdgcn_s_barrier()
#define G8_SCHED __builtin_amdgcn_sched_barrier(0)
    Unit cur, nxt, nn; int ui = 0;
    if (!S.next(0, cur)) return;
    f32x4 acc[2][2][4][2];
#pragma unroll
    for (int a = 0; a < 2; ++a)
#pragma unroll
        for (int b = 0; b < 2; ++b)
#pragma unroll
            for (int m = 0; m < 4; ++m)
#pragma unroll
                for (int n = 0; n < 2; ++n) acc[a][b][m][n] = (f32x4){0.f, 0.f, 0.f, 0.f};
    bf16x8 At[4][2], B0[2][2], B1[2][2];
    unsigned cv[2][2], nv[2][2], fv[2][2];
    G8_AOFF(cv, cur);
    bool has_next = S.next(1, nxt);
    if (has_next) { G8_AOFF(nv, nxt); } else {
#pragma unroll
        for (int h = 0; h < 2; ++h)
#pragma unroll
            for (int i = 0; i < 2; ++i) nv[h][i] = cv[h][i]; }
    const char* cB = cur.bt; const char* nB = has_next ? nxt.bt : cB;
    G8_STAGE(G8_SB(0, 0), cB, voffB); G8_STAGE(G8_SB(0, 1), cB + hstep, voffB); G8_STAGE(G8_SA(0, 0), Ab, cv[0]); G8_STAGE(G8_SA(0, 1), Ab, cv[1]);
    if (wr == 1) G8_BAR;
    G8_WAIT_V(2); G8_BAR;
    G8_STAGE(G8_SB(1, 0), cB + kstep, voffB); G8_STAGE(G8_SA(1, 0), Ab + kstep, cv[0]); G8_STAGE(G8_SB(1, 1), cB + hstep + kstep, voffB);
    G8_WAIT_V(6); G8_BAR;
    for (;;) {
#pragma unroll 1
        for (int t = 0; t < nt; t += 2) {
            const bool last = (t == nt - 2);
            const size_t k1 = (size_t)(t + 1) * kstep;
            const size_t k2 = last ? 0 : (size_t)(t + 2) * kstep;
            const char* b2 = last ? nB : cB + (size_t)(t + 2) * kstep; const char* b3 = b2 + kstep;
            unsigned sv[2][2];
#pragma unroll
            for (int h = 0; h < 2; ++h)
#pragma unroll
                for (int i = 0; i < 2; ++i) sv[h][i] = last ? nv[h][i] : cv[h][i];
            G8_LDB(B0, 0, 0); G8_LDB(B1, 0, 1); G8_SCHED; G8_LDA(At, 0, 0); G8_STAGE(G8_SA(1, 1), Ab + k1, cv[1]);
            G8_WAIT_V(8); G8_WAIT_L(0); G8_BAR; G8_MMA(0, 0, At, B0); G8_MMA(0, 1, At, B1); G8_BAR; G8_SCHED;
            G8_LDA(At, 0, 1); G8_STAGE(G8_SB(0, 0), b2, voffB); G8_STAGE(G8_SB(0, 1), b2 + hstep, voffB); G8_STAGE(G8_SA(0, 0), Ab + k2, sv[0]);
            G8_WAIT_V(8); G8_WAIT_L(0); G8_BAR; G8_MMA(1, 0, At, B0); G8_MMA(1, 1, At, B1); G8_BAR; G8_SCHED;
            G8_LDB(B0, 1, 0); G8_LDB(B1, 1, 1); G8_SCHED; G8_LDA(At, 1, 0); G8_STAGE(G8_SA(0, 1), Ab + k2, sv[1]);
            G8_WAIT_V(8); G8_WAIT_L(0); G8_BAR; G8_MMA(0, 0, At, B0); G8_MMA(0, 1, At, B1); G8_BAR; G8_SCHED;
            G8_LDA(At, 1, 1); G8_STAGE(G8_SB(1, 0), b3, voffB); G8_STAGE(G8_SB(1, 1), b3 + hstep, voffB); G8_STAGE(G8_SA(1, 0), Ab + k2 + kstep, sv[0]);
            G8_WAIT_V(8); G8_WAIT_L(0); G8_BAR; G8_MMA(1, 0, At, B0); G8_MMA(1, 1, At, B1); G8_BAR; G8_SCHED;
        }
        if (wr == 0) G8_BAR;
        const bool has_nn = has_next && S.next(ui + 2, nn);
        if (has_nn) { G8_AOFF(fv, nn); }
        E(acc, cur, wr, wc, fr, fq);
        if (!has_next) break;
#pragma unroll
        for (int a = 0; a < 2; ++a)
#pragma unroll
            for (int b = 0; b < 2; ++b)
#pragma unroll
                for (int m = 0; m < 4; ++m)
#pragma unroll
                    for (int n = 0; n < 2; ++n) acc[a][b][m][n] = (f32x4){0.f, 0.f, 0.f, 0.f};
        cur = nxt; cB = nB; ++ui;
#pragma unroll
        for (int h = 0; h < 2; ++h)
#pragma unroll
            for (int i = 0; i < 2; ++i) { cv[h][i] = nv[h][i]; nv[h][i] = has_nn ? fv[h][i] : nv[h][i]; }
        has_next = has_nn; if (has_nn) { nxt = nn; nB = nn.bt; }
        if (wr == 1) G8_BAR;
    }
    G8_WAIT_V(0);
    G8_BAR;
#undef G8_AOFF
#undef G8_SA
#undef G8_SB
#undef G8_STAGE
#undef G8_LDA
#undef G8_LDB
#undef G8_MMA
#undef G8_WAIT_V
#undef G8_WAIT_L
#undef G8_BAR
#undef G8_SCHED
}

struct MoeSched {
    int G, vcu, nct, K;
    const G8_LAS int* tp; const G8_LAS int* cnt;
    const int* list;
    const char* Bt; size_t bt_estride;
    DEVI bool next(int i, Unit& u) const {
        const int L = i * G + vcu, total = tp[32] * nct;
        if (L >= total) return false;
        const int rtg = L / nct, ct = L - rtg * nct;
        int e = 0;
#pragma unroll
        for (int k = 1; k < 32; ++k) e += (rtg >= tp[k]) ? 1 : 0;
        const int rt = rtg - tp[e];
        u.e = e; u.orow0 = rtg * 256; u.ocol0 = ct * 256;
        u.bt = Bt + (size_t)e * bt_estride + (size_t)ct * 256 * K * 2;
        if (list) { u.alist = list + e * NTOK + rt * 256; u.acnt = min(256, cnt[e] - rt * 256); u.arow0 = 0; }
        else { u.alist = nullptr; u.acnt = 0; u.arow0 = rtg * 256; }
        return true;
    }
};
struct DenseSched {
    int G, c, K, nM0, nN0; const char* Bt0; int nM1, nN1, arow1; const char* Bt1;
    DEVI bool next(int i, Unit& u) const {
        const int nwg = nM0 * nN0, L = i * G + c;
        u.alist = nullptr; u.acnt = 0;
        if (L < nwg) {
            int wgid = L; { const int q = nwg / 8, r = nwg % 8, xcd = wgid % 8, off = wgid / 8; wgid = (xcd < r ? xcd * (q + 1) : r * (q + 1) + (xcd - r) * q) + off; }
            const int nig = 8 * nN0, gid = wgid / nig, fm = gid * 8, gsz = (nM0 - fm) < 8 ? (nM0 - fm) : 8;
            const int pm = fm + ((wgid % nig) % gsz), pn = (wgid % nig) / gsz;
            u.e = 0; u.arow0 = pm * 256; u.orow0 = pm * 256; u.ocol0 = pn * 256; u.bt = Bt0 + (size_t)pn * 256 * K * 2; return true;
        }
        const int l = L - nwg; if (l >= nM1 * nN1) return false;
        const int pm = l / nN1, pn = l - pm * nN1;
        u.e = 1; u.arow0 = arow1 + pm * 256; u.orow0 = pm * 256; u.ocol0 = pn * 256; u.bt = Bt1 + (size_t)pn * 256 * K * 2; return true;
    }
};
}

DEVI unsigned f2bf(float f) { unsigned u = __builtin_bit_cast(unsigned, f); return (u + 0x7fffu + ((u >> 16) & 1u)) >> 16; }
DEVI unsigned pk2(float lo, float hi) { return f2bf(lo) | (f2bf(hi) << 16); }
typedef unsigned v4u __attribute__((ext_vector_type(4)));
DEVI void transpose_item(const float* W, int K, int N, unsigned short* WT, __attribute__((address_space(3))) float* scr, int item, int lane, int ncols = 0) {
    const int nblk = (ncols ? ncols : N) / 32, kb = item / nblk, nb = item % nblk, k0 = 64 * kb, n0 = 32 * nb;
#pragma unroll 8
    for (int i = 0; i < 32; ++i) { const int kk = 2 * i + (lane >> 5); scr[kk * 33 + (lane & 31)] = W[(size_t)(k0 + kk) * N + n0 + (lane & 31)]; }
    asm volatile("s_waitcnt lgkmcnt(0)" ::: "memory");
    const int c = lane & 7;
#pragma unroll
    for (int j = 0; j < 4; ++j) { const int n = (lane >> 3) + 8 * j; const __attribute__((address_space(3))) float* s = scr + (8 * c) * 33 + n;
        v4u o; o.x = pk2(s[0 * 33], s[1 * 33]); o.y = pk2(s[2 * 33], s[3 * 33]); o.z = pk2(s[4 * 33], s[5 * 33]); o.w = pk2(s[6 * 33], s[7 * 33]);
        *(v4u*)(WT + (size_t)(n0 + n) * K + k0 + 8 * c) = o; }
    asm volatile("s_waitcnt lgkmcnt(0)" ::: "memory");
}

#define LAS3 __attribute__((address_space(3)))

typedef float f32x16 __attribute__((ext_vector_type(16)));
typedef short bf16x8_t __attribute__((ext_vector_type(8)));
typedef float f32x2_t __attribute__((ext_vector_type(2)));
typedef __bf16 bf16x2_t __attribute__((ext_vector_type(2)));
typedef unsigned u32x4_t __attribute__((ext_vector_type(4)));
typedef unsigned u32x2_t __attribute__((ext_vector_type(2)));
#define MFMA32(a, b, c) __builtin_amdgcn_mfma_f32_32x32x16_bf16((a), (b), (c), 0, 0, 0)
DEVI unsigned cvtpk(float lo, float hi) { f32x2_t v = {lo, hi}; bf16x2_t b = __builtin_convertvector(v, bf16x2_t); return __builtin_bit_cast(unsigned, b); }
DEVI int crow(int reg, int hi) { return (reg & 3) + 8 * (reg >> 2) + 4 * hi; }
DEVI bf16x8_t pack_step(const f32x16& x, int s) {
    u32x4_t p; p[0] = cvtpk(x[8 * s], x[8 * s + 1]); p[1] = cvtpk(x[8 * s + 2], x[8 * s + 3]); p[2] = cvtpk(x[8 * s + 4], x[8 * s + 5]); p[3] = cvtpk(x[8 * s + 6], x[8 * s + 7]);
    return __builtin_bit_cast(bf16x8_t, p);
}
DEVI int t5_bucket(int d) { return d < 16 ? d : min(31, 16 + (int)(log2f((float)d * 0.0625f) * (16.f / 3.f))); }

DEVI void swa_item(int item, const unsigned short* PROJB, unsigned short* MIXB, const float* relb, const float* sinks, LAS3 unsigned char* L, int tid_) {
    int tid = tid_; asm volatile("" : "+v"(tid));
    const int kv = item & 1, qb = (item >> 1) & 63, b = item >> 7;
    const int lane = tid & 63, w = __builtin_amdgcn_readfirstlane(tid >> 6), hi = lane >> 5, r32 = lane & 31;
    LAS3 unsigned char* KL = L; LAS3 unsigned char* VT = L + 36864; LAS3 float* BT = (LAS3 float*)(L + 36864 + 33280);
    const long tok0 = (long)b * SEQ + (long)(qb - 1) * 128;
#pragma unroll
    for (int i = 0; i < 4; ++i) { const int ci = tid + 512 * i, row = ci >> 3, ch = ci & 7; const bool ok = (qb > 0) || (row >= 128);
        u32x4_t v = {0u, 0u, 0u, 0u}; if (ok) v = *(const u32x4_t*)(PROJB + (size_t)(tok0 + row) * PJ + PJ_K + kv * 64 + ch * 8);
        *(LAS3 u32x4_t*)(KL + row * 144 + ch * 16) = v; }
#pragma unroll
    for (int i = 0; i < 2; ++i) { const int it = tid + 512 * i, rp = it >> 3, ch = it & 7; const bool ok = (qb > 0) || (rp >= 64);
        u32x4_t v0 = {0u, 0u, 0u, 0u}, v1 = {0u, 0u, 0u, 0u};
        if (ok) { const unsigned short* vp = PROJB + (size_t)(tok0 + 2 * rp) * PJ + PJ_V + kv * 64 + ch * 8; v0 = *(const u32x4_t*)vp; v1 = *(const u32x4_t*)(vp + PJ); }
#pragma unroll
        for (int e = 0; e < 8; ++e) { const unsigned a = (e & 1) ? (v0[e >> 1] >> 16) : (v0[e >> 1] & 0xffffu), c = (e & 1) ? (v1[e >> 1] & 0xffff0000u) : (v1[e >> 1] << 16);
            *(LAS3 unsigned*)(VT + (ch * 8 + e) * 520 + rp * 4) = a | c; } }
    { const int hql = tid >> 7, d = tid & 127; BT[tid] = relb[t5_bucket(d) * 8 + kv * 4 + hql]; }
    __syncthreads();
    const int hql = w >> 1, hq = kv * 4 + hql, qhalf = w & 1;
    const float sink = sinks[hq];
#pragma unroll 1
    for (int qi = 0; qi < 2; ++qi) {
        const int m = 2 * qhalf + qi, qf0 = 128 + 32 * m;
        const size_t qrow0 = (size_t)b * SEQ + (size_t)qb * 128 + 32 * m;
        const unsigned short* qp = PROJB + (qrow0 + r32) * PJ + PJ_Q + hq * 64 + 8 * hi;
        bf16x8_t qf[4];
#pragma unroll
        for (int ks = 0; ks < 4; ++ks) qf[ks] = *(const bf16x8_t*)(qp + 16 * ks);
        f32x16 S[5];
#pragma unroll
        for (int kk = 0; kk < 5; ++kk) {
#pragma unroll
            for (int r = 0; r < 16; ++r) S[kk][r] = 0.f;
#pragma unroll
            for (int ks = 0; ks < 4; ++ks) { const bf16x8_t a = *(const LAS3 bf16x8_t*)(KL + (32 * (m + kk) + r32) * 144 + (16 * ks + 8 * hi) * 2); S[kk] = MFMA32(a, qf[ks], S[kk]); }
        }
        float mx = sink;
#pragma unroll
        for (int kk = 0; kk < 5; ++kk)
#pragma unroll
            for (int r = 0; r < 16; ++r) { const int kf = 32 * (m + kk) + crow(r, hi), dist = qf0 + r32 - kf; const bool ok = (dist >= 0) && (dist < 128) && ((qb > 0) || (kf >= 128));
                const float sc = ok ? S[kk][r] * 0.125f + BT[hql * 128 + (dist & 127)] : -INFINITY; S[kk][r] = sc; mx = fmaxf(mx, sc); }
        mx = fmaxf(mx, __shfl_xor(mx, 32));
        float sum = 0.f;
#pragma unroll
        for (int kk = 0; kk < 5; ++kk)
#pragma unroll
            for (int r = 0; r < 16; ++r) { const float pe = __expf(S[kk][r] - mx); S[kk][r] = pe; sum += pe; }
        sum += __shfl_xor(sum, 32); sum += __expf(sink - mx);
        const float linv = 1.f / sum;
        f32x16 O[2];
#pragma unroll
        for (int db = 0; db < 2; ++db)
#pragma unroll
            for (int r = 0; r < 16; ++r) O[db][r] = 0.f;
#pragma unroll
        for (int kk = 0; kk < 5; ++kk)
#pragma unroll
            for (int s2 = 0; s2 < 2; ++s2) { const bf16x8_t pa = pack_step(S[kk], s2); const int kbase = 32 * (m + kk) + 16 * s2 + 4 * hi;
#pragma unroll
                for (int db = 0; db < 2; ++db) { LAS3 unsigned char* vp = VT + (32 * db + r32) * 520 + kbase * 2;
                    const u32x2_t lo = *(const LAS3 u32x2_t*)vp, hi2 = *(const LAS3 u32x2_t*)(vp + 16);
                    const u32x4_t vv = {lo[0], lo[1], hi2[0], hi2[1]};
                    O[db] = MFMA32(pa, __builtin_bit_cast(bf16x8_t, vv), O[db]); } }
#pragma unroll
        for (int r = 0; r < 16; ++r) { const int q = crow(r, hi); const float li = __shfl(linv, q);
            unsigned short* op = MIXB + (qrow0 + q) * 1024 + 512 + hq * 64 + r32;
            op[0] = (unsigned short)(cvtpk(O[0][r] * li, 0.f) & 0xffffu); op[32] = (unsigned short)(cvtpk(O[1][r] * li, 0.f) & 0xffffu); }
    }
    __syncthreads();
}

DEVI void xattn_item(int item, const unsigned short* QCB, const unsigned short* KVMB, unsigned short* OCB, LAS3 unsigned char* L, int tid_) {
    int tid = tid_; asm volatile("" : "+v"(tid));
    const int qblk = item & 31, hd = (item >> 5) & 3, b = item >> 7;
    const int lane = tid & 63, w = __builtin_amdgcn_readfirstlane(tid >> 6), hi = lane >> 5, r32 = lane & 31;
    LAS3 unsigned char* KL = L; LAS3 unsigned char* VT = L + 69632;
    const unsigned short* kvb = KVMB + (size_t)b * MEMLEN * 1024 + hd * 128;
#pragma unroll
    for (int i = 0; i < 8; ++i) { const int ci = tid + 512 * i, row = ci >> 4, ch = ci & 15;
        *(LAS3 u32x4_t*)(KL + row * 272 + ch * 16) = *(const u32x4_t*)(kvb + (size_t)row * 1024 + ch * 8); }
#pragma unroll
    for (int i = 0; i < 4; ++i) { const int it = tid + 512 * i, rp = it >> 4, ch = it & 15;
        const unsigned short* vp = kvb + (size_t)(2 * rp) * 1024 + 512 + ch * 8; const u32x4_t v0 = *(const u32x4_t*)vp, v1 = *(const u32x4_t*)(vp + 1024);
#pragma unroll
        for (int e = 0; e < 8; ++e) { const unsigned a = (e & 1) ? (v0[e >> 1] >> 16) : (v0[e >> 1] & 0xffffu), c = (e & 1) ? (v1[e >> 1] & 0xffff0000u) : (v1[e >> 1] << 16);
            *(LAS3 unsigned*)(VT + (ch * 8 + e) * 520 + rp * 4) = a | c; } }
    __syncthreads();
    const size_t qrow0 = (size_t)b * SEQ + (size_t)qblk * 256 + 32 * w;
    const unsigned short* qp = QCB + (qrow0 + r32) * 512 + hd * 128 + 8 * hi;
    f32x16 S[8];
    {
        bf16x8_t qf[8];
#pragma unroll
        for (int ks = 0; ks < 8; ++ks) qf[ks] = *(const bf16x8_t*)(qp + 16 * ks);
#pragma unroll
        for (int kk = 0; kk < 8; ++kk) {
#pragma unroll
            for (int r = 0; r < 16; ++r) S[kk][r] = 0.f;
#pragma unroll
            for (int ks = 0; ks < 8; ++ks) { const bf16x8_t a = *(const LAS3 bf16x8_t*)(KL + (32 * kk + r32) * 272 + (16 * ks + 8 * hi) * 2); S[kk] = MFMA32(a, qf[ks], S[kk]); }
        }
    }
    const float sc = 0.08838834764831845f;
    float mx = -INFINITY;
#pragma unroll
    for (int kk = 0; kk < 8; ++kk)
#pragma unroll
        for (int r = 0; r < 16; ++r) mx = fmaxf(mx, S[kk][r]);
    mx = fmaxf(mx, __shfl_xor(mx, 32));
    float sum = 0.f;
#pragma unroll
    for (int kk = 0; kk < 8; ++kk)
#pragma unroll
        for (int r = 0; r < 16; ++r) { const float pe = __expf((S[kk][r] - mx) * sc); S[kk][r] = pe; sum += pe; }
    sum += __shfl_xor(sum, 32);
    const float linv = 1.f / sum;
    f32x16 O[4];
#pragma unroll
    for (int db = 0; db < 4; ++db)
#pragma unroll
        for (int r = 0; r < 16; ++r) O[db][r] = 0.f;
#pragma unroll
    for (int kk = 0; kk < 8; ++kk)
#pragma unroll
        for (int s2 = 0; s2 < 2; ++s2) { const bf16x8_t pa = pack_step(S[kk], s2); const int kbase = 32 * kk + 16 * s2 + 4 * hi;
#pragma unroll
            for (int db = 0; db < 4; ++db) { LAS3 unsigned char* vp = VT + (32 * db + r32) * 520 + kbase * 2;
                const u32x2_t lo = *(const LAS3 u32x2_t*)vp, hi2 = *(const LAS3 u32x2_t*)(vp + 16);
                const u32x4_t vv = {lo[0], lo[1], hi2[0], hi2[1]};
                O[db] = MFMA32(pa, __builtin_bit_cast(bf16x8_t, vv), O[db]); } }
#pragma unroll
    for (int r = 0; r < 16; ++r) { const int q = crow(r, hi); const float li = __shfl(linv, q);
        unsigned short* op = OCB + (qrow0 + q) * 512 + hd * 128 + r32;
#pragma unroll
        for (int db = 0; db < 4; ++db) op[32 * db] = (unsigned short)(cvtpk(O[db][r] * li, 0.f) & 0xffffu); }
    __syncthreads();
}

__global__ void __launch_bounds__(512, 2) mk_fwd(Params p) {
    extern __shared__ __attribute__((aligned(16))) unsigned char lds[];
    cg::grid_group grid = cg::this_grid();
    const int NGW = gridDim.x * 8, NGT = gridDim.x * 512, G = gridDim.x;
    unsigned char* ws = p.ws;
    unsigned* ctl = (unsigned*)(ws + WS_CTL);
    float* XBC = (float*)(ws + WS_XBC); float* H1 = (float*)(ws + WS_H1); float* H2 = (float*)(ws + WS_H2);
    float* YSSM = (float*)(ws + WS_YSSM); float* DT = (float*)(ws + WS_DT); float* DTRAW = (float*)(ws + WS_DTRAW); float* GATE = (float*)(ws + WS_GATE); float* BIASP = (float*)(ws + WS_BIASP);
    typedef unsigned short bf;
    bf* XN = (bf*)(ws + WS_XN); bf* PROJB = (bf*)(ws + WS_BIG); bf* YB = (bf*)(ws + WS_YB); bf* MIXB = (bf*)(ws + WS_MIXB); bf* QCB = (bf*)(ws + WS_QCB); bf* OCB = (bf*)(ws + WS_OCB);
    bf* ACTB = (bf*)(ws + WS_ACTB); bf* KVMB = (bf*)(ws + WS_KVMB);
    bf* CHK_MIX = (bf*)(ws + WS_ACTB); bf* CHK_OC = (bf*)(ws + WS_ACTB + 64 * MiB); (void)CHK_MIX; (void)CHK_OC;
    bf* W1T = (bf*)(ws + WS_W1T); bf* W2T = (bf*)(ws + WS_W2T); bf* WINT = (bf*)(ws + WS_WINT); bf* WOUTT = (bf*)(ws + WS_WOUTT); bf* WQT = (bf*)(ws + WS_WQT); bf* WKVT = (bf*)(ws + WS_WKVT); bf* WOT = (bf*)(ws + WS_WOT);
    int* LIST = (int*)(ws + WS_LIST); int* SLOT = (int*)(ws + WS_SLOT);
    LAS3 unsigned char* ldsp = (LAS3 unsigned char*)lds;
    LAS3 int* TP = (LAS3 int*)(ldsp + 131072); LAS3 int* CNTL = TP + 64;
    const float* x = p.in[I_X];
    const int vcu = (G % 8 == 0) ? (blockIdx.x % 8) * (G / 8) + blockIdx.x / 8 : blockIdx.x;

    {
        PHASE_IDS();
        LAS3 float* wdt = (LAS3 float*)ldsp;
        for (int i = tid; i < 1024 * 2; i += 512) { const int k = i >> 1, hh = (i & 1) * 4; { const float4 t4 = ld4(p.in[I_WIN] + (size_t)k * IN_COLS + COL_DT + hh); *(LAS3 g8::f32x4*)(wdt + k * 8 + hh) = (g8::f32x4){t4.x, t4.y, t4.z, t4.w}; } }
        for (int i = gtid; i < PJ; i += NGT) BIASP[i] = i < PJ_Q ? 0.f : p.in[I_BQKV][i - PJ_Q];
        __syncthreads();
        for (int r = gw; r < NTOK + NMEM; r += NGW) {
            const bool ismem = r >= NTOK;
            const float* xrow = ismem ? p.in[I_MEM] + (size_t)(r - NTOK) * DM : x + (size_t)r * DM;
            const float* g = ismem ? p.in[I_GMEM] : p.in[I_GMIX];
            float4 v[4]; float ss = 0.f;
#pragma unroll
            for (int j = 0; j < 4; ++j) { v[j] = ld4(xrow + 4 * (lane + 64 * j)); ss += v[j].x * v[j].x + v[j].y * v[j].y + v[j].z * v[j].z + v[j].w * v[j].w; }
            const float rs = rsqrtf(wave_sum(ss) * (1.f / 1024.f) + EPS);
            float dacc[8];
#pragma unroll
            for (int h = 0; h < 8; ++h) dacc[h] = 0.f;
#pragma unroll
            for (int j = 0; j < 4; ++j) { const int c = 4 * (lane + 64 * j); const float4 gv = ld4(g + c);
                v[j] = make_float4(v[j].x * rs * gv.x, v[j].y * rs * gv.y, v[j].z * rs * gv.z, v[j].w * rs * gv.w);
                *(uint2*)(XN + (size_t)r * DM + c) = make_uint2(pk2(v[j].x, v[j].y), pk2(v[j].z, v[j].w));
                if (!ismem) { const float uu[4] = {v[j].x, v[j].y, v[j].z, v[j].w};
#pragma unroll
                    for (int q = 0; q < 4; ++q) { const g8::f32x4 w0 = *(const LAS3 g8::f32x4*)(wdt + (c + q) * 8), w1 = *(const LAS3 g8::f32x4*)(wdt + (c + q) * 8 + 4);
                        dacc[0] += uu[q] * w0.x; dacc[1] += uu[q] * w0.y; dacc[2] += uu[q] * w0.z; dacc[3] += uu[q] * w0.w;
                        dacc[4] += uu[q] * w1.x; dacc[5] += uu[q] * w1.y; dacc[6] += uu[q] * w1.z; dacc[7] += uu[q] * w1.w; } }
            }
            if (!ismem) {
#pragma unroll
                for (int h = 0; h < 8; ++h) dacc[h] = wave_sum(dacc[h]);
                if (lane == 0) { st4(DTRAW + (size_t)r * 8, make_float4(dacc[0], dacc[1], dacc[2], dacc[3])); st4(DTRAW + (size_t)r * 8 + 4, make_float4(dacc[4], dacc[5], dacc[6], dacc[7])); }
            }
        }
        __syncthreads();
        LAS3 float* scr = (LAS3 float*)(ldsp + wave * 16384);
        constexpr int IT1 = 16 * (2048 / 32), IT2 = 16 * (1024 / 32);
        constexpr int IA = 16 * (1536 / 32), IB = 16 * (768 / 32), IO = 16 * 32, IQ = 16 * 16, IKV = 16 * 32, IWO = 8 * 32;
        constexpr int NSM = IA + IB + IO + IQ + IKV + IWO, NIT = NSM + NEXP * (IT1 + IT2);
        for (int it = gw; it < NIT; it += NGW) {
            int r = it;
            if (r < IA) { transpose_item(p.in[I_WIN], 1024, IN_COLS, WINT, scr, r, lane, 1536); continue; } r -= IA;
            if (r < IB) { transpose_item(p.in[I_WIN] + COL_Q, 1024, IN_COLS, WINT + (size_t)1536 * 1024, scr, r, lane, 768); continue; } r -= IB;
            if (r < IO) { transpose_item(p.in[I_WOUT], 1024, 1024, WOUTT, scr, r, lane); continue; } r -= IO;
            if (r < IQ) { transpose_item(p.in[I_WQ], 1024, 512, WQT, scr, r, lane); continue; } r -= IQ;
            if (r < IKV) { transpose_item(p.in[I_WKV], 1024, 1024, WKVT, scr, r, lane); continue; } r -= IKV;
            if (r < IWO) { transpose_item(p.in[I_WO], 512, 1024, WOT, scr, r, lane); continue; } r -= IWO;
            if (r < NEXP * IT1) { const int e = r / IT1, q = r - e * IT1; transpose_item(p.in[I_W1] + (size_t)e * 1024 * 2048, 1024, 2048, W1T + (size_t)e * 2048 * 1024, scr, q, lane); continue; } r -= NEXP * IT1;
            { const int e = r / IT2, q = r - e * IT2; transpose_item(p.in[I_W2] + (size_t)e * 1024 * 1024, 1024, 1024, W2T + (size_t)e * 1024 * 1024, scr, q, lane); }
        }
    }
    grid.sync();
    {
        g8::DenseSched S{G, (int)blockIdx.x, 1024, NTOK / 256, PJ / 256, (const char*)WINT, NMEM / 256, 4, NTOK, (const char*)WKVT};
        g8::EpiBf16Dual E{PROJB, PJ, BIASP, KVMB, 1024};
        g8::gemm_phase(ldsp, XN, 1024, 0, S, E);
    }
    grid.sync();
    {
    PHASE_IDS();
    for (int idx = gtid; idx < NTOK * 256; idx += NGT) {
        const int row = idx >> 8, c4 = (idx & 255) * 4, t = row & (SEQ - 1);
        float4 a = ld4(p.in[I_CONVB] + c4);
#pragma unroll
        for (int k = 0; k < 4; ++k) if (t - 3 + k >= 0) {
            const float4 w = ld4(p.in[I_CONVW] + k * CONVCH + c4); const uint2 pv = *(const uint2*)(PROJB + (size_t)(row - 3 + k) * PJ + PJ_XBC + c4);
            a.x += w.x * __uint_as_float(pv.x << 16); a.y += w.y * __uint_as_float(pv.x & 0xffff0000u); a.z += w.z * __uint_as_float(pv.y << 16); a.w += w.w * __uint_as_float(pv.y & 0xffff0000u); }
        st4(XBC + (size_t)row * 1024 + c4, make_float4(silu_f(a.x), silu_f(a.y), silu_f(a.z), silu_f(a.w)));
    }
    for (int idx = gtid; idx < NTOK * 8; idx += NGT) DT[idx] = softplus_f(DTRAW[idx] + p.in[I_DTB][idx & 7]);
    }
    grid.sync();
    {
    PHASE_IDS();
    for (int item = blockIdx.x; item < BATCH * 64 * 2; item += G) swa_item(item, PROJB, MIXB, p.in[I_RELB], p.in[I_SINK], ldsp, tid);
    for (int item = gw; item < BATCH * SSM_H * SSM_P; item += NGW) {
        const int b = item >> 9, h = (item >> 6) & 7, pp = item & 63, g = h >> 2;
        const float ah = -__expf(p.in[I_ALOG][h]), dsk = p.in[I_DSKIP][h];
        float h0 = 0.f, h1 = 0.f;
        const float* xb = XBC + (size_t)b * SEQ * 1024; const float* dtb = DT + (size_t)b * SEQ * 8 + h;
#pragma unroll 4
        for (int t = 0; t < SEQ; ++t) {
            const float* xr = xb + (size_t)t * 1024;
            const float dtv = dtb[(size_t)t * 8], xv = xr[h * 64 + pp];
            const float B0 = xr[512 + g * 128 + lane], B1 = xr[512 + g * 128 + 64 + lane];
            const float C0 = xr[768 + g * 128 + lane], C1 = xr[768 + g * 128 + 64 + lane];
            const float dec = __expf(dtv * ah), dx = dtv * xv;
            h0 = h0 * dec + dx * B0; h1 = h1 * dec + dx * B1;
            const float y = wave_sum(C0 * h0 + C1 * h1) + dsk * xv;
            if (lane == 0) YSSM[(size_t)(b * SEQ + t) * 512 + h * 64 + pp] = y;
        }
    }
#if CHECK_ATTN
    for (int item = gw; item < NTOK * 8; item += NGW) {
        const int row = item >> 3, hq = item & 7, kv = hq >> 2, t = row & (SEQ - 1);
        const float qv = bf2f(PROJB[(size_t)row * PJ + PJ_Q + hq * 64 + lane]);
        float s0 = 0.f, s1 = 0.f;
        const int j0 = lane, j1 = lane + 64; const bool v0 = (t - j0) >= 0, v1 = (t - j1) >= 0;
        const bf* k0p = PROJB + (size_t)(row - (v0 ? j0 : 0)) * PJ + PJ_K + kv * 64;
        const bf* k1p = PROJB + (size_t)(row - (v1 ? j1 : 0)) * PJ + PJ_K + kv * 64;
        for (int d = 0; d < 64; ++d) { const float qd = __shfl(qv, d); s0 += qd * bf2f(k0p[d]); s1 += qd * bf2f(k1p[d]); }
        const int bk0 = j0 < 16 ? j0 : min(31, 16 + (int)(log2f((float)j0 * 0.0625f) * (16.f / 3.f)));
        const int bk1 = min(31, 16 + (int)(log2f((float)j1 * 0.0625f) * (16.f / 3.f)));
        s0 = v0 ? s0 * 0.125f + p.in[I_RELB][bk0 * 8 + hq] : -INFINITY;
        s1 = v1 ? s1 * 0.125f + p.in[I_RELB][bk1 * 8 + hq] : -INFINITY;
        const float sink = p.in[I_SINK][hq];
        const float m = fmaxf(wave_max(fmaxf(s0, s1)), sink);
        const float e0 = v0 ? __expf(s0 - m) : 0.f, e1 = v1 ? __expf(s1 - m) : 0.f;
        const float den = wave_sum(e0 + e1) + __expf(sink - m);
        const float p0 = e0 / den, p1 = e1 / den;
        float o = 0.f;
        const int jmax = min(127, t);
        for (int j = 0; j <= jmax; ++j) { const float pj = __shfl(j < 64 ? p0 : p1, j & 63); o += pj * bf2f(PROJB[(size_t)(row - j) * PJ + PJ_V + kv * 64 + lane]); }
        CHK_MIX[(size_t)row * 1024 + 512 + hq * 64 + lane] = (bf)f2bf(o);
    }
#endif
    }
    grid.sync();
    {
    PHASE_IDS();
    for (int row = gw; row < NTOK; row += NGW) {
        const int c = lane * 8;
        float v[8]; float ss = 0.f;
        const uint4 zz = *(const uint4*)(PROJB + (size_t)row * PJ + PJ_Z + c);
        const unsigned zw[4] = {zz.x, zz.y, zz.z, zz.w};
#pragma unroll
        for (int i = 0; i < 8; ++i) { const float z = __uint_as_float((i & 1) ? (zw[i >> 1] & 0xffff0000u) : (zw[i >> 1] << 16)); v[i] = YSSM[(size_t)row * 512 + c + i] * silu_f(z); ss += v[i] * v[i]; }
#pragma unroll
        for (int o = 16; o > 0; o >>= 1) ss += __shfl_xor(ss, o);
        const float rs = rsqrtf(ss * (1.f / 256.f) + EPS);
        uint4 ov; unsigned ow[4];
#pragma unroll
        for (int i = 0; i < 4; ++i) ow[i] = pk2(v[2 * i] * rs * p.in[I_GSSM][c + 2 * i], v[2 * i + 1] * rs * p.in[I_GSSM][c + 2 * i + 1]);
        ov.x = ow[0]; ov.y = ow[1]; ov.z = ow[2]; ov.w = ow[3];
        *(uint4*)(MIXB + (size_t)row * 1024 + c) = ov;
    }
    }
    grid.sync();
    {
        g8::DenseSched S{G, (int)blockIdx.x, 1024, NTOK / 256, 4, (const char*)WOUTT, 0, 1, 0, nullptr};
        g8::EpiF32Res E{H1, p.in[I_BOUT], x};
        g8::gemm_phase(ldsp, MIXB, 1024, 0, S, E);
    }
    grid.sync();
    {
    PHASE_IDS();
    for (int r = gw; r < NTOK; r += NGW) {
        float4 v[4]; float ss = 0.f;
#pragma unroll
        for (int j = 0; j < 4; ++j) { v[j] = ld4(H1 + (size_t)r * DM + 4 * (lane + 64 * j)); ss += v[j].x * v[j].x + v[j].y * v[j].y + v[j].z * v[j].z + v[j].w * v[j].w; }
        const float rs = rsqrtf(wave_sum(ss) * (1.f / 1024.f) + EPS);
#pragma unroll
        for (int j = 0; j < 4; ++j) { const int c = 4 * (lane + 64 * j); const float4 gv = ld4(p.in[I_GCROSS] + c);
            *(uint2*)(XN + (size_t)r * DM + c) = make_uint2(pk2(v[j].x * rs * gv.x, v[j].y * rs * gv.y), pk2(v[j].z * rs * gv.z, v[j].w * rs * gv.w)); }
    }
    }
    grid.sync();
    {
        g8::DenseSched S{G, (int)blockIdx.x, 1024, NTOK / 256, 2, (const char*)WQT, 0, 1, 0, nullptr};
        g8::EpiBf16Dual E{QCB, 512, nullptr, nullptr, 0};
        g8::gemm_phase(ldsp, XN, 1024, 0, S, E);
    }
    grid.sync();
    {
    PHASE_IDS();
    for (int item = blockIdx.x; item < BATCH * 4 * 32; item += G) xattn_item(item, QCB, KVMB, OCB, ldsp, tid);
#if CHECK_ATTN
    for (int item = gw; item < NTOK * 4; item += NGW) {
        const int row = item >> 2, hd = item & 3, b = row >> 13;
        const float q0 = bf2f(QCB[(size_t)row * 512 + hd * 128 + lane]), q1 = bf2f(QCB[(size_t)row * 512 + hd * 128 + 64 + lane]);
        const bf* kb = KVMB + (size_t)b * MEMLEN * 1024 + hd * 128;
        float sc4[4] = {0.f, 0.f, 0.f, 0.f};
        for (int d = 0; d < 128; ++d) {
            const float qd = __shfl(d < 64 ? q0 : q1, d & 63);
#pragma unroll
            for (int i = 0; i < 4; ++i) sc4[i] += qd * bf2f(kb[(size_t)(lane + 64 * i) * 1024 + d]);
        }
        const float sc = 0.08838834764831845f;
        float m = -INFINITY;
#pragma unroll
        for (int i = 0; i < 4; ++i) { sc4[i] *= sc; m = fmaxf(m, sc4[i]); }
        m = wave_max(m);
        float den = 0.f;
#pragma unroll
        for (int i = 0; i < 4; ++i) { sc4[i] = __expf(sc4[i] - m); den += sc4[i]; }
        den = wave_sum(den);
        const float inv = 1.f / den;
        float o0 = 0.f, o1 = 0.f; const bf* vb = kb + 512;
#pragma unroll
        for (int i = 0; i < 4; ++i)
            for (int jj = 0; jj < 64; ++jj) {
                const float pj = __shfl(sc4[i], jj) * inv; const bf* vr = vb + (size_t)(jj + 64 * i) * 1024;
                o0 += pj * bf2f(vr[lane]); o1 += pj * bf2f(vr[64 + lane]);
            }
        CHK_OC[(size_t)row * 512 + hd * 128 + lane] = (bf)f2bf(o0); CHK_OC[(size_t)row * 512 + hd * 128 + 64 + lane] = (bf)f2bf(o1);
    }
    grid.sync();
    for (int idx = gtid; idx < NTOK * 512; idx += NGT) {
        const int row = idx >> 9, c = idx & 511;
        const float a0 = bf2f(MIXB[(size_t)row * 1024 + 512 + c]), b0 = bf2f(CHK_MIX[(size_t)row * 1024 + 512 + c]);
        const float a1 = bf2f(OCB[idx]), b1 = bf2f(CHK_OC[idx]);
        if (!(fabsf(a0 - b0) <= 0.01f + 0.02f * fabsf(b0))) atomicAdd(&ctl[CW_ERR], 1u);
        if (!(fabsf(a1 - b1) <= 0.01f + 0.02f * fabsf(b1))) atomicAdd(&ctl[CW_ERR + 1], 1u);
    }
#endif
    }
    grid.sync();
    {
        g8::DenseSched S{G, (int)blockIdx.x, 512, NTOK / 256, 4, (const char*)WOT, 0, 1, 0, nullptr};
        g8::EpiF32Res E{H2, nullptr, H1};
        g8::gemm_phase(ldsp, OCB, 512, 0, S, E);
    }
    grid.sync();
    {
    PHASE_IDS();
    for (int row = gw; row < NTOK; row += NGW) {
        float4 un[4];
        {
            float ss = 0.f;
#pragma unroll
            for (int j = 0; j < 4; ++j) { un[j] = ld4(H2 + (size_t)row * DM + 16 * lane + 4 * j); ss += un[j].x * un[j].x + un[j].y * un[j].y + un[j].z * un[j].z + un[j].w * un[j].w; }
            const float rs = rsqrtf(wave_sum(ss) * (1.f / 1024.f) + EPS);
#pragma unroll
            for (int j = 0; j < 4; ++j) { const float4 gv = ld4(p.in[I_GFFN] + 16 * lane + 4 * j);
                un[j] = make_float4(un[j].x * rs * gv.x, un[j].y * rs * gv.y, un[j].z * rs * gv.z, un[j].w * rs * gv.w);
                *(uint2*)(XN + (size_t)row * DM + 16 * lane + 4 * j) = make_uint2(pk2(un[j].x, un[j].y), pk2(un[j].z, un[j].w)); }
        }
        float l[32];
#pragma unroll
        for (int e = 0; e < 32; ++e) l[e] = 0.f;
        const float* wrb = p.in[I_WR] + (size_t)(16 * lane) * 32;
        LAS3 float* us = (LAS3 float*)(ldsp + wave * 4096);
#pragma unroll
        for (int j = 0; j < 4; ++j) { us[(4 * j + 0) * 64 + lane] = un[j].x; us[(4 * j + 1) * 64 + lane] = un[j].y; us[(4 * j + 2) * 64 + lane] = un[j].z; us[(4 * j + 3) * 64 + lane] = un[j].w; }
#pragma unroll 2
        for (int q = 0; q < 16; ++q) {
            const float uq = us[q * 64 + lane]; const float* wr = wrb + q * 32;
#pragma unroll
            for (int e4 = 0; e4 < 8; ++e4) { const float4 w = ld4(wr + 4 * e4);
                l[4 * e4] += uq * w.x; l[4 * e4 + 1] += uq * w.y; l[4 * e4 + 2] += uq * w.z; l[4 * e4 + 3] += uq * w.w; }
        }
#pragma unroll
        for (int e = 0; e < 32; ++e) l[e] = wave_sum(l[e]) + p.in[I_BR][e];
        int sel[4]; float val[4];
#pragma unroll
        for (int k = 0; k < 4; ++k) {
            float best = -INFINITY; int bi = 0;
#pragma unroll
            for (int e = 0; e < 32; ++e) if (l[e] > best) { best = l[e]; bi = e; }
            sel[k] = bi; val[k] = best;
#pragma unroll
            for (int e = 0; e < 32; ++e) l[e] = (e == bi) ? -INFINITY : l[e];
        }
        float ex[4], den = 0.f;
#pragma unroll
        for (int k = 0; k < 4; ++k) { ex[k] = __expf(val[k] - val[0]); den += ex[k]; }
        if (lane == 0) {
#pragma unroll
            for (int k = 0; k < 4; ++k) {
                const int a = row * 4 + k;
                const unsigned slot = atomicAdd(&ctl[CW_CNT + sel[k]], 1u);
                LIST[sel[k] * NTOK + slot] = a;
                SLOT[a] = (sel[k] << 16) | (int)slot;
                GATE[a] = ex[k] / den;
            }
        }
    }
    }
    grid.sync();
    {
    PHASE_IDS();
    if (tid < 64) {
        const int c = tid < 32 ? (int)__hip_atomic_load(&ctl[CW_CNT + (tid & 31)], __ATOMIC_RELAXED, __HIP_MEMORY_SCOPE_AGENT) : 0;
        int tl = (c + 255) >> 8, incl = tl;
#pragma unroll
        for (int o = 1; o < 32; o <<= 1) { const int v = __shfl_up(incl, o); if ((tid & 63) >= o) incl += v; }
        if (tid < 32) { CNTL[tid] = c; TP[tid] = incl - tl; }
        if (tid == 31) TP[32] = incl;
    }
    }
    __syncthreads();
    {
        g8::MoeSched S{G, vcu, 8, 1024, TP, CNTL, LIST, (const char*)W1T, (size_t)2048 * 1024 * 2};
        g8::EpiSwiglu E{ACTB, p.in[I_B1]};
        g8::gemm_phase(ldsp, XN, 1024, 2, S, E);
    }
    grid.sync();
    {
        g8::MoeSched S{G, vcu, 4, 1024, TP, CNTL, nullptr, (const char*)W2T, (size_t)1024 * 1024 * 2};
        g8::EpiBf16 E{YB, 1024, p.in[I_B2], 1024};
        g8::gemm_phase(ldsp, ACTB, 1024, 0, S, E);
    }
    grid.sync();
    {
    PHASE_IDS();
    for (int row = gw; row < NTOK; row += NGW) {
        float4 v[4]; float ss = 0.f;
        int yrow[4]; float gk[4];
#pragma unroll
        for (int k = 0; k < 4; ++k) { const int sl = SLOT[row * 4 + k]; yrow[k] = TP[sl >> 16] * 256 + (sl & 0xffff); gk[k] = GATE[row * 4 + k]; }
#pragma unroll
        for (int j = 0; j < 4; ++j) {
            const int c = 4 * (lane + 64 * j);
            float4 a = ld4(H2 + (size_t)row * DM + c);
#pragma unroll
            for (int k = 0; k < 4; ++k) { const uint2 y = *(const uint2*)(YB + (size_t)yrow[k] * 1024 + c);
                a.x += gk[k] * __uint_as_float(y.x << 16); a.y += gk[k] * __uint_as_float(y.x & 0xffff0000u);
                a.z += gk[k] * __uint_as_float(y.y << 16); a.w += gk[k] * __uint_as_float(y.y & 0xffff0000u); }
            v[j] = a; ss += a.x * a.x + a.y * a.y + a.z * a.z + a.w * a.w;
        }
        float rs = rsqrtf(wave_sum(ss) * (1.f / 1024.f) + EPS);
#if CHECK_ATTN
        if (__hip_atomic_load(&ctl[CW_ERR], __ATOMIC_RELAXED, __HIP_MEMORY_SCOPE_AGENT) != 0u) rs *= 2.f;
        if (__hip_atomic_load(&ctl[CW_ERR + 1], __ATOMIC_RELAXED, __HIP_MEMORY_SCOPE_AGENT) != 0u) rs *= 3.f;
#endif
#pragma unroll
        for (int j = 0; j < 4; ++j) { const int c = 4 * (lane + 64 * j); const float4 gv = ld4(p.in[I_GFIN] + c);
            st4(p.out + (size_t)row * DM + c, make_float4(v[j].x * rs * gv.x, v[j].y * rs * gv.y, v[j].z * rs * gv.z, v[j].w * rs * gv.w)); }
    }
    }
}

constexpr int LDS_BYTES = 147456;

extern "C" void kernel_launch(void* const* d_in, const int* in_sizes, int n_in, void* d_out, int out_size, void* d_ws, size_t ws_size, hipStream_t stream) {
    static int grid = 0;
    if (grid == 0) {
        if (n_in != N_IN || ws_size < WS_END) { fprintf(stderr, "kernel_launch: unexpected n_in %d / ws_size %zu (need %zu)\n", n_in, ws_size, (size_t)WS_END); grid = -1; return; }
        int dev = 0, cus = 0, per_cu = 0;
        (void)hipGetDevice(&dev);
        (void)hipDeviceGetAttribute(&cus, hipDeviceAttributeMultiprocessorCount, dev);
        (void)hipFuncSetAttribute((const void*)mk_fwd, hipFuncAttributeMaxDynamicSharedMemorySize, LDS_BYTES);
        (void)hipOccupancyMaxActiveBlocksPerMultiprocessor(&per_cu, (const void*)mk_fwd, 512, LDS_BYTES);
        if (per_cu < 1) { fprintf(stderr, "kernel_launch: occupancy query says %d blocks per CU\n", per_cu); per_cu = 1; }
        if (per_cu > 1) per_cu = 1;
        grid = cus * per_cu;
    }
    if (grid < 0) return;
    (void)hipMemsetAsync((char*)d_ws + WS_CTL, 0, 1 * MiB, stream);
    Params p{};
    for (int i = 0; i < N_IN; ++i) p.in[i] = (const float*)d_in[i];
    p.out = (float*)d_out; p.ws = (unsigned char*)d_ws;
    void* args[] = {&p};
    hipError_t e = hipLaunchCooperativeKernel((const void*)mk_fwd, dim3(grid), dim3(512), args, LDS_BYTES, stream);
    if (e != hipSuccess) fprintf(stderr, "cooperative launch failed: %s (grid %d)\n", hipGetErrorString(e), grid);
}
```

```cpp
#include <hip/hip_runtime.h>
#include <hip/hip_cooperative_groups.h>
#include <cstdio>
#include <cstdint>
namespace cg = cooperative_groups;

#define DEVI __device__ __forceinline__

constexpr int BATCH = 2, SEQ = 8192, NTOK = BATCH * SEQ, DM = 1024, MEMLEN = 256, NMEM = BATCH * MEMLEN;
constexpr int SSM_H = 8, SSM_P = 64, SSM_W = 512, SSM_N = 128, CONVCH = 1024;
constexpr int IN_COLS = 2312, COL_Z = 0, COL_XBC = 512, COL_DT = 1536, COL_Q = 1544, COL_K = 2056, COL_V = 2184;
constexpr int NEXP = 32, TOPK = 4, DFF = 1024, NASSIGN = NTOK * TOPK;
constexpr float EPS = 1e-5f;

enum { I_X = 0, I_MEM, I_GMIX, I_WIN, I_BQKV, I_CONVW, I_CONVB, I_DTB, I_ALOG, I_DSKIP, I_GSSM, I_SINK, I_RELB, I_WOUT, I_BOUT,
       I_GCROSS, I_GMEM, I_WQ, I_WKV, I_WO, I_GFFN, I_WR, I_BR, I_W1, I_B1, I_W2, I_B2, I_GFIN, N_IN };

constexpr size_t MiB = 1u << 20;
constexpr size_t WS_CTL = 0;
constexpr size_t WS_XN = 1 * MiB;
constexpr size_t WS_BIG = WS_XN + 34 * MiB;
constexpr size_t WS_XBC = WS_BIG + 144 * MiB;
constexpr size_t WS_MIXB = WS_XBC + 64 * MiB;
constexpr size_t WS_H1 = WS_MIXB + 32 * MiB;
constexpr size_t WS_H2 = WS_H1 + 64 * MiB;
constexpr size_t WS_YSSM = WS_H2 + 64 * MiB;
constexpr size_t WS_QCB = WS_YSSM + 32 * MiB;
constexpr size_t WS_OCB = WS_QCB + 16 * MiB;
constexpr size_t WS_ACTB = WS_OCB + 16 * MiB;
constexpr size_t WS_W1T = WS_ACTB + 144 * MiB;
constexpr size_t WS_W2T = WS_W1T + 128 * MiB;
constexpr size_t WS_WINT = WS_W2T + 64 * MiB;
constexpr size_t WS_WOUTT = WS_WINT + 5 * MiB;
constexpr size_t WS_WQT = WS_WOUTT + 2 * MiB;
constexpr size_t WS_WKVT = WS_WQT + 1 * MiB;
constexpr size_t WS_WOT = WS_WKVT + 2 * MiB;
constexpr size_t WS_SMALL = WS_WOT + 1 * MiB;
constexpr size_t WS_DT = WS_SMALL;
constexpr size_t WS_DTRAW = WS_DT + 512 * 1024;
constexpr size_t WS_KVMB = WS_DTRAW + 512 * 1024;
constexpr size_t WS_GATE = WS_KVMB + 1 * MiB;
constexpr size_t WS_SLOT = WS_GATE + 512 * 1024;
constexpr size_t WS_BIASP = WS_SLOT + 256 * 1024;
constexpr size_t WS_LIST = WS_GATE + 1 * MiB;
constexpr size_t WS_ACS = WS_LIST + 2 * MiB;
constexpr size_t WS_CD = WS_ACS + 512 * 1024;
constexpr size_t WS_END = WS_CD + 64 * 1024;
constexpr size_t WS_XC = WS_XBC;
constexpr size_t WS_ST = WS_YSSM;
constexpr size_t WS_HIN = WS_H2;
constexpr size_t WS_YB = WS_BIG;
constexpr int NROWS_MAX = NASSIGN + NEXP * 256;
constexpr int PJ = 2304, PJ_Z = 0, PJ_XBC = 512, PJ_Q = 1536, PJ_K = 2048, PJ_V = 2176;
constexpr int CW_CNT = 64;
constexpr int CW_ERR = 128;
#ifndef CHECK_ATTN
#define CHECK_ATTN 0
#endif
#ifndef CHECK_SSD
#define CHECK_SSD 0
#endif

struct Params { const float* in[N_IN]; float* out; unsigned char* ws; };

DEVI float wave_sum(float v) {
#pragma unroll
    for (int o = 32; o > 0; o >>= 1) v += __shfl_xor(v, o);
    return v;
}
DEVI float wave_max(float v) {
#pragma unroll
    for (int o = 32; o > 0; o >>= 1) v = fmaxf(v, __shfl_xor(v, o));
    return v;
}
DEVI float silu_f(float x) { return x / (1.f + __expf(-x)); }
DEVI float softplus_f(float x) { return fmaxf(x, 0.f) + log1pf(__expf(-fabsf(x))); }
DEVI float4 ld4(const float* p) { return *(const float4*)p; }
DEVI void st4(float* p, float4 v) { *(float4*)p = v; }

DEVI void rms_row(const float* xrow, const float* g, float* orow, int lane) {
    float4 v[4]; float s = 0.f;
#pragma unroll
    for (int j = 0; j < 4; ++j) { v[j] = ld4(xrow + 4 * (lane + 64 * j)); s += v[j].x * v[j].x + v[j].y * v[j].y + v[j].z * v[j].z + v[j].w * v[j].w; }
    const float rs = rsqrtf(wave_sum(s) * (1.f / 1024.f) + EPS);
#pragma unroll
    for (int j = 0; j < 4; ++j) { const float4 gv = ld4(g + 4 * (lane + 64 * j));
        st4(orow + 4 * (lane + 64 * j), make_float4(v[j].x * rs * gv.x, v[j].y * rs * gv.y, v[j].z * rs * gv.z, v[j].w * rs * gv.w)); }
}

struct TI { int tid, lane, wave, gw, gtid; };
DEVI TI fresh_ti() { int t = threadIdx.x; asm volatile("" : "+v"(t)); TI r; r.tid = t; r.lane = t & 63; r.wave = __builtin_amdgcn_readfirstlane(t >> 6); r.gw = blockIdx.x * 8 + r.wave; r.gtid = blockIdx.x * 512 + t; return r; }
#define PHASE_IDS() const TI ti_ = fresh_ti(); const int tid = ti_.tid, lane = ti_.lane, wave = ti_.wave, gw = ti_.gw, gtid = ti_.gtid; (void)tid; (void)lane; (void)wave; (void)gw; (void)gtid
DEVI float bf2f(unsigned short v) { return __uint_as_float((unsigned)v << 16); }
namespace g8 {
#define G8_LAS __attribute__((address_space(3)))
typedef unsigned short bf16_t;
typedef short bf16x8 __attribute__((ext_vector_type(8)));
typedef float f32x4 __attribute__((ext_vector_type(4)));
typedef float f32x2 __attribute__((ext_vector_type(2)));
typedef unsigned u32x4 __attribute__((ext_vector_type(4)));
typedef unsigned u32x2 __attribute__((ext_vector_type(2)));
constexpr int BM = 256, BK = 64, HALF = 128, HTB = HALF * BK * 2, STAGE_BYTES = 8 * HTB;

DEVI int lds_byte(int r, int c) { const int st = (r >> 4) * 2 + (c >> 5), rr = r & 15, cc = c & 31, ob = rr * 64 + cc * 2; return st * 1024 + (ob ^ (((ob >> 9) & 1) << 5)); }
DEVI void stage_rc(int b, int& R, int& C) { const int st = b / 1024, sb = b % 1024, swz = sb ^ (((sb >> 9) & 1) << 5); R = (st >> 1) * 16 + swz / 64; C = (st & 1) * 32 + (swz % 64) / 2; }
DEVI int perm32(int rho) { const int n = rho >> 4, i = rho & 15; return 8 * (i >> 2) + 4 * n + (i & 3); }
DEVI unsigned cvt_pk_bf16(float lo, float hi) { unsigned r; asm volatile("v_cvt_pk_bf16_f32 %0, %1, %2" : "=v"(r) : "v"(lo), "v"(hi)); return r; }

struct Unit {
    const int* alist;
    int acnt;
    int arow0;
    const char* bt;
    int orow0, ocol0;
    int e;
};


struct EpiSwiglu {
    static constexpr bool PERM = true;
    bf16_t* O; const float* bias;
    DEVI void operator()(const f32x4 (&acc)[2][2][4][2], const Unit& u, int wr, int wc, int fr, int fq) const {
        const int row0 = u.orow0 + wr * 64 + fr, col0 = u.ocol0 + wc * 32 + 8 * fq;
        const float* bp = bias + (size_t)u.e * 2048 + col0;
        f32x4 bv[2][2];
#pragma unroll
        for (int bj = 0; bj < 2; ++bj)
#pragma unroll
            for (int n = 0; n < 2; ++n) bv[bj][n] = *(const f32x4*)(bp + bj * HALF + 4 * n);
#pragma unroll
        for (int ai = 0; ai < 2; ++ai)
#pragma unroll
            for (int m = 0; m < 4; ++m) { bf16_t* rowp = O + (size_t)(row0 + ai * HALF + m * 16) * 1024 + (col0 >> 1);
#pragma unroll
                for (int bj = 0; bj < 2; ++bj) { const f32x4 v0 = acc[ai][bj][m][0] + bv[bj][0], v1 = acc[ai][bj][m][1] + bv[bj][1];
                    float o[4];
                    const float gl[4] = {v0[0], v0[2], v1[0], v1[2]}, li[4] = {v0[1], v0[3], v1[1], v1[3]};
#pragma unroll
                    for (int q = 0; q < 4; ++q) { const float xg = fminf(gl[q], 7.f), xl = fminf(fmaxf(li[q], -7.f), 7.f);
                        o[q] = xg * __builtin_amdgcn_rcpf(1.f + __expf(-1.702f * xg)) * (xl + 1.f); }
                    u32x2 w; w.x = cvt_pk_bf16(o[0], o[1]); w.y = cvt_pk_bf16(o[2], o[3]);
                    *(u32x2*)(rowp + bj * (HALF / 2)) = w; } }
    }
};
struct EpiBf16 {
    static constexpr bool PERM = true;
    bf16_t* O; int ldc; const float* bias; int bias_stride;
    DEVI void operator()(const f32x4 (&acc)[2][2][4][2], const Unit& u, int wr, int wc, int fr, int fq) const {
        const int row0 = u.orow0 + wr * 64 + fr, col0 = u.ocol0 + wc * 32 + 8 * fq;
        f32x4 bv[2][2];
#pragma unroll
        for (int bj = 0; bj < 2; ++bj)
#pragma unroll
            for (int n = 0; n < 2; ++n) bv[bj][n] = bias ? *(const f32x4*)(bias + (size_t)u.e * bias_stride + col0 + bj * HALF + 4 * n) : (f32x4){0.f, 0.f, 0.f, 0.f};
#pragma unroll
        for (int ai = 0; ai < 2; ++ai)
#pragma unroll
            for (int m = 0; m < 4; ++m) { bf16_t* rowp = O + (size_t)(row0 + ai * HALF + m * 16) * ldc + col0;
#pragma unroll
                for (int bj = 0; bj < 2; ++bj) { const f32x4 v0 = acc[ai][bj][m][0] + bv[bj][0], v1 = acc[ai][bj][m][1] + bv[bj][1];
                    u32x4 w; w.x = cvt_pk_bf16(v0[0], v0[1]); w.y = cvt_pk_bf16(v0[2], v0[3]); w.z = cvt_pk_bf16(v1[0], v1[1]); w.w = cvt_pk_bf16(v1[2], v1[3]);
                    *(u32x4*)(rowp + bj * HALF) = w; } }
    }
};

struct EpiBf16Dual {
    static constexpr bool PERM = true;
    bf16_t* O0; int ldc0; const float* bias0; bf16_t* O1; int ldc1;
    DEVI void operator()(const f32x4 (&acc)[2][2][4][2], const Unit& u, int wr, int wc, int fr, int fq) const {
        const int row0 = u.orow0 + wr * 64 + fr, col0 = u.ocol0 + wc * 32 + 8 * fq;
        bf16_t* O = u.e ? O1 : O0; const int ldc = u.e ? ldc1 : ldc0; const float* bias = u.e ? nullptr : bias0;
        f32x4 bv[2][2];
#pragma unroll
        for (int bj = 0; bj < 2; ++bj)
#pragma unroll
            for (int n = 0; n < 2; ++n) bv[bj][n] = bias ? *(const f32x4*)(bias + col0 + bj * HALF + 4 * n) : (f32x4){0.f, 0.f, 0.f, 0.f};
#pragma unroll
        for (int ai = 0; ai < 2; ++ai)
#pragma unroll
            for (int m = 0; m < 4; ++m) { bf16_t* rowp = O + (size_t)(row0 + ai * HALF + m * 16) * ldc + col0;
#pragma unroll
                for (int bj = 0; bj < 2; ++bj) { const f32x4 v0 = acc[ai][bj][m][0] + bv[bj][0], v1 = acc[ai][bj][m][1] + bv[bj][1];
                    u32x4 w; w.x = cvt_pk_bf16(v0[0], v0[1]); w.y = cvt_pk_bf16(v0[2], v0[3]); w.z = cvt_pk_bf16(v1[0], v1[1]); w.w = cvt_pk_bf16(v1[2], v1[3]);
                    *(u32x4*)(rowp + bj * HALF) = w; } }
    }
};
struct EpiF32Res {
    static constexpr bool PERM = false;
    float* C; const float* bias; const float* res;
    DEVI void operator()(const f32x4 (&acc)[2][2][4][2], const Unit& u, int wr, int wc, int fr, int fq) const {
        const int row0 = u.orow0 + wr * 64 + fr, col0 = u.ocol0 + wc * 32 + 4 * fq;
        f32x4 bv[2][2];
#pragma unroll
        for (int bj = 0; bj < 2; ++bj)
#pragma unroll
            for (int n = 0; n < 2; ++n) bv[bj][n] = bias ? *(const f32x4*)(bias + col0 + bj * HALF + n * 16) : (f32x4){0.f, 0.f, 0.f, 0.f};
#pragma unroll
        for (int ai = 0; ai < 2; ++ai)
#pragma unroll
            for (int m = 0; m < 4; ++m) { const size_t off = (size_t)(row0 + ai * HALF + m * 16) * 1024 + col0;
#pragma unroll
                for (int bj = 0; bj < 2; ++bj)
#pragma unroll
                    for (int n = 0; n < 2; ++n) *(f32x4*)(C + off + bj * HALF + n * 16) = acc[ai][bj][m][n] + bv[bj][n] + *(const f32x4*)(res + off + bj * HALF + n * 16);
                if (m & 1) asm volatile("" ::: "memory"); }
    }
};

template <class Epi, class Sched>
DEVI void gemm_phase(G8_LAS unsigned char* lds, const bf16_t* A, int K, int ashift, const Sched& S, const Epi& E) {
    int tid = threadIdx.x; asm volatile("" : "+v"(tid));
    const int wid = __builtin_amdgcn_readfirstlane(tid >> 6), lane = tid & 63, wr = wid >> 2, wc = wid & 3, fr = lane & 15, fq = lane >> 4;
    const int nt = K / BK;
    int Rl[2], Cl[2]; unsigned voffB[2];
#pragma unroll
    for (int i = 0; i < 2; ++i) { stage_rc(tid * 16 + i * 8192, Rl[i], Cl[i]); const int Rb = Epi::PERM ? ((Rl[i] & ~31) + perm32(Rl[i] & 31)) : Rl[i];
        voffB[i] = (unsigned)(Rb * K + Cl[i]) * 2u; }
    const size_t kstep = (size_t)(BK * 2);
    const size_t hstep = (size_t)HALF * K * 2;
    const unsigned ldsw = (unsigned)wid * 1024u;
    const int aoff = lds_byte(wr * 64 + fr, fq * 8), boff = lds_byte(wc * 32 + fr, fq * 8);
    const char* Ab = (const char*)A;
#define G8_AOFF(dst, u) do { _Pragma("unroll") for (int _h = 0; _h < 2; ++_h) _Pragma("unroll") for (int _i = 0; _i < 2; ++_i) { const int _row = _h * HALF + Rl[_i]; int _ar; \
        if ((u).alist) { const int _idx = _row < (u).acnt ? _row : 0; _ar = (u).alist[_idx] >> ashift; } else _ar = (u).arow0 + _row; \
        dst[_h][_i] = (unsigned)(_ar * K + Cl[_i]) * 2u; } } while (0)
#define G8_SA(b, h) (((b) * 2 + (h)) * HTB)
#define G8_SB(b, h) ((4 + (b) * 2 + (h)) * HTB)
#define G8_STAGE(bufoff, gbase, voff) do { _Pragma("unroll") for (int _i = 0; _i < 2; ++_i) \
        __builtin_amdgcn_global_load_lds((const unsigned*)((const char*)(gbase) + (voff)[_i]), (G8_LAS unsigned*)(lds + (bufoff) + ldsw + _i * 8192), 16, 0, 0); } while (0)
#define G8_LDA(dst, b, h) do { _Pragma("unroll") for (int m = 0; m < 4; ++m) _Pragma("unroll") for (int k = 0; k < 2; ++k) dst[m][k] = *(const G8_LAS bf16x8*)(lds + G8_SA(b, h) + aoff + m * 2048 + k * 1024); } while (0)
#define G8_LDB(dst, b, h) do { _Pragma("unroll") for (int n = 0; n < 2; ++n) _Pragma("unroll") for (int k = 0; k < 2; ++k) dst[n][k] = *(const G8_LAS bf16x8*)(lds + G8_SB(b, h) + boff + n * 2048 + k * 1024); } while (0)
#define G8_MMA(ai, bj, At, Bt) do { __builtin_amdgcn_s_setprio(1); _Pragma("unroll") for (int m = 0; m < 4; ++m) _Pragma("unroll") for (int n = 0; n < 2; ++n) _Pragma("unroll") for (int k = 0; k < 2; ++k) \
        acc[ai][bj][m][n] = __builtin_amdgcn_mfma_f32_16x16x32_bf16(Bt[n][k], At[m][k], acc[ai][bj][m][n], 0, 0, 0); __builtin_amdgcn_s_setprio(0); } while (0)
#define G8_WAIT_V(n) asm volatile("s_waitcnt vmcnt(" #n ")" ::: "memory")
#define G8_WAIT_L(n) asm volatile("s_waitcnt lgkmcnt(" #n ")" ::: "memory")
#define G8_BAR __builtin_amdgcn_s_barrier()
#define G8_SCHED __builtin_amdgcn_sched_barrier(0)
    Unit cur, nxt, nn; int ui = 0;
    if (!S.next(0, cur)) return;
    f32x4 acc[2][2][4][2];
#pragma unroll
    for (int a = 0; a < 2; ++a)
#pragma unroll
        for (int b = 0; b < 2; ++b)
#pragma unroll
            for (int m = 0; m < 4; ++m)
#pragma unroll
                for (int n = 0; n < 2; ++n) acc[a][b][m][n] = (f32x4){0.f, 0.f, 0.f, 0.f};
    bf16x8 At[4][2], B0[2][2], B1[2][2];
    unsigned cv[2][2], nv[2][2], fv[2][2];
    G8_AOFF(cv, cur);
    bool has_next = S.next(1, nxt);
    if (has_next) { G8_AOFF(nv, nxt); } else {
#pragma unroll
        for (int h = 0; h < 2; ++h)
#pragma unroll
            for (int i = 0; i < 2; ++i) nv[h][i] = cv[h][i]; }
    const char* cB = cur.bt; const char* nB = has_next ? nxt.bt : cB;
    G8_STAGE(G8_SB(0, 0), cB, voffB); G8_STAGE(G8_SB(0, 1), cB + hstep, voffB); G8_STAGE(G8_SA(0, 0), Ab, cv[0]); G8_STAGE(G8_SA(0, 1), Ab, cv[1]);
    if (wr == 1) G8_BAR;
    G8_WAIT_V(2); G8_BAR;
    G8_STAGE(G8_SB(1, 0), cB + kstep, voffB); G8_STAGE(G8_SA(1, 0), Ab + kstep, cv[0]); G8_STAGE(G8_SB(1, 1), cB + hstep + kstep, voffB);
    G8_WAIT_V(6); G8_BAR;
    for (;;) {
#pragma unroll 1
        for (int t = 0; t < nt; t += 2) {
            const bool last = (t == nt - 2);
            const size_t k1 = (size_t)(t + 1) * kstep;
            const size_t k2 = last ? 0 : (size_t)(t + 2) * kstep;
            const char* b2 = last ? nB : cB + (size_t)(t + 2) * kstep; const char* b3 = b2 + kstep;
            unsigned sv[2][2];
#pragma unroll
            for (int h = 0; h < 2; ++h)
#pragma unroll
                for (int i = 0; i < 2; ++i) sv[h][i] = last ? nv[h][i] : cv[h][i];
            G8_LDB(B0, 0, 0); G8_LDB(B1, 0, 1); G8_SCHED; G8_LDA(At, 0, 0); G8_STAGE(G8_SA(1, 1), Ab + k1, cv[1]);
            G8_WAIT_V(8); G8_WAIT_L(0); G8_BAR; G8_MMA(0, 0, At, B0); G8_MMA(0, 1, At, B1); G8_BAR; G8_SCHED;
            G8_LDA(At, 0, 1); G8_STAGE(G8_SB(0, 0), b2, voffB); G8_STAGE(G8_SB(0, 1), b2 + hstep, voffB); G8_STAGE(G8_SA(0, 0), Ab + k2, sv[0]);
            G8_WAIT_V(8); G8_WAIT_L(0); G8_BAR; G8_MMA(1, 0, At, B0); G8_MMA(1, 1, At, B1); G8_BAR; G8_SCHED;
            G8_LDB(B0, 1, 0); G8_LDB(B1, 1, 1); G8_SCHED; G8_LDA(At, 1, 0); G8_STAGE(G8_SA(0, 1), Ab + k2, sv[1]);
            G8_WAIT_V(8); G8_WAIT_L(0); G8_BAR; G8_MMA(0, 0, At, B0); G8_MMA(0, 1, At, B1); G8_BAR; G8_SCHED;
            G8_LDA(At, 1, 1); G8_STAGE(G8_SB(1, 0), b3, voffB); G8_STAGE(G8_SB(1, 1), b3 + hstep, voffB); G8_STAGE(G8_SA(1, 0), Ab + k2 + kstep, sv[0]);
            G8_WAIT_V(8); G8_WAIT_L(0); G8_BAR; G8_MMA(1, 0, At, B0); G8_MMA(1, 1, At, B1); G8_BAR; G8_SCHED;
        }
        if (wr == 0) G8_BAR;
        const bool has_nn = has_next && S.next(ui + 2, nn);
        if (has_nn) { G8_AOFF(fv, nn); }
        E(acc, cur, wr, wc, fr, fq);
        if (!has_next) break;
#pragma unroll
        for (int a = 0; a < 2; ++a)
#pragma unroll
            for (int b = 0; b < 2; ++b)
#pragma unroll
                for (int m = 0; m < 4; ++m)
#pragma unroll
                    for (int n = 0; n < 2; ++n) acc[a][b][m][n] = (f32x4){0.f, 0.f, 0.f, 0.f};
        cur = nxt; cB = nB; ++ui;
#pragma unroll
        for (int h = 0; h < 2; ++h)
#pragma unroll
            for (int i = 0; i < 2; ++i) { cv[h][i] = nv[h][i]; nv[h][i] = has_nn ? fv[h][i] : nv[h][i]; }
        has_next = has_nn; if (has_nn) { nxt = nn; nB = nn.bt; }
        if (wr == 1) G8_BAR;
    }
    G8_WAIT_V(0);
    G8_BAR;
#undef G8_AOFF
#undef G8_SA
#undef G8_SB
#undef G8_STAGE
#undef G8_LDA
#undef G8_LDB
#undef G8_MMA
#undef G8_WAIT_V
#undef G8_WAIT_L
#undef G8_BAR
#undef G8_SCHED
}

struct MoeSched {
    int G, vcu, nct, K;
    const G8_LAS int* tp; const G8_LAS int* cnt;
    const int* list;
    const char* Bt; size_t bt_estride;
    DEVI bool next(int i, Unit& u) const {
        const int L = i * G + vcu, total = tp[32] * nct;
        if (L >= total) return false;
        const int rtg = L / nct, ct = L - rtg * nct;
        int e = 0;
#pragma unroll
        for (int k = 1; k < 32; ++k) e += (rtg >= tp[k]) ? 1 : 0;
        const int rt = rtg - tp[e];
        u.e = e; u.orow0 = rtg * 256; u.ocol0 = ct * 256;
        u.bt = Bt + (size_t)e * bt_estride + (size_t)ct * 256 * K * 2;
        if (list) { u.alist = list + e * NTOK + rt * 256; u.acnt = min(256, cnt[e] - rt * 256); u.arow0 = 0; }
        else { u.alist = nullptr; u.acnt = 0; u.arow0 = rtg * 256; }
        return true;
    }
};
struct DenseSched {
    int G, c, K, nM0, nN0; const char* Bt0; int nM1, nN1, arow1; const char* Bt1;
    DEVI bool next(int i, Unit& u) const {
        const int nwg = nM0 * nN0, L = i * G + c;
        u.alist = nullptr; u.acnt = 0;
        if (L < nwg) {
            int wgid = L; { const int q = nwg / 8, r = nwg % 8, xcd = wgid % 8, off = wgid / 8; wgid = (xcd < r ? xcd * (q + 1) : r * (q + 1) + (xcd - r) * q) + off; }
            const int nig = 8 * nN0, gid = wgid / nig, fm = gid * 8, gsz = (nM0 - fm) < 8 ? (nM0 - fm) : 8;
            const int pm = fm + ((wgid % nig) % gsz), pn = (wgid % nig) / gsz;
            u.e = 0; u.arow0 = pm * 256; u.orow0 = pm * 256; u.ocol0 = pn * 256; u.bt = Bt0 + (size_t)pn * 256 * K * 2; return true;
        }
        const int l = L - nwg; if (l >= nM1 * nN1) return false;
        const int pm = l / nN1, pn = l - pm * nN1;
        u.e = 1; u.arow0 = arow1 + pm * 256; u.orow0 = pm * 256; u.ocol0 = pn * 256; u.bt = Bt1 + (size_t)pn * 256 * K * 2; return true;
    }
};
}

DEVI unsigned f2bf(float f) { unsigned u = __builtin_bit_cast(unsigned, f); return (u + 0x7fffu + ((u >> 16) & 1u)) >> 16; }
DEVI unsigned pk2(float lo, float hi) { return f2bf(lo) | (f2bf(hi) << 16); }
typedef unsigned v4u __attribute__((ext_vector_type(4)));
DEVI void transpose_item(const float* W, int K, int N, unsigned short* WT, __attribute__((address_space(3))) float* scr, int item, int lane, int ncols = 0) {
    const int nblk = (ncols ? ncols : N) / 32, kb = item / nblk, nb = item % nblk, k0 = 64 * kb, n0 = 32 * nb;
#pragma unroll 8
    for (int i = 0; i < 32; ++i) { const int kk = 2 * i + (lane >> 5); scr[kk * 33 + (lane & 31)] = W[(size_t)(k0 + kk) * N + n0 + (lane & 31)]; }
    asm volatile("s_waitcnt lgkmcnt(0)" ::: "memory");
    const int c = lane & 7;
#pragma unroll
    for (int j = 0; j < 4; ++j) { const int n = (lane >> 3) + 8 * j; const __attribute__((address_space(3))) float* s = scr + (8 * c) * 33 + n;
        v4u o; o.x = pk2(s[0 * 33], s[1 * 33]); o.y = pk2(s[2 * 33], s[3 * 33]); o.z = pk2(s[4 * 33], s[5 * 33]); o.w = pk2(s[6 * 33], s[7 * 33]);
        *(v4u*)(WT + (size_t)(n0 + n) * K + k0 + 8 * c) = o; }
    asm volatile("s_waitcnt lgkmcnt(0)" ::: "memory");
}

#define LAS3 __attribute__((address_space(3)))

typedef float f32x16 __attribute__((ext_vector_type(16)));
typedef short bf16x8_t __attribute__((ext_vector_type(8)));
typedef float f32x2_t __attribute__((ext_vector_type(2)));
typedef __bf16 bf16x2_t __attribute__((ext_vector_type(2)));
typedef unsigned u32x4_t __attribute__((ext_vector_type(4)));
typedef unsigned u32x2_t __attribute__((ext_vector_type(2)));
#define MFMA32(a, b, c) __builtin_amdgcn_mfma_f32_32x32x16_bf16((a), (b), (c), 0, 0, 0)
DEVI unsigned cvtpk(float lo, float hi) { f32x2_t v = {lo, hi}; bf16x2_t b = __builtin_convertvector(v, bf16x2_t); return __builtin_bit_cast(unsigned, b); }
DEVI int crow(int reg, int hi) { return (reg & 3) + 8 * (reg >> 2) + 4 * hi; }
DEVI bf16x8_t pack_step(const f32x16& x, int s) {
    u32x4_t p; p[0] = cvtpk(x[8 * s], x[8 * s + 1]); p[1] = cvtpk(x[8 * s + 2], x[8 * s + 3]); p[2] = cvtpk(x[8 * s + 4], x[8 * s + 5]); p[3] = cvtpk(x[8 * s + 6], x[8 * s + 7]);
    return __builtin_bit_cast(bf16x8_t, p);
}
DEVI int t5_bucket(int d) { return d < 16 ? d : min(31, 16 + (int)(log2f((float)d * 0.0625f) * (16.f / 3.f))); }

DEVI void swa_item(int item, const unsigned short* PROJB, unsigned short* MIXB, const float* relb, const float* sinks, LAS3 unsigned char* L, int tid_) {
    int tid = tid_; asm volatile("" : "+v"(tid));
    const int kv = item & 1, qb = (item >> 1) & 63, b = item >> 7;
    const int lane = tid & 63, w = __builtin_amdgcn_readfirstlane(tid >> 6), hi = lane >> 5, r32 = lane & 31;
    LAS3 unsigned char* KL = L; LAS3 unsigned char* VT = L + 36864; LAS3 float* BT = (LAS3 float*)(L + 36864 + 33280);
    const long tok0 = (long)b * SEQ + (long)(qb - 1) * 128;
#pragma unroll
    for (int i = 0; i < 4; ++i) { const int ci = tid + 512 * i, row = ci >> 3, ch = ci & 7; const bool ok = (qb > 0) || (row >= 128);
        u32x4_t v = {0u, 0u, 0u, 0u}; if (ok) v = *(const u32x4_t*)(PROJB + (size_t)(tok0 + row) * PJ + PJ_K + kv * 64 + ch * 8);
        *(LAS3 u32x4_t*)(KL + row * 144 + ch * 16) = v; }
#pragma unroll
    for (int i = 0; i < 2; ++i) { const int it = tid + 512 * i, rp = it >> 3, ch = it & 7; const bool ok = (qb > 0) || (rp >= 64);
        u32x4_t v0 = {0u, 0u, 0u, 0u}, v1 = {0u, 0u, 0u, 0u};
        if (ok) { const unsigned short* vp = PROJB + (size_t)(tok0 + 2 * rp) * PJ + PJ_V + kv * 64 + ch * 8; v0 = *(const u32x4_t*)vp; v1 = *(const u32x4_t*)(vp + PJ); }
#pragma unroll
        for (int e = 0; e < 8; ++e) { const unsigned a = (e & 1) ? (v0[e >> 1] >> 16) : (v0[e >> 1] & 0xffffu), c = (e & 1) ? (v1[e >> 1] & 0xffff0000u) : (v1[e >> 1] << 16);
            *(LAS3 unsigned*)(VT + (ch * 8 + e) * 520 + rp * 4) = a | c; } }
    { const int hql = tid >> 7, d = tid & 127; BT[tid] = relb[t5_bucket(d) * 8 + kv * 4 + hql]; }
    __syncthreads();
    const int hql = w >> 1, hq = kv * 4 + hql, qhalf = w & 1;
    const float sink = sinks[hq];
#pragma unroll 1
    for (int qi = 0; qi < 2; ++qi) {
        const int m = 2 * qhalf + qi, qf0 = 128 + 32 * m;
        const size_t qrow0 = (size_t)b * SEQ + (size_t)qb * 128 + 32 * m;
        const unsigned short* qp = PROJB + (qrow0 + r32) * PJ + PJ_Q + hq * 64 + 8 * hi;
        bf16x8_t qf[4];
#pragma unroll
        for (int ks = 0; ks < 4; ++ks) qf[ks] = *(const bf16x8_t*)(qp + 16 * ks);
        f32x16 S[5];
#pragma unroll
        for (int kk = 0; kk < 5; ++kk) {
#pragma unroll
            for (int r = 0; r < 16; ++r) S[kk][r] = 0.f;
#pragma unroll
            for (int ks = 0; ks < 4; ++ks) { const bf16x8_t a = *(const LAS3 bf16x8_t*)(KL + (32 * (m + kk) + r32) * 144 + (16 * ks + 8 * hi) * 2); S[kk] = MFMA32(a, qf[ks], S[kk]); }
        }
        float mx = sink;
#pragma unroll
        for (int kk = 0; kk < 5; ++kk)
#pragma unroll
            for (int r = 0; r < 16; ++r) { const int kf = 32 * (m + kk) + crow(r, hi), dist = qf0 + r32 - kf; const bool ok = (dist >= 0) && (dist < 128) && ((qb > 0) || (kf >= 128));
                const float sc = ok ? S[kk][r] * 0.125f + BT[hql * 128 + (dist & 127)] : -INFINITY; S[kk][r] = sc; mx = fmaxf(mx, sc); }
        mx = fmaxf(mx, __shfl_xor(mx, 32));
        float sum = 0.f;
#pragma unroll
        for (int kk = 0; kk < 5; ++kk)
#pragma unroll
            for (int r = 0; r < 16; ++r) { const float pe = __expf(S[kk][r] - mx); S[kk][r] = pe; sum += pe; }
        sum += __shfl_xor(sum, 32); sum += __expf(sink - mx);
        const float linv = 1.f / sum;
        f32x16 O[2];
#pragma unroll
        for (int db = 0; db < 2; ++db)
#pragma unroll
            for (int r = 0; r < 16; ++r) O[db][r] = 0.f;
#pragma unroll
        for (int kk = 0; kk < 5; ++kk)
#pragma unroll
            for (int s2 = 0; s2 < 2; ++s2) { const bf16x8_t pa = pack_step(S[kk], s2); const int kbase = 32 * (m + kk) + 16 * s2 + 4 * hi;
#pragma unroll
                for (int db = 0; db < 2; ++db) { LAS3 unsigned char* vp = VT + (32 * db + r32) * 520 + kbase * 2;
                    const u32x2_t lo = *(const LAS3 u32x2_t*)vp, hi2 = *(const LAS3 u32x2_t*)(vp + 16);
                    const u32x4_t vv = {lo[0], lo[1], hi2[0], hi2[1]};
                    O[db] = MFMA32(pa, __builtin_bit_cast(bf16x8_t, vv), O[db]); } }
#pragma unroll
        for (int r = 0; r < 16; ++r) { const int q = crow(r, hi); const float li = __shfl(linv, q);
            unsigned short* op = MIXB + (qrow0 + q) * 1024 + 512 + hq * 64 + r32;
            op[0] = (unsigned short)(cvtpk(O[0][r] * li, 0.f) & 0xffffu); op[32] = (unsigned short)(cvtpk(O[1][r] * li, 0.f) & 0xffffu); }
    }
    __syncthreads();
}

DEVI void xattn_item(int item, const unsigned short* QCB, const unsigned short* KVMB, unsigned short* OCB, LAS3 unsigned char* L, int tid_) {
    int tid = tid_; asm volatile("" : "+v"(tid));
    const int qblk = item & 31, hd = (item >> 5) & 3, b = item >> 7;
    const int lane = tid & 63, w = __builtin_amdgcn_readfirstlane(tid >> 6), hi = lane >> 5, r32 = lane & 31;
    LAS3 unsigned char* KL = L; LAS3 unsigned char* VT = L + 69632;
    const unsigned short* kvb = KVMB + (size_t)b * MEMLEN * 1024 + hd * 128;
#pragma unroll
    for (int i = 0; i < 8; ++i) { const int ci = tid + 512 * i, row = ci >> 4, ch = ci & 15;
        *(LAS3 u32x4_t*)(KL + row * 272 + ch * 16) = *(const u32x4_t*)(kvb + (size_t)row * 1024 + ch * 8); }
#pragma unroll
    for (int i = 0; i < 4; ++i) { const int it = tid + 512 * i, rp = it >> 4, ch = it & 15;
        const unsigned short* vp = kvb + (size_t)(2 * rp) * 1024 + 512 + ch * 8; const u32x4_t v0 = *(const u32x4_t*)vp, v1 = *(const u32x4_t*)(vp + 1024);
#pragma unroll
        for (int e = 0; e < 8; ++e) { const unsigned a = (e & 1) ? (v0[e >> 1] >> 16) : (v0[e >> 1] & 0xffffu), c = (e & 1) ? (v1[e >> 1] & 0xffff0000u) : (v1[e >> 1] << 16);
            *(LAS3 unsigned*)(VT + (ch * 8 + e) * 520 + rp * 4) = a | c; } }
    __syncthreads();
    const size_t qrow0 = (size_t)b * SEQ + (size_t)qblk * 256 + 32 * w;
    const unsigned short* qp = QCB + (qrow0 + r32) * 512 + hd * 128 + 8 * hi;
    f32x16 S[8];
    {
        bf16x8_t qf[8];
#pragma unroll
        for (int ks = 0; ks < 8; ++ks) qf[ks] = *(const bf16x8_t*)(qp + 16 * ks);
#pragma unroll
        for (int kk = 0; kk < 8; ++kk) {
#pragma unroll
            for (int r = 0; r < 16; ++r) S[kk][r] = 0.f;
#pragma unroll
            for (int ks = 0; ks < 8; ++ks) { const bf16x8_t a = *(const LAS3 bf16x8_t*)(KL + (32 * kk + r32) * 272 + (16 * ks + 8 * hi) * 2); S[kk] = MFMA32(a, qf[ks], S[kk]); }
        }
    }
    const float sc = 0.08838834764831845f;
    float mx = -INFINITY;
#pragma unroll
    for (int kk = 0; kk < 8; ++kk)
#pragma unroll
        for (int r = 0; r < 16; ++r) mx = fmaxf(mx, S[kk][r]);
    mx = fmaxf(mx, __shfl_xor(mx, 32));
    float sum = 0.f;
#pragma unroll
    for (int kk = 0; kk < 8; ++kk)
#pragma unroll
        for (int r = 0; r < 16; ++r) { const float pe = __expf((S[kk][r] - mx) * sc); S[kk][r] = pe; sum += pe; }
    sum += __shfl_xor(sum, 32);
    const float linv = 1.f / sum;
    f32x16 O[4];
#pragma unroll
    for (int db = 0; db < 4; ++db)
#pragma unroll
        for (int r = 0; r < 16; ++r) O[db][r] = 0.f;
#pragma unroll
    for (int kk = 0; kk < 8; ++kk)
#pragma unroll
        for (int s2 = 0; s2 < 2; ++s2) { const bf16x8_t pa = pack_step(S[kk], s2); const int kbase = 32 * kk + 16 * s2 + 4 * hi;
#pragma unroll
            for (int db = 0; db < 4; ++db) { LAS3 unsigned char* vp = VT + (32 * db + r32) * 520 + kbase * 2;
                const u32x2_t lo = *(const LAS3 u32x2_t*)vp, hi2 = *(const LAS3 u32x2_t*)(vp + 16);
                const u32x4_t vv = {lo[0], lo[1], hi2[0], hi2[1]};
                O[db] = MFMA32(pa, __builtin_bit_cast(bf16x8_t, vv), O[db]); } }
#pragma unroll
    for (int r = 0; r < 16; ++r) { const int q = crow(r, hi); const float li = __shfl(linv, q);
        unsigned short* op = OCB + (qrow0 + q) * 512 + hd * 128 + r32;
#pragma unroll
        for (int db = 0; db < 4; ++db) op[32 * db] = (unsigned short)(cvtpk(O[db][r] * li, 0.f) & 0xffffu); }
    __syncthreads();
}


DEVI void ssd_s1_item(int item, const unsigned short* PROJB, const float* DTRAW, const float* convw, const float* convb, const float* dtbias, const float* alog,
                      unsigned short* XC, float* DT, float* ACS, float* CD, float* ST, LAS3 unsigned char* L, int tid_) {
    int tid = tid_; asm volatile("" : "+v"(tid));
    const int g = item & 1, c = (item >> 1) & 63, b = item >> 7;
    const int lane = tid & 63, w = __builtin_amdgcn_readfirstlane(tid >> 6), hi = lane >> 5, r32 = lane & 31;
    LAS3 unsigned char* XwT = L; LAS3 unsigned char* BT = L + 69632;
    LAS3 float* dts = (LAS3 float*)(L + 104448); LAS3 float* acs = dts + 512; LAS3 float* wts = acs + 512;
    const size_t tok0 = (size_t)b * SEQ + (size_t)c * 128;
    if (w < 4) {
        const int h = 4 * g + w; const float ah = -__expf(alog[h]), db = dtbias[h];
        const float d0 = softplus_f(DTRAW[(tok0 + 2 * lane) * 8 + h] + db), d1 = softplus_f(DTRAW[(tok0 + 2 * lane + 1) * 8 + h] + db);
        const float a0 = d0 * ah, a1 = d1 * ah;
        float sc = a0 + a1;
#pragma unroll
        for (int o = 1; o < 64; o <<= 1) { const float v = __shfl_up(sc, o); if (lane >= o) sc += v; }
        const float ex = sc - (a0 + a1), c0 = ex + a0, c1 = ex + a0 + a1, cend = __shfl(sc, 63);
        dts[w * 128 + 2 * lane] = d0; dts[w * 128 + 2 * lane + 1] = d1; acs[w * 128 + 2 * lane] = c0; acs[w * 128 + 2 * lane + 1] = c1;
        wts[w * 128 + 2 * lane] = __expf(cend - c0) * d0; wts[w * 128 + 2 * lane + 1] = __expf(cend - c1) * d1;
        DT[(tok0 + 2 * lane) * 8 + h] = d0; DT[(tok0 + 2 * lane + 1) * 8 + h] = d1; ACS[(tok0 + 2 * lane) * 8 + h] = c0; ACS[(tok0 + 2 * lane + 1) * 8 + h] = c1;
        if (lane == 0) CD[((size_t)b * 64 + c) * 8 + h] = __expf(cend);
    }
    __syncthreads();
    {
        const int cg = lane, ch = cg < 32 ? g * 256 + cg * 8 : (cg < 48 ? 512 + g * 128 + (cg - 32) * 8 : 768 + g * 128 + (cg - 48) * 8);
        float wk[4][8], bb[8];
#pragma unroll
        for (int k = 0; k < 4; ++k) { const float4 a = ld4(convw + k * CONVCH + ch), d = ld4(convw + k * CONVCH + ch + 4); wk[k][0] = a.x; wk[k][1] = a.y; wk[k][2] = a.z; wk[k][3] = a.w; wk[k][4] = d.x; wk[k][5] = d.y; wk[k][6] = d.z; wk[k][7] = d.w; }
        { const float4 a = ld4(convb + ch), d = ld4(convb + ch + 4); bb[0] = a.x; bb[1] = a.y; bb[2] = a.z; bb[3] = a.w; bb[4] = d.x; bb[5] = d.y; bb[6] = d.z; bb[7] = d.w; }
        const int s0 = w * 16;
        const unsigned short* src = PROJB + (tok0 + s0) * PJ + PJ_XBC + ch;
        u32x4_t rw[19];
#pragma unroll
        for (int i = 0; i < 19; ++i) { const bool ok = (c > 0) || (s0 + i - 3 >= 0); rw[i] = (u32x4_t){0u, 0u, 0u, 0u}; if (ok) rw[i] = *(const u32x4_t*)(src + (ptrdiff_t)(i - 3) * PJ); }
        const int hl = cg >> 3;
#pragma unroll
        for (int i2 = 0; i2 < 8; ++i2) {
            float y[2][8];
#pragma unroll
            for (int q = 0; q < 2; ++q) {
                const int i = 2 * i2 + q;
#pragma unroll
                for (int e = 0; e < 8; ++e) { float a = bb[e];
#pragma unroll
                    for (int k = 0; k < 4; ++k) { const unsigned wd = rw[i + k][e >> 1]; a += wk[k][e] * __uint_as_float((e & 1) ? (wd & 0xffff0000u) : (wd << 16)); }
                    y[q][e] = silu_f(a); }
                u32x4_t o; o[0] = cvtpk(y[q][0], y[q][1]); o[1] = cvtpk(y[q][2], y[q][3]); o[2] = cvtpk(y[q][4], y[q][5]); o[3] = cvtpk(y[q][6], y[q][7]);
                *(u32x4_t*)(XC + (tok0 + s0 + i) * 1024 + ch) = o;
            }
            const int s = s0 + 2 * i2;
            if (cg < 32) { const float w0 = wts[hl * 128 + s], w1 = wts[hl * 128 + s + 1];
#pragma unroll
                for (int e = 0; e < 8; ++e) *(LAS3 unsigned*)(XwT + hl * 17408 + ((cg & 7) * 8 + e) * 272 + s * 2) = cvtpk(y[0][e] * w0, y[1][e] * w1); }
            else if (cg < 48) {
#pragma unroll
                for (int e = 0; e < 8; ++e) *(LAS3 unsigned*)(BT + ((cg - 32) * 8 + e) * 272 + s * 2) = cvtpk(y[0][e], y[1][e]); }
        }
    }
    __syncthreads();
    {
        const int pb = w >> 2, nb = w & 3;
#pragma unroll 1
        for (int hl = 0; hl < 4; ++hl) {
            f32x16 acc;
#pragma unroll
            for (int r = 0; r < 16; ++r) acc[r] = 0.f;
#pragma unroll
            for (int ks = 0; ks < 8; ++ks) { const bf16x8_t a = *(const LAS3 bf16x8_t*)(XwT + hl * 17408 + (32 * pb + r32) * 272 + (16 * ks + 8 * hi) * 2);
                const bf16x8_t bq = *(const LAS3 bf16x8_t*)(BT + (32 * nb + r32) * 272 + (16 * ks + 8 * hi) * 2); acc = MFMA32(a, bq, acc); }
            float* sp = ST + (((size_t)b * 64 + c) * 8 + 4 * g + hl) * 8192 + 32 * nb + r32;
#pragma unroll
            for (int r = 0; r < 16; ++r) sp[(32 * pb + crow(r, hi)) * 128] = acc[r];
        }
    }
    __syncthreads();
}

DEVI void ssd_s3_item(int item, const unsigned short* XC, const float* DT, const float* ACS, const unsigned short* HIN, const unsigned short* PROJB, const float* dskip, const float* gssm,
                      float* YPRE, unsigned short* MIXB, LAS3 unsigned char* L, int tid_) {
    int tid = tid_; asm volatile("" : "+v"(tid));
    const int g = item & 1, c = (item >> 1) & 63, b = item >> 7;
    const int lane = tid & 63, w = __builtin_amdgcn_readfirstlane(tid >> 6), hi = lane >> 5, r32 = lane & 31;
    LAS3 unsigned char* Cs = L; LAS3 unsigned char* BM = L + 34816; LAS3 unsigned char* XT = L + 69632; LAS3 unsigned char* HN = L + 87040;
    LAS3 float* dts = (LAS3 float*)(L + 104448); LAS3 float* acs = dts + 512; LAS3 float* rowsq = acs + 512;
    const size_t tok0 = (size_t)b * SEQ + (size_t)c * 128;
#pragma unroll
    for (int i = 0; i < 4; ++i) { const int ci = tid + 512 * i, row = ci >> 4, chk = ci & 15;
        *(LAS3 u32x4_t*)(Cs + row * 272 + chk * 16) = *(const u32x4_t*)(XC + (tok0 + row) * 1024 + 768 + g * 128 + chk * 8);
        *(LAS3 u32x4_t*)(BM + row * 272 + chk * 16) = *(const u32x4_t*)(XC + (tok0 + row) * 1024 + 512 + g * 128 + chk * 8); }
    { const int t = tid >> 2, hl = tid & 3; dts[hl * 128 + t] = DT[(tok0 + t) * 8 + 4 * g + hl]; acs[hl * 128 + t] = ACS[(tok0 + t) * 8 + 4 * g + hl]; }
    __syncthreads();
    const int lb = w >> 1;
    f32x16 CB[2];
#pragma unroll
    for (int j = 0; j < 2; ++j) {
#pragma unroll
        for (int r = 0; r < 16; ++r) CB[j][r] = 0.f;
        const int sb = 2 * (w & 1) + j;
        if (sb <= lb) {
#pragma unroll
            for (int ks = 0; ks < 8; ++ks) { const bf16x8_t a = *(const LAS3 bf16x8_t*)(Cs + (32 * lb + r32) * 272 + (16 * ks + 8 * hi) * 2);
                const bf16x8_t bq = *(const LAS3 bf16x8_t*)(BM + (32 * sb + r32) * 272 + (16 * ks + 8 * hi) * 2); CB[j] = MFMA32(a, bq, CB[j]); }
        }
    }
    __syncthreads();
    const int pb = w & 1;
    float sq[16];
#pragma unroll
    for (int r = 0; r < 16; ++r) sq[r] = 0.f;
    LAS3 unsigned char* ZS = L + 110592;
#pragma unroll 1
    for (int hl = 0; hl < 4; ++hl) {
        const int h = 4 * g + hl;
        {
            const int sp = tid >> 3, chk = tid & 7;
            const unsigned short* xp = XC + (tok0 + 2 * sp) * 1024 + h * 64 + chk * 8; const u32x4_t v0 = *(const u32x4_t*)xp, v1 = *(const u32x4_t*)(xp + 1024);
#pragma unroll
            for (int e = 0; e < 8; ++e) { const unsigned a = (e & 1) ? (v0[e >> 1] >> 16) : (v0[e >> 1] & 0xffffu), d = (e & 1) ? (v1[e >> 1] & 0xffff0000u) : (v1[e >> 1] << 16);
                *(LAS3 unsigned*)(XT + (chk * 8 + e) * 272 + sp * 4) = a | d; }
            const unsigned short* hp = HIN + (((size_t)b * 64 + c) * 8 + h) * 8192;
#pragma unroll
            for (int i = 0; i < 2; ++i) { const int ci = tid + 512 * i, row = ci >> 4, ck = ci & 15; *(LAS3 u32x4_t*)(HN + row * 272 + ck * 16) = *(const u32x4_t*)(hp + row * 128 + ck * 8); }
#pragma unroll
            for (int i = 0; i < 2; ++i) { const int ci = tid + 512 * i, row = ci >> 3, ck = ci & 7; *(LAS3 u32x4_t*)(ZS + row * 144 + ck * 16) = *(const u32x4_t*)(PROJB + (tok0 + row) * PJ + PJ_Z + h * 64 + ck * 8); }
        }
#pragma unroll
        for (int j = 0; j < 2; ++j) { const int sb = 2 * (w & 1) + j;
            if (sb <= lb) { const int s = 32 * sb + r32; const float as = acs[hl * 128 + s], ds = dts[hl * 128 + s];
#pragma unroll
                for (int r = 0; r < 16; ++r) { const int l = 32 * lb + crow(r, hi); const float v = (s <= l) ? CB[j][r] * __expf(acs[hl * 128 + l] - as) * ds : 0.f;
                    *(LAS3 unsigned short*)(BM + l * 272 + s * 2) = (unsigned short)(cvtpk(v, 0.f) & 0xffffu); } } }
        __syncthreads();
        f32x16 acc;
#pragma unroll
        for (int r = 0; r < 16; ++r) acc[r] = 0.f;
#pragma unroll
        for (int ks = 0; ks < 8; ++ks) { const bf16x8_t a = *(const LAS3 bf16x8_t*)(Cs + (32 * lb + r32) * 272 + (16 * ks + 8 * hi) * 2);
            const bf16x8_t bq = *(const LAS3 bf16x8_t*)(HN + (32 * pb + r32) * 272 + (16 * ks + 8 * hi) * 2); acc = MFMA32(a, bq, acc); }
#pragma unroll
        for (int r = 0; r < 16; ++r) acc[r] *= __expf(acs[hl * 128 + 32 * lb + crow(r, hi)]);
#pragma unroll
        for (int ks = 0; ks < 8; ++ks) if (ks < 2 * (lb + 1)) { const bf16x8_t a = *(const LAS3 bf16x8_t*)(BM + (32 * lb + r32) * 272 + (16 * ks + 8 * hi) * 2);
            const bf16x8_t bq = *(const LAS3 bf16x8_t*)(XT + (32 * pb + r32) * 272 + (16 * ks + 8 * hi) * 2); acc = MFMA32(a, bq, acc); }
        const float dsk = dskip[h]; const int pc = 32 * pb + r32;
        float* yp = YPRE + tok0 * 512 + h * 64 + pc;
#pragma unroll
        for (int r = 0; r < 16; ++r) { const int l = 32 * lb + crow(r, hi);
            const float xv = bf2f(*(const LAS3 unsigned short*)(XT + pc * 272 + l * 2)), z = bf2f(*(const LAS3 unsigned short*)(ZS + l * 144 + pc * 2));
            const float y = (acc[r] + dsk * xv) * silu_f(z); yp[l * 512] = y; sq[r] += y * y; }
        __syncthreads();
    }
#pragma unroll
    for (int r = 0; r < 16; ++r) { float v = sq[r];
#pragma unroll
        for (int o = 1; o < 32; o <<= 1) v += __shfl_xor(v, o);
        if (r32 == 0) rowsq[(32 * lb + crow(r, hi)) * 2 + pb] = v; }
    __syncthreads();
#pragma unroll 1
    for (int hl = 0; hl < 4; ++hl) { const int col = (4 * g + hl) * 64 + 32 * pb + r32; const float gs = gssm[col];
#pragma unroll
        for (int r = 0; r < 16; ++r) { const int l = 32 * lb + crow(r, hi); const float rs = rsqrtf((rowsq[l * 2] + rowsq[l * 2 + 1]) * (1.f / 256.f) + EPS);
            MIXB[(tok0 + l) * 1024 + col] = (unsigned short)(cvtpk(YPRE[(tok0 + l) * 512 + col] * rs * gs, 0.f) & 0xffffu); } }
    __syncthreads();
}

__global__ void __launch_bounds__(512, 2) mk_fwd(Params p) {
    extern __shared__ __attribute__((aligned(16))) unsigned char lds[];
    cg::grid_group grid = cg::this_grid();
    const int NGW = gridDim.x * 8, NGT = gridDim.x * 512, G = gridDim.x;
    unsigned char* ws = p.ws;
    unsigned* ctl = (unsigned*)(ws + WS_CTL);
    float* H1 = (float*)(ws + WS_H1); float* H2 = (float*)(ws + WS_H2);
    float* DT = (float*)(ws + WS_DT); float* DTRAW = (float*)(ws + WS_DTRAW); float* GATE = (float*)(ws + WS_GATE); float* BIASP = (float*)(ws + WS_BIASP);
    typedef unsigned short bf;
    bf* XN = (bf*)(ws + WS_XN); bf* PROJB = (bf*)(ws + WS_BIG); bf* YB = (bf*)(ws + WS_YB); bf* MIXB = (bf*)(ws + WS_MIXB); bf* QCB = (bf*)(ws + WS_QCB); bf* OCB = (bf*)(ws + WS_OCB);
    bf* ACTB = (bf*)(ws + WS_ACTB); bf* KVMB = (bf*)(ws + WS_KVMB);
    bf* CHK_MIX = (bf*)(ws + WS_ACTB); bf* CHK_OC = (bf*)(ws + WS_ACTB + 64 * MiB); (void)CHK_MIX; (void)CHK_OC;
    float* CHK_YSSM = (float*)(ws + WS_ACTB + 32 * MiB); float* CHK_XBC = (float*)(ws + WS_ACTB + 80 * MiB); (void)CHK_YSSM; (void)CHK_XBC;
    bf* XC = (bf*)(ws + WS_XC); float* ACS = (float*)(ws + WS_ACS); float* CD = (float*)(ws + WS_CD); float* ST = (float*)(ws + WS_ST); bf* HIN = (bf*)(ws + WS_HIN);
    bf* W1T = (bf*)(ws + WS_W1T); bf* W2T = (bf*)(ws + WS_W2T); bf* WINT = (bf*)(ws + WS_WINT); bf* WOUTT = (bf*)(ws + WS_WOUTT); bf* WQT = (bf*)(ws + WS_WQT); bf* WKVT = (bf*)(ws + WS_WKVT); bf* WOT = (bf*)(ws + WS_WOT);
    int* LIST = (int*)(ws + WS_LIST); int* SLOT = (int*)(ws + WS_SLOT);
    LAS3 unsigned char* ldsp = (LAS3 unsigned char*)lds;
    LAS3 int* TP = (LAS3 int*)(ldsp + 131072); LAS3 int* CNTL = TP + 64;
    const float* x = p.in[I_X];
    const int vcu = (G % 8 == 0) ? (blockIdx.x % 8) * (G / 8) + blockIdx.x / 8 : blockIdx.x;

    {
        PHASE_IDS();
        LAS3 float* wdt = (LAS3 float*)ldsp;
        for (int i = tid; i < 1024 * 2; i += 512) { const int k = i >> 1, hh = (i & 1) * 4; { const float4 t4 = ld4(p.in[I_WIN] + (size_t)k * IN_COLS + COL_DT + hh); *(LAS3 g8::f32x4*)(wdt + k * 8 + hh) = (g8::f32x4){t4.x, t4.y, t4.z, t4.w}; } }
        for (int i = gtid; i < PJ; i += NGT) BIASP[i] = i < PJ_Q ? 0.f : p.in[I_BQKV][i - PJ_Q];
        __syncthreads();
        for (int r = gw; r < NTOK + NMEM; r += NGW) {
            const bool ismem = r >= NTOK;
            const float* xrow = ismem ? p.in[I_MEM] + (size_t)(r - NTOK) * DM : x + (size_t)r * DM;
            const float* g = ismem ? p.in[I_GMEM] : p.in[I_GMIX];
            float4 v[4]; float ss = 0.f;
#pragma unroll
            for (int j = 0; j < 4; ++j) { v[j] = ld4(xrow + 4 * (lane + 64 * j)); ss += v[j].x * v[j].x + v[j].y * v[j].y + v[j].z * v[j].z + v[j].w * v[j].w; }
            const float rs = rsqrtf(wave_sum(ss) * (1.f / 1024.f) + EPS);
            float dacc[8];
#pragma unroll
            for (int h = 0; h < 8; ++h) dacc[h] = 0.f;
#pragma unroll
            for (int j = 0; j < 4; ++j) { const int c = 4 * (lane + 64 * j); const float4 gv = ld4(g + c);
                v[j] = make_float4(v[j].x * rs * gv.x, v[j].y * rs * gv.y, v[j].z * rs * gv.z, v[j].w * rs * gv.w);
                *(uint2*)(XN + (size_t)r * DM + c) = make_uint2(pk2(v[j].x, v[j].y), pk2(v[j].z, v[j].w));
                if (!ismem) { const float uu[4] = {v[j].x, v[j].y, v[j].z, v[j].w};
#pragma unroll
                    for (int q = 0; q < 4; ++q) { const g8::f32x4 w0 = *(const LAS3 g8::f32x4*)(wdt + (c + q) * 8), w1 = *(const LAS3 g8::f32x4*)(wdt + (c + q) * 8 + 4);
                        dacc[0] += uu[q] * w0.x; dacc[1] += uu[q] * w0.y; dacc[2] += uu[q] * w0.z; dacc[3] += uu[q] * w0.w;
                        dacc[4] += uu[q] * w1.x; dacc[5] += uu[q] * w1.y; dacc[6] += uu[q] * w1.z; dacc[7] += uu[q] * w1.w; } }
            }
            if (!ismem) {
#pragma unroll
                for (int h = 0; h < 8; ++h) dacc[h] = wave_sum(dacc[h]);
                if (lane == 0) { st4(DTRAW + (size_t)r * 8, make_float4(dacc[0], dacc[1], dacc[2], dacc[3])); st4(DTRAW + (size_t)r * 8 + 4, make_float4(dacc[4], dacc[5], dacc[6], dacc[7])); }
            }
        }
        __syncthreads();
        LAS3 float* scr = (LAS3 float*)(ldsp + wave * 16384);
        constexpr int IT1 = 16 * (2048 / 32), IT2 = 16 * (1024 / 32);
        constexpr int IA = 16 * (1536 / 32), IB = 16 * (768 / 32), IO = 16 * 32, IQ = 16 * 16, IKV = 16 * 32, IWO = 8 * 32;
        constexpr int NSM = IA + IB + IO + IQ + IKV + IWO, NIT = NSM + NEXP * (IT1 + IT2);
        for (int it = gw; it < NIT; it += NGW) {
            int r = it;
            if (r < IA) { transpose_item(p.in[I_WIN], 1024, IN_COLS, WINT, scr, r, lane, 1536); continue; } r -= IA;
            if (r < IB) { transpose_item(p.in[I_WIN] + COL_Q, 1024, IN_COLS, WINT + (size_t)1536 * 1024, scr, r, lane, 768); continue; } r -= IB;
            if (r < IO) { transpose_item(p.in[I_WOUT], 1024, 1024, WOUTT, scr, r, lane); continue; } r -= IO;
            if (r < IQ) { transpose_item(p.in[I_WQ], 1024, 512, WQT, scr, r, lane); continue; } r -= IQ;
            if (r < IKV) { transpose_item(p.in[I_WKV], 1024, 1024, WKVT, scr, r, lane); continue; } r -= IKV;
            if (r < IWO) { transpose_item(p.in[I_WO], 512, 1024, WOT, scr, r, lane); continue; } r -= IWO;
            if (r < NEXP * IT1) { const int e = r / IT1, q = r - e * IT1; transpose_item(p.in[I_W1] + (size_t)e * 1024 * 2048, 1024, 2048, W1T + (size_t)e * 2048 * 1024, scr, q, lane); continue; } r -= NEXP * IT1;
            { const int e = r / IT2, q = r - e * IT2; transpose_item(p.in[I_W2] + (size_t)e * 1024 * 1024, 1024, 1024, W2T + (size_t)e * 1024 * 1024, scr, q, lane); }
        }
    }
    grid.sync();
    {
        g8::DenseSched S{G, (int)blockIdx.x, 1024, NTOK / 256, PJ / 256, (const char*)WINT, NMEM / 256, 4, NTOK, (const char*)WKVT};
        g8::EpiBf16Dual E{PROJB, PJ, BIASP, KVMB, 1024};
        g8::gemm_phase(ldsp, XN, 1024, 0, S, E);
    }
    grid.sync();
    {
    PHASE_IDS();
    for (int item = blockIdx.x; item < BATCH * 64 * 2; item += G)
        ssd_s1_item(item, PROJB, DTRAW, p.in[I_CONVW], p.in[I_CONVB], p.in[I_DTB], p.in[I_ALOG], XC, DT, ACS, CD, ST, ldsp, tid);
#if CHECK_SSD
    for (int idx = gtid; idx < NTOK * 256; idx += NGT) {
        const int row = idx >> 8, c4 = (idx & 255) * 4, t = row & (SEQ - 1);
        float4 a = ld4(p.in[I_CONVB] + c4);
#pragma unroll
        for (int k = 0; k < 4; ++k) if (t - 3 + k >= 0) {
            const float4 w = ld4(p.in[I_CONVW] + k * CONVCH + c4); const uint2 pv = *(const uint2*)(PROJB + (size_t)(row - 3 + k) * PJ + PJ_XBC + c4);
            a.x += w.x * __uint_as_float(pv.x << 16); a.y += w.y * __uint_as_float(pv.x & 0xffff0000u); a.z += w.z * __uint_as_float(pv.y << 16); a.w += w.w * __uint_as_float(pv.y & 0xffff0000u); }
        st4(CHK_XBC + (size_t)row * 1024 + c4, make_float4(silu_f(a.x), silu_f(a.y), silu_f(a.z), silu_f(a.w)));
    }
#endif
    }
    grid.sync();
    {
    PHASE_IDS();
    for (int item = blockIdx.x; item < BATCH * 64 * 2; item += G) swa_item(item, PROJB, MIXB, p.in[I_RELB], p.in[I_SINK], ldsp, tid);
    {
        for (int el = gtid; el < BATCH * 8 * 8192; el += NGT) {
            const int bh = el >> 13, pn = el & 8191, b = bh >> 3, h = bh & 7;
            float st = 0.f;
#pragma unroll 8
            for (int c = 0; c < 64; ++c) { const size_t idx = (((size_t)b * 64 + c) * 8 + h) * 8192 + pn;
                HIN[idx] = (bf)(cvtpk(st, 0.f) & 0xffffu); st = st * CD[((size_t)b * 64 + c) * 8 + h] + ST[idx]; }
        }
    }
#if CHECK_SSD
    for (int item = gw; item < BATCH * SSM_H * SSM_P; item += NGW) {
        const int b = item >> 9, h = (item >> 6) & 7, pp = item & 63, g = h >> 2;
        const float ah = -__expf(p.in[I_ALOG][h]), dsk = p.in[I_DSKIP][h];
        float h0 = 0.f, h1 = 0.f;
        const float* xb = CHK_XBC + (size_t)b * SEQ * 1024; const float* dtb = DT + (size_t)b * SEQ * 8 + h;
#pragma unroll 4
        for (int t = 0; t < SEQ; ++t) {
            const float* xr = xb + (size_t)t * 1024;
            const float dtv = dtb[(size_t)t * 8], xv = xr[h * 64 + pp];
            const float B0 = xr[512 + g * 128 + lane], B1 = xr[512 + g * 128 + 64 + lane];
            const float C0 = xr[768 + g * 128 + lane], C1 = xr[768 + g * 128 + 64 + lane];
            const float dec = __expf(dtv * ah), dx = dtv * xv;
            h0 = h0 * dec + dx * B0; h1 = h1 * dec + dx * B1;
            const float y = wave_sum(C0 * h0 + C1 * h1) + dsk * xv;
            if (lane == 0) CHK_YSSM[(size_t)(b * SEQ + t) * 512 + h * 64 + pp] = y;
        }
    }
#endif
#if CHECK_ATTN
    for (int item = gw; item < NTOK * 8; item += NGW) {
        const int row = item >> 3, hq = item & 7, kv = hq >> 2, t = row & (SEQ - 1);
        const float qv = bf2f(PROJB[(size_t)row * PJ + PJ_Q + hq * 64 + lane]);
        float s0 = 0.f, s1 = 0.f;
        const int j0 = lane, j1 = lane + 64; const bool v0 = (t - j0) >= 0, v1 = (t - j1) >= 0;
        const bf* k0p = PROJB + (size_t)(row - (v0 ? j0 : 0)) * PJ + PJ_K + kv * 64;
        const bf* k1p = PROJB + (size_t)(row - (v1 ? j1 : 0)) * PJ + PJ_K + kv * 64;
        for (int d = 0; d < 64; ++d) { const float qd = __shfl(qv, d); s0 += qd * bf2f(k0p[d]); s1 += qd * bf2f(k1p[d]); }
        const int bk0 = j0 < 16 ? j0 : min(31, 16 + (int)(log2f((float)j0 * 0.0625f) * (16.f / 3.f)));
        const int bk1 = min(31, 16 + (int)(log2f((float)j1 * 0.0625f) * (16.f / 3.f)));
        s0 = v0 ? s0 * 0.125f + p.in[I_RELB][bk0 * 8 + hq] : -INFINITY;
        s1 = v1 ? s1 * 0.125f + p.in[I_RELB][bk1 * 8 + hq] : -INFINITY;
        const float sink = p.in[I_SINK][hq];
        const float m = fmaxf(wave_max(fmaxf(s0, s1)), sink);
        const float e0 = v0 ? __expf(s0 - m) : 0.f, e1 = v1 ? __expf(s1 - m) : 0.f;
        const float den = wave_sum(e0 + e1) + __expf(sink - m);
        const float p0 = e0 / den, p1 = e1 / den;
        float o = 0.f;
        const int jmax = min(127, t);
        for (int j = 0; j <= jmax; ++j) { const float pj = __shfl(j < 64 ? p0 : p1, j & 63); o += pj * bf2f(PROJB[(size_t)(row - j) * PJ + PJ_V + kv * 64 + lane]); }
        CHK_MIX[(size_t)row * 1024 + 512 + hq * 64 + lane] = (bf)f2bf(o);
    }
#endif
    }
    grid.sync();
    {
    PHASE_IDS();
    for (int item = blockIdx.x; item < BATCH * 64 * 2; item += G)
        ssd_s3_item(item, XC, DT, ACS, HIN, PROJB, p.in[I_DSKIP], p.in[I_GSSM], ST, MIXB, ldsp, tid);
#if CHECK_SSD
    for (int row = gw; row < NTOK; row += NGW) {
        const int c = lane * 8;
        float v[8]; float ss = 0.f;
        const uint4 zz = *(const uint4*)(PROJB + (size_t)row * PJ + PJ_Z + c);
        const unsigned zw[4] = {zz.x, zz.y, zz.z, zz.w};
#pragma unroll
        for (int i = 0; i < 8; ++i) { const float z = __uint_as_float((i & 1) ? (zw[i >> 1] & 0xffff0000u) : (zw[i >> 1] << 16)); v[i] = CHK_YSSM[(size_t)row * 512 + c + i] * silu_f(z); ss += v[i] * v[i]; }
#pragma unroll
        for (int o = 16; o > 0; o >>= 1) ss += __shfl_xor(ss, o);
        const float rs = rsqrtf(ss * (1.f / 256.f) + EPS);
        uint4 ov; unsigned ow[4];
#pragma unroll
        for (int i = 0; i < 4; ++i) ow[i] = pk2(v[2 * i] * rs * p.in[I_GSSM][c + 2 * i], v[2 * i + 1] * rs * p.in[I_GSSM][c + 2 * i + 1]);
        ov.x = ow[0]; ov.y = ow[1]; ov.z = ow[2]; ov.w = ow[3];
        *(uint4*)(CHK_MIX + (size_t)row * 1024 + c) = ov;
    }
#endif
    }
    grid.sync();
#if CHECK_SSD
    {
        grid.sync();
        PHASE_IDS();
        float num = 0.f, den = 0.f;
        for (int idx = gtid; idx < NTOK * 512; idx += NGT) { const int row = idx >> 9, c = idx & 511;
            const float a0 = bf2f(MIXB[(size_t)row * 1024 + c]), b0 = bf2f(CHK_MIX[(size_t)row * 1024 + c]); num += (a0 - b0) * (a0 - b0); den += b0 * b0; }
        num = wave_sum(num); den = wave_sum(den);
        if (lane == 0) { atomicAdd((float*)&ctl[CW_ERR + 2], num); atomicAdd((float*)&ctl[CW_ERR + 3], den); }
    }
#endif
    {
        g8::DenseSched S{G, (int)blockIdx.x, 1024, NTOK / 256, 4, (const char*)WOUTT, 0, 1, 0, nullptr};
        g8::EpiF32Res E{H1, p.in[I_BOUT], x};
        g8::gemm_phase(ldsp, MIXB, 1024, 0, S, E);
    }
    grid.sync();
    {
    PHASE_IDS();
    for (int r = gw; r < NTOK; r += NGW) {
        float4 v[4]; float ss = 0.f;
#pragma unroll
        for (int j = 0; j < 4; ++j) { v[j] = ld4(H1 + (size_t)r * DM + 4 * (lane + 64 * j)); ss += v[j].x * v[j].x + v[j].y * v[j].y + v[j].z * v[j].z + v[j].w * v[j].w; }
        const float rs = rsqrtf(wave_sum(ss) * (1.f / 1024.f) + EPS);
#pragma unroll
        for (int j = 0; j < 4; ++j) { const int c = 4 * (lane + 64 * j); const float4 gv = ld4(p.in[I_GCROSS] + c);
            *(uint2*)(XN + (size_t)r * DM + c) = make_uint2(pk2(v[j].x * rs * gv.x, v[j].y * rs * gv.y), pk2(v[j].z * rs * gv.z, v[j].w * rs * gv.w)); }
    }
    }
    grid.sync();
    {
        g8::DenseSched S{G, (int)blockIdx.x, 1024, NTOK / 256, 2, (const char*)WQT, 0, 1, 0, nullptr};
        g8::EpiBf16Dual E{QCB, 512, nullptr, nullptr, 0};
        g8::gemm_phase(ldsp, XN, 1024, 0, S, E);
    }
    grid.sync();
    {
    PHASE_IDS();
    for (int item = blockIdx.x; item < BATCH * 4 * 32; item += G) xattn_item(item, QCB, KVMB, OCB, ldsp, tid);
#if CHECK_ATTN
    for (int item = gw; item < NTOK * 4; item += NGW) {
        const int row = item >> 2, hd = item & 3, b = row >> 13;
        const float q0 = bf2f(QCB[(size_t)row * 512 + hd * 128 + lane]), q1 = bf2f(QCB[(size_t)row * 512 + hd * 128 + 64 + lane]);
        const bf* kb = KVMB + (size_t)b * MEMLEN * 1024 + hd * 128;
        float sc4[4] = {0.f, 0.f, 0.f, 0.f};
        for (int d = 0; d < 128; ++d) {
            const float qd = __shfl(d < 64 ? q0 : q1, d & 63);
#pragma unroll
            for (int i = 0; i < 4; ++i) sc4[i] += qd * bf2f(kb[(size_t)(lane + 64 * i) * 1024 + d]);
        }
        const float sc = 0.08838834764831845f;
        float m = -INFINITY;
#pragma unroll
        for (int i = 0; i < 4; ++i) { sc4[i] *= sc; m = fmaxf(m, sc4[i]); }
        m = wave_max(m);
        float den = 0.f;
#pragma unroll
        for (int i = 0; i < 4; ++i) { sc4[i] = __expf(sc4[i] - m); den += sc4[i]; }
        den = wave_sum(den);
        const float inv = 1.f / den;
        float o0 = 0.f, o1 = 0.f; const bf* vb = kb + 512;
#pragma unroll
        for (int i = 0; i < 4; ++i)
            for (int jj = 0; jj < 64; ++jj) {
                const float pj = __shfl(sc4[i], jj) * inv; const bf* vr = vb + (size_t)(jj + 64 * i) * 1024;
                o0 += pj * bf2f(vr[lane]); o1 += pj * bf2f(vr[64 + lane]);
            }
        CHK_OC[(size_t)row * 512 + hd * 128 + lane] = (bf)f2bf(o0); CHK_OC[(size_t)row * 512 + hd * 128 + 64 + lane] = (bf)f2bf(o1);
    }
    grid.sync();
    for (int idx = gtid; idx < NTOK * 512; idx += NGT) {
        const int row = idx >> 9, c = idx & 511;
        const float a0 = bf2f(MIXB[(size_t)row * 1024 + 512 + c]), b0 = bf2f(CHK_MIX[(size_t)row * 1024 + 512 + c]);
        const float a1 = bf2f(OCB[idx]), b1 = bf2f(CHK_OC[idx]);
        if (!(fabsf(a0 - b0) <= 0.01f + 0.02f * fabsf(b0))) atomicAdd(&ctl[CW_ERR], 1u);
        if (!(fabsf(a1 - b1) <= 0.01f + 0.02f * fabsf(b1))) atomicAdd(&ctl[CW_ERR + 1], 1u);
    }
#endif
    }
    grid.sync();
    {
        g8::DenseSched S{G, (int)blockIdx.x, 512, NTOK / 256, 4, (const char*)WOT, 0, 1, 0, nullptr};
        g8::EpiF32Res E{H2, nullptr, H1};
        g8::gemm_phase(ldsp, OCB, 512, 0, S, E);
    }
    grid.sync();
    {
    PHASE_IDS();
    for (int row = gw; row < NTOK; row += NGW) {
        float4 un[4];
        {
            float ss = 0.f;
#pragma unroll
            for (int j = 0; j < 4; ++j) { un[j] = ld4(H2 + (size_t)row * DM + 16 * lane + 4 * j); ss += un[j].x * un[j].x + un[j].y * un[j].y + un[j].z * un[j].z + un[j].w * un[j].w; }
            const float rs = rsqrtf(wave_sum(ss) * (1.f / 1024.f) + EPS);
#pragma unroll
            for (int j = 0; j < 4; ++j) { const float4 gv = ld4(p.in[I_GFFN] + 16 * lane + 4 * j);
                un[j] = make_float4(un[j].x * rs * gv.x, un[j].y * rs * gv.y, un[j].z * rs * gv.z, un[j].w * rs * gv.w);
                *(uint2*)(XN + (size_t)row * DM + 16 * lane + 4 * j) = make_uint2(pk2(un[j].x, un[j].y), pk2(un[j].z, un[j].w)); }
        }
        float l[32];
#pragma unroll
        for (int e = 0; e < 32; ++e) l[e] = 0.f;
        const float* wrb = p.in[I_WR] + (size_t)(16 * lane) * 32;
        LAS3 float* us = (LAS3 float*)(ldsp + wave * 4096);
#pragma unroll
        for (int j = 0; j < 4; ++j) { us[(4 * j + 0) * 64 + lane] = un[j].x; us[(4 * j + 1) * 64 + lane] = un[j].y; us[(4 * j + 2) * 64 + lane] = un[j].z; us[(4 * j + 3) * 64 + lane] = un[j].w; }
#pragma unroll 2
        for (int q = 0; q < 16; ++q) {
            const float uq = us[q * 64 + lane]; const float* wr = wrb + q * 32;
#pragma unroll
            for (int e4 = 0; e4 < 8; ++e4) { const float4 w = ld4(wr + 4 * e4);
                l[4 * e4] += uq * w.x; l[4 * e4 + 1] += uq * w.y; l[4 * e4 + 2] += uq * w.z; l[4 * e4 + 3] += uq * w.w; }
        }
#pragma unroll
        for (int e = 0; e < 32; ++e) l[e] = wave_sum(l[e]) + p.in[I_BR][e];
        int sel[4]; float val[4];
#pragma unroll
        for (int k = 0; k < 4; ++k) {
            float best = -INFINITY; int bi = 0;
#pragma unroll
            for (int e = 0; e < 32; ++e) if (l[e] > best) { best = l[e]; bi = e; }
            sel[k] = bi; val[k] = best;
#pragma unroll
            for (int e = 0; e < 32; ++e) l[e] = (e == bi) ? -INFINITY : l[e];
        }
        float ex[4], den = 0.f;
#pragma unroll
        for (int k = 0; k < 4; ++k) { ex[k] = __expf(val[k] - val[0]); den += ex[k]; }
        if (lane == 0) {
#pragma unroll
            for (int k = 0; k < 4; ++k) {
                const int a = row * 4 + k;
                const unsigned slot = atomicAdd(&ctl[CW_CNT + sel[k]], 1u);
                LIST[sel[k] * NTOK + slot] = a;
                SLOT[a] = (sel[k] << 16) | (int)slot;
                GATE[a] = ex[k] / den;
            }
        }
    }
    }
    grid.sync();
    {
    PHASE_IDS();
    if (tid < 64) {
        const int c = tid < 32 ? (int)__hip_atomic_load(&ctl[CW_CNT + (tid & 31)], __ATOMIC_RELAXED, __HIP_MEMORY_SCOPE_AGENT) : 0;
        int tl = (c + 255) >> 8, incl = tl;
#pragma unroll
        for (int o = 1; o < 32; o <<= 1) { const int v = __shfl_up(incl, o); if ((tid & 63) >= o) incl += v; }
        if (tid < 32) { CNTL[tid] = c; TP[tid] = incl - tl; }
        if (tid == 31) TP[32] = incl;
    }
    }
    __syncthreads();
    {
        g8::MoeSched S{G, vcu, 8, 1024, TP, CNTL, LIST, (const char*)W1T, (size_t)2048 * 1024 * 2};
        g8::EpiSwiglu E{ACTB, p.in[I_B1]};
        g8::gemm_phase(ldsp, XN, 1024, 2, S, E);
    }
    grid.sync();
    {
        g8::MoeSched S{G, vcu, 4, 1024, TP, CNTL, nullptr, (const char*)W2T, (size_t)1024 * 1024 * 2};
        g8::EpiBf16 E{YB, 1024, p.in[I_B2], 1024};
        g8::gemm_phase(ldsp, ACTB, 1024, 0, S, E);
    }
    grid.sync();
    {
    PHASE_IDS();
    for (int row = gw; row < NTOK; row += NGW) {
        float4 v[4]; float ss = 0.f;
        int yrow[4]; float gk[4];
#pragma unroll
        for (int k = 0; k < 4; ++k) { const int sl = SLOT[row * 4 + k]; yrow[k] = TP[sl >> 16] * 256 + (sl & 0xffff); gk[k] = GATE[row * 4 + k]; }
#pragma unroll
        for (int j = 0; j < 4; ++j) {
            const int c = 4 * (lane + 64 * j);
            float4 a = ld4(H2 + (size_t)row * DM + c);
#pragma unroll
            for (int k = 0; k < 4; ++k) { const uint2 y = *(const uint2*)(YB + (size_t)yrow[k] * 1024 + c);
                a.x += gk[k] * __uint_as_float(y.x << 16); a.y += gk[k] * __uint_as_float(y.x & 0xffff0000u);
                a.z += gk[k] * __uint_as_float(y.y << 16); a.w += gk[k] * __uint_as_float(y.y & 0xffff0000u); }
            v[j] = a; ss += a.x * a.x + a.y * a.y + a.z * a.z + a.w * a.w;
        }
        float rs = rsqrtf(wave_sum(ss) * (1.f / 1024.f) + EPS);
#if CHECK_SSD
        { const float en = __uint_as_float(__hip_atomic_load(&ctl[CW_ERR + 2], __ATOMIC_RELAXED, __HIP_MEMORY_SCOPE_AGENT)), ed = __uint_as_float(__hip_atomic_load(&ctl[CW_ERR + 3], __ATOMIC_RELAXED, __HIP_MEMORY_SCOPE_AGENT)); rs *= 1.f + sqrtf(en / ed); }
#endif
#if CHECK_ATTN
        if (__hip_atomic_load(&ctl[CW_ERR], __ATOMIC_RELAXED, __HIP_MEMORY_SCOPE_AGENT) != 0u) rs *= 2.f;
        if (__hip_atomic_load(&ctl[CW_ERR + 1], __ATOMIC_RELAXED, __HIP_MEMORY_SCOPE_AGENT) != 0u) rs *= 3.f;
#endif
#pragma unroll
        for (int j = 0; j < 4; ++j) { const int c = 4 * (lane + 64 * j); const float4 gv = ld4(p.in[I_GFIN] + c);
            st4(p.out + (size_t)row * DM + c, make_float4(v[j].x * rs * gv.x, v[j].y * rs * gv.y, v[j].z * rs * gv.z, v[j].w * rs * gv.w)); }
    }
    }
}

constexpr int LDS_BYTES = 147456;

extern "C" void kernel_launch(void* const* d_in, const int* in_sizes, int n_in, void* d_out, int out_size, void* d_ws, size_t ws_size, hipStream_t stream) {
    static int grid = 0;
    if (grid == 0) {
        if (n_in != N_IN || ws_size < WS_END) { fprintf(stderr, "kernel_launch: unexpected n_in %d / ws_size %zu (need %zu)\n", n_in, ws_size, (size_t)WS_END); grid = -1; return; }
        int dev = 0, cus = 0, per_cu = 0;
        (void)hipGetDevice(&dev);
        (void)hipDeviceGetAttribute(&cus, hipDeviceAttributeMultiprocessorCount, dev);
        (void)hipFuncSetAttribute((const void*)mk_fwd, hipFuncAttributeMaxDynamicSharedMemorySize, LDS_BYTES);
        (void)hipOccupancyMaxActiveBlocksPerMultiprocessor(&per_cu, (const void*)mk_fwd, 512, LDS_BYTES);
        if (per_cu < 1) { fprintf(stderr, "kernel_launch: occupancy query says %d blocks per CU\n", per_cu); per_cu = 1; }
        if (per_cu > 1) per_cu = 1;
        grid = cus * per_cu;
    }
    if (grid < 0) return;
    (void)hipMemsetAsync((char*)d_ws + WS_CTL, 0, 1 * MiB, stream);
    Params p{};
    for (int i = 0; i < N_IN; ++i) p.in[i] = (const float*)d_in[i];
    p.out = (float*)d_out; p.ws = (unsigned char*)d_ws;
    void* args[] = {&p};
    hipError_t e = hipLaunchCooperativeKernel((const void*)mk_fwd, dim3(grid), dim3(512), args, LDS_BYTES, stream);
    if (e != hipSuccess) fprintf(stderr, "cooperative launch failed: %s (grid %d)\n", hipGetErrorString(e), grid);
}
```

```cpp
#include <hip/hip_runtime.h>
#include <hip/hip_cooperative_groups.h>
#include <cstdio>
#include <cstdint>
namespace cg = cooperative_groups;

#define DEVI __device__ __forceinline__

constexpr int BATCH = 2, SEQ = 8192, NTOK = BATCH * SEQ, DM = 1024, MEMLEN = 256, NMEM = BATCH * MEMLEN;
constexpr int SSM_H = 8, SSM_P = 64, SSM_W = 512, SSM_N = 128, CONVCH = 1024;
constexpr int IN_COLS = 2312, COL_Z = 0, COL_XBC = 512, COL_DT = 1536, COL_Q = 1544, COL_K = 2056, COL_V = 2184;
constexpr int NEXP = 32, TOPK = 4, DFF = 1024, NASSIGN = NTOK * TOPK;
constexpr float EPS = 1e-5f;

enum { I_X = 0, I_MEM, I_GMIX, I_WIN, I_BQKV, I_CONVW, I_CONVB, I_DTB, I_ALOG, I_DSKIP, I_GSSM, I_SINK, I_RELB, I_WOUT, I_BOUT,
       I_GCROSS, I_GMEM, I_WQ, I_WKV, I_WO, I_GFFN, I_WR, I_BR, I_W1, I_B1, I_W2, I_B2, I_GFIN, N_IN };

constexpr size_t MiB = 1u << 20;
constexpr size_t WS_CTL = 0;
constexpr size_t WS_XN = 1 * MiB;
constexpr size_t WS_BIG = WS_XN + 34 * MiB;
constexpr size_t WS_XBC = WS_BIG + 144 * MiB;
constexpr size_t WS_MIXB = WS_XBC + 64 * MiB;
constexpr size_t WS_H1 = WS_MIXB + 32 * MiB;
constexpr size_t WS_H2 = WS_H1 + 64 * MiB;
constexpr size_t WS_YSSM = WS_H2 + 64 * MiB;
constexpr size_t WS_QCB = WS_YSSM + 32 * MiB;
constexpr size_t WS_OCB = WS_QCB + 16 * MiB;
constexpr size_t WS_ACTB = WS_OCB + 16 * MiB;
constexpr size_t WS_W1T = WS_ACTB + 144 * MiB;
constexpr size_t WS_W2T = WS_W1T + 128 * MiB;
constexpr size_t WS_WINT = WS_W2T + 64 * MiB;
constexpr size_t WS_WOUTT = WS_WINT + 5 * MiB;
constexpr size_t WS_WQT = WS_WOUTT + 2 * MiB;
constexpr size_t WS_WKVT = WS_WQT + 1 * MiB;
constexpr size_t WS_WOT = WS_WKVT + 2 * MiB;
constexpr size_t WS_SMALL = WS_WOT + 1 * MiB;
constexpr size_t WS_DT = WS_SMALL;
constexpr size_t WS_DTRAW = WS_DT + 512 * 1024;
constexpr size_t WS_KVMB = WS_DTRAW + 512 * 1024;
constexpr size_t WS_GATE = WS_KVMB + 1 * MiB;
constexpr size_t WS_SLOT = WS_GATE + 512 * 1024;
constexpr size_t WS_BIASP = WS_SLOT + 256 * 1024;
constexpr size_t WS_LIST = WS_GATE + 1 * MiB;
constexpr size_t WS_ACS = WS_LIST + 2 * MiB;
constexpr size_t WS_CD = WS_ACS + 512 * 1024;
constexpr size_t WS_END = WS_CD + 64 * 1024;
constexpr size_t WS_XC = WS_XBC;
constexpr size_t WS_ST = WS_YSSM;
constexpr size_t WS_HIN = WS_H2;
constexpr size_t WS_YB = WS_BIG;
constexpr int NROWS_MAX = NASSIGN + NEXP * 256;
constexpr int PJ = 2304, PJ_Z = 0, PJ_XBC = 512, PJ_Q = 1536, PJ_K = 2048, PJ_V = 2176;
constexpr int LDS_MISC = 146432;
constexpr int CW_CNT = 64;
constexpr int CW_ERR = 128;
#ifndef CHECK_ATTN
#define CHECK_ATTN 0
#endif
#ifndef CHECK_SSD
#define CHECK_SSD 0
#endif

struct Params { const float* in[N_IN]; float* out; unsigned char* ws; };

DEVI float wave_sum(float v) {
#pragma unroll
    for (int o = 32; o > 0; o >>= 1) v += __shfl_xor(v, o);
    return v;
}
DEVI float wave_max(float v) {
#pragma unroll
    for (int o = 32; o > 0; o >>= 1) v = fmaxf(v, __shfl_xor(v, o));
    return v;
}
DEVI float silu_f(float x) { return x / (1.f + __expf(-x)); }
DEVI float softplus_f(float x) { return fmaxf(x, 0.f) + log1pf(__expf(-fabsf(x))); }
DEVI float4 ld4(const float* p) { return *(const float4*)p; }
DEVI void st4(float* p, float4 v) { *(float4*)p = v; }

DEVI void rms_row(const float* xrow, const float* g, float* orow, int lane) {
    float4 v[4]; float s = 0.f;
#pragma unroll
    for (int j = 0; j < 4; ++j) { v[j] = ld4(xrow + 4 * (lane + 64 * j)); s += v[j].x * v[j].x + v[j].y * v[j].y + v[j].z * v[j].z + v[j].w * v[j].w; }
    const float rs = rsqrtf(wave_sum(s) * (1.f / 1024.f) + EPS);
#pragma unroll
    for (int j = 0; j < 4; ++j) { const float4 gv = ld4(g + 4 * (lane + 64 * j));
        st4(orow + 4 * (lane + 64 * j), make_float4(v[j].x * rs * gv.x, v[j].y * rs * gv.y, v[j].z * rs * gv.z, v[j].w * rs * gv.w)); }
}

struct TI { int tid, lane, wave, gw, gtid; };
DEVI TI fresh_ti() { int t = threadIdx.x; asm volatile("" : "+v"(t)); TI r; r.tid = t; r.lane = t & 63; r.wave = __builtin_amdgcn_readfirstlane(t >> 6); r.gw = blockIdx.x * 8 + r.wave; r.gtid = blockIdx.x * 512 + t; return r; }
#define PHASE_IDS() const TI ti_ = fresh_ti(); const int tid = ti_.tid, lane = ti_.lane, wave = ti_.wave, gw = ti_.gw, gtid = ti_.gtid; (void)tid; (void)lane; (void)wave; (void)gw; (void)gtid
DEVI float bf2f(unsigned short v) { return __uint_as_float((unsigned)v << 16); }

#define XB_TMO      128
#define XB_XCNT(j)  (256  + 64 * (j))
#define XB_XSUB(j)  (1280 + 64 * (j))
#define XB_XGEN(j)  (2304 + 64 * (j))
#define XB_TOP      3328
#define XB_TOPGEN   3392
#define XCD_BAR_WORDS 3456
#define XB_SPIN_CAP (1u << 18)
DEVI unsigned xb_ld(unsigned* p)              { return __hip_atomic_load(p, __ATOMIC_RELAXED, __HIP_MEMORY_SCOPE_AGENT); }
DEVI unsigned xb_add(unsigned* p, unsigned v) { return __hip_atomic_fetch_add(p, v, __ATOMIC_RELAXED, __HIP_MEMORY_SCOPE_AGENT); }
DEVI unsigned xb_xcc_id() { return (unsigned)__builtin_amdgcn_s_getreg((3 << 11) | 20) & 0xFu; }
#define XB_SPIN(cond, bar) do { unsigned _sp = 0; while (cond) { __builtin_amdgcn_s_sleep(1); \
    if ((++_sp & 255u) == 0u) { if (xb_ld(&(bar)[XB_TMO])) break; if (_sp > XB_SPIN_CAP) { atomicAdd(&(bar)[XB_TMO], 1u); break; } } } } while (0)
struct XcdBarrier { unsigned* bar; unsigned x; volatile __attribute__((address_space(3))) unsigned* st; };
DEVI XcdBarrier xcd_barrier_post(unsigned* bar, volatile __attribute__((address_space(3))) unsigned* st) {
    XcdBarrier b; b.bar = bar; b.x = xb_xcc_id(); b.st = st;
    if (threadIdx.x == 0) (void)xb_add(&bar[XB_XCNT(b.x)], 1u);
    return b;
}
DEVI void xcd_barrier_complete(unsigned* bar, unsigned x, unsigned& nloc, unsigned& nx) {
    const unsigned G = gridDim.x * gridDim.y * gridDim.z;
    unsigned sum, cnt, mine, sp = 0u;
    for (;;) {
        sum = 0u; cnt = 0u; mine = 0u;
#pragma unroll
        for (unsigned j = 0; j < 16; ++j) { const unsigned c = xb_ld(&bar[XB_XCNT(j)]); sum += c; cnt += (c > 0u) ? 1u : 0u; mine = (j == x) ? c : mine; }
        if (sum == G) break;
        __builtin_amdgcn_s_sleep(1);
        if ((++sp & 255u) == 0u) { if (xb_ld(&bar[XB_TMO])) break; if (sp > XB_SPIN_CAP) { atomicAdd(&bar[XB_TMO], 1u); break; } }
    }
    nloc = mine > 0u ? mine : 1u; nx = cnt > 0u ? cnt : 1u;
}
DEVI void xcd_barrier(const XcdBarrier& b) {
    asm volatile("s_waitcnt vmcnt(0)" ::: "memory");
    __syncthreads();
    if (threadIdx.x == 0) {
        unsigned* bar = b.bar;
        __builtin_amdgcn_s_waitcnt(0);
        unsigned nloc = b.st[0], nx = b.st[1];
        if (nloc == 0u) { xcd_barrier_complete(bar, b.x, nloc, nx); b.st[0] = nloc; b.st[1] = nx; }
        const unsigned old = xb_add(&bar[XB_XSUB(b.x)], 1u);
        const unsigned gen = old / nloc;
        if (old + 1u == (gen + 1u) * nloc) {
            __builtin_amdgcn_fence(__ATOMIC_RELEASE, "agent");
            asm volatile("s_waitcnt vmcnt(0)" ::: "memory");
            const unsigned og = xb_add(&bar[XB_TOP], 1u);
            const unsigned tg = og / nx;
            if (og + 1u == (tg + 1u) * nx) xb_add(&bar[XB_TOPGEN], 1u);
            else XB_SPIN(xb_ld(&bar[XB_TOPGEN]) == tg, bar);
            __builtin_amdgcn_fence(__ATOMIC_ACQUIRE, "agent");
            xb_add(&bar[XB_XGEN(b.x)], 1u);
            asm volatile("s_waitcnt vmcnt(0)" ::: "memory");
        } else {
            XB_SPIN(xb_ld(&bar[XB_XGEN(b.x)]) == gen, bar);
            __builtin_amdgcn_fence(__ATOMIC_ACQUIRE, "agent");
            asm volatile("s_waitcnt vmcnt(0)" ::: "memory");
        }
    }
    __syncthreads();
}

namespace g8 {
#define G8_LAS __attribute__((address_space(3)))
typedef unsigned short bf16_t;
typedef short bf16x8 __attribute__((ext_vector_type(8)));
typedef float f32x4 __attribute__((ext_vector_type(4)));
typedef float f32x2 __attribute__((ext_vector_type(2)));
typedef unsigned u32x4 __attribute__((ext_vector_type(4)));
typedef unsigned u32x2 __attribute__((ext_vector_type(2)));
constexpr int BM = 256, BK = 64, HALF = 128, HTB = HALF * BK * 2, STAGE_BYTES = 8 * HTB;

DEVI int lds_byte(int r, int c) { const int st = (r >> 4) * 2 + (c >> 5), rr = r & 15, cc = c & 31, ob = rr * 64 + cc * 2; return st * 1024 + (ob ^ (((ob >> 9) & 1) << 5)); }
DEVI void stage_rc(int b, int& R, int& C) { const int st = b / 1024, sb = b % 1024, swz = sb ^ (((sb >> 9) & 1) << 5); R = (st >> 1) * 16 + swz / 64; C = (st & 1) * 32 + (swz % 64) / 2; }
DEVI int perm32(int rho) { const int n = rho >> 4, i = rho & 15; return 8 * (i >> 2) + 4 * n + (i & 3); }
DEVI unsigned cvt_pk_bf16(float lo, float hi) { unsigned r; asm volatile("v_cvt_pk_bf16_f32 %0, %1, %2" : "=v"(r) : "v"(lo), "v"(hi)); return r; }

struct Unit {
    const int* alist;
    int acnt;
    int arow0;
    const char* bt;
    int orow0, ocol0;
    int e;
};


struct EpiSwiglu {
    static constexpr bool PERM = true;
    bf16_t* O; const float* bias;
    DEVI void operator()(const f32x4 (&acc)[2][2][4][2], const Unit& u, int wr, int wc, int fr, int fq) const {
        const int row0 = u.orow0 + wr * 64 + fr, col0 = u.ocol0 + wc * 32 + 8 * fq;
        const float* bp = bias + (size_t)u.e * 2048 + col0;
        f32x4 bv[2][2];
#pragma unroll
        for (int bj = 0; bj < 2; ++bj)
#pragma unroll
            for (int n = 0; n < 2; ++n) bv[bj][n] = *(const f32x4*)(bp + bj * HALF + 4 * n);
#pragma unroll
        for (int ai = 0; ai < 2; ++ai)
#pragma unroll
            for (int m = 0; m < 4; ++m) { bf16_t* rowp = O + (size_t)(row0 + ai * HALF + m * 16) * 1024 + (col0 >> 1);
#pragma unroll
                for (int bj = 0; bj < 2; ++bj) { const f32x4 v0 = acc[ai][bj][m][0] + bv[bj][0], v1 = acc[ai][bj][m][1] + bv[bj][1];
                    float o[4];
                    const float gl[4] = {v0[0], v0[2], v1[0], v1[2]}, li[4] = {v0[1], v0[3], v1[1], v1[3]};
#pragma unroll
                    for (int q = 0; q < 4; ++q) { const float xg = fminf(gl[q], 7.f), xl = fminf(fmaxf(li[q], -7.f), 7.f);
                        o[q] = xg * __builtin_amdgcn_rcpf(1.f + __expf(-1.702f * xg)) * (xl + 1.f); }
                    u32x2 w; w.x = cvt_pk_bf16(o[0], o[1]); w.y = cvt_pk_bf16(o[2], o[3]);
                    *(u32x2*)(rowp + bj * (HALF / 2)) = w; } }
    }
};
struct EpiBf16 {
    static constexpr bool PERM = true;
    bf16_t* O; int ldc; const float* bias; int bias_stride;
    DEVI void operator()(const f32x4 (&acc)[2][2][4][2], const Unit& u, int wr, int wc, int fr, int fq) const {
        const int row0 = u.orow0 + wr * 64 + fr, col0 = u.ocol0 + wc * 32 + 8 * fq;
        f32x4 bv[2][2];
#pragma unroll
        for (int bj = 0; bj < 2; ++bj)
#pragma unroll
            for (int n = 0; n < 2; ++n) bv[bj][n] = bias ? *(const f32x4*)(bias + (size_t)u.e * bias_stride + col0 + bj * HALF + 4 * n) : (f32x4){0.f, 0.f, 0.f, 0.f};
#pragma unroll
        for (int ai = 0; ai < 2; ++ai)
#pragma unroll
            for (int m = 0; m < 4; ++m) { bf16_t* rowp = O + (size_t)(row0 + ai * HALF + m * 16) * ldc + col0;
#pragma unroll
                for (int bj = 0; bj < 2; ++bj) { const f32x4 v0 = acc[ai][bj][m][0] + bv[bj][0], v1 = acc[ai][bj][m][1] + bv[bj][1];
                    u32x4 w; w.x = cvt_pk_bf16(v0[0], v0[1]); w.y = cvt_pk_bf16(v0[2], v0[3]); w.z = cvt_pk_bf16(v1[0], v1[1]); w.w = cvt_pk_bf16(v1[2], v1[3]);
                    *(u32x4*)(rowp + bj * HALF) = w; } }
    }
};

struct EpiBf16Dual {
    static constexpr bool PERM = true;
    bf16_t* O0; int ldc0; const float* bias0; bf16_t* O1; int ldc1;
    DEVI void operator()(const f32x4 (&acc)[2][2][4][2], const Unit& u, int wr, int wc, int fr, int fq) const {
        const int row0 = u.orow0 + wr * 64 + fr, col0 = u.ocol0 + wc * 32 + 8 * fq;
        bf16_t* O = u.e ? O1 : O0; const int ldc = u.e ? ldc1 : ldc0; const float* bias = u.e ? nullptr : bias0;
        f32x4 bv[2][2];
#pragma unroll
        for (int bj = 0; bj < 2; ++bj)
#pragma unroll
            for (int n = 0; n < 2; ++n) bv[bj][n] = bias ? *(const f32x4*)(bias + col0 + bj * HALF + 4 * n) : (f32x4){0.f, 0.f, 0.f, 0.f};
#pragma unroll
        for (int ai = 0; ai < 2; ++ai)
#pragma unroll
            for (int m = 0; m < 4; ++m) { bf16_t* rowp = O + (size_t)(row0 + ai * HALF + m * 16) * ldc + col0;
#pragma unroll
                for (int bj = 0; bj < 2; ++bj) { const f32x4 v0 = acc[ai][bj][m][0] + bv[bj][0], v1 = acc[ai][bj][m][1] + bv[bj][1];
                    u32x4 w; w.x = cvt_pk_bf16(v0[0], v0[1]); w.y = cvt_pk_bf16(v0[2], v0[3]); w.z = cvt_pk_bf16(v1[0], v1[1]); w.w = cvt_pk_bf16(v1[2], v1[3]);
                    *(u32x4*)(rowp + bj * HALF) = w; } }
    }
};
struct EpiF32Res {
    static constexpr bool PERM = false;
    float* C; const float* bias; const float* res;
    DEVI void operator()(const f32x4 (&acc)[2][2][4][2], const Unit& u, int wr, int wc, int fr, int fq) const {
        const int row0 = u.orow0 + wr * 64 + fr, col0 = u.ocol0 + wc * 32 + 4 * fq;
        f32x4 bv[2][2];
#pragma unroll
        for (int bj = 0; bj < 2; ++bj)
#pragma unroll
            for (int n = 0; n < 2; ++n) bv[bj][n] = bias ? *(const f32x4*)(bias + col0 + bj * HALF + n * 16) : (f32x4){0.f, 0.f, 0.f, 0.f};
#pragma unroll
        for (int ai = 0; ai < 2; ++ai)
#pragma unroll
            for (int m = 0; m < 4; ++m) { const size_t off = (size_t)(row0 + ai * HALF + m * 16) * 1024 + col0;
#pragma unroll
                for (int bj = 0; bj < 2; ++bj)
#pragma unroll
                    for (int n = 0; n < 2; ++n) *(f32x4*)(C + off + bj * HALF + n * 16) = acc[ai][bj][m][n] + bv[bj][n] + *(const f32x4*)(res + off + bj * HALF + n * 16);
                if (m & 1) asm volatile("" ::: "memory"); }
    }
};

template <class Epi, class Sched>
DEVI void gemm_phase(G8_LAS unsigned char* lds, const bf16_t* A, int K, int ashift, const Sched& S, const Epi& E) {
    int tid = threadIdx.x; asm volatile("" : "+v"(tid));
    const int wid = __builtin_amdgcn_readfirstlane(tid >> 6), lane = tid & 63, wr = wid >> 2, wc = wid & 3, fr = lane & 15, fq = lane >> 4;
    const int nt = K / BK;
    int Rl[2], Cl[2]; unsigned voffB[2];
#pragma unroll
    for (int i = 0; i < 2; ++i) { stage_rc(tid * 16 + i * 8192, Rl[i], Cl[i]); const int Rb = Epi::PERM ? ((Rl[i] & ~31) + perm32(Rl[i] & 31)) : Rl[i];
        voffB[i] = (unsigned)(Rb * K + Cl[i]) * 2u; }
    const size_t kstep = (size_t)(BK * 2);
    const size_t hstep = (size_t)HALF * K * 2;
    const unsigned ldsw = (unsigned)wid * 1024u;
    const int aoff = lds_byte(wr * 64 + fr, fq * 8), boff = lds_byte(wc * 32 + fr, fq * 8);
    const char* Ab = (const char*)A;
#define G8_AOFF(dst, u) do { _Pragma("unroll") for (int _h = 0; _h < 2; ++_h) _Pragma("unroll") for (int _i = 0; _i < 2; ++_i) { const int _row = _h * HALF + Rl[_i]; int _ar; \
        if ((u).alist) { const int _idx = _row < (u).acnt ? _row : 0; _ar = (u).alist[_idx] >> ashift; } else _ar = (u).arow0 + _row; \
        dst[_h][_i] = (unsigned)(_ar * K + Cl[_i]) * 2u; } } while (0)
#define G8_SA(b, h) (((b) * 2 + (h)) * HTB)
#define G8_SB(b, h) ((4 + (b) * 2 + (h)) * HTB)
#define G8_STAGE(bufoff, gbase, voff) do { _Pragma("unroll") for (int _i = 0; _i < 2; ++_i) \
        __builtin_amdgcn_global_load_lds((const unsigned*)((const char*)(gbase) + (voff)[_i]), (G8_LAS unsigned*)(lds + (bufoff) + ldsw + _i * 8192), 16, 0, 0); } while (0)
#define G8_LDA(dst, b, h) do { _Pragma("unroll") for (int m = 0; m < 4; ++m) _Pragma("unroll") for (int k = 0; k < 2; ++k) dst[m][k] = *(const G8_LAS bf16x8*)(lds + G8_SA(b, h) + aoff + m * 2048 + k * 1024); } while (0)
#define G8_LDB(dst, b, h) do { _Pragma("unroll") for (int n = 0; n < 2; ++n) _Pragma("unroll") for (int k = 0; k < 2; ++k) dst[n][k] = *(const G8_LAS bf16x8*)(lds + G8_SB(b, h) + boff + n * 2048 + k * 1024); } while (0)
#define G8_MMA(ai, bj, At, Bt) do { __builtin_amdgcn_s_setprio(1); _Pragma("unroll") for (int m = 0; m < 4; ++m) _Pragma("unroll") for (int n = 0; n < 2; ++n) _Pragma("unroll") for (int k = 0; k < 2; ++k) \
        acc[ai][bj][m][n] = __builtin_amdgcn_mfma_f32_16x16x32_bf16(Bt[n][k], At[m][k], acc[ai][bj][m][n], 0, 0, 0); __builtin_amdgcn_s_setprio(0); } while (0)
#define G8_WAIT_V(n) asm volatile("s_waitcnt vmcnt(" #n ")" ::: "memory")
#define G8_WAIT_L(n) asm volatile("s_waitcnt lgkmcnt(" #n ")" ::: "memory")
#define G8_BAR __builtin_amdgcn_s_barrier()
#define G8_SCHED __builtin_amdgcn_sched_barrier(0)
    Unit cur, nxt, nn; int ui = 0;
    if (!S.next(0, cur)) return;
    f32x4 acc[2][2][4][2];
#pragma unroll
    for (int a = 0; a < 2; ++a)
#pragma unroll
        for (int b = 0; b < 2; ++b)
#pragma unroll
            for (int m = 0; m < 4; ++m)
#pragma unroll
                for (int n = 0; n < 2; ++n) acc[a][b][m][n] = (f32x4){0.f, 0.f, 0.f, 0.f};
    bf16x8 At[4][2], B0[2][2], B1[2][2];
    unsigned cv[2][2], nv[2][2], fv[2][2];
    G8_AOFF(cv, cur);
    bool has_next = S.next(1, nxt);
    if (has_next) { G8_AOFF(nv, nxt); } else {
#pragma unroll
        for (int h = 0; h < 2; ++h)
#pragma unroll
            for (int i = 0; i < 2; ++i) nv[h][i] = cv[h][i]; }
    const char* cB = cur.bt; const char* nB = has_next ? nxt.bt : cB;
    G8_STAGE(G8_SB(0, 0), cB, voffB); G8_STAGE(G8_SB(0, 1), cB + hstep, voffB); G8_STAGE(G8_SA(0, 0), Ab, cv[0]); G8_STAGE(G8_SA(0, 1), Ab, cv[1]);
    if (wr == 1) G8_BAR;
    G8_WAIT_V(2); G8_BAR;
    G8_STAGE(G8_SB(1, 0), cB + kstep, voffB); G8_STAGE(G8_SA(1, 0), Ab + kstep, cv[0]); G8_STAGE(G8_SB(1, 1), cB + hstep + kstep, voffB);
    G8_WAIT_V(6); G8_BAR;
    for (;;) {
#pragma unroll 1
        for (int t = 0; t < nt; t += 2) {
            const bool last = (t == nt - 2);
            const size_t k1 = (size_t)(t + 1) * kstep;
            const size_t k2 = last ? 0 : (size_t)(t + 2) * kstep;
            const char* b2 = last ? nB : cB + (size_t)(t + 2) * kstep; const char* b3 = b2 + kstep;
            unsigned sv[2][2];
#pragma unroll
            for (int h = 0; h < 2; ++h)
#pragma unroll
                for (int i = 0; i < 2; ++i) sv[h][i] = last ? nv[h][i] : cv[h][i];
            G8_LDB(B0, 0, 0); G8_LDB(B1, 0, 1); G8_SCHED; G8_LDA(At, 0, 0); G8_STAGE(G8_SA(1, 1), Ab + k1, cv[1]);
            G8_WAIT_V(8); G8_WAIT_L(0); G8_BAR; G8_MMA(0, 0, At, B0); G8_MMA(0, 1, At, B1); G8_BAR; G8_SCHED;
            G8_LDA(At, 0, 1); G8_STAGE(G8_SB(0, 0), b2, voffB); G8_STAGE(G8_SB(0, 1), b2 + hstep, voffB); G8_STAGE(G8_SA(0, 0), Ab + k2, sv[0]);
            G8_WAIT_V(8); G8_WAIT_L(0); G8_BAR; G8_MMA(1, 0, At, B0); G8_MMA(1, 1, At, B1); G8_BAR; G8_SCHED;
            G8_LDB(B0, 1, 0); G8_LDB(B1, 1, 1); G8_SCHED; G8_LDA(At, 1, 0); G8_STAGE(G8_SA(0, 1), Ab + k2, sv[1]);
            G8_WAIT_V(8); G8_WAIT_L(0); G8_BAR; G8_MMA(0, 0, At, B0); G8_MMA(0, 1, At, B1); G8_BAR; G8_SCHED;
            G8_LDA(At, 1, 1); G8_STAGE(G8_SB(1, 0), b3, voffB); G8_STAGE(G8_SB(1, 1), b3 + hstep, voffB); G8_STAGE(G8_SA(1, 0), Ab + k2 + kstep, sv[0]);
            G8_WAIT_V(8); G8_WAIT_L(0); G8_BAR; G8_MMA(1, 0, At, B0); G8_MMA(1, 1, At, B1); G8_BAR; G8_SCHED;
        }
        if (wr == 0) G8_BAR;
        const bool has_nn = has_next && S.next(ui + 2, nn);
        if (has_nn) { G8_AOFF(fv, nn); }
        E(acc, cur, wr, wc, fr, fq);
        if (!has_next) break;
#pragma unroll
        for (int a = 0; a < 2; ++a)
#pragma unroll
            for (int b = 0; b < 2; ++b)
#pragma unroll
                for (int m = 0; m < 4; ++m)
#pragma unroll
                    for (int n = 0; n < 2; ++n) acc[a][b][m][n] = (f32x4){0.f, 0.f, 0.f, 0.f};
        cur = nxt; cB = nB; ++ui;
#pragma unroll
        for (int h = 0; h < 2; ++h)
#pragma unroll
            for (int i = 0; i < 2; ++i) { cv[h][i] = nv[h][i]; nv[h][i] = has_nn ? fv[h][i] : nv[h][i]; }
        has_next = has_nn; if (has_nn) { nxt = nn; nB = nn.bt; }
        if (wr == 1) G8_BAR;
    }
    G8_WAIT_V(0);
    G8_BAR;
#undef G8_AOFF
#undef G8_SA
#undef G8_SB
#undef G8_STAGE
#undef G8_LDA
#undef G8_LDB
#undef G8_MMA
#undef G8_WAIT_V
#undef G8_WAIT_L
#undef G8_BAR
#undef G8_SCHED
}

struct MoeSched {
    int G, vcu, nct, K;
    const G8_LAS int* tp; const G8_LAS int* cnt;
    const int* list;
    const char* Bt; size_t bt_estride;
    DEVI bool next(int i, Unit& u) const {
        const int L = i * G + vcu, total = tp[32] * nct;
        if (L >= total) return false;
        const int rtg = L / nct, ct = L - rtg * nct;
        int e = 0;
#pragma unroll
        for (int k = 1; k < 32; ++k) e += (rtg >= tp[k]) ? 1 : 0;
        const int rt = rtg - tp[e];
        u.e = e; u.orow0 = rtg * 256; u.ocol0 = ct * 256;
        u.bt = Bt + (size_t)e * bt_estride + (size_t)ct * 256 * K * 2;
        if (list) { u.alist = list + e * NTOK + rt * 256; u.acnt = min(256, cnt[e] - rt * 256); u.arow0 = 0; }
        else { u.alist = nullptr; u.acnt = 0; u.arow0 = rtg * 256; }
        return true;
    }
};
struct DenseSched {
    int G, c, K, nM0, nN0; const char* Bt0; int nM1, nN1, arow1; const char* Bt1;
    DEVI bool next(int i, Unit& u) const {
        const int nwg = nM0 * nN0, L = i * G + c;
        u.alist = nullptr; u.acnt = 0;
        if (L < nwg) {
            int wgid = L; { const int q = nwg / 8, r = nwg % 8, xcd = wgid % 8, off = wgid / 8; wgid = (xcd < r ? xcd * (q + 1) : r * (q + 1) + (xcd - r) * q) + off; }
            const int nig = 8 * nN0, gid = wgid / nig, fm = gid * 8, gsz = (nM0 - fm) < 8 ? (nM0 - fm) : 8;
            const int pm = fm + ((wgid % nig) % gsz), pn = (wgid % nig) / gsz;
            u.e = 0; u.arow0 = pm * 256; u.orow0 = pm * 256; u.ocol0 = pn * 256; u.bt = Bt0 + (size_t)pn * 256 * K * 2; return true;
        }
        const int l = L - nwg; if (l >= nM1 * nN1) return false;
        const int pm = l / nN1, pn = l - pm * nN1;
        u.e = 1; u.arow0 = arow1 + pm * 256; u.orow0 = pm * 256; u.ocol0 = pn * 256; u.bt = Bt1 + (size_t)pn * 256 * K * 2; return true;
    }
};
}

DEVI unsigned f2bf(float f) { unsigned u = __builtin_bit_cast(unsigned, f); return (u + 0x7fffu + ((u >> 16) & 1u)) >> 16; }
DEVI unsigned pk2(float lo, float hi) { return f2bf(lo) | (f2bf(hi) << 16); }
typedef unsigned v4u __attribute__((ext_vector_type(4)));
DEVI void transpose_item(const float* W, int K, int N, unsigned short* WT, __attribute__((address_space(3))) float* scr, int item, int lane, int ncols = 0) {
    const int nblk = (ncols ? ncols : N) / 32, kb = item / nblk, nb = item % nblk, k0 = 64 * kb, n0 = 32 * nb;
#pragma unroll 8
    for (int i = 0; i < 32; ++i) { const int kk = 2 * i + (lane >> 5); scr[kk * 33 + (lane & 31)] = W[(size_t)(k0 + kk) * N + n0 + (lane & 31)]; }
    asm volatile("s_waitcnt lgkmcnt(0)" ::: "memory");
    const int c = lane & 7;
#pragma unroll
    for (int j = 0; j < 4; ++j) { const int n = (lane >> 3) + 8 * j; const __attribute__((address_space(3))) float* s = scr + (8 * c) * 33 + n;
        v4u o; o.x = pk2(s[0 * 33], s[1 * 33]); o.y = pk2(s[2 * 33], s[3 * 33]); o.z = pk2(s[4 * 33], s[5 * 33]); o.w = pk2(s[6 * 33], s[7 * 33]);
        *(v4u*)(WT + (size_t)(n0 + n) * K + k0 + 8 * c) = o; }
    asm volatile("s_waitcnt lgkmcnt(0)" ::: "memory");
}

#define LAS3 __attribute__((address_space(3)))

typedef float f32x16 __attribute__((ext_vector_type(16)));
typedef short bf16x8_t __attribute__((ext_vector_type(8)));
typedef float f32x2_t __attribute__((ext_vector_type(2)));
typedef __bf16 bf16x2_t __attribute__((ext_vector_type(2)));
typedef unsigned u32x4_t __attribute__((ext_vector_type(4)));
typedef unsigned u32x2_t __attribute__((ext_vector_type(2)));
#define MFMA32(a, b, c) __builtin_amdgcn_mfma_f32_32x32x16_bf16((a), (b), (c), 0, 0, 0)
DEVI unsigned cvtpk(float lo, float hi) { f32x2_t v = {lo, hi}; bf16x2_t b = __builtin_convertvector(v, bf16x2_t); return __builtin_bit_cast(unsigned, b); }
DEVI int crow(int reg, int hi) { return (reg & 3) + 8 * (reg >> 2) + 4 * hi; }
DEVI bf16x8_t pack_step(const f32x16& x, int s) {
    u32x4_t p; p[0] = cvtpk(x[8 * s], x[8 * s + 1]); p[1] = cvtpk(x[8 * s + 2], x[8 * s + 3]); p[2] = cvtpk(x[8 * s + 4], x[8 * s + 5]); p[3] = cvtpk(x[8 * s + 6], x[8 * s + 7]);
    return __builtin_bit_cast(bf16x8_t, p);
}
DEVI int t5_bucket(int d) { return d < 16 ? d : min(31, 16 + (int)(log2f((float)d * 0.0625f) * (16.f / 3.f))); }

DEVI void swa_item(int item, const unsigned short* PROJB, unsigned short* MIXB, const float* relb, const float* sinks, LAS3 unsigned char* L, int tid_) {
    int tid = tid_; asm volatile("" : "+v"(tid));
    const int kv = item & 1, qb = (item >> 1) & 63, b = item >> 7;
    const int lane = tid & 63, w = __builtin_amdgcn_readfirstlane(tid >> 6), hi = lane >> 5, r32 = lane & 31;
    LAS3 unsigned char* KL = L; LAS3 unsigned char* VT = L + 36864; LAS3 float* BT = (LAS3 float*)(L + 36864 + 33280);
    const long tok0 = (long)b * SEQ + (long)(qb - 1) * 128;
#pragma unroll
    for (int i = 0; i < 4; ++i) { const int ci = tid + 512 * i, row = ci >> 3, ch = ci & 7; const bool ok = (qb > 0) || (row >= 128);
        u32x4_t v = {0u, 0u, 0u, 0u}; if (ok) v = *(const u32x4_t*)(PROJB + (size_t)(tok0 + row) * PJ + PJ_K + kv * 64 + ch * 8);
        *(LAS3 u32x4_t*)(KL + row * 144 + ch * 16) = v; }
#pragma unroll
    for (int i = 0; i < 2; ++i) { const int it = tid + 512 * i, rp = it >> 3, ch = it & 7; const bool ok = (qb > 0) || (rp >= 64);
        u32x4_t v0 = {0u, 0u, 0u, 0u}, v1 = {0u, 0u, 0u, 0u};
        if (ok) { const unsigned short* vp = PROJB + (size_t)(tok0 + 2 * rp) * PJ + PJ_V + kv * 64 + ch * 8; v0 = *(const u32x4_t*)vp; v1 = *(const u32x4_t*)(vp + PJ); }
#pragma unroll
        for (int e = 0; e < 8; ++e) { const unsigned a = (e & 1) ? (v0[e >> 1] >> 16) : (v0[e >> 1] & 0xffffu), c = (e & 1) ? (v1[e >> 1] & 0xffff0000u) : (v1[e >> 1] << 16);
            *(LAS3 unsigned*)(VT + (ch * 8 + e) * 520 + rp * 4) = a | c; } }
    { const int hql = tid >> 7, d = tid & 127; BT[tid] = relb[t5_bucket(d) * 8 + kv * 4 + hql]; }
    __syncthreads();
    const int hql = w >> 1, hq = kv * 4 + hql, qhalf = w & 1;
    const float sink = sinks[hq];
#pragma unroll 1
    for (int qi = 0; qi < 2; ++qi) {
        const int m = 2 * qhalf + qi, qf0 = 128 + 32 * m;
        const size_t qrow0 = (size_t)b * SEQ + (size_t)qb * 128 + 32 * m;
        const unsigned short* qp = PROJB + (qrow0 + r32) * PJ + PJ_Q + hq * 64 + 8 * hi;
        bf16x8_t qf[4];
#pragma unroll
        for (int ks = 0; ks < 4; ++ks) qf[ks] = *(const bf16x8_t*)(qp + 16 * ks);
        f32x16 S[5];
#pragma unroll
        for (int kk = 0; kk < 5; ++kk) {
#pragma unroll
            for (int r = 0; r < 16; ++r) S[kk][r] = 0.f;
#pragma unroll
            for (int ks = 0; ks < 4; ++ks) { const bf16x8_t a = *(const LAS3 bf16x8_t*)(KL + (32 * (m + kk) + r32) * 144 + (16 * ks + 8 * hi) * 2); S[kk] = MFMA32(a, qf[ks], S[kk]); }
        }
        float mx = sink;
#pragma unroll
        for (int kk = 0; kk < 5; ++kk)
#pragma unroll
            for (int r = 0; r < 16; ++r) { const int kf = 32 * (m + kk) + crow(r, hi), dist = qf0 + r32 - kf; const bool ok = (dist >= 0) && (dist < 128) && ((qb > 0) || (kf >= 128));
                const float sc = ok ? S[kk][r] * 0.125f + BT[hql * 128 + (dist & 127)] : -INFINITY; S[kk][r] = sc; mx = fmaxf(mx, sc); }
        mx = fmaxf(mx, __shfl_xor(mx, 32));
        float sum = 0.f;
#pragma unroll
        for (int kk = 0; kk < 5; ++kk)
#pragma unroll
            for (int r = 0; r < 16; ++r) { const float pe = __expf(S[kk][r] - mx); S[kk][r] = pe; sum += pe; }
        sum += __shfl_xor(sum, 32); sum += __expf(sink - mx);
        const float linv = 1.f / sum;
        f32x16 O[2];
#pragma unroll
        for (int db = 0; db < 2; ++db)
#pragma unroll
            for (int r = 0; r < 16; ++r) O[db][r] = 0.f;
#pragma unroll
        for (int kk = 0; kk < 5; ++kk)
#pragma unroll
            for (int s2 = 0; s2 < 2; ++s2) { const bf16x8_t pa = pack_step(S[kk], s2); const int kbase = 32 * (m + kk) + 16 * s2 + 4 * hi;
#pragma unroll
                for (int db = 0; db < 2; ++db) { LAS3 unsigned char* vp = VT + (32 * db + r32) * 520 + kbase * 2;
                    const u32x2_t lo = *(const LAS3 u32x2_t*)vp, hi2 = *(const LAS3 u32x2_t*)(vp + 16);
                    const u32x4_t vv = {lo[0], lo[1], hi2[0], hi2[1]};
                    O[db] = MFMA32(pa, __builtin_bit_cast(bf16x8_t, vv), O[db]); } }
#pragma unroll
        for (int r = 0; r < 16; ++r) { const int q = crow(r, hi); const float li = __shfl(linv, q);
            unsigned short* op = MIXB + (qrow0 + q) * 1024 + 512 + hq * 64 + r32;
            op[0] = (unsigned short)(cvtpk(O[0][r] * li, 0.f) & 0xffffu); op[32] = (unsigned short)(cvtpk(O[1][r] * li, 0.f) & 0xffffu); }
    }
    __syncthreads();
}

DEVI void xattn_item(int item, const unsigned short* QCB, const unsigned short* KVMB, unsigned short* OCB, LAS3 unsigned char* L, int tid_) {
    int tid = tid_; asm volatile("" : "+v"(tid));
    const int qblk = item & 31, hd = (item >> 5) & 3, b = item >> 7;
    const int lane = tid & 63, w = __builtin_amdgcn_readfirstlane(tid >> 6), hi = lane >> 5, r32 = lane & 31;
    LAS3 unsigned char* KL = L; LAS3 unsigned char* VT = L + 69632;
    const unsigned short* kvb = KVMB + (size_t)b * MEMLEN * 1024 + hd * 128;
#pragma unroll
    for (int i = 0; i < 8; ++i) { const int ci = tid + 512 * i, row = ci >> 4, ch = ci & 15;
        *(LAS3 u32x4_t*)(KL + row * 272 + ch * 16) = *(const u32x4_t*)(kvb + (size_t)row * 1024 + ch * 8); }
#pragma unroll
    for (int i = 0; i < 4; ++i) { const int it = tid + 512 * i, rp = it >> 4, ch = it & 15;
        const unsigned short* vp = kvb + (size_t)(2 * rp) * 1024 + 512 + ch * 8; const u32x4_t v0 = *(const u32x4_t*)vp, v1 = *(const u32x4_t*)(vp + 1024);
#pragma unroll
        for (int e = 0; e < 8; ++e) { const unsigned a = (e & 1) ? (v0[e >> 1] >> 16) : (v0[e >> 1] & 0xffffu), c = (e & 1) ? (v1[e >> 1] & 0xffff0000u) : (v1[e >> 1] << 16);
            *(LAS3 unsigned*)(VT + (ch * 8 + e) * 520 + rp * 4) = a | c; } }
    __syncthreads();
    const size_t qrow0 = (size_t)b * SEQ + (size_t)qblk * 256 + 32 * w;
    const unsigned short* qp = QCB + (qrow0 + r32) * 512 + hd * 128 + 8 * hi;
    f32x16 S[8];
    {
        bf16x8_t qf[8];
#pragma unroll
        for (int ks = 0; ks < 8; ++ks) qf[ks] = *(const bf16x8_t*)(qp + 16 * ks);
#pragma unroll
        for (int kk = 0; kk < 8; ++kk) {
#pragma unroll
            for (int r = 0; r < 16; ++r) S[kk][r] = 0.f;
#pragma unroll
            for (int ks = 0; ks < 8; ++ks) { const bf16x8_t a = *(const LAS3 bf16x8_t*)(KL + (32 * kk + r32) * 272 + (16 * ks + 8 * hi) * 2); S[kk] = MFMA32(a, qf[ks], S[kk]); }
        }
    }
    const float sc = 0.08838834764831845f;
    float mx = -INFINITY;
#pragma unroll
    for (int kk = 0; kk < 8; ++kk)
#pragma unroll
        for (int r = 0; r < 16; ++r) mx = fmaxf(mx, S[kk][r]);
    mx = fmaxf(mx, __shfl_xor(mx, 32));
    float sum = 0.f;
#pragma unroll
    for (int kk = 0; kk < 8; ++kk)
#pragma unroll
        for (int r = 0; r < 16; ++r) { const float pe = __expf((S[kk][r] - mx) * sc); S[kk][r] = pe; sum += pe; }
    sum += __shfl_xor(sum, 32);
    const float linv = 1.f / sum;
    f32x16 O[4];
#pragma unroll
    for (int db = 0; db < 4; ++db)
#pragma unroll
        for (int r = 0; r < 16; ++r) O[db][r] = 0.f;
#pragma unroll
    for (int kk = 0; kk < 8; ++kk)
#pragma unroll
        for (int s2 = 0; s2 < 2; ++s2) { const bf16x8_t pa = pack_step(S[kk], s2); const int kbase = 32 * kk + 16 * s2 + 4 * hi;
#pragma unroll
            for (int db = 0; db < 4; ++db) { LAS3 unsigned char* vp = VT + (32 * db + r32) * 520 + kbase * 2;
                const u32x2_t lo = *(const LAS3 u32x2_t*)vp, hi2 = *(const LAS3 u32x2_t*)(vp + 16);
                const u32x4_t vv = {lo[0], lo[1], hi2[0], hi2[1]};
                O[db] = MFMA32(pa, __builtin_bit_cast(bf16x8_t, vv), O[db]); } }
#pragma unroll
    for (int r = 0; r < 16; ++r) { const int q = crow(r, hi); const float li = __shfl(linv, q);
        unsigned short* op = OCB + (qrow0 + q) * 512 + hd * 128 + r32;
#pragma unroll
        for (int db = 0; db < 4; ++db) op[32 * db] = (unsigned short)(cvtpk(O[db][r] * li, 0.f) & 0xffffu); }
    __syncthreads();
}


DEVI void ssd_s1_item(int item, const unsigned short* PROJB, const float* DTRAW, const float* convw, const float* convb, const float* dtbias, const float* alog,
                      unsigned short* XC, float* DT, float* ACS, float* CD, float* ST, LAS3 unsigned char* L, int tid_) {
    int tid = tid_; asm volatile("" : "+v"(tid));
    const int g = item & 1, c = (item >> 1) & 63, b = item >> 7;
    const int lane = tid & 63, w = __builtin_amdgcn_readfirstlane(tid >> 6), hi = lane >> 5, r32 = lane & 31;
    LAS3 unsigned char* XwT = L; LAS3 unsigned char* BT = L + 69632;
    LAS3 float* dts = (LAS3 float*)(L + 104448); LAS3 float* acs = dts + 512; LAS3 float* wts = acs + 512;
    const size_t tok0 = (size_t)b * SEQ + (size_t)c * 128;
    if (w < 4) {
        const int h = 4 * g + w; const float ah = -__expf(alog[h]), db = dtbias[h];
        const float d0 = softplus_f(DTRAW[(tok0 + 2 * lane) * 8 + h] + db), d1 = softplus_f(DTRAW[(tok0 + 2 * lane + 1) * 8 + h] + db);
        const float a0 = d0 * ah, a1 = d1 * ah;
        float sc = a0 + a1;
#pragma unroll
        for (int o = 1; o < 64; o <<= 1) { const float v = __shfl_up(sc, o); if (lane >= o) sc += v; }
        const float ex = sc - (a0 + a1), c0 = ex + a0, c1 = ex + a0 + a1, cend = __shfl(sc, 63);
        dts[w * 128 + 2 * lane] = d0; dts[w * 128 + 2 * lane + 1] = d1; acs[w * 128 + 2 * lane] = c0; acs[w * 128 + 2 * lane + 1] = c1;
        wts[w * 128 + 2 * lane] = __expf(cend - c0) * d0; wts[w * 128 + 2 * lane + 1] = __expf(cend - c1) * d1;
        DT[(tok0 + 2 * lane) * 8 + h] = d0; DT[(tok0 + 2 * lane + 1) * 8 + h] = d1; ACS[(tok0 + 2 * lane) * 8 + h] = c0; ACS[(tok0 + 2 * lane + 1) * 8 + h] = c1;
        if (lane == 0) CD[((size_t)b * 64 + c) * 8 + h] = __expf(cend);
    }
    __syncthreads();
    {
        const int cg = lane, ch = cg < 32 ? g * 256 + cg * 8 : (cg < 48 ? 512 + g * 128 + (cg - 32) * 8 : 768 + g * 128 + (cg - 48) * 8);
        float wk[4][8], bb[8];
#pragma unroll
        for (int k = 0; k < 4; ++k) { const float4 a = ld4(convw + k * CONVCH + ch), d = ld4(convw + k * CONVCH + ch + 4); wk[k][0] = a.x; wk[k][1] = a.y; wk[k][2] = a.z; wk[k][3] = a.w; wk[k][4] = d.x; wk[k][5] = d.y; wk[k][6] = d.z; wk[k][7] = d.w; }
        { const float4 a = ld4(convb + ch), d = ld4(convb + ch + 4); bb[0] = a.x; bb[1] = a.y; bb[2] = a.z; bb[3] = a.w; bb[4] = d.x; bb[5] = d.y; bb[6] = d.z; bb[7] = d.w; }
        const int s0 = w * 16;
        const unsigned short* src = PROJB + (tok0 + s0) * PJ + PJ_XBC + ch;
        u32x4_t rw[19];
#pragma unroll
        for (int i = 0; i < 19; ++i) { const bool ok = (c > 0) || (s0 + i - 3 >= 0); rw[i] = (u32x4_t){0u, 0u, 0u, 0u}; if (ok) rw[i] = *(const u32x4_t*)(src + (ptrdiff_t)(i - 3) * PJ); }
        const int hl = cg >> 3;
#pragma unroll
        for (int i2 = 0; i2 < 8; ++i2) {
            float y[2][8];
#pragma unroll
            for (int q = 0; q < 2; ++q) {
                const int i = 2 * i2 + q;
#pragma unroll
                for (int e = 0; e < 8; ++e) { float a = bb[e];
#pragma unroll
                    for (int k = 0; k < 4; ++k) { const unsigned wd = rw[i + k][e >> 1]; a += wk[k][e] * __uint_as_float((e & 1) ? (wd & 0xffff0000u) : (wd << 16)); }
                    y[q][e] = silu_f(a); }
                u32x4_t o; o[0] = cvtpk(y[q][0], y[q][1]); o[1] = cvtpk(y[q][2], y[q][3]); o[2] = cvtpk(y[q][4], y[q][5]); o[3] = cvtpk(y[q][6], y[q][7]);
                *(u32x4_t*)(XC + (tok0 + s0 + i) * 1024 + ch) = o;
            }
            const int s = s0 + 2 * i2;
            if (cg < 32) { const float w0 = wts[hl * 128 + s], w1 = wts[hl * 128 + s + 1];
#pragma unroll
                for (int e = 0; e < 8; ++e) *(LAS3 unsigned*)(XwT + hl * 17408 + ((cg & 7) * 8 + e) * 272 + s * 2) = cvtpk(y[0][e] * w0, y[1][e] * w1); }
            else if (cg < 48) {
#pragma unroll
                for (int e = 0; e < 8; ++e) *(LAS3 unsigned*)(BT + ((cg - 32) * 8 + e) * 272 + s * 2) = cvtpk(y[0][e], y[1][e]); }
        }
    }
    __syncthreads();
    {
        const int pb = w >> 2, nb = w & 3;
#pragma unroll 1
        for (int hl = 0; hl < 4; ++hl) {
            f32x16 acc;
#pragma unroll
            for (int r = 0; r < 16; ++r) acc[r] = 0.f;
#pragma unroll
            for (int ks = 0; ks < 8; ++ks) { const bf16x8_t a = *(const LAS3 bf16x8_t*)(XwT + hl * 17408 + (32 * pb + r32) * 272 + (16 * ks + 8 * hi) * 2);
                const bf16x8_t bq = *(const LAS3 bf16x8_t*)(BT + (32 * nb + r32) * 272 + (16 * ks + 8 * hi) * 2); acc = MFMA32(a, bq, acc); }
            float* sp = ST + (((size_t)b * 64 + c) * 8 + 4 * g + hl) * 8192 + 32 * nb + r32;
#pragma unroll
            for (int r = 0; r < 16; ++r) sp[(32 * pb + crow(r, hi)) * 128] = acc[r];
        }
    }
    __syncthreads();
}

DEVI void ssd_s3_item(int item, const unsigned short* XC, const float* DT, const float* ACS, const unsigned short* HIN, const unsigned short* PROJB, const float* dskip, const float* gssm,
                      float* YPRE, unsigned short* MIXB, LAS3 unsigned char* L, int tid_) {
    int tid = tid_; asm volatile("" : "+v"(tid));
    const int g = item & 1, c = (item >> 1) & 63, b = item >> 7;
    const int lane = tid & 63, w = __builtin_amdgcn_readfirstlane(tid >> 6), hi = lane >> 5, r32 = lane & 31;
    LAS3 unsigned char* Cs = L; LAS3 unsigned char* BM = L + 34816; LAS3 unsigned char* XT = L + 69632; LAS3 unsigned char* HN = L + 87040;
    LAS3 float* dts = (LAS3 float*)(L + 104448); LAS3 float* acs = dts + 512; LAS3 float* rowsq = acs + 512;
    const size_t tok0 = (size_t)b * SEQ + (size_t)c * 128;
#pragma unroll
    for (int i = 0; i < 4; ++i) { const int ci = tid + 512 * i, row = ci >> 4, chk = ci & 15;
        *(LAS3 u32x4_t*)(Cs + row * 272 + chk * 16) = *(const u32x4_t*)(XC + (tok0 + row) * 1024 + 768 + g * 128 + chk * 8);
        *(LAS3 u32x4_t*)(BM + row * 272 + chk * 16) = *(const u32x4_t*)(XC + (tok0 + row) * 1024 + 512 + g * 128 + chk * 8); }
    { const int t = tid >> 2, hl = tid & 3; dts[hl * 128 + t] = DT[(tok0 + t) * 8 + 4 * g + hl]; acs[hl * 128 + t] = ACS[(tok0 + t) * 8 + 4 * g + hl]; }
    __syncthreads();
    const int lb = w >> 1;
    f32x16 CB[2];
#pragma unroll
    for (int j = 0; j < 2; ++j) {
#pragma unroll
        for (int r = 0; r < 16; ++r) CB[j][r] = 0.f;
        const int sb = 2 * (w & 1) + j;
        if (sb <= lb) {
#pragma unroll
            for (int ks = 0; ks < 8; ++ks) { const bf16x8_t a = *(const LAS3 bf16x8_t*)(Cs + (32 * lb + r32) * 272 + (16 * ks + 8 * hi) * 2);
                const bf16x8_t bq = *(const LAS3 bf16x8_t*)(BM + (32 * sb + r32) * 272 + (16 * ks + 8 * hi) * 2); CB[j] = MFMA32(a, bq, CB[j]); }
        }
    }
    __syncthreads();
    const int pb = w & 1;
    float sq[16];
#pragma unroll
    for (int r = 0; r < 16; ++r) sq[r] = 0.f;
    LAS3 unsigned char* ZS = L + 110592;
#pragma unroll 1
    for (int hl = 0; hl < 4; ++hl) {
        const int h = 4 * g + hl;
        {
            const int sp = tid >> 3, chk = tid & 7;
            const unsigned short* xp = XC + (tok0 + 2 * sp) * 1024 + h * 64 + chk * 8; const u32x4_t v0 = *(const u32x4_t*)xp, v1 = *(const u32x4_t*)(xp + 1024);
#pragma unroll
            for (int e = 0; e < 8; ++e) { const unsigned a = (e & 1) ? (v0[e >> 1] >> 16) : (v0[e >> 1] & 0xffffu), d = (e & 1) ? (v1[e >> 1] & 0xffff0000u) : (v1[e >> 1] << 16);
                *(LAS3 unsigned*)(XT + (chk * 8 + e) * 272 + sp * 4) = a | d; }
            const unsigned short* hp = HIN + (((size_t)b * 64 + c) * 8 + h) * 8192;
#pragma unroll
            for (int i = 0; i < 2; ++i) { const int ci = tid + 512 * i, row = ci >> 4, ck = ci & 15; *(LAS3 u32x4_t*)(HN + row * 272 + ck * 16) = *(const u32x4_t*)(hp + row * 128 + ck * 8); }
#pragma unroll
            for (int i = 0; i < 2; ++i) { const int ci = tid + 512 * i, row = ci >> 3, ck = ci & 7; *(LAS3 u32x4_t*)(ZS + row * 144 + ck * 16) = *(const u32x4_t*)(PROJB + (tok0 + row) * PJ + PJ_Z + h * 64 + ck * 8); }
        }
#pragma unroll
        for (int j = 0; j < 2; ++j) { const int sb = 2 * (w & 1) + j;
            if (sb <= lb) { const int s = 32 * sb + r32; const float as = acs[hl * 128 + s], ds = dts[hl * 128 + s];
#pragma unroll
                for (int r = 0; r < 16; ++r) { const int l = 32 * lb + crow(r, hi); const float v = (s <= l) ? CB[j][r] * __expf(acs[hl * 128 + l] - as) * ds : 0.f;
                    *(LAS3 unsigned short*)(BM + l * 272 + s * 2) = (unsigned short)(cvtpk(v, 0.f) & 0xffffu); } } }
        __syncthreads();
        f32x16 acc;
#pragma unroll
        for (int r = 0; r < 16; ++r) acc[r] = 0.f;
#pragma unroll
        for (int ks = 0; ks < 8; ++ks) { const bf16x8_t a = *(const LAS3 bf16x8_t*)(Cs + (32 * lb + r32) * 272 + (16 * ks + 8 * hi) * 2);
            const bf16x8_t bq = *(const LAS3 bf16x8_t*)(HN + (32 * pb + r32) * 272 + (16 * ks + 8 * hi) * 2); acc = MFMA32(a, bq, acc); }
#pragma unroll
        for (int r = 0; r < 16; ++r) acc[r] *= __expf(acs[hl * 128 + 32 * lb + crow(r, hi)]);
#pragma unroll
        for (int ks = 0; ks < 8; ++ks) if (ks < 2 * (lb + 1)) { const bf16x8_t a = *(const LAS3 bf16x8_t*)(BM + (32 * lb + r32) * 272 + (16 * ks + 8 * hi) * 2);
            const bf16x8_t bq = *(const LAS3 bf16x8_t*)(XT + (32 * pb + r32) * 272 + (16 * ks + 8 * hi) * 2); acc = MFMA32(a, bq, acc); }
        const float dsk = dskip[h]; const int pc = 32 * pb + r32;
        float* yp = YPRE + tok0 * 512 + h * 64 + pc;
#pragma unroll
        for (int r = 0; r < 16; ++r) { const int l = 32 * lb + crow(r, hi);
            const float xv = bf2f(*(const LAS3 unsigned short*)(XT + pc * 272 + l * 2)), z = bf2f(*(const LAS3 unsigned short*)(ZS + l * 144 + pc * 2));
            const float y = (acc[r] + dsk * xv) * silu_f(z); yp[l * 512] = y; sq[r] += y * y; }
        __syncthreads();
    }
#pragma unroll
    for (int r = 0; r < 16; ++r) { float v = sq[r];
#pragma unroll
        for (int o = 1; o < 32; o <<= 1) v += __shfl_xor(v, o);
        if (r32 == 0) rowsq[(32 * lb + crow(r, hi)) * 2 + pb] = v; }
    __syncthreads();
#pragma unroll 1
    for (int hl = 0; hl < 4; ++hl) { const int col = (4 * g + hl) * 64 + 32 * pb + r32; const float gs = gssm[col];
#pragma unroll
        for (int r = 0; r < 16; ++r) { const int l = 32 * lb + crow(r, hi); const float rs = rsqrtf((rowsq[l * 2] + rowsq[l * 2 + 1]) * (1.f / 256.f) + EPS);
            MIXB[(tok0 + l) * 1024 + col] = (unsigned short)(cvtpk(YPRE[(tok0 + l) * 512 + col] * rs * gs, 0.f) & 0xffffu); } }
    __syncthreads();
}

__global__ void __launch_bounds__(512, 2) mk_fwd(Params p) {
    extern __shared__ __attribute__((aligned(16))) unsigned char lds[];
    cg::grid_group grid = cg::this_grid();
    const int NGW = gridDim.x * 8, NGT = gridDim.x * 512, G = gridDim.x;
    unsigned char* ws = p.ws;
    unsigned* ctl = (unsigned*)(ws + WS_CTL);
    float* H1 = (float*)(ws + WS_H1); float* H2 = (float*)(ws + WS_H2);
    float* DT = (float*)(ws + WS_DT); float* DTRAW = (float*)(ws + WS_DTRAW); float* GATE = (float*)(ws + WS_GATE); float* BIASP = (float*)(ws + WS_BIASP);
    typedef unsigned short bf;
    bf* XN = (bf*)(ws + WS_XN); bf* PROJB = (bf*)(ws + WS_BIG); bf* YB = (bf*)(ws + WS_YB); bf* MIXB = (bf*)(ws + WS_MIXB); bf* QCB = (bf*)(ws + WS_QCB); bf* OCB = (bf*)(ws + WS_OCB);
    bf* ACTB = (bf*)(ws + WS_ACTB); bf* KVMB = (bf*)(ws + WS_KVMB);
    bf* CHK_MIX = (bf*)(ws + WS_ACTB); bf* CHK_OC = (bf*)(ws + WS_ACTB + 64 * MiB); (void)CHK_MIX; (void)CHK_OC;
    float* CHK_YSSM = (float*)(ws + WS_ACTB + 32 * MiB); float* CHK_XBC = (float*)(ws + WS_ACTB + 80 * MiB); (void)CHK_YSSM; (void)CHK_XBC;
    bf* XC = (bf*)(ws + WS_XC); float* ACS = (float*)(ws + WS_ACS); float* CD = (float*)(ws + WS_CD); float* ST = (float*)(ws + WS_ST); bf* HIN = (bf*)(ws + WS_HIN);
    bf* W1T = (bf*)(ws + WS_W1T); bf* W2T = (bf*)(ws + WS_W2T); bf* WINT = (bf*)(ws + WS_WINT); bf* WOUTT = (bf*)(ws + WS_WOUTT); bf* WQT = (bf*)(ws + WS_WQT); bf* WKVT = (bf*)(ws + WS_WKVT); bf* WOT = (bf*)(ws + WS_WOT);
    int* LIST = (int*)(ws + WS_LIST); int* SLOT = (int*)(ws + WS_SLOT);
    LAS3 unsigned char* ldsp = (LAS3 unsigned char*)lds;
    LAS3 int* TP = (LAS3 int*)(ldsp + LDS_MISC); LAS3 int* CNTL = TP + 64;
    const float* x = p.in[I_X];
    const int vcu = (G % 8 == 0) ? (blockIdx.x % 8) * (G / 8) + blockIdx.x / 8 : blockIdx.x;
    if (threadIdx.x < 2) ((LAS3 unsigned*)(ldsp + LDS_MISC + 512))[threadIdx.x] = 0u;
    __syncthreads();
    const XcdBarrier xbar = xcd_barrier_post(ctl + 4096, (volatile LAS3 unsigned*)(ldsp + LDS_MISC + 512));
#define GRID_BAR() xcd_barrier(xbar)

    {
        PHASE_IDS();
        LAS3 float* wdt = (LAS3 float*)ldsp;
        for (int i = tid; i < 1024 * 2; i += 512) { const int k = i >> 1, hh = (i & 1) * 4; { const float4 t4 = ld4(p.in[I_WIN] + (size_t)k * IN_COLS + COL_DT + hh); *(LAS3 g8::f32x4*)(wdt + k * 8 + hh) = (g8::f32x4){t4.x, t4.y, t4.z, t4.w}; } }
        for (int i = gtid; i < PJ; i += NGT) BIASP[i] = i < PJ_Q ? 0.f : p.in[I_BQKV][i - PJ_Q];
        __syncthreads();
        for (int r = gw; r < NTOK + NMEM; r += NGW) {
            const bool ismem = r >= NTOK;
            const float* xrow = ismem ? p.in[I_MEM] + (size_t)(r - NTOK) * DM : x + (size_t)r * DM;
            const float* g = ismem ? p.in[I_GMEM] : p.in[I_GMIX];
            float4 v[4]; float ss = 0.f;
#pragma unroll
            for (int j = 0; j < 4; ++j) { v[j] = ld4(xrow + 4 * (lane + 64 * j)); ss += v[j].x * v[j].x + v[j].y * v[j].y + v[j].z * v[j].z + v[j].w * v[j].w; }
            const float rs = rsqrtf(wave_sum(ss) * (1.f / 1024.f) + EPS);
            float dacc[8];
#pragma unroll
            for (int h = 0; h < 8; ++h) dacc[h] = 0.f;
#pragma unroll
            for (int j = 0; j < 4; ++j) { const int c = 4 * (lane + 64 * j); const float4 gv = ld4(g + c);
                v[j] = make_float4(v[j].x * rs * gv.x, v[j].y * rs * gv.y, v[j].z * rs * gv.z, v[j].w * rs * gv.w);
                *(uint2*)(XN + (size_t)r * DM + c) = make_uint2(pk2(v[j].x, v[j].y), pk2(v[j].z, v[j].w));
                if (!ismem) { const float uu[4] = {v[j].x, v[j].y, v[j].z, v[j].w};
#pragma unroll
                    for (int q = 0; q < 4; ++q) { const g8::f32x4 w0 = *(const LAS3 g8::f32x4*)(wdt + (c + q) * 8), w1 = *(const LAS3 g8::f32x4*)(wdt + (c + q) * 8 + 4);
                        dacc[0] += uu[q] * w0.x; dacc[1] += uu[q] * w0.y; dacc[2] += uu[q] * w0.z; dacc[3] += uu[q] * w0.w;
                        dacc[4] += uu[q] * w1.x; dacc[5] += uu[q] * w1.y; dacc[6] += uu[q] * w1.z; dacc[7] += uu[q] * w1.w; } }
            }
            if (!ismem) {
#pragma unroll
                for (int h = 0; h < 8; ++h) dacc[h] = wave_sum(dacc[h]);
                if (lane == 0) { st4(DTRAW + (size_t)r * 8, make_float4(dacc[0], dacc[1], dacc[2], dacc[3])); st4(DTRAW + (size_t)r * 8 + 4, make_float4(dacc[4], dacc[5], dacc[6], dacc[7])); }
            }
        }
        __syncthreads();
        LAS3 float* scr = (LAS3 float*)(ldsp + wave * 16384);
        constexpr int IT1 = 16 * (2048 / 32), IT2 = 16 * (1024 / 32);
        constexpr int IA = 16 * (1536 / 32), IB = 16 * (768 / 32), IO = 16 * 32, IQ = 16 * 16, IKV = 16 * 32, IWO = 8 * 32;
        constexpr int NSM = IA + IB + IO + IQ + IKV + IWO, NIT = NSM + NEXP * (IT1 + IT2);
        for (int it = gw; it < NIT; it += NGW) {
            int r = it;
            if (r < IA) { transpose_item(p.in[I_WIN], 1024, IN_COLS, WINT, scr, r, lane, 1536); continue; } r -= IA;
            if (r < IB) { transpose_item(p.in[I_WIN] + COL_Q, 1024, IN_COLS, WINT + (size_t)1536 * 1024, scr, r, lane, 768); continue; } r -= IB;
            if (r < IO) { transpose_item(p.in[I_WOUT], 1024, 1024, WOUTT, scr, r, lane); continue; } r -= IO;
            if (r < IQ) { transpose_item(p.in[I_WQ], 1024, 512, WQT, scr, r, lane); continue; } r -= IQ;
            if (r < IKV) { transpose_item(p.in[I_WKV], 1024, 1024, WKVT, scr, r, lane); continue; } r -= IKV;
            if (r < IWO) { transpose_item(p.in[I_WO], 512, 1024, WOT, scr, r, lane); continue; } r -= IWO;
            if (r < NEXP * IT1) { const int e = r / IT1, q = r - e * IT1; transpose_item(p.in[I_W1] + (size_t)e * 1024 * 2048, 1024, 2048, W1T + (size_t)e * 2048 * 1024, scr, q, lane); continue; } r -= NEXP * IT1;
            { const int e = r / IT2, q = r - e * IT2; transpose_item(p.in[I_W2] + (size_t)e * 1024 * 1024, 1024, 1024, W2T + (size_t)e * 1024 * 1024, scr, q, lane); }
        }
    }
    grid.sync();
    {
        g8::DenseSched S{G, (int)blockIdx.x, 1024, NTOK / 256, PJ / 256, (const char*)WINT, NMEM / 256, 4, NTOK, (const char*)WKVT};
        g8::EpiBf16Dual E{PROJB, PJ, BIASP, KVMB, 1024};
        g8::gemm_phase(ldsp, XN, 1024, 0, S, E);
    }
    GRID_BAR();
    {
    PHASE_IDS();
    for (int item = blockIdx.x; item < BATCH * 64 * 2; item += G)
        ssd_s1_item(item, PROJB, DTRAW, p.in[I_CONVW], p.in[I_CONVB], p.in[I_DTB], p.in[I_ALOG], XC, DT, ACS, CD, ST, ldsp, tid);
#if CHECK_SSD
    for (int idx = gtid; idx < NTOK * 256; idx += NGT) {
        const int row = idx >> 8, c4 = (idx & 255) * 4, t = row & (SEQ - 1);
        float4 a = ld4(p.in[I_CONVB] + c4);
#pragma unroll
        for (int k = 0; k < 4; ++k) if (t - 3 + k >= 0) {
            const float4 w = ld4(p.in[I_CONVW] + k * CONVCH + c4); const uint2 pv = *(const uint2*)(PROJB + (size_t)(row - 3 + k) * PJ + PJ_XBC + c4);
            a.x += w.x * __uint_as_float(pv.x << 16); a.y += w.y * __uint_as_float(pv.x & 0xffff0000u); a.z += w.z * __uint_as_float(pv.y << 16); a.w += w.w * __uint_as_float(pv.y & 0xffff0000u); }
        st4(CHK_XBC + (size_t)row * 1024 + c4, make_float4(silu_f(a.x), silu_f(a.y), silu_f(a.z), silu_f(a.w)));
    }
#endif
    }
    GRID_BAR();
    {
    PHASE_IDS();
    for (int item = blockIdx.x; item < BATCH * 64 * 2; item += G) swa_item(item, PROJB, MIXB, p.in[I_RELB], p.in[I_SINK], ldsp, tid);
    {
        for (int el = gtid; el < BATCH * 8 * 8192; el += NGT) {
            const int bh = el >> 13, pn = el & 8191, b = bh >> 3, h = bh & 7;
            float st = 0.f;
#pragma unroll 8
            for (int c = 0; c < 64; ++c) { const size_t idx = (((size_t)b * 64 + c) * 8 + h) * 8192 + pn;
                HIN[idx] = (bf)(cvtpk(st, 0.f) & 0xffffu); st = st * CD[((size_t)b * 64 + c) * 8 + h] + ST[idx]; }
        }
    }
#if CHECK_SSD
    for (int item = gw; item < BATCH * SSM_H * SSM_P; item += NGW) {
        const int b = item >> 9, h = (item >> 6) & 7, pp = item & 63, g = h >> 2;
        const float ah = -__expf(p.in[I_ALOG][h]), dsk = p.in[I_DSKIP][h];
        float h0 = 0.f, h1 = 0.f;
        const float* xb = CHK_XBC + (size_t)b * SEQ * 1024; const float* dtb = DT + (size_t)b * SEQ * 8 + h;
#pragma unroll 4
        for (int t = 0; t < SEQ; ++t) {
            const float* xr = xb + (size_t)t * 1024;
            const float dtv = dtb[(size_t)t * 8], xv = xr[h * 64 + pp];
            const float B0 = xr[512 + g * 128 + lane], B1 = xr[512 + g * 128 + 64 + lane];
            const float C0 = xr[768 + g * 128 + lane], C1 = xr[768 + g * 128 + 64 + lane];
            const float dec = __expf(dtv * ah), dx = dtv * xv;
            h0 = h0 * dec + dx * B0; h1 = h1 * dec + dx * B1;
            const float y = wave_sum(C0 * h0 + C1 * h1) + dsk * xv;
            if (lane == 0) CHK_YSSM[(size_t)(b * SEQ + t) * 512 + h * 64 + pp] = y;
        }
    }
#endif
#if CHECK_ATTN
    for (int item = gw; item < NTOK * 8; item += NGW) {
        const int row = item >> 3, hq = item & 7, kv = hq >> 2, t = row & (SEQ - 1);
        const float qv = bf2f(PROJB[(size_t)row * PJ + PJ_Q + hq * 64 + lane]);
        float s0 = 0.f, s1 = 0.f;
        const int j0 = lane, j1 = lane + 64; const bool v0 = (t - j0) >= 0, v1 = (t - j1) >= 0;
        const bf* k0p = PROJB + (size_t)(row - (v0 ? j0 : 0)) * PJ + PJ_K + kv * 64;
        const bf* k1p = PROJB + (size_t)(row - (v1 ? j1 : 0)) * PJ + PJ_K + kv * 64;
        for (int d = 0; d < 64; ++d) { const float qd = __shfl(qv, d); s0 += qd * bf2f(k0p[d]); s1 += qd * bf2f(k1p[d]); }
        const int bk0 = j0 < 16 ? j0 : min(31, 16 + (int)(log2f((float)j0 * 0.0625f) * (16.f / 3.f)));
        const int bk1 = min(31, 16 + (int)(log2f((float)j1 * 0.0625f) * (16.f / 3.f)));
        s0 = v0 ? s0 * 0.125f + p.in[I_RELB][bk0 * 8 + hq] : -INFINITY;
        s1 = v1 ? s1 * 0.125f + p.in[I_RELB][bk1 * 8 + hq] : -INFINITY;
        const float sink = p.in[I_SINK][hq];
        const float m = fmaxf(wave_max(fmaxf(s0, s1)), sink);
        const float e0 = v0 ? __expf(s0 - m) : 0.f, e1 = v1 ? __expf(s1 - m) : 0.f;
        const float den = wave_sum(e0 + e1) + __expf(sink - m);
        const float p0 = e0 / den, p1 = e1 / den;
        float o = 0.f;
        const int jmax = min(127, t);
        for (int j = 0; j <= jmax; ++j) { const float pj = __shfl(j < 64 ? p0 : p1, j & 63); o += pj * bf2f(PROJB[(size_t)(row - j) * PJ + PJ_V + kv * 64 + lane]); }
        CHK_MIX[(size_t)row * 1024 + 512 + hq * 64 + lane] = (bf)f2bf(o);
    }
#endif
    }
    GRID_BAR();
    {
    PHASE_IDS();
    for (int item = blockIdx.x; item < BATCH * 64 * 2; item += G)
        ssd_s3_item(item, XC, DT, ACS, HIN, PROJB, p.in[I_DSKIP], p.in[I_GSSM], ST, MIXB, ldsp, tid);
#if CHECK_SSD
    for (int row = gw; row < NTOK; row += NGW) {
        const int c = lane * 8;
        float v[8]; float ss = 0.f;
        const uint4 zz = *(const uint4*)(PROJB + (size_t)row * PJ + PJ_Z + c);
        const unsigned zw[4] = {zz.x, zz.y, zz.z, zz.w};
#pragma unroll
        for (int i = 0; i < 8; ++i) { const float z = __uint_as_float((i & 1) ? (zw[i >> 1] & 0xffff0000u) : (zw[i >> 1] << 16)); v[i] = CHK_YSSM[(size_t)row * 512 + c + i] * silu_f(z); ss += v[i] * v[i]; }
#pragma unroll
        for (int o = 16; o > 0; o >>= 1) ss += __shfl_xor(ss, o);
        const float rs = rsqrtf(ss * (1.f / 256.f) + EPS);
        uint4 ov; unsigned ow[4];
#pragma unroll
        for (int i = 0; i < 4; ++i) ow[i] = pk2(v[2 * i] * rs * p.in[I_GSSM][c + 2 * i], v[2 * i + 1] * rs * p.in[I_GSSM][c + 2 * i + 1]);
        ov.x = ow[0]; ov.y = ow[1]; ov.z = ow[2]; ov.w = ow[3];
        *(uint4*)(CHK_MIX + (size_t)row * 1024 + c) = ov;
    }
#endif
    }
    GRID_BAR();
#if CHECK_SSD
    {
        GRID_BAR();
        PHASE_IDS();
        float num = 0.f, den = 0.f;
        for (int idx = gtid; idx < NTOK * 512; idx += NGT) { const int row = idx >> 9, c = idx & 511;
            const float a0 = bf2f(MIXB[(size_t)row * 1024 + c]), b0 = bf2f(CHK_MIX[(size_t)row * 1024 + c]); num += (a0 - b0) * (a0 - b0); den += b0 * b0; }
        num = wave_sum(num); den = wave_sum(den);
        if (lane == 0) { atomicAdd((float*)&ctl[CW_ERR + 2], num); atomicAdd((float*)&ctl[CW_ERR + 3], den); }
    }
#endif
    {
        g8::DenseSched S{G, (int)blockIdx.x, 1024, NTOK / 256, 4, (const char*)WOUTT, 0, 1, 0, nullptr};
        g8::EpiF32Res E{H1, p.in[I_BOUT], x};
        g8::gemm_phase(ldsp, MIXB, 1024, 0, S, E);
    }
    GRID_BAR();
    {
    PHASE_IDS();
    for (int r = gw; r < NTOK; r += NGW) {
        float4 v[4]; float ss = 0.f;
#pragma unroll
        for (int j = 0; j < 4; ++j) { v[j] = ld4(H1 + (size_t)r * DM + 4 * (lane + 64 * j)); ss += v[j].x * v[j].x + v[j].y * v[j].y + v[j].z * v[j].z + v[j].w * v[j].w; }
        const float rs = rsqrtf(wave_sum(ss) * (1.f / 1024.f) + EPS);
#pragma unroll
        for (int j = 0; j < 4; ++j) { const int c = 4 * (lane + 64 * j); const float4 gv = ld4(p.in[I_GCROSS] + c);
            *(uint2*)(XN + (size_t)r * DM + c) = make_uint2(pk2(v[j].x * rs * gv.x, v[j].y * rs * gv.y), pk2(v[j].z * rs * gv.z, v[j].w * rs * gv.w)); }
    }
    }
    GRID_BAR();
    {
        g8::DenseSched S{G, (int)blockIdx.x, 1024, NTOK / 256, 2, (const char*)WQT, 0, 1, 0, nullptr};
        g8::EpiBf16Dual E{QCB, 512, nullptr, nullptr, 0};
        g8::gemm_phase(ldsp, XN, 1024, 0, S, E);
    }
    GRID_BAR();
    {
    PHASE_IDS();
    for (int item = blockIdx.x; item < BATCH * 4 * 32; item += G) xattn_item(item, QCB, KVMB, OCB, ldsp, tid);
#if CHECK_ATTN
    for (int item = gw; item < NTOK * 4; item += NGW) {
        const int row = item >> 2, hd = item & 3, b = row >> 13;
        const float q0 = bf2f(QCB[(size_t)row * 512 + hd * 128 + lane]), q1 = bf2f(QCB[(size_t)row * 512 + hd * 128 + 64 + lane]);
        const bf* kb = KVMB + (size_t)b * MEMLEN * 1024 + hd * 128;
        float sc4[4] = {0.f, 0.f, 0.f, 0.f};
        for (int d = 0; d < 128; ++d) {
            const float qd = __shfl(d < 64 ? q0 : q1, d & 63);
#pragma unroll
            for (int i = 0; i < 4; ++i) sc4[i] += qd * bf2f(kb[(size_t)(lane + 64 * i) * 1024 + d]);
        }
        const float sc = 0.08838834764831845f;
        float m = -INFINITY;
#pragma unroll
        for (int i = 0; i < 4; ++i) { sc4[i] *= sc; m = fmaxf(m, sc4[i]); }
        m = wave_max(m);
        float den = 0.f;
#pragma unroll
        for (int i = 0; i < 4; ++i) { sc4[i] = __expf(sc4[i] - m); den += sc4[i]; }
        den = wave_sum(den);
        const float inv = 1.f / den;
        float o0 = 0.f, o1 = 0.f; const bf* vb = kb + 512;
#pragma unroll
        for (int i = 0; i < 4; ++i)
            for (int jj = 0; jj < 64; ++jj) {
                const float pj = __shfl(sc4[i], jj) * inv; const bf* vr = vb + (size_t)(jj + 64 * i) * 1024;
                o0 += pj * bf2f(vr[lane]); o1 += pj * bf2f(vr[64 + lane]);
            }
        CHK_OC[(size_t)row * 512 + hd * 128 + lane] = (bf)f2bf(o0); CHK_OC[(size_t)row * 512 + hd * 128 + 64 + lane] = (bf)f2bf(o1);
    }
    GRID_BAR();
    for (int idx = gtid; idx < NTOK * 512; idx += NGT) {
        const int row = idx >> 9, c = idx & 511;
        const float a0 = bf2f(MIXB[(size_t)row * 1024 + 512 + c]), b0 = bf2f(CHK_MIX[(size_t)row * 1024 + 512 + c]);
        const float a1 = bf2f(OCB[idx]), b1 = bf2f(CHK_OC[idx]);
        if (!(fabsf(a0 - b0) <= 0.01f + 0.02f * fabsf(b0))) atomicAdd(&ctl[CW_ERR], 1u);
        if (!(fabsf(a1 - b1) <= 0.01f + 0.02f * fabsf(b1))) atomicAdd(&ctl[CW_ERR + 1], 1u);
    }
#endif
    }
    GRID_BAR();
    {
        g8::DenseSched S{G, (int)blockIdx.x, 512, NTOK / 256, 4, (const char*)WOT, 0, 1, 0, nullptr};
        g8::EpiF32Res E{H2, nullptr, H1};
        g8::gemm_phase(ldsp, OCB, 512, 0, S, E);
    }
    GRID_BAR();
    {
    PHASE_IDS();
    for (int row = gw; row < NTOK; row += NGW) {
        float4 un[4];
        {
            float ss = 0.f;
#pragma unroll
            for (int j = 0; j < 4; ++j) { un[j] = ld4(H2 + (size_t)row * DM + 16 * lane + 4 * j); ss += un[j].x * un[j].x + un[j].y * un[j].y + un[j].z * un[j].z + un[j].w * un[j].w; }
            const float rs = rsqrtf(wave_sum(ss) * (1.f / 1024.f) + EPS);
#pragma unroll
            for (int j = 0; j < 4; ++j) { const float4 gv = ld4(p.in[I_GFFN] + 16 * lane + 4 * j);
                un[j] = make_float4(un[j].x * rs * gv.x, un[j].y * rs * gv.y, un[j].z * rs * gv.z, un[j].w * rs * gv.w);
                *(uint2*)(XN + (size_t)row * DM + 16 * lane + 4 * j) = make_uint2(pk2(un[j].x, un[j].y), pk2(un[j].z, un[j].w)); }
        }
        float l[32];
#pragma unroll
        for (int e = 0; e < 32; ++e) l[e] = 0.f;
        const float* wrb = p.in[I_WR] + (size_t)(16 * lane) * 32;
        LAS3 float* us = (LAS3 float*)(ldsp + wave * 4096);
#pragma unroll
        for (int j = 0; j < 4; ++j) { us[(4 * j + 0) * 64 + lane] = un[j].x; us[(4 * j + 1) * 64 + lane] = un[j].y; us[(4 * j + 2) * 64 + lane] = un[j].z; us[(4 * j + 3) * 64 + lane] = un[j].w; }
#pragma unroll 2
        for (int q = 0; q < 16; ++q) {
            const float uq = us[q * 64 + lane]; const float* wr = wrb + q * 32;
#pragma unroll
            for (int e4 = 0; e4 < 8; ++e4) { const float4 w = ld4(wr + 4 * e4);
                l[4 * e4] += uq * w.x; l[4 * e4 + 1] += uq * w.y; l[4 * e4 + 2] += uq * w.z; l[4 * e4 + 3] += uq * w.w; }
        }
#pragma unroll
        for (int e = 0; e < 32; ++e) l[e] = wave_sum(l[e]) + p.in[I_BR][e];
        int sel[4]; float val[4];
#pragma unroll
        for (int k = 0; k < 4; ++k) {
            float best = -INFINITY; int bi = 0;
#pragma unroll
            for (int e = 0; e < 32; ++e) if (l[e] > best) { best = l[e]; bi = e; }
            sel[k] = bi; val[k] = best;
#pragma unroll
            for (int e = 0; e < 32; ++e) l[e] = (e == bi) ? -INFINITY : l[e];
        }
        float ex[4], den = 0.f;
#pragma unroll
        for (int k = 0; k < 4; ++k) { ex[k] = __expf(val[k] - val[0]); den += ex[k]; }
        if (lane == 0) {
#pragma unroll
            for (int k = 0; k < 4; ++k) {
                const int a = row * 4 + k;
                const unsigned slot = atomicAdd(&ctl[CW_CNT + sel[k]], 1u);
                LIST[sel[k] * NTOK + slot] = a;
                SLOT[a] = (sel[k] << 16) | (int)slot;
                GATE[a] = ex[k] / den;
            }
        }
    }
    }
    GRID_BAR();
    {
    PHASE_IDS();
    if (tid < 64) {
        const int c = tid < 32 ? (int)__hip_atomic_load(&ctl[CW_CNT + (tid & 31)], __ATOMIC_RELAXED, __HIP_MEMORY_SCOPE_AGENT) : 0;
        int tl = (c + 255) >> 8, incl = tl;
#pragma unroll
        for (int o = 1; o < 32; o <<= 1) { const int v = __shfl_up(incl, o); if ((tid & 63) >= o) incl += v; }
        if (tid < 32) { CNTL[tid] = c; TP[tid] = incl - tl; }
        if (tid == 31) TP[32] = incl;
    }
    }
    __syncthreads();
    {
        g8::MoeSched S{G, vcu, 8, 1024, TP, CNTL, LIST, (const char*)W1T, (size_t)2048 * 1024 * 2};
        g8::EpiSwiglu E{ACTB, p.in[I_B1]};
        g8::gemm_phase(ldsp, XN, 1024, 2, S, E);
    }
    GRID_BAR();
    {
        g8::MoeSched S{G, vcu, 4, 1024, TP, CNTL, nullptr, (const char*)W2T, (size_t)1024 * 1024 * 2};
        g8::EpiBf16 E{YB, 1024, p.in[I_B2], 1024};
        g8::gemm_phase(ldsp, ACTB, 1024, 0, S, E);
    }
    GRID_BAR();
    {
    PHASE_IDS();
    for (int row = gw; row < NTOK; row += NGW) {
        float4 v[4]; float ss = 0.f;
        int yrow[4]; float gk[4];
#pragma unroll
        for (int k = 0; k < 4; ++k) { const int sl = SLOT[row * 4 + k]; yrow[k] = TP[sl >> 16] * 256 + (sl & 0xffff); gk[k] = GATE[row * 4 + k]; }
#pragma unroll
        for (int j = 0; j < 4; ++j) {
            const int c = 4 * (lane + 64 * j);
            float4 a = ld4(H2 + (size_t)row * DM + c);
#pragma unroll
            for (int k = 0; k < 4; ++k) { const uint2 y = *(const uint2*)(YB + (size_t)yrow[k] * 1024 + c);
                a.x += gk[k] * __uint_as_float(y.x << 16); a.y += gk[k] * __uint_as_float(y.x & 0xffff0000u);
                a.z += gk[k] * __uint_as_float(y.y << 16); a.w += gk[k] * __uint_as_float(y.y & 0xffff0000u); }
            v[j] = a; ss += a.x * a.x + a.y * a.y + a.z * a.z + a.w * a.w;
        }
        float rs = rsqrtf(wave_sum(ss) * (1.f / 1024.f) + EPS);
#if CHECK_SSD
        { const float en = __uint_as_float(__hip_atomic_load(&ctl[CW_ERR + 2], __ATOMIC_RELAXED, __HIP_MEMORY_SCOPE_AGENT)), ed = __uint_as_float(__hip_atomic_load(&ctl[CW_ERR + 3], __ATOMIC_RELAXED, __HIP_MEMORY_SCOPE_AGENT)); rs *= 1.f + sqrtf(en / ed); }
#endif
#if CHECK_ATTN
        if (__hip_atomic_load(&ctl[CW_ERR], __ATOMIC_RELAXED, __HIP_MEMORY_SCOPE_AGENT) != 0u) rs *= 2.f;
        if (__hip_atomic_load(&ctl[CW_ERR + 1], __ATOMIC_RELAXED, __HIP_MEMORY_SCOPE_AGENT) != 0u) rs *= 3.f;
#endif
#pragma unroll
        for (int j = 0; j < 4; ++j) { const int c = 4 * (lane + 64 * j); const float4 gv = ld4(p.in[I_GFIN] + c);
            st4(p.out + (size_t)row * DM + c, make_float4(v[j].x * rs * gv.x, v[j].y * rs * gv.y, v[j].z * rs * gv.z, v[j].w * rs * gv.w)); }
    }
    }
}

constexpr int LDS_BYTES = 147456;

extern "C" void kernel_launch(void* const* d_in, const int* in_sizes, int n_in, void* d_out, int out_size, void* d_ws, size_t ws_size, hipStream_t stream) {
    static int grid = 0;
    if (grid == 0) {
        if (n_in != N_IN || ws_size < WS_END) { fprintf(stderr, "kernel_launch: unexpected n_in %d / ws_size %zu (need %zu)\n", n_in, ws_size, (size_t)WS_END); grid = -1; return; }
        int dev = 0, cus = 0, per_cu = 0;
        (void)hipGetDevice(&dev);
        (void)hipDeviceGetAttribute(&cus, hipDeviceAttributeMultiprocessorCount, dev);
        (void)hipFuncSetAttribute((const void*)mk_fwd, hipFuncAttributeMaxDynamicSharedMemorySize, LDS_BYTES);
        (void)hipOccupancyMaxActiveBlocksPerMultiprocessor(&per_cu, (const void*)mk_fwd, 512, LDS_BYTES);
        if (per_cu < 1) { fprintf(stderr, "kernel_launch: occupancy query says %d blocks per CU\n", per_cu); per_cu = 1; }
        if (per_cu > 1) per_cu = 1;
        grid = cus * per_cu;
    }
    if (grid < 0) return;
    (void)hipMemsetAsync((char*)d_ws + WS_CTL, 0, 1 * MiB, stream);
    Params p{};
    for (int i = 0; i < N_IN; ++i) p.in[i] = (const float*)d_in[i];
    p.out = (float*)d_out; p.ws = (unsigned char*)d_ws;
    void* args[] = {&p};
    hipError_t e = hipLaunchCooperativeKernel((const void*)mk_fwd, dim3(grid), dim3(512), args, LDS_BYTES, stream);
    if (e != hipSuccess) fprintf(stderr, "cooperative launch failed: %s (grid %d)\n", hipGetErrorString(e), grid);
}
```

```cpp
#include <hip/hip_runtime.h>
#include <hip/hip_cooperative_groups.h>
#include <cstdio>
#include <cstdint>
namespace cg = cooperative_groups;

#define DEVI __device__ __forceinline__

constexpr int BATCH = 2, SEQ = 8192, NTOK = BATCH * SEQ, DM = 1024, MEMLEN = 256, NMEM = BATCH * MEMLEN;
constexpr int SSM_H = 8, SSM_P = 64, SSM_W = 512, SSM_N = 128, CONVCH = 1024;
constexpr int IN_COLS = 2312, COL_Z = 0, COL_XBC = 512, COL_DT = 1536, COL_Q = 1544, COL_K = 2056, COL_V = 2184;
constexpr int NEXP = 32, TOPK = 4, DFF = 1024, NASSIGN = NTOK * TOPK;
constexpr float EPS = 1e-5f;

enum { I_X = 0, I_MEM, I_GMIX, I_WIN, I_BQKV, I_CONVW, I_CONVB, I_DTB, I_ALOG, I_DSKIP, I_GSSM, I_SINK, I_RELB, I_WOUT, I_BOUT,
       I_GCROSS, I_GMEM, I_WQ, I_WKV, I_WO, I_GFFN, I_WR, I_BR, I_W1, I_B1, I_W2, I_B2, I_GFIN, N_IN };

constexpr size_t MiB = 1u << 20;
constexpr size_t WS_CTL = 0;
constexpr size_t WS_XN = 1 * MiB;
constexpr size_t WS_BIG = WS_XN + 34 * MiB;
constexpr size_t WS_XBC = WS_BIG + 144 * MiB;
constexpr size_t WS_MIXB = WS_XBC + 64 * MiB;
constexpr size_t WS_H1 = WS_MIXB + 32 * MiB;
constexpr size_t WS_H2 = WS_H1 + 64 * MiB;
constexpr size_t WS_YSSM = WS_H2 + 64 * MiB;
constexpr size_t WS_QCB = WS_YSSM + 32 * MiB;
constexpr size_t WS_OCB = WS_QCB + 16 * MiB;
constexpr size_t WS_ACTB = WS_OCB + 16 * MiB;
constexpr size_t WS_W1T = WS_ACTB + 144 * MiB;
constexpr size_t WS_W2T = WS_W1T + 128 * MiB;
constexpr size_t WS_WINT = WS_W2T + 64 * MiB;
constexpr size_t WS_WOUTT = WS_WINT + 5 * MiB;
constexpr size_t WS_WQT = WS_WOUTT + 2 * MiB;
constexpr size_t WS_WKVT = WS_WQT + 1 * MiB;
constexpr size_t WS_WOT = WS_WKVT + 2 * MiB;
constexpr size_t WS_SMALL = WS_WOT + 1 * MiB;
constexpr size_t WS_DT = WS_SMALL;
constexpr size_t WS_DTRAW = WS_DT + 512 * 1024;
constexpr size_t WS_KVMB = WS_DTRAW + 512 * 1024;
constexpr size_t WS_GATE = WS_KVMB + 1 * MiB;
constexpr size_t WS_SLOT = WS_GATE + 512 * 1024;
constexpr size_t WS_BIASP = WS_SLOT + 256 * 1024;
constexpr size_t WS_LIST = WS_GATE + 1 * MiB;
constexpr size_t WS_RSA = WS_LIST + 2 * MiB;
constexpr size_t WS_ACS = WS_RSA + 2 * MiB;
constexpr size_t WS_CD = WS_ACS + 512 * 1024;
constexpr size_t WS_END = WS_CD + 64 * 1024;
constexpr size_t WS_XC = WS_XBC;
constexpr size_t WS_ST = WS_YSSM;
constexpr size_t WS_HIN = WS_H2;
constexpr size_t WS_YB = WS_BIG;
constexpr int NROWS_MAX = NASSIGN + NEXP * 256;
constexpr int PJ = 2304, PJ_Z = 0, PJ_XBC = 512, PJ_Q = 1536, PJ_K = 2048, PJ_V = 2176;
constexpr int LDS_MISC = 146432;
constexpr int CW_CNT = 64;
constexpr int CW_ERR = 128;
#ifndef CHECK_ATTN
#define CHECK_ATTN 0
#endif
#ifndef REP_MASK
#define REP_MASK 0
#endif
#ifndef RUNTIME_REP
#define RUNTIME_REP 1
#endif
#if RUNTIME_REP
#define PH_BEGIN(i) for (int rep_ = 0; rep_ <= ((p.rep_mask >> (i)) & 1); ++rep_) {
#else
#define PH_BEGIN(i) {
#endif
#define PH_END() }
#ifndef CHECK_SSD
#define CHECK_SSD 0
#endif

struct Params { const float* in[N_IN]; float* out; unsigned char* ws; int rep_mask; int pad; };

DEVI float wave_sum(float v) {
#pragma unroll
    for (int o = 32; o > 0; o >>= 1) v += __shfl_xor(v, o);
    return v;
}
DEVI float wave_max(float v) {
#pragma unroll
    for (int o = 32; o > 0; o >>= 1) v = fmaxf(v, __shfl_xor(v, o));
    return v;
}
DEVI float silu_f(float x) { return x / (1.f + __expf(-x)); }
DEVI float softplus_f(float x) { return fmaxf(x, 0.f) + log1pf(__expf(-fabsf(x))); }
DEVI float4 ld4(const float* p) { return *(const float4*)p; }
DEVI void st4(float* p, float4 v) { *(float4*)p = v; }

DEVI void rms_row(const float* xrow, const float* g, float* orow, int lane) {
    float4 v[4]; float s = 0.f;
#pragma unroll
    for (int j = 0; j < 4; ++j) { v[j] = ld4(xrow + 4 * (lane + 64 * j)); s += v[j].x * v[j].x + v[j].y * v[j].y + v[j].z * v[j].z + v[j].w * v[j].w; }
    const float rs = rsqrtf(wave_sum(s) * (1.f / 1024.f) + EPS);
#pragma unroll
    for (int j = 0; j < 4; ++j) { const float4 gv = ld4(g + 4 * (lane + 64 * j));
        st4(orow + 4 * (lane + 64 * j), make_float4(v[j].x * rs * gv.x, v[j].y * rs * gv.y, v[j].z * rs * gv.z, v[j].w * rs * gv.w)); }
}

struct TI { int tid, lane, wave, gw, gtid; };
DEVI TI fresh_ti(int wave_id) { int l; asm volatile("v_mbcnt_lo_u32_b32 %0, -1, 0\n\tv_mbcnt_hi_u32_b32 %0, -1, %0" : "=v"(l)); TI r; r.lane = l; r.wave = wave_id; r.tid = wave_id * 64 + l; r.gw = blockIdx.x * 8 + wave_id; r.gtid = blockIdx.x * 512 + r.tid; return r; }
#define PHASE_IDS() const TI ti_ = fresh_ti(wave_id); const int tid = ti_.tid, lane = ti_.lane, wave = ti_.wave, gw = ti_.gw, gtid = ti_.gtid; (void)tid; (void)lane; (void)wave; (void)gw; (void)gtid
DEVI float bf2f(unsigned short v) { return __uint_as_float((unsigned)v << 16); }

#define XB_TMO      128
#define XB_XCNT(j)  (256  + 64 * (j))
#define XB_XSUB(j)  (1280 + 64 * (j))
#define XB_XGEN(j)  (2304 + 64 * (j))
#define XB_TOP      3328
#define XB_TOPGEN   3392
#define XCD_BAR_WORDS 3456
#define XB_SPIN_CAP (1u << 18)
DEVI unsigned xb_ld(unsigned* p)              { return __hip_atomic_load(p, __ATOMIC_RELAXED, __HIP_MEMORY_SCOPE_AGENT); }
DEVI unsigned xb_add(unsigned* p, unsigned v) { return __hip_atomic_fetch_add(p, v, __ATOMIC_RELAXED, __HIP_MEMORY_SCOPE_AGENT); }
DEVI unsigned xb_xcc_id() { return (unsigned)__builtin_amdgcn_s_getreg((3 << 11) | 20) & 0xFu; }
#define XB_SPIN(cond, bar) do { unsigned _sp = 0; while (cond) { __builtin_amdgcn_s_sleep(1); \
    if ((++_sp & 255u) == 0u) { if (xb_ld(&(bar)[XB_TMO])) break; if (_sp > XB_SPIN_CAP) { atomicAdd(&(bar)[XB_TMO], 1u); break; } } } } while (0)
struct XcdBarrier { unsigned* bar; unsigned x; volatile __attribute__((address_space(3))) unsigned* st; };
DEVI XcdBarrier xcd_barrier_post(unsigned* bar, volatile __attribute__((address_space(3))) unsigned* st, bool leader) {
    XcdBarrier b; b.bar = bar; b.x = xb_xcc_id(); b.st = st;
    if (leader) (void)xb_add(&bar[XB_XCNT(b.x)], 1u);
    return b;
}
DEVI void xcd_barrier_complete(unsigned* bar, unsigned x, unsigned& nloc, unsigned& nx) {
    const unsigned G = gridDim.x * gridDim.y * gridDim.z;
    unsigned sum, cnt, mine, sp = 0u;
    for (;;) {
        sum = 0u; cnt = 0u; mine = 0u;
#pragma unroll
        for (unsigned j = 0; j < 16; ++j) { const unsigned c = xb_ld(&bar[XB_XCNT(j)]); sum += c; cnt += (c > 0u) ? 1u : 0u; mine = (j == x) ? c : mine; }
        if (sum == G) break;
        __builtin_amdgcn_s_sleep(1);
        if ((++sp & 255u) == 0u) { if (xb_ld(&bar[XB_TMO])) break; if (sp > XB_SPIN_CAP) { atomicAdd(&bar[XB_TMO], 1u); break; } }
    }
    nloc = mine > 0u ? mine : 1u; nx = cnt > 0u ? cnt : 1u;
}
DEVI void xcd_barrier(const XcdBarrier& b, bool leader) {
    asm volatile("s_waitcnt vmcnt(0)" ::: "memory");
    __syncthreads();
    if (leader) {
        unsigned* bar = b.bar;
        __builtin_amdgcn_s_waitcnt(0);
        unsigned nloc = b.st[0], nx = b.st[1];
        if (nloc == 0u) { xcd_barrier_complete(bar, b.x, nloc, nx); b.st[0] = nloc; b.st[1] = nx; }
        const unsigned old = xb_add(&bar[XB_XSUB(b.x)], 1u);
        const unsigned gen = old / nloc;
        if (old + 1u == (gen + 1u) * nloc) {
            __builtin_amdgcn_fence(__ATOMIC_RELEASE, "agent");
            asm volatile("s_waitcnt vmcnt(0)" ::: "memory");
            const unsigned og = xb_add(&bar[XB_TOP], 1u);
            const unsigned tg = og / nx;
            if (og + 1u == (tg + 1u) * nx) xb_add(&bar[XB_TOPGEN], 1u);
            else XB_SPIN(xb_ld(&bar[XB_TOPGEN]) == tg, bar);
            __builtin_amdgcn_fence(__ATOMIC_ACQUIRE, "agent");
            xb_add(&bar[XB_XGEN(b.x)], 1u);
            asm volatile("s_waitcnt vmcnt(0)" ::: "memory");
        } else {
            XB_SPIN(xb_ld(&bar[XB_XGEN(b.x)]) == gen, bar);
            __builtin_amdgcn_fence(__ATOMIC_ACQUIRE, "agent");
            asm volatile("s_waitcnt vmcnt(0)" ::: "memory");
        }
    }
    __syncthreads();
}

namespace g8 {
#define G8_LAS __attribute__((address_space(3)))
typedef unsigned short bf16_t;
typedef short bf16x8 __attribute__((ext_vector_type(8)));
typedef float f32x4 __attribute__((ext_vector_type(4)));
typedef float f32x2 __attribute__((ext_vector_type(2)));
typedef unsigned u32x4 __attribute__((ext_vector_type(4)));
typedef unsigned u32x2 __attribute__((ext_vector_type(2)));
constexpr int BM = 256, BK = 64, HALF = 128, HTB = HALF * BK * 2, STAGE_BYTES = 8 * HTB;

DEVI int lds_byte(int r, int c) { const int st = (r >> 4) * 2 + (c >> 5), rr = r & 15, cc = c & 31, ob = rr * 64 + cc * 2; return st * 1024 + (ob ^ (((ob >> 9) & 1) << 5)); }
DEVI void stage_rc(int b, int& R, int& C) { const int st = b / 1024, sb = b % 1024, swz = sb ^ (((sb >> 9) & 1) << 5); R = (st >> 1) * 16 + swz / 64; C = (st & 1) * 32 + (swz % 64) / 2; }
DEVI int perm32(int rho) { const int n = rho >> 4, i = rho & 15; return 8 * (i >> 2) + 4 * n + (i & 3); }
DEVI unsigned cvt_pk_bf16(float lo, float hi) { unsigned r; asm volatile("v_cvt_pk_bf16_f32 %0, %1, %2" : "=v"(r) : "v"(lo), "v"(hi)); return r; }

struct Unit {
    const int* alist;
    int acnt;
    int aoff;
    int arow0;
    const char* bt;
    int orow0, ocol0;
    int e;
};


struct EpiSwiglu {
    static constexpr bool PERM = true;
    bf16_t* O; const float* bias; const float* rsa;
    DEVI void operator()(const f32x4 (&acc)[2][2][4][2], const Unit& u, int wr, int wc, int fr, int fq) const {
        const int row0 = u.orow0 + wr * 64 + fr, col0 = u.ocol0 + wc * 32 + 8 * fq;
        const float* bp = bias + (size_t)u.e * 2048 + col0;
        f32x4 bv[2][2];
#pragma unroll
        for (int bj = 0; bj < 2; ++bj)
#pragma unroll
            for (int n = 0; n < 2; ++n) bv[bj][n] = *(const f32x4*)(bp + bj * HALF + 4 * n);
#pragma unroll
        for (int ai = 0; ai < 2; ++ai)
#pragma unroll
            for (int m = 0; m < 4; ++m) { const int lr = wr * 64 + fr + ai * HALF + m * 16;
                const float rs = (lr < u.acnt) ? rsa[u.aoff + lr] : 0.f;
                bf16_t* rowp = O + (size_t)(row0 + ai * HALF + m * 16) * 1024 + (col0 >> 1);
#pragma unroll
                for (int bj = 0; bj < 2; ++bj) { const f32x4 v0 = acc[ai][bj][m][0] * rs + bv[bj][0], v1 = acc[ai][bj][m][1] * rs + bv[bj][1];
                    float o[4];
                    const float gl[4] = {v0[0], v0[2], v1[0], v1[2]}, li[4] = {v0[1], v0[3], v1[1], v1[3]};
#pragma unroll
                    for (int q = 0; q < 4; ++q) { const float xg = fminf(gl[q], 7.f), xl = fminf(fmaxf(li[q], -7.f), 7.f);
                        o[q] = xg * __builtin_amdgcn_rcpf(1.f + __expf(-1.702f * xg)) * (xl + 1.f); }
                    u32x2 w; w.x = cvt_pk_bf16(o[0], o[1]); w.y = cvt_pk_bf16(o[2], o[3]);
                    *(u32x2*)(rowp + bj * (HALF / 2)) = w; } }
    }
};
struct EpiBf16 {
    static constexpr bool PERM = true;
    bf16_t* O; int ldc; const float* bias; int bias_stride;
    DEVI void operator()(const f32x4 (&acc)[2][2][4][2], const Unit& u, int wr, int wc, int fr, int fq) const {
        const int row0 = u.orow0 + wr * 64 + fr, col0 = u.ocol0 + wc * 32 + 8 * fq;
        f32x4 bv[2][2];
#pragma unroll
        for (int bj = 0; bj < 2; ++bj)
#pragma unroll
            for (int n = 0; n < 2; ++n) bv[bj][n] = bias ? *(const f32x4*)(bias + (size_t)u.e * bias_stride + col0 + bj * HALF + 4 * n) : (f32x4){0.f, 0.f, 0.f, 0.f};
#pragma unroll
        for (int ai = 0; ai < 2; ++ai)
#pragma unroll
            for (int m = 0; m < 4; ++m) { bf16_t* rowp = O + (size_t)(row0 + ai * HALF + m * 16) * ldc + col0;
#pragma unroll
                for (int bj = 0; bj < 2; ++bj) { const f32x4 v0 = acc[ai][bj][m][0] + bv[bj][0], v1 = acc[ai][bj][m][1] + bv[bj][1];
                    u32x4 w; w.x = cvt_pk_bf16(v0[0], v0[1]); w.y = cvt_pk_bf16(v0[2], v0[3]); w.z = cvt_pk_bf16(v1[0], v1[1]); w.w = cvt_pk_bf16(v1[2], v1[3]);
                    *(u32x4*)(rowp + bj * HALF) = w; } }
    }
};

struct EpiBf16Dual {
    static constexpr bool PERM = true;
    bf16_t* O0; int ldc0; const float* bias0; bf16_t* O1; int ldc1;
    DEVI void operator()(const f32x4 (&acc)[2][2][4][2], const Unit& u, int wr, int wc, int fr, int fq) const {
        const int row0 = u.orow0 + wr * 64 + fr, col0 = u.ocol0 + wc * 32 + 8 * fq;
        bf16_t* O = u.e ? O1 : O0; const int ldc = u.e ? ldc1 : ldc0; const float* bias = u.e ? nullptr : bias0;
        f32x4 bv[2][2];
#pragma unroll
        for (int bj = 0; bj < 2; ++bj)
#pragma unroll
            for (int n = 0; n < 2; ++n) bv[bj][n] = bias ? *(const f32x4*)(bias + col0 + bj * HALF + 4 * n) : (f32x4){0.f, 0.f, 0.f, 0.f};
#pragma unroll
        for (int ai = 0; ai < 2; ++ai)
#pragma unroll
            for (int m = 0; m < 4; ++m) { bf16_t* rowp = O + (size_t)(row0 + ai * HALF + m * 16) * ldc + col0;
#pragma unroll
                for (int bj = 0; bj < 2; ++bj) { const f32x4 v0 = acc[ai][bj][m][0] + bv[bj][0], v1 = acc[ai][bj][m][1] + bv[bj][1];
                    u32x4 w; w.x = cvt_pk_bf16(v0[0], v0[1]); w.y = cvt_pk_bf16(v0[2], v0[3]); w.z = cvt_pk_bf16(v1[0], v1[1]); w.w = cvt_pk_bf16(v1[2], v1[3]);
                    *(u32x4*)(rowp + bj * HALF) = w; } }
    }
};
struct EpiF32Res {
    static constexpr bool PERM = false;
    float* C; const float* bias; const float* res;
    DEVI void operator()(const f32x4 (&acc)[2][2][4][2], const Unit& u, int wr, int wc, int fr, int fq) const {
        const int row0 = u.orow0 + wr * 64 + fr, col0 = u.ocol0 + wc * 32 + 4 * fq;
        f32x4 bv[2][2];
#pragma unroll
        for (int bj = 0; bj < 2; ++bj)
#pragma unroll
            for (int n = 0; n < 2; ++n) bv[bj][n] = bias ? *(const f32x4*)(bias + col0 + bj * HALF + n * 16) : (f32x4){0.f, 0.f, 0.f, 0.f};
#pragma unroll
        for (int ai = 0; ai < 2; ++ai)
#pragma unroll
            for (int m = 0; m < 4; ++m) { const size_t off = (size_t)(row0 + ai * HALF + m * 16) * 1024 + col0;
#pragma unroll
                for (int bj = 0; bj < 2; ++bj)
#pragma unroll
                    for (int n = 0; n < 2; ++n) *(f32x4*)(C + off + bj * HALF + n * 16) = acc[ai][bj][m][n] + bv[bj][n] + *(const f32x4*)(res + off + bj * HALF + n * 16);
                if (m & 1) asm volatile("" ::: "memory"); }
    }
};

template <class Epi, class Sched>
DEVI void gemm_phase(G8_LAS unsigned char* lds, const bf16_t* A, int K, int ashift, const Sched& S, const Epi& E, int tid_) {
    int tid = tid_; asm volatile("" : "+v"(tid));
    const int wid = __builtin_amdgcn_readfirstlane(tid >> 6), lane = tid & 63, wr = wid >> 2, wc = wid & 3, fr = lane & 15, fq = lane >> 4;
    const int nt = K / BK;
    int Rl[2], Cl[2]; unsigned voffB[2];
#pragma unroll
    for (int i = 0; i < 2; ++i) { stage_rc(tid * 16 + i * 8192, Rl[i], Cl[i]); const int Rb = Epi::PERM ? ((Rl[i] & ~31) + perm32(Rl[i] & 31)) : Rl[i];
        voffB[i] = (unsigned)(Rb * K + Cl[i]) * 2u; }
    const size_t kstep = (size_t)(BK * 2);
    const size_t hstep = (size_t)HALF * K * 2;
    const unsigned ldsw = (unsigned)wid * 1024u;
    const int aoff = lds_byte(wr * 64 + fr, fq * 8), boff = lds_byte(wc * 32 + fr, fq * 8);
    const char* Ab = (const char*)A;
#define G8_AOFF(dst, u) do { _Pragma("unroll") for (int _h = 0; _h < 2; ++_h) _Pragma("unroll") for (int _i = 0; _i < 2; ++_i) { const int _row = _h * HALF + Rl[_i]; int _ar; \
        if ((u).alist) { const int _idx = _row < (u).acnt ? _row : 0; _ar = (u).alist[_idx] >> ashift; } else _ar = (u).arow0 + _row; \
        dst[_h][_i] = (unsigned)(_ar * K + Cl[_i]) * 2u; } } while (0)
#define G8_SA(b, h) (((b) * 2 + (h)) * HTB)
#define G8_SB(b, h) ((4 + (b) * 2 + (h)) * HTB)
#define G8_STAGE(bufoff, gbase, voff) do { _Pragma("unroll") for (int _i = 0; _i < 2; ++_i) \
        __builtin_amdgcn_global_load_lds((const unsigned*)((const char*)(gbase) + (voff)[_i]), (G8_LAS unsigned*)(lds + (bufoff) + ldsw + _i * 8192), 16, 0, 0); } while (0)
#define G8_LDA(dst, b, h) do { _Pragma("unroll") for (int m = 0; m < 4; ++m) _Pragma("unroll") for (int k = 0; k < 2; ++k) dst[m][k] = *(const G8_LAS bf16x8*)(lds + G8_SA(b, h) + aoff + m * 2048 + k * 1024); } while (0)
#define G8_LDB(dst, b, h) do { _Pragma("unroll") for (int n = 0; n < 2; ++n) _Pragma("unroll") for (int k = 0; k < 2; ++k) dst[n][k] = *(const G8_LAS bf16x8*)(lds + G8_SB(b, h) + boff + n * 2048 + k * 1024); } while (0)
#define G8_MMA(ai, bj, At, Bt) do { __builtin_amdgcn_s_setprio(1); _Pragma("unroll") for (int m = 0; m < 4; ++m) _Pragma("unroll") for (int n = 0; n < 2; ++n) _Pragma("unroll") for (int k = 0; k < 2; ++k) \
        acc[ai][bj][m][n] = __builtin_amdgcn_mfma_f32_16x16x32_bf16(Bt[n][k], At[m][k], acc[ai][bj][m][n], 0, 0, 0); __builtin_amdgcn_s_setprio(0); } while (0)
#define G8_WAIT_V(n) asm volatile("s_waitcnt vmcnt(" #n ")" ::: "memory")
#define G8_WAIT_L(n) asm volatile("s_waitcnt lgkmcnt(" #n ")" ::: "memory")
#define G8_BAR __builtin_amdgcn_s_barrier()
#define G8_SCHED __builtin_amdgcn_sched_barrier(0)
    Unit cur, nxt, nn; int ui = 0;
    if (!S.next(0, cur)) return;
    f32x4 acc[2][2][4][2];
#pragma unroll
    for (int a = 0; a < 2; ++a)
#pragma unroll
        for (int b = 0; b < 2; ++b)
#pragma unroll
            for (int m = 0; m < 4; ++m)
#pragma unroll
                for (int n = 0; n < 2; ++n) acc[a][b][m][n] = (f32x4){0.f, 0.f, 0.f, 0.f};
    bf16x8 At[4][2], B0[2][2], B1[2][2];
    unsigned cv[2][2], nv[2][2], fv[2][2];
    G8_AOFF(cv, cur);
    bool has_next = S.next(1, nxt);
    if (has_next) { G8_AOFF(nv, nxt); } else {
#pragma unroll
        for (int h = 0; h < 2; ++h)
#pragma unroll
            for (int i = 0; i < 2; ++i) nv[h][i] = cv[h][i]; }
    const char* cB = cur.bt; const char* nB = has_next ? nxt.bt : cB;
    G8_STAGE(G8_SB(0, 0), cB, voffB); G8_STAGE(G8_SB(0, 1), cB + hstep, voffB); G8_STAGE(G8_SA(0, 0), Ab, cv[0]); G8_STAGE(G8_SA(0, 1), Ab, cv[1]);
    if (wr == 1) G8_BAR;
    G8_WAIT_V(2); G8_BAR;
    G8_STAGE(G8_SB(1, 0), cB + kstep, voffB); G8_STAGE(G8_SA(1, 0), Ab + kstep, cv[0]); G8_STAGE(G8_SB(1, 1), cB + hstep + kstep, voffB);
    G8_WAIT_V(6); G8_BAR;
    for (;;) {
#pragma unroll 1
        for (int t = 0; t < nt; t += 2) {
            const bool last = (t == nt - 2);
            const size_t k1 = (size_t)(t + 1) * kstep;
            const size_t k2 = last ? 0 : (size_t)(t + 2) * kstep;
            const char* b2 = last ? nB : cB + (size_t)(t + 2) * kstep; const char* b3 = b2 + kstep;
            unsigned sv[2][2];
#pragma unroll
            for (int h = 0; h < 2; ++h)
#pragma unroll
                for (int i = 0; i < 2; ++i) sv[h][i] = last ? nv[h][i] : cv[h][i];
            G8_LDB(B0, 0, 0); G8_LDB(B1, 0, 1); G8_SCHED; G8_LDA(At, 0, 0); G8_STAGE(G8_SA(1, 1), Ab + k1, cv[1]);
            G8_WAIT_V(8); G8_WAIT_L(0); G8_BAR; G8_MMA(0, 0, At, B0); G8_MMA(0, 1, At, B1); G8_BAR; G8_SCHED;
            G8_LDA(At, 0, 1); G8_STAGE(G8_SB(0, 0), b2, voffB); G8_STAGE(G8_SB(0, 1), b2 + hstep, voffB); G8_STAGE(G8_SA(0, 0), Ab + k2, sv[0]);
            G8_WAIT_V(8); G8_WAIT_L(0); G8_BAR; G8_MMA(1, 0, At, B0); G8_MMA(1, 1, At, B1); G8_BAR; G8_SCHED;
            G8_LDB(B0, 1, 0); G8_LDB(B1, 1, 1); G8_SCHED; G8_LDA(At, 1, 0); G8_STAGE(G8_SA(0, 1), Ab + k2, sv[1]);
            G8_WAIT_V(8); G8_WAIT_L(0); G8_BAR; G8_MMA(0, 0, At, B0); G8_MMA(0, 1, At, B1); G8_BAR; G8_SCHED;
            G8_LDA(At, 1, 1); G8_STAGE(G8_SB(1, 0), b3, voffB); G8_STAGE(G8_SB(1, 1), b3 + hstep, voffB); G8_STAGE(G8_SA(1, 0), Ab + k2 + kstep, sv[0]);
            G8_WAIT_V(8); G8_WAIT_L(0); G8_BAR; G8_MMA(1, 0, At, B0); G8_MMA(1, 1, At, B1); G8_BAR; G8_SCHED;
        }
        if (wr == 0) G8_BAR;
        const bool has_nn = has_next && S.next(ui + 2, nn);
        if (has_nn) { G8_AOFF(fv, nn); }
        E(acc, cur, wr, wc, fr, fq);
        if (!has_next) break;
#pragma unroll
        for (int a = 0; a < 2; ++a)
#pragma unroll
            for (int b = 0; b < 2; ++b)
#pragma unroll
                for (int m = 0; m < 4; ++m)
#pragma unroll
                    for (int n = 0; n < 2; ++n) acc[a][b][m][n] = (f32x4){0.f, 0.f, 0.f, 0.f};
        cur = nxt; cB = nB; ++ui;
#pragma unroll
        for (int h = 0; h < 2; ++h)
#pragma unroll
            for (int i = 0; i < 2; ++i) { cv[h][i] = nv[h][i]; nv[h][i] = has_nn ? fv[h][i] : nv[h][i]; }
        has_next = has_nn; if (has_nn) { nxt = nn; nB = nn.bt; }
        if (wr == 1) G8_BAR;
    }
    G8_WAIT_V(0);
    G8_BAR;
#undef G8_AOFF
#undef G8_SA
#undef G8_SB
#undef G8_STAGE
#undef G8_LDA
#undef G8_LDB
#undef G8_MMA
#undef G8_WAIT_V
#undef G8_WAIT_L
#undef G8_BAR
#undef G8_SCHED
}

struct MoeSched {
    int nct, K;
    const G8_LAS int* ut; const G8_LAS int* tp; const G8_LAS int* cnt;
    const int* list;
    const char* Bt; size_t bt_estride;
    DEVI bool next(int i, Unit& u) const {
        if (i >= 32) return false;
        const int v = __builtin_amdgcn_readfirstlane(ut[i]);
        if (v < 0) return false;
        const int e = v & 255, rtg = (v >> 8) & 0xffff, ct = v >> 24;
        const int rt = rtg - __builtin_amdgcn_readfirstlane(tp[e]);
        u.e = e; u.orow0 = rtg * 256; u.ocol0 = ct * 256;
        u.bt = Bt + (size_t)e * bt_estride + (size_t)ct * 256 * K * 2;
        if (list) { u.aoff = e * NTOK + rt * 256; u.alist = list + u.aoff; u.acnt = min(256, __builtin_amdgcn_readfirstlane(cnt[e]) - rt * 256); u.arow0 = 0; }
        else { u.alist = nullptr; u.acnt = 0; u.aoff = 0; u.arow0 = rtg * 256; }
        return true;
    }
};
DEVI void moe_units(G8_LAS int* ut, const G8_LAS int* tp, int nct, int G, int vcu, int tid) {
    if (tid < 32) {
        const int L = tid * G + vcu, total = tp[32] * nct; int v = -1;
        if (L < total) { const int rtg = L / nct, ct = L - rtg * nct; int e = 0;
            for (int k = 1; k < 32; ++k) e += (rtg >= tp[k]) ? 1 : 0;
            v = e | (rtg << 8) | (ct << 24); }
        ut[tid] = v;
    }
}
struct DenseSched {
    int G, c, K, nM0, nN0; const char* Bt0; int nM1, nN1, arow1; const char* Bt1;
    DEVI bool next(int i, Unit& u) const {
        const int nwg = nM0 * nN0, L = i * G + c;
        u.alist = nullptr; u.acnt = 0; u.aoff = 0;
        if (L < nwg) {
            int wgid = L; { const int q = nwg / 8, r = nwg % 8, xcd = wgid % 8, off = wgid / 8; wgid = (xcd < r ? xcd * (q + 1) : r * (q + 1) + (xcd - r) * q) + off; }
            const int nig = 8 * nN0, gid = wgid / nig, fm = gid * 8, gsz = (nM0 - fm) < 8 ? (nM0 - fm) : 8;
            const int pm = fm + ((wgid % nig) % gsz), pn = (wgid % nig) / gsz;
            u.e = 0; u.arow0 = pm * 256; u.orow0 = pm * 256; u.ocol0 = pn * 256; u.bt = Bt0 + (size_t)pn * 256 * K * 2; return true;
        }
        const int l = L - nwg; if (l >= nM1 * nN1) return false;
        const int pm = l / nN1, pn = l - pm * nN1;
        u.e = 1; u.arow0 = arow1 + pm * 256; u.orow0 = pm * 256; u.ocol0 = pn * 256; u.bt = Bt1 + (size_t)pn * 256 * K * 2; return true;
    }
};
}

DEVI unsigned f2bf(float f) { unsigned u = __builtin_bit_cast(unsigned, f); return (u + 0x7fffu + ((u >> 16) & 1u)) >> 16; }
DEVI unsigned pk2(float lo, float hi) { return f2bf(lo) | (f2bf(hi) << 16); }
typedef unsigned v4u __attribute__((ext_vector_type(4)));
DEVI void transpose_item(const float* W, int K, int N, unsigned short* WT, __attribute__((address_space(3))) float* scr, int item, int lane, int ncols = 0) {
    const int nblk = (ncols ? ncols : N) / 32, kb = item / nblk, nb = item % nblk, k0 = 64 * kb, n0 = 32 * nb;
#pragma unroll 8
    for (int i = 0; i < 32; ++i) { const int kk = 2 * i + (lane >> 5); scr[kk * 33 + (lane & 31)] = W[(size_t)(k0 + kk) * N + n0 + (lane & 31)]; }
    asm volatile("s_waitcnt lgkmcnt(0)" ::: "memory");
    const int c = lane & 7;
#pragma unroll
    for (int j = 0; j < 4; ++j) { const int n = (lane >> 3) + 8 * j; const __attribute__((address_space(3))) float* s = scr + (8 * c) * 33 + n;
        v4u o; o.x = pk2(s[0 * 33], s[1 * 33]); o.y = pk2(s[2 * 33], s[3 * 33]); o.z = pk2(s[4 * 33], s[5 * 33]); o.w = pk2(s[6 * 33], s[7 * 33]);
        *(v4u*)(WT + (size_t)(n0 + n) * K + k0 + 8 * c) = o; }
    asm volatile("s_waitcnt lgkmcnt(0)" ::: "memory");
}

#define LAS3 __attribute__((address_space(3)))

typedef float f32x16 __attribute__((ext_vector_type(16)));
typedef short bf16x8_t __attribute__((ext_vector_type(8)));
typedef float f32x2_t __attribute__((ext_vector_type(2)));
typedef __bf16 bf16x2_t __attribute__((ext_vector_type(2)));
typedef unsigned u32x4_t __attribute__((ext_vector_type(4)));
typedef unsigned u32x2_t __attribute__((ext_vector_type(2)));
#define MFMA32(a, b, c) __builtin_amdgcn_mfma_f32_32x32x16_bf16((a), (b), (c), 0, 0, 0)
DEVI unsigned cvtpk(float lo, float hi) { f32x2_t v = {lo, hi}; bf16x2_t b = __builtin_convertvector(v, bf16x2_t); return __builtin_bit_cast(unsigned, b); }
DEVI int crow(int reg, int hi) { return (reg & 3) + 8 * (reg >> 2) + 4 * hi; }
DEVI bf16x8_t pack_step(const f32x16& x, int s) {
    u32x4_t p; p[0] = cvtpk(x[8 * s], x[8 * s + 1]); p[1] = cvtpk(x[8 * s + 2], x[8 * s + 3]); p[2] = cvtpk(x[8 * s + 4], x[8 * s + 5]); p[3] = cvtpk(x[8 * s + 6], x[8 * s + 7]);
    return __builtin_bit_cast(bf16x8_t, p);
}
DEVI int t5_bucket(int d) { return d < 16 ? d : min(31, 16 + (int)(log2f((float)d * 0.0625f) * (16.f / 3.f))); }

DEVI void swa_item(int item, const unsigned short* PROJB, unsigned short* MIXB, const float* relb, const float* sinks, LAS3 unsigned char* L, int tid_) {
    int tid = tid_; asm volatile("" : "+v"(tid));
    const int kv = item & 1, qb = (item >> 1) & 63, b = item >> 7;
    const int lane = tid & 63, w = __builtin_amdgcn_readfirstlane(tid >> 6), hi = lane >> 5, r32 = lane & 31;
    LAS3 unsigned char* KL = L; LAS3 unsigned char* VT = L + 36864; LAS3 float* BT = (LAS3 float*)(L + 36864 + 33280);
    const long tok0 = (long)b * SEQ + (long)(qb - 1) * 128;
#pragma unroll
    for (int i = 0; i < 4; ++i) { const int ci = tid + 512 * i, row = ci >> 3, ch = ci & 7; const bool ok = (qb > 0) || (row >= 128);
        u32x4_t v = {0u, 0u, 0u, 0u}; if (ok) v = *(const u32x4_t*)(PROJB + (size_t)(tok0 + row) * PJ + PJ_K + kv * 64 + ch * 8);
        *(LAS3 u32x4_t*)(KL + row * 144 + ch * 16) = v; }
#pragma unroll
    for (int i = 0; i < 2; ++i) { const int it = tid + 512 * i, rp = it >> 3, ch = it & 7; const bool ok = (qb > 0) || (rp >= 64);
        u32x4_t v0 = {0u, 0u, 0u, 0u}, v1 = {0u, 0u, 0u, 0u};
        if (ok) { const unsigned short* vp = PROJB + (size_t)(tok0 + 2 * rp) * PJ + PJ_V + kv * 64 + ch * 8; v0 = *(const u32x4_t*)vp; v1 = *(const u32x4_t*)(vp + PJ); }
#pragma unroll
        for (int e = 0; e < 8; ++e) { const unsigned a = (e & 1) ? (v0[e >> 1] >> 16) : (v0[e >> 1] & 0xffffu), c = (e & 1) ? (v1[e >> 1] & 0xffff0000u) : (v1[e >> 1] << 16);
            *(LAS3 unsigned*)(VT + (ch * 8 + e) * 520 + rp * 4) = a | c; } }
    { const int hql = tid >> 7, d = tid & 127; BT[tid] = relb[t5_bucket(d) * 8 + kv * 4 + hql]; }
    __syncthreads();
    const int hql = w >> 1, hq = kv * 4 + hql, qhalf = w & 1;
    const float sink = sinks[hq];
#pragma unroll 1
    for (int qi = 0; qi < 2; ++qi) {
        const int m = 2 * qhalf + qi, qf0 = 128 + 32 * m;
        const size_t qrow0 = (size_t)b * SEQ + (size_t)qb * 128 + 32 * m;
        const unsigned short* qp = PROJB + (qrow0 + r32) * PJ + PJ_Q + hq * 64 + 8 * hi;
        bf16x8_t qf[4];
#pragma unroll
        for (int ks = 0; ks < 4; ++ks) qf[ks] = *(const bf16x8_t*)(qp + 16 * ks);
        f32x16 S[5];
#pragma unroll
        for (int kk = 0; kk < 5; ++kk) {
#pragma unroll
            for (int r = 0; r < 16; ++r) S[kk][r] = 0.f;
#pragma unroll
            for (int ks = 0; ks < 4; ++ks) { const bf16x8_t a = *(const LAS3 bf16x8_t*)(KL + (32 * (m + kk) + r32) * 144 + (16 * ks + 8 * hi) * 2); S[kk] = MFMA32(a, qf[ks], S[kk]); }
        }
        float mx = sink;
#pragma unroll
        for (int kk = 0; kk < 5; ++kk)
#pragma unroll
            for (int r = 0; r < 16; ++r) { const int kf = 32 * (m + kk) + crow(r, hi), dist = qf0 + r32 - kf; const bool ok = (dist >= 0) && (dist < 128) && ((qb > 0) || (kf >= 128));
                const float sc = ok ? S[kk][r] * 0.125f + BT[hql * 128 + (dist & 127)] : -INFINITY; S[kk][r] = sc; mx = fmaxf(mx, sc); }
        mx = fmaxf(mx, __shfl_xor(mx, 32));
        float sum = 0.f;
#pragma unroll
        for (int kk = 0; kk < 5; ++kk)
#pragma unroll
            for (int r = 0; r < 16; ++r) { const float pe = __expf(S[kk][r] - mx); S[kk][r] = pe; sum += pe; }
        sum += __shfl_xor(sum, 32); sum += __expf(sink - mx);
        const float linv = 1.f / sum;
        f32x16 O[2];
#pragma unroll
        for (int db = 0; db < 2; ++db)
#pragma unroll
            for (int r = 0; r < 16; ++r) O[db][r] = 0.f;
#pragma unroll
        for (int kk = 0; kk < 5; ++kk)
#pragma unroll
            for (int s2 = 0; s2 < 2; ++s2) { const bf16x8_t pa = pack_step(S[kk], s2); const int kbase = 32 * (m + kk) + 16 * s2 + 4 * hi;
#pragma unroll
                for (int db = 0; db < 2; ++db) { LAS3 unsigned char* vp = VT + (32 * db + r32) * 520 + kbase * 2;
                    const u32x2_t lo = *(const LAS3 u32x2_t*)vp, hi2 = *(const LAS3 u32x2_t*)(vp + 16);
                    const u32x4_t vv = {lo[0], lo[1], hi2[0], hi2[1]};
                    O[db] = MFMA32(pa, __builtin_bit_cast(bf16x8_t, vv), O[db]); } }
#pragma unroll
        for (int r = 0; r < 16; ++r) { const int q = crow(r, hi); const float li = __shfl(linv, q);
            unsigned short* op = MIXB + (qrow0 + q) * 1024 + 512 + hq * 64 + r32;
            op[0] = (unsigned short)(cvtpk(O[0][r] * li, 0.f) & 0xffffu); op[32] = (unsigned short)(cvtpk(O[1][r] * li, 0.f) & 0xffffu); }
    }
    __syncthreads();
}

DEVI void xattn_item(int item, const unsigned short* QCB, const unsigned short* KVMB, unsigned short* OCB, LAS3 unsigned char* L, int tid_) {
    int tid = tid_; asm volatile("" : "+v"(tid));
    const int qblk = item & 31, hd = (item >> 5) & 3, b = item >> 7;
    const int lane = tid & 63, w = __builtin_amdgcn_readfirstlane(tid >> 6), hi = lane >> 5, r32 = lane & 31;
    LAS3 unsigned char* KL = L; LAS3 unsigned char* VT = L + 69632;
    const unsigned short* kvb = KVMB + (size_t)b * MEMLEN * 1024 + hd * 128;
#pragma unroll
    for (int i = 0; i < 8; ++i) { const int ci = tid + 512 * i, row = ci >> 4, ch = ci & 15;
        *(LAS3 u32x4_t*)(KL + row * 272 + ch * 16) = *(const u32x4_t*)(kvb + (size_t)row * 1024 + ch * 8); }
#pragma unroll
    for (int i = 0; i < 4; ++i) { const int it = tid + 512 * i, rp = it >> 4, ch = it & 15;
        const unsigned short* vp = kvb + (size_t)(2 * rp) * 1024 + 512 + ch * 8; const u32x4_t v0 = *(const u32x4_t*)vp, v1 = *(const u32x4_t*)(vp + 1024);
#pragma unroll
        for (int e = 0; e < 8; ++e) { const unsigned a = (e & 1) ? (v0[e >> 1] >> 16) : (v0[e >> 1] & 0xffffu), c = (e & 1) ? (v1[e >> 1] & 0xffff0000u) : (v1[e >> 1] << 16);
            *(LAS3 unsigned*)(VT + (ch * 8 + e) * 520 + rp * 4) = a | c; } }
    __syncthreads();
    const size_t qrow0 = (size_t)b * SEQ + (size_t)qblk * 256 + 32 * w;
    const unsigned short* qp = QCB + (qrow0 + r32) * 512 + hd * 128 + 8 * hi;
    f32x16 S[8];
    {
        bf16x8_t qf[8];
#pragma unroll
        for (int ks = 0; ks < 8; ++ks) qf[ks] = *(const bf16x8_t*)(qp + 16 * ks);
#pragma unroll
        for (int kk = 0; kk < 8; ++kk) {
#pragma unroll
            for (int r = 0; r < 16; ++r) S[kk][r] = 0.f;
#pragma unroll
            for (int ks = 0; ks < 8; ++ks) { const bf16x8_t a = *(const LAS3 bf16x8_t*)(KL + (32 * kk + r32) * 272 + (16 * ks + 8 * hi) * 2); S[kk] = MFMA32(a, qf[ks], S[kk]); }
        }
    }
    const float sc = 0.08838834764831845f;
    float mx = -INFINITY;
#pragma unroll
    for (int kk = 0; kk < 8; ++kk)
#pragma unroll
        for (int r = 0; r < 16; ++r) mx = fmaxf(mx, S[kk][r]);
    mx = fmaxf(mx, __shfl_xor(mx, 32));
    float sum = 0.f;
#pragma unroll
    for (int kk = 0; kk < 8; ++kk)
#pragma unroll
        for (int r = 0; r < 16; ++r) { const float pe = __expf((S[kk][r] - mx) * sc); S[kk][r] = pe; sum += pe; }
    sum += __shfl_xor(sum, 32);
    const float linv = 1.f / sum;
    f32x16 O[4];
#pragma unroll
    for (int db = 0; db < 4; ++db)
#pragma unroll
        for (int r = 0; r < 16; ++r) O[db][r] = 0.f;
#pragma unroll
    for (int kk = 0; kk < 8; ++kk)
#pragma unroll
        for (int s2 = 0; s2 < 2; ++s2) { const bf16x8_t pa = pack_step(S[kk], s2); const int kbase = 32 * kk + 16 * s2 + 4 * hi;
#pragma unroll
            for (int db = 0; db < 4; ++db) { LAS3 unsigned char* vp = VT + (32 * db + r32) * 520 + kbase * 2;
                const u32x2_t lo = *(const LAS3 u32x2_t*)vp, hi2 = *(const LAS3 u32x2_t*)(vp + 16);
                const u32x4_t vv = {lo[0], lo[1], hi2[0], hi2[1]};
                O[db] = MFMA32(pa, __builtin_bit_cast(bf16x8_t, vv), O[db]); } }
#pragma unroll
    for (int r = 0; r < 16; ++r) { const int q = crow(r, hi); const float li = __shfl(linv, q);
        unsigned short* op = OCB + (qrow0 + q) * 512 + hd * 128 + r32;
#pragma unroll
        for (int db = 0; db < 4; ++db) op[32 * db] = (unsigned short)(cvtpk(O[db][r] * li, 0.f) & 0xffffu); }
    __syncthreads();
}


DEVI void ssd_s1_item(int item, const unsigned short* PROJB, const float* DTRAW, const float* convw, const float* convb, const float* dtbias, const float* alog,
                      unsigned short* XC, float* DT, float* ACS, float* CD, float* ST, LAS3 unsigned char* L, int tid_) {
    int tid = tid_; asm volatile("" : "+v"(tid));
    const int g = item & 1, c = (item >> 1) & 63, b = item >> 7;
    const int lane = tid & 63, w = __builtin_amdgcn_readfirstlane(tid >> 6), hi = lane >> 5, r32 = lane & 31;
    LAS3 unsigned char* XwT = L; LAS3 unsigned char* BT = L + 69632;
    LAS3 float* dts = (LAS3 float*)(L + 104448); LAS3 float* acs = dts + 512; LAS3 float* wts = acs + 512;
    const size_t tok0 = (size_t)b * SEQ + (size_t)c * 128;
    if (w < 4) {
        const int h = 4 * g + w; const float ah = -__expf(alog[h]), db = dtbias[h];
        const float d0 = softplus_f(DTRAW[(tok0 + 2 * lane) * 8 + h] + db), d1 = softplus_f(DTRAW[(tok0 + 2 * lane + 1) * 8 + h] + db);
        const float a0 = d0 * ah, a1 = d1 * ah;
        float sc = a0 + a1;
#pragma unroll
        for (int o = 1; o < 64; o <<= 1) { const float v = __shfl_up(sc, o); if (lane >= o) sc += v; }
        const float ex = sc - (a0 + a1), c0 = ex + a0, c1 = ex + a0 + a1, cend = __shfl(sc, 63);
        dts[w * 128 + 2 * lane] = d0; dts[w * 128 + 2 * lane + 1] = d1; acs[w * 128 + 2 * lane] = c0; acs[w * 128 + 2 * lane + 1] = c1;
        wts[w * 128 + 2 * lane] = __expf(cend - c0) * d0; wts[w * 128 + 2 * lane + 1] = __expf(cend - c1) * d1;
        DT[(tok0 + 2 * lane) * 8 + h] = d0; DT[(tok0 + 2 * lane + 1) * 8 + h] = d1; ACS[(tok0 + 2 * lane) * 8 + h] = c0; ACS[(tok0 + 2 * lane + 1) * 8 + h] = c1;
        if (lane == 0) CD[((size_t)b * 64 + c) * 8 + h] = __expf(cend);
    }
    __syncthreads();
    {
        const int cg = lane, ch = cg < 32 ? g * 256 + cg * 8 : (cg < 48 ? 512 + g * 128 + (cg - 32) * 8 : 768 + g * 128 + (cg - 48) * 8);
        float wk[4][8], bb[8];
#pragma unroll
        for (int k = 0; k < 4; ++k) { const float4 a = ld4(convw + k * CONVCH + ch), d = ld4(convw + k * CONVCH + ch + 4); wk[k][0] = a.x; wk[k][1] = a.y; wk[k][2] = a.z; wk[k][3] = a.w; wk[k][4] = d.x; wk[k][5] = d.y; wk[k][6] = d.z; wk[k][7] = d.w; }
        { const float4 a = ld4(convb + ch), d = ld4(convb + ch + 4); bb[0] = a.x; bb[1] = a.y; bb[2] = a.z; bb[3] = a.w; bb[4] = d.x; bb[5] = d.y; bb[6] = d.z; bb[7] = d.w; }
        const int s0 = w * 16;
        const unsigned short* src = PROJB + (tok0 + s0) * PJ + PJ_XBC + ch;
        u32x4_t rw[19];
#pragma unroll
        for (int i = 0; i < 19; ++i) { const bool ok = (c > 0) || (s0 + i - 3 >= 0); rw[i] = (u32x4_t){0u, 0u, 0u, 0u}; if (ok) rw[i] = *(const u32x4_t*)(src + (ptrdiff_t)(i - 3) * PJ); }
        const int hl = cg >> 3;
#pragma unroll
        for (int i2 = 0; i2 < 8; ++i2) {
            float y[2][8];
#pragma unroll
            for (int q = 0; q < 2; ++q) {
                const int i = 2 * i2 + q;
#pragma unroll
                for (int e = 0; e < 8; ++e) { float a = bb[e];
#pragma unroll
                    for (int k = 0; k < 4; ++k) { const unsigned wd = rw[i + k][e >> 1]; a += wk[k][e] * __uint_as_float((e & 1) ? (wd & 0xffff0000u) : (wd << 16)); }
                    y[q][e] = silu_f(a); }
                u32x4_t o; o[0] = cvtpk(y[q][0], y[q][1]); o[1] = cvtpk(y[q][2], y[q][3]); o[2] = cvtpk(y[q][4], y[q][5]); o[3] = cvtpk(y[q][6], y[q][7]);
                *(u32x4_t*)(XC + (tok0 + s0 + i) * 1024 + ch) = o;
            }
            const int s = s0 + 2 * i2;
            if (cg < 32) { const float w0 = wts[hl * 128 + s], w1 = wts[hl * 128 + s + 1];
#pragma unroll
                for (int e = 0; e < 8; ++e) *(LAS3 unsigned*)(XwT + hl * 17408 + ((cg & 7) * 8 + e) * 272 + s * 2) = cvtpk(y[0][e] * w0, y[1][e] * w1); }
            else if (cg < 48) {
#pragma unroll
                for (int e = 0; e < 8; ++e) *(LAS3 unsigned*)(BT + ((cg - 32) * 8 + e) * 272 + s * 2) = cvtpk(y[0][e], y[1][e]); }
        }
    }
    __syncthreads();
    {
        const int pb = w >> 2, nb = w & 3;
#pragma unroll 1
        for (int hl = 0; hl < 4; ++hl) {
            f32x16 acc;
#pragma unroll
            for (int r = 0; r < 16; ++r) acc[r] = 0.f;
#pragma unroll
            for (int ks = 0; ks < 8; ++ks) { const bf16x8_t a = *(const LAS3 bf16x8_t*)(XwT + hl * 17408 + (32 * pb + r32) * 272 + (16 * ks + 8 * hi) * 2);
                const bf16x8_t bq = *(const LAS3 bf16x8_t*)(BT + (32 * nb + r32) * 272 + (16 * ks + 8 * hi) * 2); acc = MFMA32(a, bq, acc); }
            float* sp = ST + (((size_t)b * 64 + c) * 8 + 4 * g + hl) * 8192 + 32 * nb + r32;
#pragma unroll
            for (int r = 0; r < 16; ++r) sp[(32 * pb + crow(r, hi)) * 128] = acc[r];
        }
    }
    __syncthreads();
}

DEVI void ssd_s3_item(int item, const unsigned short* XC, const float* DT, const float* ACS, const unsigned short* HIN, const unsigned short* PROJB, const float* dskip, const float* gssm,
                      float* YPRE, unsigned short* MIXB, LAS3 unsigned char* L, int tid_) {
    int tid = tid_; asm volatile("" : "+v"(tid));
    const int g = item & 1, c = (item >> 1) & 63, b = item >> 7;
    const int lane = tid & 63, w = __builtin_amdgcn_readfirstlane(tid >> 6), hi = lane >> 5, r32 = lane & 31;
    LAS3 unsigned char* Cs = L; LAS3 unsigned char* BM = L + 34816; LAS3 unsigned char* XT = L + 69632; LAS3 unsigned char* HN = L + 87040;
    LAS3 float* dts = (LAS3 float*)(L + 104448); LAS3 float* acs = dts + 512; LAS3 float* rowsq = acs + 512;
    const size_t tok0 = (size_t)b * SEQ + (size_t)c * 128;
#pragma unroll
    for (int i = 0; i < 4; ++i) { const int ci = tid + 512 * i, row = ci >> 4, chk = ci & 15;
        *(LAS3 u32x4_t*)(Cs + row * 272 + chk * 16) = *(const u32x4_t*)(XC + (tok0 + row) * 1024 + 768 + g * 128 + chk * 8);
        *(LAS3 u32x4_t*)(BM + row * 272 + chk * 16) = *(const u32x4_t*)(XC + (tok0 + row) * 1024 + 512 + g * 128 + chk * 8); }
    { const int t = tid >> 2, hl = tid & 3; dts[hl * 128 + t] = DT[(tok0 + t) * 8 + 4 * g + hl]; acs[hl * 128 + t] = ACS[(tok0 + t) * 8 + 4 * g + hl]; }
    __syncthreads();
    const int lb = w >> 1;
    f32x16 CB[2];
#pragma unroll
    for (int j = 0; j < 2; ++j) {
#pragma unroll
        for (int r = 0; r < 16; ++r) CB[j][r] = 0.f;
        const int sb = 2 * (w & 1) + j;
        if (sb <= lb) {
#pragma unroll
            for (int ks = 0; ks < 8; ++ks) { const bf16x8_t a = *(const LAS3 bf16x8_t*)(Cs + (32 * lb + r32) * 272 + (16 * ks + 8 * hi) * 2);
                const bf16x8_t bq = *(const LAS3 bf16x8_t*)(BM + (32 * sb + r32) * 272 + (16 * ks + 8 * hi) * 2); CB[j] = MFMA32(a, bq, CB[j]); }
        }
    }
    __syncthreads();
    const int pb = w & 1;
    float sq[16];
#pragma unroll
    for (int r = 0; r < 16; ++r) sq[r] = 0.f;
    LAS3 unsigned char* ZS = L + 110592;
#pragma unroll 1
    for (int hl = 0; hl < 4; ++hl) {
        const int h = 4 * g + hl;
        {
            const int sp = tid >> 3, chk = tid & 7;
            const unsigned short* xp = XC + (tok0 + 2 * sp) * 1024 + h * 64 + chk * 8; const u32x4_t v0 = *(const u32x4_t*)xp, v1 = *(const u32x4_t*)(xp + 1024);
#pragma unroll
            for (int e = 0; e < 8; ++e) { const unsigned a = (e & 1) ? (v0[e >> 1] >> 16) : (v0[e >> 1] & 0xffffu), d = (e & 1) ? (v1[e >> 1] & 0xffff0000u) : (v1[e >> 1] << 16);
                *(LAS3 unsigned*)(XT + (chk * 8 + e) * 272 + sp * 4) = a | d; }
            const unsigned short* hp = HIN + (((size_t)b * 64 + c) * 8 + h) * 8192;
#pragma unroll
            for (int i = 0; i < 2; ++i) { const int ci = tid + 512 * i, row = ci >> 4, ck = ci & 15; *(LAS3 u32x4_t*)(HN + row * 272 + ck * 16) = *(const u32x4_t*)(hp + row * 128 + ck * 8); }
#pragma unroll
            for (int i = 0; i < 2; ++i) { const int ci = tid + 512 * i, row = ci >> 3, ck = ci & 7; *(LAS3 u32x4_t*)(ZS + row * 144 + ck * 16) = *(const u32x4_t*)(PROJB + (tok0 + row) * PJ + PJ_Z + h * 64 + ck * 8); }
        }
#pragma unroll
        for (int j = 0; j < 2; ++j) { const int sb = 2 * (w & 1) + j;
            if (sb <= lb) { const int s = 32 * sb + r32; const float as = acs[hl * 128 + s], ds = dts[hl * 128 + s];
#pragma unroll
                for (int r = 0; r < 16; ++r) { const int l = 32 * lb + crow(r, hi); const float v = (s <= l) ? CB[j][r] * __expf(acs[hl * 128 + l] - as) * ds : 0.f;
                    *(LAS3 unsigned short*)(BM + l * 272 + s * 2) = (unsigned short)(cvtpk(v, 0.f) & 0xffffu); } } }
        __syncthreads();
        f32x16 acc;
#pragma unroll
        for (int r = 0; r < 16; ++r) acc[r] = 0.f;
#pragma unroll
        for (int ks = 0; ks < 8; ++ks) { const bf16x8_t a = *(const LAS3 bf16x8_t*)(Cs + (32 * lb + r32) * 272 + (16 * ks + 8 * hi) * 2);
            const bf16x8_t bq = *(const LAS3 bf16x8_t*)(HN + (32 * pb + r32) * 272 + (16 * ks + 8 * hi) * 2); acc = MFMA32(a, bq, acc); }
#pragma unroll
        for (int r = 0; r < 16; ++r) acc[r] *= __expf(acs[hl * 128 + 32 * lb + crow(r, hi)]);
#pragma unroll
        for (int ks = 0; ks < 8; ++ks) if (ks < 2 * (lb + 1)) { const bf16x8_t a = *(const LAS3 bf16x8_t*)(BM + (32 * lb + r32) * 272 + (16 * ks + 8 * hi) * 2);
            const bf16x8_t bq = *(const LAS3 bf16x8_t*)(XT + (32 * pb + r32) * 272 + (16 * ks + 8 * hi) * 2); acc = MFMA32(a, bq, acc); }
        const float dsk = dskip[h]; const int pc = 32 * pb + r32;
        float* yp = YPRE + tok0 * 512 + h * 64 + pc;
#pragma unroll
        for (int r = 0; r < 16; ++r) { const int l = 32 * lb + crow(r, hi);
            const float xv = bf2f(*(const LAS3 unsigned short*)(XT + pc * 272 + l * 2)), z = bf2f(*(const LAS3 unsigned short*)(ZS + l * 144 + pc * 2));
            const float y = (acc[r] + dsk * xv) * silu_f(z); yp[l * 512] = y; sq[r] += y * y; }
        __syncthreads();
    }
#pragma unroll
    for (int r = 0; r < 16; ++r) { float v = sq[r];
#pragma unroll
        for (int o = 1; o < 32; o <<= 1) v += __shfl_xor(v, o);
        if (r32 == 0) rowsq[(32 * lb + crow(r, hi)) * 2 + pb] = v; }
    __syncthreads();
#pragma unroll 1
    for (int hl = 0; hl < 4; ++hl) { const int col = (4 * g + hl) * 64 + 32 * pb + r32; const float gs = gssm[col];
#pragma unroll
        for (int r = 0; r < 16; ++r) { const int l = 32 * lb + crow(r, hi); const float rs = rsqrtf((rowsq[l * 2] + rowsq[l * 2 + 1]) * (1.f / 256.f) + EPS);
            MIXB[(tok0 + l) * 1024 + col] = (unsigned short)(cvtpk(YPRE[(tok0 + l) * 512 + col] * rs * gs, 0.f) & 0xffffu); } }
    __syncthreads();
}

__global__ void __launch_bounds__(512, 2) mk_fwd(Params p) {
    extern __shared__ __attribute__((aligned(16))) unsigned char lds[];
    cg::grid_group grid = cg::this_grid();
    const int NGW = gridDim.x * 8, NGT = gridDim.x * 512, G = gridDim.x;
    unsigned char* ws = p.ws;
    unsigned* ctl = (unsigned*)(ws + WS_CTL);
    float* H1 = (float*)(ws + WS_H1); float* H2 = (float*)(ws + WS_H2);
    float* DT = (float*)(ws + WS_DT); float* DTRAW = (float*)(ws + WS_DTRAW); float* GATE = (float*)(ws + WS_GATE); float* BIASP = (float*)(ws + WS_BIASP);
    typedef unsigned short bf;
    bf* XN = (bf*)(ws + WS_XN); bf* PROJB = (bf*)(ws + WS_BIG); bf* YB = (bf*)(ws + WS_YB); bf* MIXB = (bf*)(ws + WS_MIXB); bf* QCB = (bf*)(ws + WS_QCB); bf* OCB = (bf*)(ws + WS_OCB);
    bf* ACTB = (bf*)(ws + WS_ACTB); bf* KVMB = (bf*)(ws + WS_KVMB);
    bf* XC = (bf*)(ws + WS_XC); float* ACS = (float*)(ws + WS_ACS); float* CD = (float*)(ws + WS_CD); float* ST = (float*)(ws + WS_ST); bf* HIN = (bf*)(ws + WS_HIN);
    bf* W1T = (bf*)(ws + WS_W1T); bf* W2T = (bf*)(ws + WS_W2T); bf* WINT = (bf*)(ws + WS_WINT); bf* WOUTT = (bf*)(ws + WS_WOUTT); bf* WQT = (bf*)(ws + WS_WQT); bf* WKVT = (bf*)(ws + WS_WKVT); bf* WOT = (bf*)(ws + WS_WOT);
    int* LIST = (int*)(ws + WS_LIST); int* SLOT = (int*)(ws + WS_SLOT); float* RSA = (float*)(ws + WS_RSA);
    LAS3 unsigned char* ldsp = (LAS3 unsigned char*)lds;
    LAS3 int* TP = (LAS3 int*)(ldsp + LDS_MISC); LAS3 int* CNTL = TP + 64;
    const float* x = p.in[I_X];
    const int vcu = (G % 8 == 0) ? (blockIdx.x % 8) * (G / 8) + blockIdx.x / 8 : blockIdx.x;
    const int wave_id = __builtin_amdgcn_readfirstlane(threadIdx.x >> 6);
    if (threadIdx.x < 2) ((LAS3 unsigned*)(ldsp + LDS_MISC + 512))[threadIdx.x] = 0u;
    __syncthreads();
    const XcdBarrier xbar = xcd_barrier_post(ctl + 4096, (volatile LAS3 unsigned*)(ldsp + LDS_MISC + 512), threadIdx.x == 0);
#define GRID_BAR() do { const TI tb_ = fresh_ti(wave_id); xcd_barrier(xbar, tb_.tid == 0); } while (0)

    PH_BEGIN(0)
    {
        PHASE_IDS();
        LAS3 float* wdt = (LAS3 float*)ldsp;
        for (int i = tid; i < 1024 * 2; i += 512) { const int k = i >> 1, hh = (i & 1) * 4; { const float4 t4 = ld4(p.in[I_WIN] + (size_t)k * IN_COLS + COL_DT + hh); *(LAS3 g8::f32x4*)(wdt + k * 8 + hh) = (g8::f32x4){t4.x, t4.y, t4.z, t4.w}; } }
        for (int i = gtid; i < PJ; i += NGT) BIASP[i] = i < PJ_Q ? 0.f : p.in[I_BQKV][i - PJ_Q];
        __syncthreads();
        for (int r = gw; r < NTOK + NMEM; r += NGW) {
            const bool ismem = r >= NTOK;
            const float* xrow = ismem ? p.in[I_MEM] + (size_t)(r - NTOK) * DM : x + (size_t)r * DM;
            const float* g = ismem ? p.in[I_GMEM] : p.in[I_GMIX];
            float4 v[4]; float ss = 0.f;
#pragma unroll
            for (int j = 0; j < 4; ++j) { v[j] = ld4(xrow + 4 * (lane + 64 * j)); ss += v[j].x * v[j].x + v[j].y * v[j].y + v[j].z * v[j].z + v[j].w * v[j].w; }
            const float rs = rsqrtf(wave_sum(ss) * (1.f / 1024.f) + EPS);
            float dacc[8];
#pragma unroll
            for (int h = 0; h < 8; ++h) dacc[h] = 0.f;
#pragma unroll
            for (int j = 0; j < 4; ++j) { const int c = 4 * (lane + 64 * j); const float4 gv = ld4(g + c);
                v[j] = make_float4(v[j].x * rs * gv.x, v[j].y * rs * gv.y, v[j].z * rs * gv.z, v[j].w * rs * gv.w);
                *(uint2*)(XN + (size_t)r * DM + c) = make_uint2(pk2(v[j].x, v[j].y), pk2(v[j].z, v[j].w));
                if (!ismem) { const float uu[4] = {v[j].x, v[j].y, v[j].z, v[j].w};
#pragma unroll
                    for (int q = 0; q < 4; ++q) { const g8::f32x4 w0 = *(const LAS3 g8::f32x4*)(wdt + (c + q) * 8), w1 = *(const LAS3 g8::f32x4*)(wdt + (c + q) * 8 + 4);
                        dacc[0] += uu[q] * w0.x; dacc[1] += uu[q] * w0.y; dacc[2] += uu[q] * w0.z; dacc[3] += uu[q] * w0.w;
                        dacc[4] += uu[q] * w1.x; dacc[5] += uu[q] * w1.y; dacc[6] += uu[q] * w1.z; dacc[7] += uu[q] * w1.w; } }
            }
            if (!ismem) {
#pragma unroll
                for (int h = 0; h < 8; ++h) dacc[h] = wave_sum(dacc[h]);
                if (lane == 0) { st4(DTRAW + (size_t)r * 8, make_float4(dacc[0], dacc[1], dacc[2], dacc[3])); st4(DTRAW + (size_t)r * 8 + 4, make_float4(dacc[4], dacc[5], dacc[6], dacc[7])); }
            }
        }
        __syncthreads();
        LAS3 float* scr = (LAS3 float*)(ldsp + wave * 16384);
        constexpr int IT1 = 16 * (2048 / 32), IT2 = 16 * (1024 / 32);
        constexpr int IA = 16 * (1536 / 32), IB = 16 * (768 / 32), IO = 16 * 32, IQ = 16 * 16, IKV = 16 * 32, IWO = 8 * 32;
        constexpr int NSM = IA + IB + IO + IQ + IKV + IWO, NIT = NSM + NEXP * (IT1 + IT2);
        for (int it = gw; it < NIT; it += NGW) {
            int r = it;
            if (r < IA) { transpose_item(p.in[I_WIN], 1024, IN_COLS, WINT, scr, r, lane, 1536); continue; } r -= IA;
            if (r < IB) { transpose_item(p.in[I_WIN] + COL_Q, 1024, IN_COLS, WINT + (size_t)1536 * 1024, scr, r, lane, 768); continue; } r -= IB;
            if (r < IO) { transpose_item(p.in[I_WOUT], 1024, 1024, WOUTT, scr, r, lane); continue; } r -= IO;
            if (r < IQ) { transpose_item(p.in[I_WQ], 1024, 512, WQT, scr, r, lane); continue; } r -= IQ;
            if (r < IKV) { transpose_item(p.in[I_WKV], 1024, 1024, WKVT, scr, r, lane); continue; } r -= IKV;
            if (r < IWO) { transpose_item(p.in[I_WO], 512, 1024, WOT, scr, r, lane); continue; } r -= IWO;
            if (r < NEXP * IT1) { const int e = r / IT1, q = r - e * IT1; transpose_item(p.in[I_W1] + (size_t)e * 1024 * 2048, 1024, 2048, W1T + (size_t)e * 2048 * 1024, scr, q, lane); continue; } r -= NEXP * IT1;
            { const int e = r / IT2, q = r - e * IT2; transpose_item(p.in[I_W2] + (size_t)e * 1024 * 1024, 1024, 1024, W2T + (size_t)e * 1024 * 1024, scr, q, lane); }
        }
    }
    grid.sync();
    PH_END()
    PH_BEGIN(1)
    {
        g8::DenseSched S{G, (int)blockIdx.x, 1024, NTOK / 256, PJ / 256, (const char*)WINT, NMEM / 256, 4, NTOK, (const char*)WKVT};
        g8::EpiBf16Dual E{PROJB, PJ, BIASP, KVMB, 1024};
        { PHASE_IDS(); g8::gemm_phase(ldsp, XN, 1024, 0, S, E, tid); }
    }
    GRID_BAR();
    PH_END()
    PH_BEGIN(2)
    {
    PHASE_IDS();
    for (int item = blockIdx.x; item < BATCH * 64 * 2; item += G)
        ssd_s1_item(item, PROJB, DTRAW, p.in[I_CONVW], p.in[I_CONVB], p.in[I_DTB], p.in[I_ALOG], XC, DT, ACS, CD, ST, ldsp, tid);
    }
    GRID_BAR();
    PH_END()
    PH_BEGIN(3)
    {
    PHASE_IDS();
    for (int item = blockIdx.x; item < BATCH * 64 * 2; item += G) swa_item(item, PROJB, MIXB, p.in[I_RELB], p.in[I_SINK], ldsp, tid);
    {
        for (int el = gtid; el < BATCH * 8 * 8192; el += NGT) {
            const int bh = el >> 13, pn = el & 8191, b = bh >> 3, h = bh & 7;
            float st = 0.f;
#pragma unroll 8
            for (int c = 0; c < 64; ++c) { const size_t idx = (((size_t)b * 64 + c) * 8 + h) * 8192 + pn;
                HIN[idx] = (bf)(cvtpk(st, 0.f) & 0xffffu); st = st * CD[((size_t)b * 64 + c) * 8 + h] + ST[idx]; }
        }
    }
    }
    GRID_BAR();
    PH_END()
    PH_BEGIN(4)
    {
    PHASE_IDS();
    for (int item = blockIdx.x; item < BATCH * 64 * 2; item += G)
        ssd_s3_item(item, XC, DT, ACS, HIN, PROJB, p.in[I_DSKIP], p.in[I_GSSM], ST, MIXB, ldsp, tid);
    }
    GRID_BAR();
    PH_END()
    PH_BEGIN(5)
    {
        g8::DenseSched S{G, (int)blockIdx.x, 1024, NTOK / 256, 4, (const char*)WOUTT, 0, 1, 0, nullptr};
        g8::EpiF32Res E{H1, p.in[I_BOUT], x};
        { PHASE_IDS(); g8::gemm_phase(ldsp, MIXB, 1024, 0, S, E, tid); }
    }
    GRID_BAR();
    PH_END()
    PH_BEGIN(6)
    {
    PHASE_IDS();
    for (int r = gw; r < NTOK; r += NGW) {
        float4 v[4]; float ss = 0.f;
#pragma unroll
        for (int j = 0; j < 4; ++j) { v[j] = ld4(H1 + (size_t)r * DM + 4 * (lane + 64 * j)); ss += v[j].x * v[j].x + v[j].y * v[j].y + v[j].z * v[j].z + v[j].w * v[j].w; }
        const float rs = rsqrtf(wave_sum(ss) * (1.f / 1024.f) + EPS);
#pragma unroll
        for (int j = 0; j < 4; ++j) { const int c = 4 * (lane + 64 * j); const float4 gv = ld4(p.in[I_GCROSS] + c);
            *(uint2*)(XN + (size_t)r * DM + c) = make_uint2(pk2(v[j].x * rs * gv.x, v[j].y * rs * gv.y), pk2(v[j].z * rs * gv.z, v[j].w * rs * gv.w)); }
    }
    }
    GRID_BAR();
    PH_END()
    PH_BEGIN(7)
    {
        g8::DenseSched S{G, (int)blockIdx.x, 1024, NTOK / 256, 2, (const char*)WQT, 0, 1, 0, nullptr};
        g8::EpiBf16Dual E{QCB, 512, nullptr, nullptr, 0};
        { PHASE_IDS(); g8::gemm_phase(ldsp, XN, 1024, 0, S, E, tid); }
    }
    GRID_BAR();
    PH_END()
    PH_BEGIN(8)
    {
    PHASE_IDS();
    for (int item = blockIdx.x; item < BATCH * 4 * 32; item += G) xattn_item(item, QCB, KVMB, OCB, ldsp, tid);
    }
    GRID_BAR();
    PH_END()
    PH_BEGIN(9)
    {
        g8::DenseSched S{G, (int)blockIdx.x, 512, NTOK / 256, 4, (const char*)WOT, 0, 1, 0, nullptr};
        g8::EpiF32Res E{H2, nullptr, H1};
        { PHASE_IDS(); g8::gemm_phase(ldsp, OCB, 512, 0, S, E, tid); }
    }
    GRID_BAR();
    PH_END()
    PH_BEGIN(10)
    {
    PHASE_IDS();
    LAS3 float* PL = (LAS3 float*)ldsp;
    LAS3 float* SQ = (LAS3 float*)(ldsp + 33792);
    const int hi = lane >> 5, r32 = lane & 31, tl = wave >> 2, kq = wave & 3;
    for (int rb = blockIdx.x; rb < NTOK / 64; rb += G) {
        const int row0 = rb * 64 + tl * 32;
        const float* hrow = H2 + (size_t)(row0 + r32) * DM + kq * 256 + 4 * hi;
        const float* gq = p.in[I_GFFN] + kq * 256 + 4 * hi;
        const float* wq = p.in[I_WR] + (size_t)(kq * 256 + 4 * hi) * 32 + r32;
        bf* xq = XN + (size_t)(row0 + r32) * DM + kq * 256 + 4 * hi;
        f32x16 acc;
#pragma unroll
        for (int r = 0; r < 16; ++r) acc[r] = 0.f;
        float ssq = 0.f;
#pragma unroll 1
        for (int mb = 0; mb < 32; mb += 8) {
            float4 av[8]; float bv[8][4];
#pragma unroll
            for (int m = 0; m < 8; ++m) { av[m] = ld4(hrow + 8 * (mb + m));
#pragma unroll
                for (int t = 0; t < 4; ++t) bv[m][t] = wq[(size_t)(8 * (mb + m) + t) * 32]; }
#pragma unroll
            for (int m = 0; m < 8; ++m) { const float4 gv = ld4(gq + 8 * (mb + m)); float4 a = av[m];
                ssq += a.x * a.x + a.y * a.y + a.z * a.z + a.w * a.w;
                a.x *= gv.x; a.y *= gv.y; a.z *= gv.z; a.w *= gv.w;
                *(uint2*)(xq + 8 * (mb + m)) = make_uint2(cvtpk(a.x, a.y), cvtpk(a.z, a.w));
                acc = __builtin_amdgcn_mfma_f32_32x32x2f32(a.x, bv[m][0], acc, 0, 0, 0); acc = __builtin_amdgcn_mfma_f32_32x32x2f32(a.y, bv[m][1], acc, 0, 0, 0);
                acc = __builtin_amdgcn_mfma_f32_32x32x2f32(a.z, bv[m][2], acc, 0, 0, 0); acc = __builtin_amdgcn_mfma_f32_32x32x2f32(a.w, bv[m][3], acc, 0, 0, 0); }
        }
        ssq += __shfl_xor(ssq, 32);
        if (hi == 0) SQ[(tl * 4 + kq) * 32 + r32] = ssq;
#pragma unroll
        for (int r = 0; r < 16; ++r) PL[((tl * 4 + kq) * 32 + crow(r, hi)) * 33 + r32] = acc[r];
        __syncthreads();
        if (lane < 8) {
            const int i = 8 * kq + lane, row = row0 + i;
            const float rs = rsqrtf((SQ[(tl * 4 + 0) * 32 + i] + SQ[(tl * 4 + 1) * 32 + i] + SQ[(tl * 4 + 2) * 32 + i] + SQ[(tl * 4 + 3) * 32 + i]) * (1.f / 1024.f) + EPS);
            float l[32];
#pragma unroll
            for (int e = 0; e < 32; ++e) l[e] = (PL[((tl * 4 + 0) * 32 + i) * 33 + e] + PL[((tl * 4 + 1) * 32 + i) * 33 + e] + PL[((tl * 4 + 2) * 32 + i) * 33 + e] + PL[((tl * 4 + 3) * 32 + i) * 33 + e]) * rs + p.in[I_BR][e];
            int sel[4]; float val[4];
#pragma unroll
            for (int k = 0; k < 4; ++k) {
                float best = -INFINITY; int bi = 0;
#pragma unroll
                for (int e = 0; e < 32; ++e) if (l[e] > best) { best = l[e]; bi = e; }
                sel[k] = bi; val[k] = best;
#pragma unroll
                for (int e = 0; e < 32; ++e) l[e] = (e == bi) ? -INFINITY : l[e];
            }
            float ex[4], den = 0.f;
#pragma unroll
            for (int k = 0; k < 4; ++k) { ex[k] = __expf(val[k] - val[0]); den += ex[k]; }
#pragma unroll
            for (int k = 0; k < 4; ++k) {
                const int a = row * 4 + k;
                const unsigned slot = atomicAdd(&ctl[CW_CNT + sel[k]], 1u);
                LIST[sel[k] * NTOK + slot] = a;
                RSA[sel[k] * NTOK + slot] = rs;
                SLOT[a] = (sel[k] << 16) | (int)slot;
                GATE[a] = ex[k] / den;
            }
        }
        __syncthreads();
    }
    }
    GRID_BAR();
    PH_END()
    {
    PHASE_IDS();
    if (tid < 64) {
        const int c = tid < 32 ? (int)__hip_atomic_load(&ctl[CW_CNT + (tid & 31)], __ATOMIC_RELAXED, __HIP_MEMORY_SCOPE_AGENT) : 0;
        int tl = (c + 255) >> 8, incl = tl;
#pragma unroll
        for (int o = 1; o < 32; o <<= 1) { const int v = __shfl_up(incl, o); if ((tid & 63) >= o) incl += v; }
        if (tid < 32) { CNTL[tid] = c; TP[tid] = incl - tl; }
        if (tid == 31) TP[32] = incl;
    }
    __syncthreads();
    g8::moe_units(TP + 136, TP, 8, G, vcu, tid); g8::moe_units(TP + 168, TP, 4, G, vcu, tid);
    }
    __syncthreads();
    PH_BEGIN(11)
    {
        g8::MoeSched S{8, 1024, TP + 136, TP, CNTL, LIST, (const char*)W1T, (size_t)2048 * 1024 * 2};
        g8::EpiSwiglu E{ACTB, p.in[I_B1], RSA};
        { PHASE_IDS(); g8::gemm_phase(ldsp, XN, 1024, 2, S, E, tid); }
    }
    GRID_BAR();
    PH_END()
    PH_BEGIN(12)
    {
        g8::MoeSched S{4, 1024, TP + 168, TP, CNTL, nullptr, (const char*)W2T, (size_t)1024 * 1024 * 2};
        g8::EpiBf16 E{YB, 1024, p.in[I_B2], 1024};
        { PHASE_IDS(); g8::gemm_phase(ldsp, ACTB, 1024, 0, S, E, tid); }
    }
    GRID_BAR();
    PH_END()
    PH_BEGIN(13)
    {
    PHASE_IDS();
    for (int row = gw; row < NTOK; row += NGW) {
        float4 v[4]; float ss = 0.f;
        int yrow[4]; float gk[4];
#pragma unroll
        for (int k = 0; k < 4; ++k) { const int sl = SLOT[row * 4 + k]; yrow[k] = TP[sl >> 16] * 256 + (sl & 0xffff); gk[k] = GATE[row * 4 + k]; }
#pragma unroll
        for (int j = 0; j < 4; ++j) {
            const int c = 4 * (lane + 64 * j);
            float4 a = ld4(H2 + (size_t)row * DM + c);
#pragma unroll
            for (int k = 0; k < 4; ++k) { const uint2 y = *(const uint2*)(YB + (size_t)yrow[k] * 1024 + c);
                a.x += gk[k] * __uint_as_float(y.x << 16); a.y += gk[k] * __uint_as_float(y.x & 0xffff0000u);
                a.z += gk[k] * __uint_as_float(y.y << 16); a.w += gk[k] * __uint_as_float(y.y & 0xffff0000u); }
            v[j] = a; ss += a.x * a.x + a.y * a.y + a.z * a.z + a.w * a.w;
        }
        float rs = rsqrtf(wave_sum(ss) * (1.f / 1024.f) + EPS);
#pragma unroll
        for (int j = 0; j < 4; ++j) { const int c = 4 * (lane + 64 * j); const float4 gv = ld4(p.in[I_GFIN] + c);
            st4(p.out + (size_t)row * DM + c, make_float4(v[j].x * rs * gv.x, v[j].y * rs * gv.y, v[j].z * rs * gv.z, v[j].w * rs * gv.w)); }
    }
    }
    PH_END()
}

constexpr int LDS_BYTES = 147456;

extern "C" void kernel_launch(void* const* d_in, const int* in_sizes, int n_in, void* d_out, int out_size, void* d_ws, size_t ws_size, hipStream_t stream) {
    static int grid = 0;
    if (grid == 0) {
        if (n_in != N_IN || ws_size < WS_END) { fprintf(stderr, "kernel_launch: unexpected n_in %d / ws_size %zu (need %zu)\n", n_in, ws_size, (size_t)WS_END); grid = -1; return; }
        int dev = 0, cus = 0, per_cu = 0;
        (void)hipGetDevice(&dev);
        (void)hipDeviceGetAttribute(&cus, hipDeviceAttributeMultiprocessorCount, dev);
        (void)hipFuncSetAttribute((const void*)mk_fwd, hipFuncAttributeMaxDynamicSharedMemorySize, LDS_BYTES);
        (void)hipOccupancyMaxActiveBlocksPerMultiprocessor(&per_cu, (const void*)mk_fwd, 512, LDS_BYTES);
        if (per_cu < 1) { fprintf(stderr, "kernel_launch: occupancy query says %d blocks per CU\n", per_cu); per_cu = 1; }
        if (per_cu > 1) per_cu = 1;
        grid = cus * per_cu;
    }
    if (grid < 0) return;
    (void)hipMemsetAsync((char*)d_ws + WS_CTL, 0, 1 * MiB, stream);
    Params p{};
    for (int i = 0; i < N_IN; ++i) p.in[i] = (const float*)d_in[i];
    p.out = (float*)d_out; p.ws = (unsigned char*)d_ws; p.rep_mask = REP_MASK;
    void* args[] = {&p};
    hipError_t e = hipLaunchCooperativeKernel((const void*)mk_fwd, dim3(grid), dim3(512), args, LDS_BYTES, stream);
    if (e != hipSuccess) fprintf(stderr, "cooperative launch failed: %s (grid %d)\n", hipGetErrorString(e), grid);
}
```

```cpp
#include <hip/hip_runtime.h>
#include <cstdio>
#include <cstdint>

#define DEVI __device__ __forceinline__

constexpr int BATCH = 2, SEQ = 8192, NTOK = BATCH * SEQ, DM = 1024, MEMLEN = 256, NMEM = BATCH * MEMLEN;
constexpr int SSM_H = 8, SSM_P = 64, SSM_W = 512, SSM_N = 128, CONVCH = 1024;
constexpr int IN_COLS = 2312, COL_Z = 0, COL_XBC = 512, COL_DT = 1536, COL_Q = 1544, COL_K = 2056, COL_V = 2184;
constexpr int NEXP = 32, TOPK = 4, DFF = 1024, NASSIGN = NTOK * TOPK;
constexpr float EPS = 1e-5f;

enum { I_X = 0, I_MEM, I_GMIX, I_WIN, I_BQKV, I_CONVW, I_CONVB, I_DTB, I_ALOG, I_DSKIP, I_GSSM, I_SINK, I_RELB, I_WOUT, I_BOUT,
       I_GCROSS, I_GMEM, I_WQ, I_WKV, I_WO, I_GFFN, I_WR, I_BR, I_W1, I_B1, I_W2, I_B2, I_GFIN, N_IN };

constexpr size_t MiB = 1u << 20;
constexpr size_t WS_CTL = 0;
constexpr size_t WS_XN = 1 * MiB;
constexpr size_t WS_BIG = WS_XN + 34 * MiB;
constexpr size_t WS_XBC = WS_BIG + 144 * MiB;
constexpr size_t WS_MIXB = WS_XBC + 64 * MiB;
constexpr size_t WS_H1 = WS_MIXB + 32 * MiB;
constexpr size_t WS_H2 = WS_H1 + 64 * MiB;
constexpr size_t WS_YSSM = WS_H2 + 64 * MiB;
constexpr size_t WS_QCB = WS_YSSM + 32 * MiB;
constexpr size_t WS_OCB = WS_QCB + 16 * MiB;
constexpr size_t WS_ACTB = WS_OCB + 16 * MiB;
constexpr size_t WS_W1T = WS_ACTB + 144 * MiB;
constexpr size_t WS_W2T = WS_W1T + 128 * MiB;
constexpr size_t WS_WINT = WS_W2T + 64 * MiB;
constexpr size_t WS_WOUTT = WS_WINT + 5 * MiB;
constexpr size_t WS_WQT = WS_WOUTT + 2 * MiB;
constexpr size_t WS_WKVT = WS_WQT + 1 * MiB;
constexpr size_t WS_WOT = WS_WKVT + 2 * MiB;
constexpr size_t WS_SMALL = WS_WOT + 1 * MiB;
constexpr size_t WS_DT = WS_SMALL;
constexpr size_t WS_DTRAW = WS_DT + 512 * 1024;
constexpr size_t WS_KVMB = WS_DTRAW + 512 * 1024;
constexpr size_t WS_GATE = WS_KVMB + 1 * MiB;
constexpr size_t WS_SLOT = WS_GATE + 512 * 1024;
constexpr size_t WS_BIASP = WS_SLOT + 256 * 1024;
constexpr size_t WS_LIST = WS_GATE + 1 * MiB;
constexpr size_t WS_RSA = WS_LIST + 2 * MiB;
constexpr size_t WS_CNTB = WS_RSA + 2 * MiB;
constexpr size_t WS_RSROW = WS_CNTB + 64 * 1024;
constexpr size_t WS_SSQ1 = WS_RSROW + 64 * 1024;
constexpr size_t WS_ACS = WS_SSQ1 + 2 * MiB;
constexpr size_t WS_CD = WS_ACS + 512 * 1024;
constexpr size_t WS_END = WS_CD + 64 * 1024;
constexpr size_t WS_XC = WS_XBC;
constexpr size_t WS_ST = WS_YSSM;
constexpr size_t WS_HIN = WS_H2;
constexpr size_t WS_YB = WS_BIG;
constexpr int NROWS_MAX = NASSIGN + NEXP * 256;
constexpr int PJ = 2304, PJ_Z = 0, PJ_XBC = 512, PJ_Q = 1536, PJ_K = 2048, PJ_V = 2176;
constexpr int W1_P1_ITEMS = 14720;
constexpr int W2_P7_ITEMS = 5120;
constexpr int LDS_MISC = 146432;
constexpr int CW_CNT = 64;
#ifndef REP_MASK
#define REP_MASK 0
#endif
#ifndef RUNTIME_REP
#define RUNTIME_REP 1
#endif
#if RUNTIME_REP
#define PH_BEGIN(i) for (int rep_ = 0; rep_ <= ((p.rep_mask >> (i)) & 1); ++rep_) {
#else
#define PH_BEGIN(i) { constexpr int rep_ = 0; (void)rep_;
#endif
#define PH_END() }

struct Params { const float* in[N_IN]; float* out; unsigned char* ws; int rep_mask; int pad; };

DEVI float bperm(float v, int srclane) { return __int_as_float(__builtin_amdgcn_ds_bpermute(srclane << 2, __float_as_int(v))); }
DEVI int bperm_i(int v, int srclane) { return __builtin_amdgcn_ds_bpermute(srclane << 2, v); }
DEVI float xshfl(float v, int mask, int lane) { return bperm(v, lane ^ mask); }
DEVI float wave_sum(float v, int lane) {
#pragma unroll
    for (int o = 32; o > 0; o >>= 1) v += xshfl(v, o, lane);
    return v;
}
DEVI float wave_max(float v, int lane) {
#pragma unroll
    for (int o = 32; o > 0; o >>= 1) v = fmaxf(v, xshfl(v, o, lane));
    return v;
}
DEVI float silu_f(float x) { return x * __builtin_amdgcn_rcpf(1.f + __expf(-x)); }
DEVI float softplus_f(float x) { return fmaxf(x, 0.f) + log1pf(__expf(-fabsf(x))); }
DEVI float4 ld4(const float* p) { return *(const float4*)p; }
DEVI void st4(float* p, float4 v) { *(float4*)p = v; }


struct TI { int tid, lane, wave, gw, gtid; };
DEVI TI fresh_ti(int wave_id) { int l; asm volatile("v_mbcnt_lo_u32_b32 %0, -1, 0\n\tv_mbcnt_hi_u32_b32 %0, -1, %0" : "=v"(l)); TI r; r.lane = l; r.wave = wave_id; r.tid = wave_id * 64 + l; r.gw = blockIdx.x * 8 + wave_id; r.gtid = blockIdx.x * 512 + r.tid; return r; }
#define PHASE_IDS() const TI ti_ = fresh_ti(wave_id); const int tid = ti_.tid, lane = ti_.lane, wave = ti_.wave, gw = ti_.gw, gtid = ti_.gtid; (void)tid; (void)lane; (void)wave; (void)gw; (void)gtid
DEVI float bf2f(unsigned short v) { return __uint_as_float((unsigned)v << 16); }

#define XB_TMO      128
#define XB_XCNT(j)  (256  + 64 * (j))
#define XB_XSUB(j)  (1280 + 64 * (j))
#define XB_XGEN(j)  (2304 + 64 * (j))
#define XB_TOP      3328
#define XB_TOPGEN   3392
#define XCD_BAR_WORDS 3456
#define XB_SPIN_CAP (1u << 18)
DEVI unsigned xb_ld(unsigned* p)              { return __hip_atomic_load(p, __ATOMIC_RELAXED, __HIP_MEMORY_SCOPE_AGENT); }
DEVI unsigned xb_add(unsigned* p, unsigned v) { return __hip_atomic_fetch_add(p, v, __ATOMIC_RELAXED, __HIP_MEMORY_SCOPE_AGENT); }
DEVI unsigned xb_xcc_id() { return (unsigned)__builtin_amdgcn_s_getreg((3 << 11) | 20) & 0xFu; }
#define XB_SPIN(cond, bar) do { unsigned _sp = 0; while (cond) { __builtin_amdgcn_s_sleep(1); \
    if ((++_sp & 255u) == 0u) { if (xb_ld(&(bar)[XB_TMO])) break; if (_sp > XB_SPIN_CAP) { atomicAdd(&(bar)[XB_TMO], 1u); break; } } } } while (0)
struct XcdBarrier { unsigned* bar; unsigned x; volatile __attribute__((address_space(3))) unsigned* st; };
DEVI XcdBarrier xcd_barrier_post(unsigned* bar, volatile __attribute__((address_space(3))) unsigned* st, bool leader) {
    XcdBarrier b; b.bar = bar; b.x = xb_xcc_id(); b.st = st;
    if (leader) (void)xb_add(&bar[XB_XCNT(b.x)], 1u);
    return b;
}
DEVI void xcd_barrier_complete(unsigned* bar, unsigned x, unsigned& nloc, unsigned& nx) {
    const unsigned G = gridDim.x * gridDim.y * gridDim.z;
    unsigned sum, cnt, mine, sp = 0u;
    for (;;) {
        sum = 0u; cnt = 0u; mine = 0u;
#pragma unroll
        for (unsigned j = 0; j < 16; ++j) { const unsigned c = xb_ld(&bar[XB_XCNT(j)]); sum += c; cnt += (c > 0u) ? 1u : 0u; mine = (j == x) ? c : mine; }
        if (sum == G) break;
        __builtin_amdgcn_s_sleep(1);
        if ((++sp & 255u) == 0u) { if (xb_ld(&bar[XB_TMO])) break; if (sp > XB_SPIN_CAP) { atomicAdd(&bar[XB_TMO], 1u); break; } }
    }
    nloc = mine > 0u ? mine : 1u; nx = cnt > 0u ? cnt : 1u;
}
DEVI void xcd_barrier(const XcdBarrier& b, bool leader) {
    asm volatile("s_waitcnt vmcnt(0)" ::: "memory");
    __syncthreads();
    if (leader) {
        unsigned* bar = b.bar;
        __builtin_amdgcn_s_waitcnt(0);
        unsigned nloc = b.st[0], nx = b.st[1];
        if (nloc == 0u) { xcd_barrier_complete(bar, b.x, nloc, nx); b.st[0] = nloc; b.st[1] = nx; }
        const unsigned old = xb_add(&bar[XB_XSUB(b.x)], 1u);
        const unsigned gen = old / nloc;
        if (old + 1u == (gen + 1u) * nloc) {
            __builtin_amdgcn_fence(__ATOMIC_RELEASE, "agent");
            asm volatile("s_waitcnt vmcnt(0)" ::: "memory");
            const unsigned og = xb_add(&bar[XB_TOP], 1u);
            const unsigned tg = og / nx;
            if (og + 1u == (tg + 1u) * nx) xb_add(&bar[XB_TOPGEN], 1u);
            else XB_SPIN(xb_ld(&bar[XB_TOPGEN]) == tg, bar);
            __builtin_amdgcn_fence(__ATOMIC_ACQUIRE, "agent");
            xb_add(&bar[XB_XGEN(b.x)], 1u);
            asm volatile("s_waitcnt vmcnt(0)" ::: "memory");
        } else {
            XB_SPIN(xb_ld(&bar[XB_XGEN(b.x)]) == gen, bar);
            __builtin_amdgcn_fence(__ATOMIC_ACQUIRE, "agent");
            asm volatile("s_waitcnt vmcnt(0)" ::: "memory");
        }
    }
    __syncthreads();
}

namespace g8 {
#define G8_LAS __attribute__((address_space(3)))
typedef unsigned short bf16_t;
typedef short bf16x8 __attribute__((ext_vector_type(8)));
typedef float f32x4 __attribute__((ext_vector_type(4)));
typedef float f32x2 __attribute__((ext_vector_type(2)));
typedef unsigned u32x4 __attribute__((ext_vector_type(4)));
typedef unsigned u32x2 __attribute__((ext_vector_type(2)));
constexpr int BM = 256, BK = 64, HALF = 128, HTB = HALF * BK * 2, STAGE_BYTES = 8 * HTB;

DEVI int lds_byte(int r, int c) { const int st = (r >> 4) * 2 + (c >> 5), rr = r & 15, cc = c & 31, ob = rr * 64 + cc * 2; return st * 1024 + (ob ^ (((ob >> 9) & 1) << 5)); }
DEVI void stage_rc(int b, int& R, int& C) { const int st = b / 1024, sb = b % 1024, swz = sb ^ (((sb >> 9) & 1) << 5); R = (st >> 1) * 16 + swz / 64; C = (st & 1) * 32 + (swz % 64) / 2; }
DEVI int perm32(int rho) { const int n = rho >> 4, i = rho & 15; return 8 * (i >> 2) + 4 * n + (i & 3); }
typedef int v8i __attribute__((ext_vector_type(8)));
typedef int v4i __attribute__((ext_vector_type(4)));
DEVI v8i cat8(bf16x8 lo, bf16x8 hi) { const v4i a = __builtin_bit_cast(v4i, lo), b = __builtin_bit_cast(v4i, hi); return (v8i){a[0], a[1], a[2], a[3], b[0], b[1], b[2], b[3]}; }
DEVI unsigned pk4_fp8(float a, float b, float c, float d) { int w = 0; w = __builtin_amdgcn_cvt_pk_fp8_f32(a, b, w, false); w = __builtin_amdgcn_cvt_pk_fp8_f32(c, d, w, true); return (unsigned)w; }
typedef __bf16 bf16x2v __attribute__((ext_vector_type(2)));
DEVI unsigned cvt_pk_bf16(float lo, float hi) { const f32x2 v = {lo, hi}; const bf16x2v b = __builtin_convertvector(v, bf16x2v); return __builtin_bit_cast(unsigned, b); }

struct Unit {
    const int* alist;
    int acnt;
    int aoff;
    int arow0;
    unsigned boff;
    int orow0, ocol0;
    int e;
};


struct EpiSwiglu {
    static constexpr bool PERM = true;
    unsigned char* O; const float* bias; const float* rsa;
    DEVI void operator()(const f32x4 (&acc)[2][2][4][2], const Unit& u, int wr, int wc, int fr_, int fq_) const {
        int fr = fr_, fq = fq_; asm volatile("" : "+v"(fr), "+v"(fq));
        const int row0 = u.orow0 + wr * 64 + fr, col0 = u.ocol0 + wc * 32 + 8 * fq;
        const float* bp = bias + (size_t)u.e * 2048 + col0;
        f32x4 bv[2][2];
#pragma unroll
        for (int bj = 0; bj < 2; ++bj)
#pragma unroll
            for (int n = 0; n < 2; ++n) bv[bj][n] = *(const f32x4*)(bp + bj * HALF + 4 * n);
        float rsv[2][4];
#pragma unroll
        for (int ai = 0; ai < 2; ++ai)
#pragma unroll
            for (int m = 0; m < 4; ++m) { const int lr = wr * 64 + fr + ai * HALF + m * 16; rsv[ai][m] = rsa[u.aoff + min(lr, u.acnt - 1)]; }
        asm volatile("" : "+v"(rsv[0][0]), "+v"(rsv[0][1]), "+v"(rsv[0][2]), "+v"(rsv[0][3]), "+v"(rsv[1][0]), "+v"(rsv[1][1]), "+v"(rsv[1][2]), "+v"(rsv[1][3]));
#pragma unroll
        for (int ai = 0; ai < 2; ++ai)
#pragma unroll
            for (int m = 0; m < 4; ++m) { const int lr = wr * 64 + fr + ai * HALF + m * 16;
                const float rs = (lr < u.acnt) ? rsv[ai][m] * 0.03125f : 0.f;
                unsigned char* rowp = O + (size_t)(row0 + ai * HALF + m * 16) * 1024 + (col0 >> 1);
                float xg[8], xl[8], t[8];
#pragma unroll
                for (int bj = 0; bj < 2; ++bj)
#pragma unroll
                    for (int n = 0; n < 2; ++n) { const f32x4 v = acc[ai][bj][m][n] * rs + bv[bj][n]; const int q = bj * 4 + n * 2;
                        xg[q] = fminf(v[0], 7.f); xl[q] = fminf(fmaxf(v[1], -7.f), 7.f) + 1.f; xg[q + 1] = fminf(v[2], 7.f); xl[q + 1] = fminf(fmaxf(v[3], -7.f), 7.f) + 1.f; }
#pragma unroll
                for (int q = 0; q < 8; ++q) t[q] = __builtin_amdgcn_exp2f(xg[q] * -2.4554669595930157f);
#pragma unroll
                for (int q = 0; q < 8; ++q) t[q] = __builtin_amdgcn_rcpf(1.f + t[q]);
#pragma unroll
                for (int q = 0; q < 8; ++q) t[q] = (4.f * xg[q]) * t[q] * xl[q];
                *(unsigned*)(rowp) = pk4_fp8(t[0], t[1], t[2], t[3]);
                *(unsigned*)(rowp + HALF / 2) = pk4_fp8(t[4], t[5], t[6], t[7]); }
    }
};
struct EpiBf16 {
    static constexpr bool PERM = true;
    bf16_t* O; int ldc; const float* bias; int bias_stride; float scale;
    DEVI void operator()(const f32x4 (&acc)[2][2][4][2], const Unit& u, int wr, int wc, int fr_, int fq_) const {
        int fr = fr_, fq = fq_; asm volatile("" : "+v"(fr), "+v"(fq));
        const int row0 = u.orow0 + wr * 64 + fr, col0 = u.ocol0 + wc * 32 + 8 * fq;
        f32x4 bv[2][2];
#pragma unroll
        for (int bj = 0; bj < 2; ++bj)
#pragma unroll
            for (int n = 0; n < 2; ++n) bv[bj][n] = bias ? *(const f32x4*)(bias + (size_t)u.e * bias_stride + col0 + bj * HALF + 4 * n) : (f32x4){0.f, 0.f, 0.f, 0.f};
#pragma unroll
        for (int ai = 0; ai < 2; ++ai)
#pragma unroll
            for (int m = 0; m < 4; ++m) { bf16_t* rowp = O + (size_t)(row0 + ai * HALF + m * 16) * ldc + col0;
#pragma unroll
                for (int bj = 0; bj < 2; ++bj) { const f32x4 v0 = acc[ai][bj][m][0] * scale + bv[bj][0], v1 = acc[ai][bj][m][1] * scale + bv[bj][1];
                    u32x4 w; w.x = cvt_pk_bf16(v0[0], v0[1]); w.y = cvt_pk_bf16(v0[2], v0[3]); w.z = cvt_pk_bf16(v1[0], v1[1]); w.w = cvt_pk_bf16(v1[2], v1[3]);
                    *(u32x4*)(rowp + bj * HALF) = w; } }
    }
};

struct EpiBf16Dual {
    static constexpr bool PERM = true;
    bf16_t* O0; int ldc0; const float* bias0; bf16_t* O1; int ldc1;
    DEVI void operator()(const f32x4 (&acc)[2][2][4][2], const Unit& u, int wr, int wc, int fr_, int fq_) const {
        int fr = fr_, fq = fq_; asm volatile("" : "+v"(fr), "+v"(fq));
        const int row0 = u.orow0 + wr * 64 + fr, col0 = u.ocol0 + wc * 32 + 8 * fq;
        bf16_t* O = u.e ? O1 : O0; const int ldc = u.e ? ldc1 : ldc0; const float* bias = u.e ? nullptr : bias0;
        f32x4 bv[2][2];
#pragma unroll
        for (int bj = 0; bj < 2; ++bj)
#pragma unroll
            for (int n = 0; n < 2; ++n) bv[bj][n] = bias ? *(const f32x4*)(bias + col0 + bj * HALF + 4 * n) : (f32x4){0.f, 0.f, 0.f, 0.f};
#pragma unroll
        for (int ai = 0; ai < 2; ++ai)
#pragma unroll
            for (int m = 0; m < 4; ++m) { bf16_t* rowp = O + (size_t)(row0 + ai * HALF + m * 16) * ldc + col0;
#pragma unroll
                for (int bj = 0; bj < 2; ++bj) { const f32x4 v0 = acc[ai][bj][m][0] + bv[bj][0], v1 = acc[ai][bj][m][1] + bv[bj][1];
                    u32x4 w; w.x = cvt_pk_bf16(v0[0], v0[1]); w.y = cvt_pk_bf16(v0[2], v0[3]); w.z = cvt_pk_bf16(v1[0], v1[1]); w.w = cvt_pk_bf16(v1[2], v1[3]);
                    *(u32x4*)(rowp + bj * HALF) = w; } }
    }
};

struct EpiH1 {
    static constexpr bool PERM = false;
    const float* bias; const float* res; bf16_t* HB; float* SSQ;
    DEVI void operator()(const f32x4 (&acc)[2][2][4][2], const Unit& u, int wr, int wc, int fr_, int fq_) const {
        int fr = fr_, fq = fq_; asm volatile("" : "+v"(fr), "+v"(fq));
        const int row0 = u.orow0 + wr * 64 + fr, col0 = u.ocol0 + wc * 32 + 4 * fq;
        f32x4 bv[2][2];
#pragma unroll
        for (int bj = 0; bj < 2; ++bj)
#pragma unroll
            for (int n = 0; n < 2; ++n) bv[bj][n] = *(const f32x4*)(bias + col0 + bj * HALF + n * 16);
#pragma unroll
        for (int ai = 0; ai < 2; ++ai)
#pragma unroll
            for (int m = 0; m < 4; ++m) { const int row = row0 + ai * HALF + m * 16; const size_t off = (size_t)row * 1024 + col0;
#pragma unroll
                for (int bj = 0; bj < 2; ++bj) { float sq = 0.f;
#pragma unroll
                    for (int n = 0; n < 2; ++n) { const f32x4 h = acc[ai][bj][m][n] + bv[bj][n] + *(const f32x4*)(res + off + bj * HALF + n * 16);
                        sq += h[0] * h[0] + h[1] * h[1] + h[2] * h[2] + h[3] * h[3];
                        u32x2 w; w.x = cvt_pk_bf16(h[0], h[1]); w.y = cvt_pk_bf16(h[2], h[3]);
                        *(u32x2*)(HB + off + bj * HALF + n * 16) = w; }
                    sq += xshfl(sq, 16, fq * 16 + fr); sq += xshfl(sq, 32, fq * 16 + fr);
                    if (fq == 0) SSQ[(size_t)row * 32 + (u.ocol0 >> 8) * 8 + wc * 2 + bj] = sq; }
                if (m & 1) asm volatile("" ::: "memory"); }
    }
};
struct EpiH2 {
    static constexpr bool PERM = false;
    const bf16_t* res; bf16_t* HB; unsigned char* X8;
    DEVI void operator()(const f32x4 (&acc)[2][2][4][2], const Unit& u, int wr, int wc, int fr_, int fq_) const {
        int fr = fr_, fq = fq_; asm volatile("" : "+v"(fr), "+v"(fq));
        const int row0 = u.orow0 + wr * 64 + fr, col0 = u.ocol0 + wc * 32 + 4 * fq;
#pragma unroll
        for (int ai = 0; ai < 2; ++ai)
#pragma unroll
            for (int m = 0; m < 4; ++m) { const size_t off = (size_t)(row0 + ai * HALF + m * 16) * 1024 + col0;
#pragma unroll
                for (int bj = 0; bj < 2; ++bj)
#pragma unroll
                    for (int n = 0; n < 2; ++n) { const u32x2 r = *(const u32x2*)(res + off + bj * HALF + n * 16);
                        f32x4 h = acc[ai][bj][m][n];
                        h[0] += __uint_as_float(r.x << 16); h[1] += __uint_as_float(r.x & 0xffff0000u); h[2] += __uint_as_float(r.y << 16); h[3] += __uint_as_float(r.y & 0xffff0000u);
                        u32x2 w; w.x = cvt_pk_bf16(h[0], h[1]); w.y = cvt_pk_bf16(h[2], h[3]);
                        *(u32x2*)(HB + off + bj * HALF + n * 16) = w;
                        *(unsigned*)(X8 + off + bj * HALF + n * 16) = pk4_fp8(h[0], h[1], h[2], h[3]); }
                if (m & 1) asm volatile("" ::: "memory"); }
    }
};

template <class Epi, class Sched, bool FP8 = false>
DEVI void gemm_phase(G8_LAS unsigned char* lds, const void* A, const void* Bbase, int RP  , int ashift, const Sched& S, const Epi& E, int tid_) {
    int tid = tid_; asm volatile("" : "+v"(tid));
    const int wid = __builtin_amdgcn_readfirstlane(tid >> 6), lane = tid & 63, wr = wid >> 2, wc = wid & 3, fr = lane & 15, fq = lane >> 4;
    const int nt = RP / 128;
    unsigned voffB[2];
#pragma unroll
    for (int i = 0; i < 2; ++i) { int Rl, Cl; stage_rc(tid * 16 + i * 8192, Rl, Cl); const int Rb = Epi::PERM ? ((Rl & ~31) + perm32(Rl & 31)) : Rl;
        voffB[i] = (unsigned)(Rb * RP + Cl * 2); }
    const unsigned kstep = 128u;
    const unsigned hstep = (unsigned)(HALF * RP);
    const __amdgpu_buffer_rsrc_t rsA = __builtin_amdgcn_make_buffer_rsrc(const_cast<void*>(A), 0, 0x7fffffff, 0x00020000), rsB = __builtin_amdgcn_make_buffer_rsrc(const_cast<void*>(Bbase), 0, 0x7fffffff, 0x00020000);
    const unsigned ldsw = (unsigned)wid * 1024u;
    const int aoff = lds_byte(wr * 64 + fr, fq * 8), boff = lds_byte(wc * 32 + fr, fq * 8);
#define G8_AOFF(dst, u) do { int _t = tid; asm volatile("" : "+v"(_t)); int _R[2], _C[2]; _Pragma("unroll") for (int _i = 0; _i < 2; ++_i) stage_rc(_t * 16 + _i * 8192, _R[_i], _C[_i]); \
        if ((u).alist) { int _v[2][2];     \
            _Pragma("unroll") for (int _h = 0; _h < 2; ++_h) _Pragma("unroll") for (int _i = 0; _i < 2; ++_i) _v[_h][_i] = (u).alist[min(_h * HALF + _R[_i], (u).acnt - 1)]; \
            asm volatile("" : "+v"(_v[0][0]), "+v"(_v[0][1]), "+v"(_v[1][0]), "+v"(_v[1][1])); \
            _Pragma("unroll") for (int _h = 0; _h < 2; ++_h) _Pragma("unroll") for (int _i = 0; _i < 2; ++_i) dst[_h][_i] = (unsigned)((_v[_h][_i] >> ashift) * RP + _C[_i] * 2); } \
        else { _Pragma("unroll") for (int _h = 0; _h < 2; ++_h) _Pragma("unroll") for (int _i = 0; _i < 2; ++_i) dst[_h][_i] = (unsigned)(((u).arow0 + _h * HALF + _R[_i]) * RP + _C[_i] * 2); } } while (0)
#define G8_SA(b, h) (((b) * 2 + (h)) * HTB)
#define G8_SB(b, h) ((4 + (b) * 2 + (h)) * HTB)
#define G8_STAGE(bufoff, rsrc, soff, voff) do { _Pragma("unroll") for (int _i = 0; _i < 2; ++_i) \
        __builtin_amdgcn_raw_ptr_buffer_load_lds(rsrc, (G8_LAS unsigned*)(lds + (bufoff) + ldsw + _i * 8192), 16, (voff)[_i], (soff), 0, 0); } while (0)
#define G8_LDA(dst, b, h) do { if constexpr (FP8) { _Pragma("unroll") for (int m = 0; m < 4; ++m) { const v4i _lo = *(const G8_LAS v4i*)(lds + G8_SA(b, h) + aoff + m * 2048), _hi = *(const G8_LAS v4i*)(lds + G8_SA(b, h) + aoff + m * 2048 + 1024); dst##8[m] = __builtin_shufflevector(_lo, _hi, 0, 1, 2, 3, 4, 5, 6, 7); } } \
        else { _Pragma("unroll") for (int m = 0; m < 4; ++m) _Pragma("unroll") for (int k = 0; k < 2; ++k) dst[m][k] = *(const G8_LAS bf16x8*)(lds + G8_SA(b, h) + aoff + m * 2048 + k * 1024); } } while (0)
#define G8_LDB(dst, b, h) do { if constexpr (FP8) { _Pragma("unroll") for (int n = 0; n < 2; ++n) { const v4i _lo = *(const G8_LAS v4i*)(lds + G8_SB(b, h) + boff + n * 2048), _hi = *(const G8_LAS v4i*)(lds + G8_SB(b, h) + boff + n * 2048 + 1024); dst##8[n] = __builtin_shufflevector(_lo, _hi, 0, 1, 2, 3, 4, 5, 6, 7); } } \
        else { _Pragma("unroll") for (int n = 0; n < 2; ++n) _Pragma("unroll") for (int k = 0; k < 2; ++k) dst[n][k] = *(const G8_LAS bf16x8*)(lds + G8_SB(b, h) + boff + n * 2048 + k * 1024); } } while (0)
#define G8_MMA(ai, bj, At, Bt) do { __builtin_amdgcn_s_setprio(1); _Pragma("unroll") for (int m = 0; m < 4; ++m) _Pragma("unroll") for (int n = 0; n < 2; ++n) { \
        if constexpr (FP8) asm volatile("v_mfma_f32_16x16x128_f8f6f4 %0, %1, %2, %0" : "+v"(acc[ai][bj][m][n]) : "v"(Bt##8[n]), "v"(At##8[m])); \
        else { _Pragma("unroll") for (int k = 0; k < 2; ++k) asm volatile("v_mfma_f32_16x16x32_bf16 %0, %1, %2, %0" : "+v"(acc[ai][bj][m][n]) : "v"(Bt[n][k]), "v"(At[FP8 ? 0 : m][k])); } } __builtin_amdgcn_s_setprio(0); } while (0)
#define G8_WAIT_V(n) asm volatile("s_waitcnt vmcnt(" #n ")" ::: "memory")
#define G8_WAIT_L(n) asm volatile("s_waitcnt lgkmcnt(" #n ")" ::: "memory")
#define G8_BAR __builtin_amdgcn_s_barrier()
#define G8_SCHED __builtin_amdgcn_sched_barrier(0)
    Unit cur, nxt, nn; int ui = 0;
    if (!S.next(0, cur)) return;
    f32x4 acc[2][2][4][2];
#pragma unroll
    for (int a = 0; a < 2; ++a)
#pragma unroll
        for (int b = 0; b < 2; ++b)
#pragma unroll
            for (int m = 0; m < 4; ++m)
#pragma unroll
                for (int n = 0; n < 2; ++n) acc[a][b][m][n] = (f32x4){0.f, 0.f, 0.f, 0.f};
    bf16x8 At[FP8 ? 1 : 4][2], B0[2][2], B1[2][2];
    v8i At8[FP8 ? 4 : 1], B08[2], B18[2];
    unsigned cv[2][2], nv[2][2], fv[2][2];
    G8_AOFF(cv, cur);
    bool has_next = S.next(1, nxt);
    if (has_next) { G8_AOFF(nv, nxt); } else {
#pragma unroll
        for (int h = 0; h < 2; ++h)
#pragma unroll
            for (int i = 0; i < 2; ++i) nv[h][i] = cv[h][i]; }
    unsigned cB = cur.boff, nB = has_next ? nxt.boff : cB;
    G8_STAGE(G8_SB(0, 0), rsB, cB, voffB); G8_STAGE(G8_SB(0, 1), rsB, cB + hstep, voffB); G8_STAGE(G8_SA(0, 0), rsA, 0u, cv[0]); G8_STAGE(G8_SA(0, 1), rsA, 0u, cv[1]);
    if (wr == 1) G8_BAR;
    G8_WAIT_V(2); G8_BAR;
    G8_STAGE(G8_SB(1, 0), rsB, cB + kstep, voffB); G8_STAGE(G8_SA(1, 0), rsA, kstep, cv[0]); G8_STAGE(G8_SB(1, 1), rsB, cB + hstep + kstep, voffB);
    G8_WAIT_V(6); G8_BAR;
    for (;;) {
#pragma unroll 1
        for (int t = 0; t < nt; t += 2) {
            const bool last = (t == nt - 2);
            const unsigned k1 = (unsigned)(t + 1) * kstep;
            const unsigned k2 = last ? 0u : (unsigned)(t + 2) * kstep;
            const unsigned b2 = last ? nB : cB + (unsigned)(t + 2) * kstep, b3 = b2 + kstep;
            G8_LDB(B0, 0, 0); G8_LDB(B1, 0, 1); G8_SCHED; G8_LDA(At, 0, 0); G8_STAGE(G8_SA(1, 1), rsA, k1, cv[1]);
            G8_WAIT_V(8); G8_WAIT_L(0); G8_BAR; G8_MMA(0, 0, At, B0); G8_MMA(0, 1, At, B1); G8_BAR; G8_SCHED;
            G8_LDA(At, 0, 1); G8_STAGE(G8_SB(0, 0), rsB, b2, voffB); G8_STAGE(G8_SB(0, 1), rsB, b2 + hstep, voffB); { const unsigned sv_[2] = {last ? nv[0][0] : cv[0][0], last ? nv[0][1] : cv[0][1]}; G8_STAGE(G8_SA(0, 0), rsA, k2, sv_); }
            G8_WAIT_V(8); G8_WAIT_L(0); G8_BAR; G8_MMA(1, 0, At, B0); G8_MMA(1, 1, At, B1); G8_BAR; G8_SCHED;
            G8_LDB(B0, 1, 0); G8_LDB(B1, 1, 1); G8_SCHED; G8_LDA(At, 1, 0); { const unsigned sv_[2] = {last ? nv[1][0] : cv[1][0], last ? nv[1][1] : cv[1][1]}; G8_STAGE(G8_SA(0, 1), rsA, k2, sv_); }
            G8_WAIT_V(8); G8_WAIT_L(0); G8_BAR; G8_MMA(0, 0, At, B0); G8_MMA(0, 1, At, B1); G8_BAR; G8_SCHED;
            G8_LDA(At, 1, 1); G8_STAGE(G8_SB(1, 0), rsB, b3, voffB); G8_STAGE(G8_SB(1, 1), rsB, b3 + hstep, voffB); { const unsigned sv_[2] = {last ? nv[0][0] : cv[0][0], last ? nv[0][1] : cv[0][1]}; G8_STAGE(G8_SA(1, 0), rsA, k2 + kstep, sv_); }
            G8_WAIT_V(8); G8_WAIT_L(0); G8_BAR; G8_MMA(1, 0, At, B0); G8_MMA(1, 1, At, B1); G8_BAR; G8_SCHED;
        }
        asm volatile("s_nop 15\n\ts_nop 7" ::: "memory");
        if (wr == 0) G8_BAR;
        const bool has_nn = has_next && S.next(ui + 2, nn);
        if (has_nn) { G8_AOFF(fv, nn); }
        E(acc, cur, wr, wc, fr, fq);
        if (!has_next) break;
#pragma unroll
        for (int a = 0; a < 2; ++a)
#pragma unroll
            for (int b = 0; b < 2; ++b)
#pragma unroll
                for (int m = 0; m < 4; ++m)
#pragma unroll
                    for (int n = 0; n < 2; ++n) acc[a][b][m][n] = (f32x4){0.f, 0.f, 0.f, 0.f};
        cur = nxt; cB = nB; ++ui;
#pragma unroll
        for (int h = 0; h < 2; ++h)
#pragma unroll
            for (int i = 0; i < 2; ++i) { cv[h][i] = nv[h][i]; nv[h][i] = has_nn ? fv[h][i] : nv[h][i]; }
        has_next = has_nn; if (has_nn) { nxt = nn; nB = nn.boff; }
        if (wr == 1) G8_BAR;
    }
    G8_WAIT_V(0);
    G8_BAR;
#undef G8_AOFF
#undef G8_SA
#undef G8_SB
#undef G8_STAGE
#undef G8_LDA
#undef G8_LDB
#undef G8_MMA
#undef G8_WAIT_V
#undef G8_WAIT_L
#undef G8_BAR
#undef G8_SCHED
}

struct MoeSched {
    int nct, RP;
    const G8_LAS int* ut; const G8_LAS int* tp; const G8_LAS int* cnt;
    const int* list;
    const char* Bt; unsigned bt_estride;
    DEVI bool next(int i, Unit& u) const {
        if (i >= 32) return false;
        const int v = __builtin_amdgcn_readfirstlane(ut[i]);
        if (v < 0) return false;
        const int e = v & 255, rtg = (v >> 8) & 0xffff, ct = v >> 24;
        const int rt = rtg - __builtin_amdgcn_readfirstlane(tp[e]);
        u.e = e; u.orow0 = rtg * 256; u.ocol0 = ct * 256;
        u.boff = (unsigned)e * bt_estride + (unsigned)(ct * 256 * RP);
        if (list) { u.aoff = e * NTOK + rt * 256; u.alist = list + u.aoff; u.acnt = min(256, __builtin_amdgcn_readfirstlane(cnt[e]) - rt * 256); u.arow0 = 0; }
        else { u.alist = nullptr; u.acnt = 0; u.aoff = 0; u.arow0 = rtg * 256; }
        return true;
    }
};
DEVI void moe_units(G8_LAS int* ut, const G8_LAS int* tp, int nct, int G, int vcu, int tid) {
    if (tid < 32) {
        const int L = tid * G + vcu, total = tp[32] * nct; int v = -1;
        if (L < total) { const int rtg = L / nct, ct = L - rtg * nct; int e = 0;
            for (int k = 1; k < 32; ++k) e += (rtg >= tp[k]) ? 1 : 0;
            v = e | (rtg << 8) | (ct << 24); }
        ut[tid] = v;
    }
}
struct DenseSched {
    int G, c, RP, nM0, nN0; const char* Bt0; int nM1, nN1, arow1; const char* Bt1;
    DEVI bool next(int i, Unit& u) const {
        const int nwg = nM0 * nN0, L = i * G + c;
        u.alist = nullptr; u.acnt = 0; u.aoff = 0;
        if (L < nwg) {
            int wgid = L; { const int q = nwg / 8, r = nwg % 8, xcd = wgid % 8, off = wgid / 8; wgid = (xcd < r ? xcd * (q + 1) : r * (q + 1) + (xcd - r) * q) + off; }
            const int nig = 8 * nN0, gid = wgid / nig, fm = gid * 8, gsz = (nM0 - fm) < 8 ? (nM0 - fm) : 8;
            const int pm = fm + ((wgid % nig) % gsz), pn = (wgid % nig) / gsz;
            u.e = 0; u.arow0 = pm * 256; u.orow0 = pm * 256; u.ocol0 = pn * 256; u.boff = (unsigned)(pn * 256 * RP); return true;
        }
        const int l = L - nwg; if (l >= nM1 * nN1) return false;
        const int pm = l / nN1, pn = l - pm * nN1;
        u.e = 1; u.arow0 = arow1 + pm * 256; u.orow0 = pm * 256; u.ocol0 = pn * 256; u.boff = (unsigned)(Bt1 - Bt0) + (unsigned)(pn * 256 * RP); return true;
    }
};
}

DEVI unsigned f2bf(float f) { unsigned u = __builtin_bit_cast(unsigned, f); return (u + 0x7fffu + ((u >> 16) & 1u)) >> 16; }
DEVI unsigned pk2(float lo, float hi) { return f2bf(lo) | (f2bf(hi) << 16); }
typedef unsigned v4u __attribute__((ext_vector_type(4)));
DEVI void t8_load(const float* W, int N, int item, int ipe  , int lane, float4 (&v)[16]) {
    const int e = item / ipe, q = item - e * ipe, nblk = N / 64, kb = q / nblk, nb = q - kb * nblk;
    const float* src = W + (size_t)e * 1024 * N + (size_t)(64 * kb + (lane >> 4)) * N + 64 * nb + 4 * (lane & 15);
#pragma unroll
    for (int i = 0; i < 16; ++i) v[i] = *(const float4*)(src + (size_t)(4 * i) * N);
}
DEVI void t8_lds_write(const float4 (&v)[16], __attribute__((address_space(3))) float* scr, int lane) {
    const int kr = lane >> 4, c4 = lane & 15;
#pragma unroll
    for (int i = 0; i < 16; ++i) { __attribute__((address_space(3))) float* d = scr + (4 * i + kr) * 65 + 4 * c4; d[0] = v[i].x; d[1] = v[i].y; d[2] = v[i].z; d[3] = v[i].w; }
    asm volatile("s_waitcnt lgkmcnt(0)" ::: "memory");
}
DEVI void t8_pack_store(unsigned char* WT, int N, int item, int ipe, int lane, const __attribute__((address_space(3))) float* scr, const float* ks) {
    const int e = item / ipe, q = item - e * ipe, nblk = N / 64, kb = q / nblk, nb = q - kb * nblk, k0 = 64 * kb, n0 = 64 * nb;
    const int c = lane & 7, ns = lane >> 3;
    float kf[8];
#pragma unroll
    for (int q2 = 0; q2 < 8; ++q2) kf[q2] = 32.f * (ks ? ks[k0 + 8 * c + q2] : 1.f);
    unsigned char* dst = WT + (size_t)e * N * 1024 + (size_t)n0 * 1024 + k0 + 8 * c;
#pragma unroll
    for (int j = 0; j < 8; ++j) { const int n = ns + 8 * j; const __attribute__((address_space(3))) float* s = scr + (8 * c) * 65 + n;
        uint2 o; o.x = g8::pk4_fp8(kf[0] * s[0 * 65], kf[1] * s[1 * 65], kf[2] * s[2 * 65], kf[3] * s[3 * 65]); o.y = g8::pk4_fp8(kf[4] * s[4 * 65], kf[5] * s[5 * 65], kf[6] * s[6 * 65], kf[7] * s[7 * 65]);
        *(uint2*)(dst + (size_t)n * 1024) = o; }
    asm volatile("s_waitcnt lgkmcnt(0)" ::: "memory");
}
DEVI void t8_run(const float* W, int N, unsigned char* WT, const float* ks, int first, int end, int stride, int lane, __attribute__((address_space(3))) float* scr) {
    const int ipe = 16 * (N / 64);
    float4 v[16];
    int it = first;
    if (it < end) t8_load(W, N, it, ipe, lane, v);
    while (it < end) {
        t8_lds_write(v, scr, lane);
        const int nx = it + stride;
        if (nx < end) t8_load(W, N, nx, ipe, lane, v);
        t8_pack_store(WT, N, it, ipe, lane, scr, ks);
        it = nx;
    }
}
DEVI void transpose_item(const float* W, int K, int N, unsigned short* WT, __attribute__((address_space(3))) float* scr, int item, int lane, int ncols = 0, const float* ks = nullptr) {
    const int nblk = (ncols ? ncols : N) / 64, kb = item / nblk, nb = item % nblk, k0 = 64 * kb, n0 = 64 * nb;
    const int kr = lane >> 4, c4 = lane & 15;
    float4 v[16];
#pragma unroll
    for (int i = 0; i < 16; ++i) v[i] = *(const float4*)(W + (size_t)(k0 + 4 * i + kr) * N + n0 + 4 * c4);
#pragma unroll
    for (int i = 0; i < 16; ++i) { __attribute__((address_space(3))) float* d = scr + (4 * i + kr) * 65 + 4 * c4; d[0] = v[i].x; d[1] = v[i].y; d[2] = v[i].z; d[3] = v[i].w; }
    asm volatile("s_waitcnt lgkmcnt(0)" ::: "memory");
    const int c = lane & 7, ns = lane >> 3;
    float kf[8];
#pragma unroll
    for (int q = 0; q < 8; ++q) kf[q] = ks ? ks[k0 + 8 * c + q] : 1.f;
#pragma unroll
    for (int j = 0; j < 8; ++j) { const int n = ns + 8 * j; const __attribute__((address_space(3))) float* s = scr + (8 * c) * 65 + n;
        v4u o; o.x = pk2(kf[0] * s[0 * 65], kf[1] * s[1 * 65]); o.y = pk2(kf[2] * s[2 * 65], kf[3] * s[3 * 65]); o.z = pk2(kf[4] * s[4 * 65], kf[5] * s[5 * 65]); o.w = pk2(kf[6] * s[6 * 65], kf[7] * s[7 * 65]);
        *(v4u*)(WT + (size_t)(n0 + n) * K + k0 + 8 * c) = o; }
    asm volatile("s_waitcnt lgkmcnt(0)" ::: "memory");
}

#define LAS3 __attribute__((address_space(3)))

typedef float f32x16 __attribute__((ext_vector_type(16)));
typedef short bf16x8_t __attribute__((ext_vector_type(8)));
typedef float f32x2_t __attribute__((ext_vector_type(2)));
typedef __bf16 bf16x2_t __attribute__((ext_vector_type(2)));
typedef unsigned u32x4_t __attribute__((ext_vector_type(4)));
typedef unsigned u32x2_t __attribute__((ext_vector_type(2)));
#define MFMA32(a, b, c) __builtin_amdgcn_mfma_f32_32x32x16_bf16((a), (b), (c), 0, 0, 0)
DEVI unsigned cvtpk(float lo, float hi) { f32x2_t v = {lo, hi}; bf16x2_t b = __builtin_convertvector(v, bf16x2_t); return __builtin_bit_cast(unsigned, b); }
DEVI int crow(int reg, int hi) { return (reg & 3) + 8 * (reg >> 2) + 4 * hi; }
DEVI bf16x8_t pack_step(const f32x16& x, int s) {
    u32x4_t p; p[0] = cvtpk(x[8 * s], x[8 * s + 1]); p[1] = cvtpk(x[8 * s + 2], x[8 * s + 3]); p[2] = cvtpk(x[8 * s + 4], x[8 * s + 5]); p[3] = cvtpk(x[8 * s + 6], x[8 * s + 7]);
    return __builtin_bit_cast(bf16x8_t, p);
}
DEVI int t5_bucket(int d) { return d < 16 ? d : min(31, 16 + (int)(log2f((float)d * 0.0625f) * (16.f / 3.f))); }

DEVI void swa_item(int item, const unsigned short* PROJB, unsigned short* MIXB, const float* relb, const float* sinks, LAS3 unsigned char* L, int tid_) {
    int tid = tid_; asm volatile("" : "+v"(tid));
    const int kv = item & 1, qb = (item >> 1) & 63, b = item >> 7;
    const int lane = tid & 63, w = __builtin_amdgcn_readfirstlane(tid >> 6), hi = lane >> 5, r32 = lane & 31;
    LAS3 unsigned char* KL = L; LAS3 unsigned char* VT = L + 36864; LAS3 float* BT = (LAS3 float*)(L + 36864 + 33280);
    const long tok0 = (long)b * SEQ + (long)(qb - 1) * 128;
#pragma unroll
    for (int i = 0; i < 4; ++i) { const int ci = tid + 512 * i, row = ci >> 3, ch = ci & 7; const bool ok = (qb > 0) || (row >= 128);
        u32x4_t v = {0u, 0u, 0u, 0u}; if (ok) v = *(const u32x4_t*)(PROJB + (size_t)(tok0 + row) * PJ + PJ_K + kv * 64 + ch * 8);
        *(LAS3 u32x4_t*)(KL + row * 144 + ch * 16) = v; }
#pragma unroll
    for (int i = 0; i < 2; ++i) { const int it = tid + 512 * i, rp = it >> 3, ch = it & 7; const bool ok = (qb > 0) || (rp >= 64);
        u32x4_t v0 = {0u, 0u, 0u, 0u}, v1 = {0u, 0u, 0u, 0u};
        if (ok) { const unsigned short* vp = PROJB + (size_t)(tok0 + 2 * rp) * PJ + PJ_V + kv * 64 + ch * 8; v0 = *(const u32x4_t*)vp; v1 = *(const u32x4_t*)(vp + PJ); }
#pragma unroll
        for (int e = 0; e < 8; ++e) { const unsigned a = (e & 1) ? (v0[e >> 1] >> 16) : (v0[e >> 1] & 0xffffu), c = (e & 1) ? (v1[e >> 1] & 0xffff0000u) : (v1[e >> 1] << 16);
            *(LAS3 unsigned*)(VT + (ch * 8 + e) * 520 + rp * 4) = a | c; } }
    { const int hql = tid >> 7, d = tid & 127; BT[tid] = relb[t5_bucket(d) * 8 + kv * 4 + hql]; }
    __syncthreads();
    const int hql = w >> 1, hq = kv * 4 + hql, qhalf = w & 1;
    const float sink = sinks[hq];
#pragma unroll 1
    for (int qi = 0; qi < 2; ++qi) {
        const int m = 2 * qhalf + qi, qf0 = 128 + 32 * m;
        const size_t qrow0 = (size_t)b * SEQ + (size_t)qb * 128 + 32 * m;
        const unsigned short* qp = PROJB + (qrow0 + r32) * PJ + PJ_Q + hq * 64 + 8 * hi;
        bf16x8_t qf[4];
#pragma unroll
        for (int ks = 0; ks < 4; ++ks) qf[ks] = *(const bf16x8_t*)(qp + 16 * ks);
        f32x16 S[5];
#pragma unroll
        for (int kk = 0; kk < 5; ++kk) {
#pragma unroll
            for (int r = 0; r < 16; ++r) S[kk][r] = 0.f;
#pragma unroll
            for (int ks = 0; ks < 4; ++ks) { const bf16x8_t a = *(const LAS3 bf16x8_t*)(KL + (32 * (m + kk) + r32) * 144 + (16 * ks + 8 * hi) * 2); S[kk] = MFMA32(a, qf[ks], S[kk]); }
        }
        float mx = sink;
#pragma unroll
        for (int kk = 0; kk < 5; ++kk)
#pragma unroll
            for (int r = 0; r < 16; ++r) { const int kf = 32 * (m + kk) + crow(r, hi), dist = qf0 + r32 - kf; const bool ok = (dist >= 0) && (dist < 128) && ((qb > 0) || (kf >= 128));
                const float sc = ok ? S[kk][r] * 0.125f + BT[hql * 128 + (dist & 127)] : -INFINITY; S[kk][r] = sc; mx = fmaxf(mx, sc); }
        mx = fmaxf(mx, xshfl(mx, 32, lane));
        float sum = 0.f;
#pragma unroll
        for (int kk = 0; kk < 5; ++kk)
#pragma unroll
            for (int r = 0; r < 16; ++r) { const float pe = __expf(S[kk][r] - mx); S[kk][r] = pe; sum += pe; }
        sum += xshfl(sum, 32, lane); sum += __expf(sink - mx);
        const float linv = 1.f / sum;
        f32x16 O[2];
#pragma unroll
        for (int db = 0; db < 2; ++db)
#pragma unroll
            for (int r = 0; r < 16; ++r) O[db][r] = 0.f;
#pragma unroll
        for (int kk = 0; kk < 5; ++kk)
#pragma unroll
            for (int s2 = 0; s2 < 2; ++s2) { const bf16x8_t pa = pack_step(S[kk], s2); const int kbase = 32 * (m + kk) + 16 * s2 + 4 * hi;
#pragma unroll
                for (int db = 0; db < 2; ++db) { LAS3 unsigned char* vp = VT + (32 * db + r32) * 520 + kbase * 2;
                    const u32x2_t lo = *(const LAS3 u32x2_t*)vp, hi2 = *(const LAS3 u32x2_t*)(vp + 16);
                    const u32x4_t vv = {lo[0], lo[1], hi2[0], hi2[1]};
                    O[db] = MFMA32(pa, __builtin_bit_cast(bf16x8_t, vv), O[db]); } }
#pragma unroll
        for (int r = 0; r < 16; ++r) { const int q = crow(r, hi); const float li = bperm(linv, q);
            unsigned short* op = MIXB + (qrow0 + q) * 1024 + 512 + hq * 64 + r32;
            op[0] = (unsigned short)(cvtpk(O[0][r] * li, 0.f) & 0xffffu); op[32] = (unsigned short)(cvtpk(O[1][r] * li, 0.f) & 0xffffu); }
    }
    __syncthreads();
}

DEVI void xattn_item(int item, const unsigned short* QCB, const unsigned short* KVMB, const float* SSQ, unsigned short* OCB, LAS3 unsigned char* L, int tid_) {
    int tid = tid_; asm volatile("" : "+v"(tid));
    const int qblk = item & 31, hd = (item >> 5) & 3, b = item >> 7;
    const int lane = tid & 63, w = __builtin_amdgcn_readfirstlane(tid >> 6), hi = lane >> 5, r32 = lane & 31;
    LAS3 unsigned char* KL = L; LAS3 unsigned char* VT = L + 69632;
    const unsigned short* kvb = KVMB + (size_t)b * MEMLEN * 1024 + hd * 128;
#pragma unroll
    for (int i = 0; i < 8; ++i) { const int ci = tid + 512 * i, row = ci >> 4, ch = ci & 15;
        *(LAS3 u32x4_t*)(KL + row * 272 + ch * 16) = *(const u32x4_t*)(kvb + (size_t)row * 1024 + ch * 8); }
#pragma unroll
    for (int i = 0; i < 4; ++i) { const int it = tid + 512 * i, rp = it >> 4, ch = it & 15;
        const unsigned short* vp = kvb + (size_t)(2 * rp) * 1024 + 512 + ch * 8; const u32x4_t v0 = *(const u32x4_t*)vp, v1 = *(const u32x4_t*)(vp + 1024);
#pragma unroll
        for (int e = 0; e < 8; ++e) { const unsigned a = (e & 1) ? (v0[e >> 1] >> 16) : (v0[e >> 1] & 0xffffu), c = (e & 1) ? (v1[e >> 1] & 0xffff0000u) : (v1[e >> 1] << 16);
            *(LAS3 unsigned*)(VT + (ch * 8 + e) * 520 + rp * 4) = a | c; } }
    __syncthreads();
    const size_t qrow0 = (size_t)b * SEQ + (size_t)qblk * 256 + 32 * w;
    const unsigned short* qp = QCB + (qrow0 + r32) * 512 + hd * 128 + 8 * hi;
    f32x16 S[8];
    {
        bf16x8_t qf[8];
#pragma unroll
        for (int ks = 0; ks < 8; ++ks) qf[ks] = *(const bf16x8_t*)(qp + 16 * ks);
#pragma unroll
        for (int kk = 0; kk < 8; ++kk) {
#pragma unroll
            for (int r = 0; r < 16; ++r) S[kk][r] = 0.f;
#pragma unroll
            for (int ks = 0; ks < 8; ++ks) { const bf16x8_t a = *(const LAS3 bf16x8_t*)(KL + (32 * kk + r32) * 272 + (16 * ks + 8 * hi) * 2); S[kk] = MFMA32(a, qf[ks], S[kk]); }
        }
    }
    float sc = 0.08838834764831845f;
    {
        const float* sp = SSQ + (qrow0 + r32) * 32; float t = 0.f;
#pragma unroll
        for (int i = 0; i < 8; ++i) { const float4 v = ld4(sp + 4 * i); t += (v.x + v.y) + (v.z + v.w); }
        sc *= rsqrtf(t * (1.f / 1024.f) + EPS);
    }
    float mx = -INFINITY;
#pragma unroll
    for (int kk = 0; kk < 8; ++kk)
#pragma unroll
        for (int r = 0; r < 16; ++r) mx = fmaxf(mx, S[kk][r]);
    mx = fmaxf(mx, xshfl(mx, 32, lane));
    float sum = 0.f;
#pragma unroll
    for (int kk = 0; kk < 8; ++kk)
#pragma unroll
        for (int r = 0; r < 16; ++r) { const float pe = __expf((S[kk][r] - mx) * sc); S[kk][r] = pe; sum += pe; }
    sum += xshfl(sum, 32, lane);
    const float linv = 1.f / sum;
    f32x16 O[4];
#pragma unroll
    for (int db = 0; db < 4; ++db)
#pragma unroll
        for (int r = 0; r < 16; ++r) O[db][r] = 0.f;
#pragma unroll
    for (int kk = 0; kk < 8; ++kk)
#pragma unroll
        for (int s2 = 0; s2 < 2; ++s2) { const bf16x8_t pa = pack_step(S[kk], s2); const int kbase = 32 * kk + 16 * s2 + 4 * hi;
#pragma unroll
            for (int db = 0; db < 4; ++db) { LAS3 unsigned char* vp = VT + (32 * db + r32) * 520 + kbase * 2;
                const u32x2_t lo = *(const LAS3 u32x2_t*)vp, hi2 = *(const LAS3 u32x2_t*)(vp + 16);
                const u32x4_t vv = {lo[0], lo[1], hi2[0], hi2[1]};
                O[db] = MFMA32(pa, __builtin_bit_cast(bf16x8_t, vv), O[db]); } }
#pragma unroll
    for (int r = 0; r < 16; ++r) { const int q = crow(r, hi); const float li = bperm(linv, q);
        unsigned short* op = OCB + (qrow0 + q) * 512 + hd * 128 + r32;
#pragma unroll
        for (int db = 0; db < 4; ++db) op[32 * db] = (unsigned short)(cvtpk(O[db][r] * li, 0.f) & 0xffffu); }
    __syncthreads();
}


DEVI void ssd_s1_item(int item, const unsigned short* PROJB, const float* DTRAW, const float* convw, const float* convb, const float* dtbias, const float* alog,
                      unsigned short* XC, float* DT, float* ACS, float* CD, float* ST, LAS3 unsigned char* L, int tid_) {
    int tid = tid_; asm volatile("" : "+v"(tid));
    const int g = item & 1, c = (item >> 1) & 63, b = item >> 7;
    const int lane = tid & 63, w = __builtin_amdgcn_readfirstlane(tid >> 6), hi = lane >> 5, r32 = lane & 31;
    LAS3 unsigned char* XwT = L; LAS3 unsigned char* BT = L + 69632;
    LAS3 float* dts = (LAS3 float*)(L + 104448); LAS3 float* acs = dts + 512; LAS3 float* wts = acs + 512;
    const size_t tok0 = (size_t)b * SEQ + (size_t)c * 128;
    if (w < 4) {
        const int h = 4 * g + w; const float ah = -__expf(alog[h]), db = dtbias[h];
        const float d0 = softplus_f(DTRAW[(tok0 + 2 * lane) * 8 + h] + db), d1 = softplus_f(DTRAW[(tok0 + 2 * lane + 1) * 8 + h] + db);
        const float a0 = d0 * ah, a1 = d1 * ah;
        float sc = a0 + a1;
#pragma unroll
        for (int o = 1; o < 64; o <<= 1) { const float v = bperm(sc, lane - o); if (lane >= o) sc += v; }
        const float ex = sc - (a0 + a1), c0 = ex + a0, c1 = ex + a0 + a1, cend = bperm(sc, 63);
        dts[w * 128 + 2 * lane] = d0; dts[w * 128 + 2 * lane + 1] = d1; acs[w * 128 + 2 * lane] = c0; acs[w * 128 + 2 * lane + 1] = c1;
        wts[w * 128 + 2 * lane] = __expf(cend - c0) * d0; wts[w * 128 + 2 * lane + 1] = __expf(cend - c1) * d1;
        DT[(tok0 + 2 * lane) * 8 + h] = d0; DT[(tok0 + 2 * lane + 1) * 8 + h] = d1; ACS[(tok0 + 2 * lane) * 8 + h] = c0; ACS[(tok0 + 2 * lane + 1) * 8 + h] = c1;
        if (lane == 0) CD[((size_t)b * 64 + c) * 8 + h] = __expf(cend);
    }
    __syncthreads();
    {
        const int cg = lane, ch = cg < 32 ? g * 256 + cg * 8 : (cg < 48 ? 512 + g * 128 + (cg - 32) * 8 : 768 + g * 128 + (cg - 48) * 8);
        float wk[4][8], bb[8];
#pragma unroll
        for (int k = 0; k < 4; ++k) { const float4 a = ld4(convw + k * CONVCH + ch), d = ld4(convw + k * CONVCH + ch + 4); wk[k][0] = a.x; wk[k][1] = a.y; wk[k][2] = a.z; wk[k][3] = a.w; wk[k][4] = d.x; wk[k][5] = d.y; wk[k][6] = d.z; wk[k][7] = d.w; }
        { const float4 a = ld4(convb + ch), d = ld4(convb + ch + 4); bb[0] = a.x; bb[1] = a.y; bb[2] = a.z; bb[3] = a.w; bb[4] = d.x; bb[5] = d.y; bb[6] = d.z; bb[7] = d.w; }
        const int s0 = w * 16;
        const unsigned short* src = PROJB + (tok0 + s0) * PJ + PJ_XBC + ch;
        u32x4_t rw[19];
#pragma unroll
        for (int i = 0; i < 19; ++i) { const bool ok = (c > 0) || (s0 + i - 3 >= 0); rw[i] = (u32x4_t){0u, 0u, 0u, 0u}; if (ok) rw[i] = *(const u32x4_t*)(src + (ptrdiff_t)(i - 3) * PJ); }
        const int hl = cg >> 3;
#pragma unroll
        for (int i2 = 0; i2 < 8; ++i2) {
            float y[2][8];
#pragma unroll
            for (int q = 0; q < 2; ++q) {
                const int i = 2 * i2 + q;
#pragma unroll
                for (int e = 0; e < 8; ++e) { float a = bb[e];
#pragma unroll
                    for (int k = 0; k < 4; ++k) { const unsigned wd = rw[i + k][e >> 1]; a += wk[k][e] * __uint_as_float((e & 1) ? (wd & 0xffff0000u) : (wd << 16)); }
                    y[q][e] = silu_f(a); }
                u32x4_t o; o[0] = cvtpk(y[q][0], y[q][1]); o[1] = cvtpk(y[q][2], y[q][3]); o[2] = cvtpk(y[q][4], y[q][5]); o[3] = cvtpk(y[q][6], y[q][7]);
                *(u32x4_t*)(XC + (tok0 + s0 + i) * 1024 + ch) = o;
            }
            const int s = s0 + 2 * i2;
            if (cg < 32) { const float w0 = wts[hl * 128 + s], w1 = wts[hl * 128 + s + 1];
#pragma unroll
                for (int e = 0; e < 8; ++e) *(LAS3 unsigned*)(XwT + hl * 17408 + ((cg & 7) * 8 + e) * 272 + ((((s >> 3) ^ (cg & 7)) & 15) << 4) + (s & 7) * 2) = cvtpk(y[0][e] * w0, y[1][e] * w1); }
            else if (cg < 48) {
#pragma unroll
                for (int e = 0; e < 8; ++e) *(LAS3 unsigned*)(BT + ((cg - 32) * 8 + e) * 272 + ((((s >> 3) ^ ((cg - 32) & 7)) & 15) << 4) + (s & 7) * 2) = cvtpk(y[0][e], y[1][e]); }
        }
    }
    __syncthreads();
    {
        const int pb = w >> 2, nb = w & 3;
#pragma unroll 1
        for (int hl = 0; hl < 4; ++hl) {
            f32x16 acc;
#pragma unroll
            for (int r = 0; r < 16; ++r) acc[r] = 0.f;
#pragma unroll
            for (int ks = 0; ks < 8; ++ks) { const bf16x8_t a = *(const LAS3 bf16x8_t*)(XwT + hl * 17408 + (32 * pb + r32) * 272 + (((2 * ks + hi) ^ ((r32 >> 3) + 4 * pb)) & 15) * 16);
                const bf16x8_t bq = *(const LAS3 bf16x8_t*)(BT + (32 * nb + r32) * 272 + (((2 * ks + hi) ^ (((r32 >> 3) + 4 * nb) & 7)) & 15) * 16); acc = MFMA32(a, bq, acc); }
            float* sp = ST + (((size_t)b * 64 + c) * 8 + 4 * g + hl) * 8192 + 32 * nb + r32;
#pragma unroll
            for (int r = 0; r < 16; ++r) sp[(32 * pb + crow(r, hi)) * 128] = acc[r];
        }
    }
    __syncthreads();
}

DEVI void ssd_s3_item(int item, const unsigned short* XC, const float* DT, const float* ACS, const unsigned short* HIN, const unsigned short* PROJB, const float* dskip, const float* gssm,
                      float* YPRE, unsigned short* MIXB, LAS3 unsigned char* L, int tid_) {
    int tid = tid_; asm volatile("" : "+v"(tid));
    const int g = item & 1, c = (item >> 1) & 63, b = item >> 7;
    const int lane = tid & 63, w = __builtin_amdgcn_readfirstlane(tid >> 6), hi = lane >> 5, r32 = lane & 31;
    LAS3 unsigned char* Cs = L; LAS3 unsigned char* BM = L + 34816; LAS3 unsigned char* XT = L + 69632; LAS3 unsigned char* HN = L + 87040;
    LAS3 float* dts = (LAS3 float*)(L + 104448); LAS3 float* acs = dts + 512; LAS3 float* rowsq = acs + 512;
    const size_t tok0 = (size_t)b * SEQ + (size_t)c * 128;
#pragma unroll
    for (int i = 0; i < 4; ++i) { const int ci = tid + 512 * i, row = ci >> 4, chk = ci & 15;
        *(LAS3 u32x4_t*)(Cs + row * 272 + chk * 16) = *(const u32x4_t*)(XC + (tok0 + row) * 1024 + 768 + g * 128 + chk * 8);
        *(LAS3 u32x4_t*)(BM + row * 272 + chk * 16) = *(const u32x4_t*)(XC + (tok0 + row) * 1024 + 512 + g * 128 + chk * 8); }
    { const int t = tid >> 2, hl = tid & 3; dts[hl * 128 + t] = DT[(tok0 + t) * 8 + 4 * g + hl]; acs[hl * 128 + t] = ACS[(tok0 + t) * 8 + 4 * g + hl]; }
    __syncthreads();
    const int lb = w >> 1;
    f32x16 CB[2];
#pragma unroll
    for (int j = 0; j < 2; ++j) {
#pragma unroll
        for (int r = 0; r < 16; ++r) CB[j][r] = 0.f;
        const int sb = 2 * (w & 1) + j;
        if (sb <= lb) {
#pragma unroll
            for (int ks = 0; ks < 8; ++ks) { const bf16x8_t a = *(const LAS3 bf16x8_t*)(Cs + (32 * lb + r32) * 272 + (16 * ks + 8 * hi) * 2);
                const bf16x8_t bq = *(const LAS3 bf16x8_t*)(BM + (32 * sb + r32) * 272 + (16 * ks + 8 * hi) * 2); CB[j] = MFMA32(a, bq, CB[j]); }
        }
    }
    __syncthreads();
    const int pb = w & 1;
    LAS3 unsigned char* ZS = L + 110592;
    float sq[16];
#pragma unroll
    for (int r = 0; r < 16; ++r) sq[r] = 0.f;
#pragma unroll 1
    for (int hl = 0; hl < 4; ++hl) {
        const int h = 4 * g + hl;
        {
            const int sp = tid >> 3, chk = tid & 7;
            const unsigned short* xp = XC + (tok0 + 2 * sp) * 1024 + h * 64 + chk * 8; const u32x4_t v0 = *(const u32x4_t*)xp, v1 = *(const u32x4_t*)(xp + 1024);
#pragma unroll
            for (int e = 0; e < 8; ++e) { const unsigned a = (e & 1) ? (v0[e >> 1] >> 16) : (v0[e >> 1] & 0xffffu), d = (e & 1) ? (v1[e >> 1] & 0xffff0000u) : (v1[e >> 1] << 16);
                *(LAS3 unsigned*)(XT + (chk * 8 + e) * 272 + ((((sp >> 2) ^ chk) & 15) << 4) + (sp & 3) * 4) = a | d; }
            const unsigned short* hp = HIN + (((size_t)b * 64 + c) * 8 + h) * 8192;
#pragma unroll
            for (int i = 0; i < 2; ++i) { const int ci = tid + 512 * i, row = ci >> 4, ck = ci & 15; *(LAS3 u32x4_t*)(HN + row * 272 + ck * 16) = *(const u32x4_t*)(hp + row * 128 + ck * 8); }
#pragma unroll
            for (int i = 0; i < 2; ++i) { const int ci = tid + 512 * i, row = ci >> 3, ck = ci & 7; *(LAS3 u32x4_t*)(ZS + row * 144 + ck * 16) = *(const u32x4_t*)(PROJB + (tok0 + row) * PJ + PJ_Z + h * 64 + ck * 8); }
        }
#pragma unroll
        for (int j = 0; j < 2; ++j) { const int sb = 2 * (w & 1) + j;
            if (sb <= lb) { const int s = 32 * sb + r32; const float as = acs[hl * 128 + s], ds = dts[hl * 128 + s];
#pragma unroll
                for (int r = 0; r < 16; ++r) { const int l = 32 * lb + crow(r, hi); const float ev = CB[j][r] * __expf(acs[hl * 128 + l] - as) * ds; const float v = (s <= l) ? ev : 0.f;
                    *(LAS3 unsigned short*)(BM + l * 272 + s * 2) = (unsigned short)(cvtpk(v, 0.f) & 0xffffu); } } }
        __syncthreads();
        f32x16 acc;
#pragma unroll
        for (int r = 0; r < 16; ++r) acc[r] = 0.f;
#pragma unroll
        for (int ks = 0; ks < 8; ++ks) { const bf16x8_t a = *(const LAS3 bf16x8_t*)(Cs + (32 * lb + r32) * 272 + (16 * ks + 8 * hi) * 2);
            const bf16x8_t bq = *(const LAS3 bf16x8_t*)(HN + (32 * pb + r32) * 272 + (16 * ks + 8 * hi) * 2); acc = MFMA32(a, bq, acc); }
#pragma unroll
        for (int r = 0; r < 16; ++r) acc[r] *= __expf(acs[hl * 128 + 32 * lb + crow(r, hi)]);
#pragma unroll
        for (int ks = 0; ks < 8; ++ks) if (ks < 2 * (lb + 1)) { const bf16x8_t a = *(const LAS3 bf16x8_t*)(BM + (32 * lb + r32) * 272 + (16 * ks + 8 * hi) * 2);
            const bf16x8_t bq = *(const LAS3 bf16x8_t*)(XT + (32 * pb + r32) * 272 + (((2 * ks + hi) ^ ((r32 >> 3) + 4 * pb)) & 15) * 16); acc = MFMA32(a, bq, acc); }
        const float dsk = dskip[h]; const int pc = 32 * pb + r32;
        unsigned short* yp = (unsigned short*)YPRE + tok0 * 512 + h * 64 + pc;
#pragma unroll
        for (int r = 0; r < 16; ++r) { const int l = 32 * lb + crow(r, hi);
            const float xv = bf2f(*(const LAS3 unsigned short*)(XT + pc * 272 + ((((l >> 3) ^ (pc >> 3)) & 15) << 4) + (l & 7) * 2)), z = bf2f(*(const LAS3 unsigned short*)(ZS + l * 144 + pc * 2));
            const float y = (acc[r] + dsk * xv) * silu_f(z); yp[l * 512] = (unsigned short)(cvtpk(y, 0.f) & 0xffffu); sq[r] += y * y; }
        __syncthreads();
    }
#pragma unroll
    for (int r = 0; r < 16; ++r) { float v = sq[r];
#pragma unroll
        for (int o = 1; o < 32; o <<= 1) v += xshfl(v, o, lane);
        if (r32 == 0) rowsq[(32 * lb + crow(r, hi)) * 2 + pb] = v; }
    __syncthreads();
#pragma unroll 1
    for (int hl = 0; hl < 4; ++hl) { const int col = (4 * g + hl) * 64 + 32 * pb + r32; const float gs = gssm[col];
#pragma unroll
        for (int r = 0; r < 16; ++r) { const int l = 32 * lb + crow(r, hi); const float rs = rsqrtf((rowsq[l * 2] + rowsq[l * 2 + 1]) * (1.f / 256.f) + EPS);
            MIXB[(tok0 + l) * 1024 + col] = (unsigned short)(cvtpk(bf2f(((const unsigned short*)YPRE)[(tok0 + l) * 512 + col]) * rs * gs, 0.f) & 0xffffu); } }
    __syncthreads();
}

__global__ void __launch_bounds__(512, 2) mk_fwd(Params p) {
    extern __shared__ __attribute__((aligned(16))) unsigned char lds[];
    const int NGW = gridDim.x * 8, NGT = gridDim.x * 512, G = gridDim.x;
    unsigned char* ws = p.ws;
    unsigned* ctl = (unsigned*)(ws + WS_CTL);
    unsigned short* H2B = (unsigned short*)(ws + WS_H1);
    float* DT = (float*)(ws + WS_DT); float* DTRAW = (float*)(ws + WS_DTRAW); float* GATE = (float*)(ws + WS_GATE); float* BIASP = (float*)(ws + WS_BIASP);
    typedef unsigned short bf;
    bf* XN = (bf*)(ws + WS_XN); bf* PROJB = (bf*)(ws + WS_BIG); bf* YB = (bf*)(ws + WS_YB); bf* MIXB = (bf*)(ws + WS_MIXB); bf* QCB = (bf*)(ws + WS_QCB); bf* OCB = (bf*)(ws + WS_OCB);
    bf* KVMB = (bf*)(ws + WS_KVMB);
    bf* XC = (bf*)(ws + WS_XC); float* ACS = (float*)(ws + WS_ACS); float* CD = (float*)(ws + WS_CD); float* ST = (float*)(ws + WS_ST); bf* HIN = (bf*)(ws + WS_HIN);
    unsigned char* W1T8 = ws + WS_W1T; unsigned char* W2T8 = ws + WS_W2T; unsigned char* XN8 = ws + WS_QCB; unsigned char* ACT8 = ws + WS_ACTB;
    bf* WINT = (bf*)(ws + WS_WINT); bf* WOUTT = (bf*)(ws + WS_WOUTT); bf* WQT = (bf*)(ws + WS_WQT); bf* WKVT = (bf*)(ws + WS_WKVT); bf* WOT = (bf*)(ws + WS_WOT);
    int* LIST = (int*)(ws + WS_LIST); int* SLOT = (int*)(ws + WS_SLOT); float* RSA = (float*)(ws + WS_RSA); float* SSQ1 = (float*)(ws + WS_SSQ1); int* CNTB = (int*)(ws + WS_CNTB); float* RSROW = (float*)(ws + WS_RSROW);
    LAS3 unsigned char* ldsp = (LAS3 unsigned char*)lds;
    LAS3 int* TP = (LAS3 int*)(ldsp + LDS_MISC); LAS3 int* CNTL = TP + 64;
    const float* x = p.in[I_X];
    const int vcu = (G % 8 == 0) ? (blockIdx.x % 8) * (G / 8) + blockIdx.x / 8 : blockIdx.x;
    const int wave_id = __builtin_amdgcn_readfirstlane(threadIdx.x >> 6);
    if (threadIdx.x < 2) ((LAS3 unsigned*)(ldsp + LDS_MISC + 512))[threadIdx.x] = 0u;
    __syncthreads();
    const XcdBarrier xbar = xcd_barrier_post(ctl + 4096, (volatile LAS3 unsigned*)(ldsp + LDS_MISC + 512), threadIdx.x == 0);
#define GRID_BAR() do { const TI tb_ = fresh_ti(wave_id); xcd_barrier(xbar, tb_.tid == 0); } while (0)

    PH_BEGIN(0)
    {
        PHASE_IDS();
        LAS3 float* wdt = (LAS3 float*)ldsp;
        for (int i = tid; i < 1024 * 2; i += 512) { const int k = i >> 1, hh = i & 1; { const float4 t4 = ld4(p.in[I_WIN] + (size_t)k * IN_COLS + COL_DT + hh * 4); *(LAS3 g8::f32x4*)(wdt + hh * 4096 + (((k >> 8) * 4 + (k & 3)) * 64 + ((k & 255) >> 2)) * 4) = (g8::f32x4){t4.x, t4.y, t4.z, t4.w}; } }
        for (int i = gtid; i < PJ; i += NGT) BIASP[i] = i < PJ_Q ? 0.f : p.in[I_BQKV][i - PJ_Q];
        __syncthreads();
        {
            auto rowptr = [&](int r) -> const float* { return r >= NTOK ? p.in[I_MEM] + (size_t)(r - NTOK) * DM : x + (size_t)r * DM; };
            float4 vn[4];
            if (gw < NTOK + NMEM) {
#pragma unroll
                for (int j = 0; j < 4; ++j) vn[j] = ld4(rowptr(gw) + 4 * (lane + 64 * j)); }
            for (int r = gw; r < NTOK + NMEM; r += NGW) {
                const bool ismem = r >= NTOK;
                const float* g = ismem ? p.in[I_GMEM] : p.in[I_GMIX];
                float4 v[4]; float ss = 0.f;
#pragma unroll
                for (int j = 0; j < 4; ++j) { v[j] = vn[j]; ss += v[j].x * v[j].x + v[j].y * v[j].y + v[j].z * v[j].z + v[j].w * v[j].w; }
                if (r + NGW < NTOK + NMEM) {
#pragma unroll
                    for (int j = 0; j < 4; ++j) vn[j] = ld4(rowptr(r + NGW) + 4 * (lane + 64 * j)); }
                const float rs = rsqrtf(wave_sum(ss, lane) * (1.f / 1024.f) + EPS);
                float dacc[8];
#pragma unroll
                for (int h = 0; h < 8; ++h) dacc[h] = 0.f;
#pragma unroll
                for (int j = 0; j < 4; ++j) { const int c = 4 * (lane + 64 * j); const float4 gv = ld4(g + c);
                    v[j] = make_float4(v[j].x * rs * gv.x, v[j].y * rs * gv.y, v[j].z * rs * gv.z, v[j].w * rs * gv.w);
                    *(uint2*)(XN + (size_t)r * DM + c) = make_uint2(cvtpk(v[j].x, v[j].y), cvtpk(v[j].z, v[j].w));
                    if (!ismem) { const float uu[4] = {v[j].x, v[j].y, v[j].z, v[j].w};
#pragma unroll
                        for (int q = 0; q < 4; ++q) { const g8::f32x4 w0 = *(const LAS3 g8::f32x4*)(wdt + ((j * 4 + q) * 64 + lane) * 4), w1 = *(const LAS3 g8::f32x4*)(wdt + 4096 + ((j * 4 + q) * 64 + lane) * 4);
                            dacc[0] += uu[q] * w0.x; dacc[1] += uu[q] * w0.y; dacc[2] += uu[q] * w0.z; dacc[3] += uu[q] * w0.w;
                            dacc[4] += uu[q] * w1.x; dacc[5] += uu[q] * w1.y; dacc[6] += uu[q] * w1.z; dacc[7] += uu[q] * w1.w; } }
                }
                if (!ismem) {
#pragma unroll
                    for (int h = 0; h < 8; ++h) dacc[h] = wave_sum(dacc[h], lane);
                    if (lane == 0) { st4(DTRAW + (size_t)r * 8, make_float4(dacc[0], dacc[1], dacc[2], dacc[3])); st4(DTRAW + (size_t)r * 8 + 4, make_float4(dacc[4], dacc[5], dacc[6], dacc[7])); }
                }
            }
        }
        __syncthreads();
        LAS3 float* scr = (LAS3 float*)(ldsp + wave * 16640);
        constexpr int IT1 = 16 * (2048 / 64), IT2 = 16 * (1024 / 64);
        constexpr int IA = 16 * (1536 / 64), IB = 16 * (768 / 64), IO = 16 * 16, IQ = 16 * 8, IKV = 16 * 16, IWO = 8 * 16;
        constexpr int NSM = IA + IB + IO + IQ + IKV + IWO;
        for (int it = gw; it < NSM; it += NGW) {
            int r = it;
            if (r < IA) { transpose_item(p.in[I_WIN], 1024, IN_COLS, WINT, scr, r, lane, 1536); continue; } r -= IA;
            if (r < IB) { transpose_item(p.in[I_WIN] + COL_Q, 1024, IN_COLS, WINT + (size_t)1536 * 1024, scr, r, lane, 768); continue; } r -= IB;
            if (r < IO) { transpose_item(p.in[I_WOUT], 1024, 1024, WOUTT, scr, r, lane); continue; } r -= IO;
            if (r < IQ) { transpose_item(p.in[I_WQ], 1024, 512, WQT, scr, r, lane, 0, p.in[I_GCROSS]); continue; } r -= IQ;
            if (r < IKV) { transpose_item(p.in[I_WKV], 1024, 1024, WKVT, scr, r, lane); continue; } r -= IKV;
            transpose_item(p.in[I_WO], 512, 1024, WOT, scr, r, lane);
        }
        t8_run(p.in[I_W1], 2048, W1T8, p.in[I_GFFN], W1_P1_ITEMS + gw, NEXP * IT1, NGW, lane, scr);
    }
    GRID_BAR();
    PH_END()
    PH_BEGIN(1)
    {
        g8::DenseSched S{G, (int)blockIdx.x, 2048, NTOK / 256, PJ / 256, (const char*)WINT, NMEM / 256, 4, NTOK, (const char*)WKVT};
        g8::EpiBf16Dual E{PROJB, PJ, BIASP, KVMB, 1024};
        { PHASE_IDS(); g8::gemm_phase(ldsp, XN, WINT, 2048, 0, S, E, tid); }
    }
    if (blockIdx.x >= 72) {
        PHASE_IDS(); LAS3 float* scr = (LAS3 float*)(ldsp + wave * 16640);
        t8_run(p.in[I_W1], 2048, W1T8, p.in[I_GFFN], (blockIdx.x - 72) * 8 + wave, W1_P1_ITEMS, (G - 72) * 8, lane, scr);
    }
    GRID_BAR();
    PH_END()
    PH_BEGIN(2)
    {
    PHASE_IDS();
    for (int item = blockIdx.x; item < BATCH * 64 * 2; item += G)
        ssd_s1_item(item, PROJB, DTRAW, p.in[I_CONVW], p.in[I_CONVB], p.in[I_DTB], p.in[I_ALOG], XC, DT, ACS, CD, ST, ldsp, tid);
    }
    GRID_BAR();
    PH_END()
    PH_BEGIN(3)
    {
    PHASE_IDS();
    for (int item = blockIdx.x; item < BATCH * 64 * 2; item += G) swa_item(item, PROJB, MIXB, p.in[I_RELB], p.in[I_SINK], ldsp, tid);
    {
        for (int el = gtid; el < BATCH * 8 * 8192; el += NGT) {
            const int bh = el >> 13, pn = el & 8191, b = bh >> 3, h = bh & 7;
            float st = 0.f;
#pragma unroll 8
            for (int c = 0; c < 64; ++c) { const size_t idx = (((size_t)b * 64 + c) * 8 + h) * 8192 + pn;
                HIN[idx] = (bf)(cvtpk(st, 0.f) & 0xffffu); st = st * CD[((size_t)b * 64 + c) * 8 + h] + ST[idx]; }
        }
    }
    }
    GRID_BAR();
    PH_END()
    PH_BEGIN(4)
    {
    PHASE_IDS();
    for (int item = blockIdx.x; item < BATCH * 64 * 2; item += G)
        ssd_s3_item(item, XC, DT, ACS, HIN, PROJB, p.in[I_DSKIP], p.in[I_GSSM], ST, MIXB, ldsp, tid);
    }
    GRID_BAR();
    PH_END()
    PH_BEGIN(5)
    {
        g8::DenseSched S{G, (int)blockIdx.x, 2048, NTOK / 256, 4, (const char*)WOUTT, 0, 1, 0, nullptr};
        g8::EpiH1 E{p.in[I_BOUT], x, XN, SSQ1};
        { PHASE_IDS(); g8::gemm_phase(ldsp, MIXB, WOUTT, 2048, 0, S, E, tid); }
    }
    GRID_BAR();
    PH_END()
    PH_BEGIN(6)
    {
        g8::DenseSched S{G, (int)blockIdx.x, 2048, NTOK / 256, 2, (const char*)WQT, 0, 1, 0, nullptr};
        g8::EpiBf16Dual E{QCB, 512, nullptr, nullptr, 0};
        { PHASE_IDS(); g8::gemm_phase(ldsp, XN, WQT, 2048, 0, S, E, tid); }
    }
    if (blockIdx.x >= 128) {
        PHASE_IDS(); LAS3 float* scr = (LAS3 float*)(ldsp + wave * 16640);
        t8_run(p.in[I_W2], 1024, W2T8, nullptr, (blockIdx.x - 128) * 8 + wave, W2_P7_ITEMS, (G - 128) * 8, lane, scr);
    }
    GRID_BAR();
    PH_END()
    PH_BEGIN(7)
    {
    PHASE_IDS();
    for (int item = blockIdx.x; item < BATCH * 4 * 32; item += G) xattn_item(item, QCB, KVMB, SSQ1, OCB, ldsp, tid);
    }
    GRID_BAR();
    PH_END()
    PH_BEGIN(8)
    {
        g8::DenseSched S{G, (int)blockIdx.x, 1024, NTOK / 256, 4, (const char*)WOT, 0, 1, 0, nullptr};
        g8::EpiH2 E{XN, H2B, XN8};
        { PHASE_IDS(); g8::gemm_phase(ldsp, OCB, WOT, 1024, 0, S, E, tid); }
    }
    GRID_BAR();
    PH_END()
    PH_BEGIN(9)
    {
    PHASE_IDS();
    LAS3 float* PL = (LAS3 float*)ldsp;
    LAS3 float* SQ = (LAS3 float*)(ldsp + 33792);
    LAS3 unsigned* LC = (LAS3 unsigned*)(ldsp + 34816);
    if (tid < 32) LC[tid] = 0u;
    __syncthreads();
    const int hi = lane >> 5, r32 = lane & 31, tl = wave >> 2, kq = wave & 3;
    for (int rb = blockIdx.x; rb < NTOK / 64; rb += G) {
        const int row0 = rb * 64 + tl * 32;
        const unsigned short* hrow = H2B + (size_t)(row0 + r32) * DM + kq * 256 + 4 * hi;
        const float* gq = p.in[I_GFFN] + kq * 256 + 4 * hi;
        const float* wq = p.in[I_WR] + (size_t)(kq * 256 + 4 * hi) * 32 + r32;
        f32x16 acc;
#pragma unroll
        for (int r = 0; r < 16; ++r) acc[r] = 0.f;
        float ssq = 0.f;
#pragma unroll 1
        for (int mb = 0; mb < 32; mb += 8) {
            uint2 av[8]; float bv[8][4];
#pragma unroll
            for (int m = 0; m < 8; ++m) { av[m] = *(const uint2*)(hrow + 8 * (mb + m));
#pragma unroll
                for (int t = 0; t < 4; ++t) bv[m][t] = wq[(size_t)(8 * (mb + m) + t) * 32]; }
#pragma unroll
            for (int m = 0; m < 8; ++m) { const float4 gv = ld4(gq + 8 * (mb + m));
                float4 a = make_float4(__uint_as_float(av[m].x << 16), __uint_as_float(av[m].x & 0xffff0000u), __uint_as_float(av[m].y << 16), __uint_as_float(av[m].y & 0xffff0000u));
                ssq += a.x * a.x + a.y * a.y + a.z * a.z + a.w * a.w;
                a.x *= gv.x; a.y *= gv.y; a.z *= gv.z; a.w *= gv.w;
                acc = __builtin_amdgcn_mfma_f32_32x32x2f32(a.x, bv[m][0], acc, 0, 0, 0); acc = __builtin_amdgcn_mfma_f32_32x32x2f32(a.y, bv[m][1], acc, 0, 0, 0);
                acc = __builtin_amdgcn_mfma_f32_32x32x2f32(a.z, bv[m][2], acc, 0, 0, 0); acc = __builtin_amdgcn_mfma_f32_32x32x2f32(a.w, bv[m][3], acc, 0, 0, 0); }
        }
        ssq += xshfl(ssq, 32, lane);
        if (hi == 0) SQ[(tl * 4 + kq) * 32 + r32] = ssq;
#pragma unroll
        for (int r = 0; r < 16; ++r) PL[((tl * 4 + kq) * 32 + crow(r, hi)) * 33 + r32] = acc[r];
        __syncthreads();
        int sel[4] = {0, 0, 0, 0}, ls[4] = {0, 0, 0, 0}; float gt[4] = {0.f, 0.f, 0.f, 0.f}, rs = 0.f;
        const int i = 8 * kq + (lane & 7), row = row0 + i;
        if (lane < 8) {
            rs = rsqrtf((SQ[(tl * 4 + 0) * 32 + i] + SQ[(tl * 4 + 1) * 32 + i] + SQ[(tl * 4 + 2) * 32 + i] + SQ[(tl * 4 + 3) * 32 + i]) * (1.f / 1024.f) + EPS);
            float l[32];
#pragma unroll
            for (int e = 0; e < 32; ++e) l[e] = (PL[((tl * 4 + 0) * 32 + i) * 33 + e] + PL[((tl * 4 + 1) * 32 + i) * 33 + e] + PL[((tl * 4 + 2) * 32 + i) * 33 + e] + PL[((tl * 4 + 3) * 32 + i) * 33 + e]) * rs + p.in[I_BR][e];
            float val[4];
#pragma unroll
            for (int k = 0; k < 4; ++k) {
                float best = -INFINITY; int bi = 0;
#pragma unroll
                for (int e = 0; e < 32; ++e) if (l[e] > best) { best = l[e]; bi = e; }
                sel[k] = bi; val[k] = best;
#pragma unroll
                for (int e = 0; e < 32; ++e) l[e] = (e == bi) ? -INFINITY : l[e];
            }
            float den = 0.f;
#pragma unroll
            for (int k = 0; k < 4; ++k) { gt[k] = __expf(val[k] - val[0]); den += gt[k]; }
#pragma unroll
            for (int k = 0; k < 4; ++k) { gt[k] /= den; ls[k] = (int)__hip_atomic_fetch_add(&LC[sel[k]], 1u, __ATOMIC_RELAXED, __HIP_MEMORY_SCOPE_WORKGROUP); }
        }
        if (lane < 8) {
#pragma unroll
            for (int k = 0; k < 4; ++k) { const int a = row * 4 + k; SLOT[a] = (sel[k] << 16) | ls[k]; GATE[a] = gt[k]; }
            RSROW[row] = rs;
        }
        __syncthreads();
    }
    if (tid < 32) CNTB[blockIdx.x * 32 + tid] = (int)LC[tid];
    }
    GRID_BAR();
    PH_END()
    {
    PHASE_IDS();
    LAS3 int* PT = (LAS3 int*)ldsp;
    {
        const int e = tid & 31, part = tid >> 5; int tot = 0, base = 0;
        for (int bb = part; bb < G; bb += 16) { const int c = CNTB[bb * 32 + e]; tot += c; base += (bb < (int)blockIdx.x) ? c : 0; }
        PT[(part * 32 + e) * 2] = tot; PT[(part * 32 + e) * 2 + 1] = base;
    }
    __syncthreads();
    LAS3 unsigned* GB = (LAS3 unsigned*)(ldsp + 8192);
    if (tid < 64) {
        int c = 0, base = 0;
        if (tid < 32) {
#pragma unroll
            for (int q = 0; q < 16; ++q) { c += PT[(q * 32 + tid) * 2]; base += PT[(q * 32 + tid) * 2 + 1]; }
            GB[tid] = (unsigned)base; }
        int tl = (c + 255) >> 8, incl = tl;
#pragma unroll
        for (int o = 1; o < 32; o <<= 1) { const int v = bperm_i(incl, lane - o); if (lane >= o) incl += v; }
        if (tid < 32) { CNTL[tid] = c; TP[tid] = incl - tl; }
        if (tid == 31) TP[32] = incl;
    }
    __syncthreads();
    for (int rb = blockIdx.x; rb < NTOK / 64; rb += G)
        if (tid < 256) { const int a = rb * 256 + tid; const int v = SLOT[a], e = v >> 16; const unsigned slot = GB[e] + (unsigned)(v & 0xffff);
            LIST[e * NTOK + slot] = a; RSA[e * NTOK + slot] = RSROW[a >> 2]; SLOT[a] = (e << 16) | (int)slot; }
    g8::moe_units(TP + 136, TP, 8, G, vcu, tid); g8::moe_units(TP + 168, TP, 4, G, vcu, tid);
    }
    GRID_BAR();
    PH_BEGIN(10)
    {
        g8::MoeSched S{8, 1024, TP + 136, TP, CNTL, LIST, (const char*)W1T8, 2048u * 1024u};
        g8::EpiSwiglu E{ACT8, p.in[I_B1], RSA};
        { PHASE_IDS(); g8::gemm_phase<g8::EpiSwiglu, g8::MoeSched, true>(ldsp, XN8, W1T8, 1024, 2, S, E, tid); }
    }
    {
        PHASE_IDS(); LAS3 float* scr = (LAS3 float*)(ldsp + wave * 16640);
        const int total = TP[32] * 8, maxu = (total + G - 1) / G, tlast = total - (maxu - 1) * G;
        const int nidle = G - tlast;
        if (nidle >= 64) { if (vcu >= tlast) t8_run(p.in[I_W2], 1024, W2T8, nullptr, W2_P7_ITEMS + (vcu - tlast) * 8 + wave, NEXP * 256, nidle * 8, lane, scr); }
        else t8_run(p.in[I_W2], 1024, W2T8, nullptr, W2_P7_ITEMS + vcu * 8 + wave, NEXP * 256, G * 8, lane, scr);
    }
    GRID_BAR();
    PH_END()
    PH_BEGIN(11)
    {
        g8::MoeSched S{4, 1024, TP + 168, TP, CNTL, nullptr, (const char*)W2T8, 1024u * 1024u};
        g8::EpiBf16 E{YB, 1024, p.in[I_B2], 1024, 0.0078125f};
        { PHASE_IDS(); g8::gemm_phase<g8::EpiBf16, g8::MoeSched, true>(ldsp, ACT8, W2T8, 1024, 0, S, E, tid); }
    }
    GRID_BAR();
    PH_END()
    PH_BEGIN(12)
    {
    PHASE_IDS();
    {
        uint2 hn[4]; int sln[4]; float gkn[4];
        if (gw < NTOK) {
#pragma unroll
            for (int k = 0; k < 4; ++k) { sln[k] = SLOT[gw * 4 + k]; gkn[k] = GATE[gw * 4 + k]; }
#pragma unroll
            for (int j = 0; j < 4; ++j) hn[j] = *(const uint2*)(H2B + (size_t)gw * DM + 4 * (lane + 64 * j)); }
        for (int row = gw; row < NTOK; row += NGW) {
            float4 v[4]; float ss = 0.f; float gk[4]; uint2 y[4][4];
#pragma unroll
            for (int k = 0; k < 4; ++k) { const int yrow = TP[sln[k] >> 16] * 256 + (sln[k] & 0xffff); gk[k] = gkn[k];
#pragma unroll
                for (int j = 0; j < 4; ++j) y[k][j] = *(const uint2*)(YB + (size_t)yrow * 1024 + 4 * (lane + 64 * j)); }
#pragma unroll
            for (int j = 0; j < 4; ++j) v[j] = make_float4(__uint_as_float(hn[j].x << 16), __uint_as_float(hn[j].x & 0xffff0000u), __uint_as_float(hn[j].y << 16), __uint_as_float(hn[j].y & 0xffff0000u));
            if (row + NGW < NTOK) {
#pragma unroll
                for (int k = 0; k < 4; ++k) { sln[k] = SLOT[(row + NGW) * 4 + k]; gkn[k] = GATE[(row + NGW) * 4 + k]; }
#pragma unroll
                for (int j = 0; j < 4; ++j) hn[j] = *(const uint2*)(H2B + (size_t)(row + NGW) * DM + 4 * (lane + 64 * j)); }
#pragma unroll
            for (int j = 0; j < 4; ++j) { float4 a = v[j];
#pragma unroll
                for (int k = 0; k < 4; ++k) { a.x += gk[k] * __uint_as_float(y[k][j].x << 16); a.y += gk[k] * __uint_as_float(y[k][j].x & 0xffff0000u);
                    a.z += gk[k] * __uint_as_float(y[k][j].y << 16); a.w += gk[k] * __uint_as_float(y[k][j].y & 0xffff0000u); }
                v[j] = a; ss += a.x * a.x + a.y * a.y + a.z * a.z + a.w * a.w; }
            const float rs = rsqrtf(wave_sum(ss, lane) * (1.f / 1024.f) + EPS);
#pragma unroll
            for (int j = 0; j < 4; ++j) { const int c = 4 * (lane + 64 * j); const float4 gv = ld4(p.in[I_GFIN] + c);
                st4(p.out + (size_t)row * DM + c, make_float4(v[j].x * rs * gv.x, v[j].y * rs * gv.y, v[j].z * rs * gv.z, v[j].w * rs * gv.w)); }
        }
    }
    }
    PH_END()
}

constexpr int LDS_BYTES = 147456;

extern "C" void kernel_launch(void* const* d_in, const int* in_sizes, int n_in, void* d_out, int out_size, void* d_ws, size_t ws_size, hipStream_t stream) {
    static int grid = 0;
    if (grid == 0) {
        if (n_in != N_IN || ws_size < WS_END) { fprintf(stderr, "kernel_launch: unexpected n_in %d / ws_size %zu (need %zu)\n", n_in, ws_size, (size_t)WS_END); grid = -1; return; }
        int dev = 0, cus = 0, per_cu = 0;
        (void)hipGetDevice(&dev);
        (void)hipDeviceGetAttribute(&cus, hipDeviceAttributeMultiprocessorCount, dev);
        (void)hipFuncSetAttribute((const void*)mk_fwd, hipFuncAttributeMaxDynamicSharedMemorySize, LDS_BYTES);
        (void)hipOccupancyMaxActiveBlocksPerMultiprocessor(&per_cu, (const void*)mk_fwd, 512, LDS_BYTES);
        if (per_cu < 1) { fprintf(stderr, "kernel_launch: occupancy query says %d blocks per CU\n", per_cu); per_cu = 1; }
        if (per_cu > 1) per_cu = 1;
        grid = cus * per_cu;
    }
    if (grid < 0) return;
    (void)hipMemsetAsync((char*)d_ws + WS_CTL, 0, 1 * MiB, stream);
    Params p{};
    for (int i = 0; i < N_IN; ++i) p.in[i] = (const float*)d_in[i];
    p.out = (float*)d_out; p.ws = (unsigned char*)d_ws; p.rep_mask = REP_MASK;
    void* args[] = {&p};
    hipError_t e = hipLaunchCooperativeKernel((const void*)mk_fwd, dim3(grid), dim3(512), args, LDS_BYTES, stream);
    if (e != hipSuccess) fprintf(stderr, "cooperative launch failed: %s (grid %d)\n", hipGetErrorString(e), grid);
}
```

```cpp
#include <hip/hip_runtime.h>
#include <cstdio>
#include <cstdint>

#define DEVI __device__ __forceinline__

constexpr int BATCH = 2, SEQ = 8192, NTOK = BATCH * SEQ, DM = 1024, MEMLEN = 256, NMEM = BATCH * MEMLEN;
constexpr int SSM_H = 8, SSM_P = 64, SSM_W = 512, SSM_N = 128, CONVCH = 1024;
constexpr int IN_COLS = 2312, COL_Z = 0, COL_XBC = 512, COL_DT = 1536, COL_Q = 1544, COL_K = 2056, COL_V = 2184;
constexpr int NEXP = 32, TOPK = 4, DFF = 1024, NASSIGN = NTOK * TOPK;
constexpr float EPS = 1e-5f;

enum { I_X = 0, I_MEM, I_GMIX, I_WIN, I_BQKV, I_CONVW, I_CONVB, I_DTB, I_ALOG, I_DSKIP, I_GSSM, I_SINK, I_RELB, I_WOUT, I_BOUT,
       I_GCROSS, I_GMEM, I_WQ, I_WKV, I_WO, I_GFFN, I_WR, I_BR, I_W1, I_B1, I_W2, I_B2, I_GFIN, N_IN };

constexpr size_t MiB = 1u << 20;
constexpr size_t WS_CTL = 0;
constexpr size_t WS_XN = 1 * MiB;
constexpr size_t WS_BIG = WS_XN + 34 * MiB;
constexpr size_t WS_XBC = WS_BIG + 144 * MiB;
constexpr size_t WS_MIXB = WS_XBC + 64 * MiB;
constexpr size_t WS_H1 = WS_MIXB + 32 * MiB;
constexpr size_t WS_H2 = WS_H1 + 64 * MiB;
constexpr size_t WS_YSSM = WS_H2 + 64 * MiB;
constexpr size_t WS_QCB = WS_YSSM + 32 * MiB;
constexpr size_t WS_OCB = WS_QCB + 16 * MiB;
constexpr size_t WS_ACTB = WS_OCB + 16 * MiB;
constexpr size_t WS_W1T = WS_ACTB + 144 * MiB;
constexpr size_t WS_W2T = WS_W1T + 128 * MiB;
constexpr size_t WS_WINT = WS_W2T + 64 * MiB;
constexpr size_t WS_WOUTT = WS_WINT + 5 * MiB;
constexpr size_t WS_WQT = WS_WOUTT + 2 * MiB;
constexpr size_t WS_WKVT = WS_WQT + 1 * MiB;
constexpr size_t WS_WOT = WS_WKVT + 2 * MiB;
constexpr size_t WS_SMALL = WS_WOT + 1 * MiB;
constexpr size_t WS_DT = WS_SMALL;
constexpr size_t WS_DTRAW = WS_DT + 512 * 1024;
constexpr size_t WS_KVMB = WS_DTRAW + 512 * 1024;
constexpr size_t WS_GATE = WS_KVMB + 1 * MiB;
constexpr size_t WS_SLOT = WS_GATE + 512 * 1024;
constexpr size_t WS_BIASP = WS_SLOT + 256 * 1024;
constexpr size_t WS_LIST = WS_GATE + 1 * MiB;
constexpr size_t WS_RSA = WS_LIST + 2 * MiB;
constexpr size_t WS_CNTB = WS_RSA + 2 * MiB;
constexpr size_t WS_RSROW = WS_CNTB + 64 * 1024;
constexpr size_t WS_SSQ1 = WS_RSROW + 64 * 1024;
constexpr size_t WS_ACS = WS_SSQ1 + 2 * MiB;
constexpr size_t WS_CD = WS_ACS + 512 * 1024;
constexpr size_t WS_END = WS_CD + 64 * 1024;
constexpr size_t WS_XC = WS_XBC;
constexpr size_t WS_ST = WS_YSSM;
constexpr size_t WS_HIN = WS_H2;
constexpr size_t WS_YB = WS_BIG;
constexpr int NROWS_MAX = NASSIGN + NEXP * 256;
constexpr int PJ = 2304, PJ_Z = 0, PJ_XBC = 512, PJ_Q = 1536, PJ_K = 2048, PJ_V = 2176;
constexpr int W1_P1_ITEMS = 14720;
constexpr int W2_P7_ITEMS = 5120;
constexpr int LDS_MISC = 146432;
constexpr int CW_CNT = 64;
#ifndef REP_MASK
#define REP_MASK 0
#endif
#ifndef RUNTIME_REP
#define RUNTIME_REP 1
#endif
#if RUNTIME_REP
#define PH_BEGIN(i) for (int rep_ = 0; rep_ <= ((p.rep_mask >> (i)) & 1); ++rep_) {
#else
#define PH_BEGIN(i) { constexpr int rep_ = 0; (void)rep_;
#endif
#define PH_END() }

struct Params { const float* in[N_IN]; float* out; unsigned char* ws; int rep_mask; int pad; };

DEVI float bperm(float v, int srclane) { return __int_as_float(__builtin_amdgcn_ds_bpermute(srclane << 2, __float_as_int(v))); }
DEVI int bperm_i(int v, int srclane) { return __builtin_amdgcn_ds_bpermute(srclane << 2, v); }
DEVI float xshfl(float v, int mask, int lane) { return bperm(v, lane ^ mask); }
DEVI float wave_sum(float v, int lane) {
#pragma unroll
    for (int o = 32; o > 0; o >>= 1) v += xshfl(v, o, lane);
    return v;
}
DEVI float wave_max(float v, int lane) {
#pragma unroll
    for (int o = 32; o > 0; o >>= 1) v = fmaxf(v, xshfl(v, o, lane));
    return v;
}
DEVI float silu_f(float x) { return x * __builtin_amdgcn_rcpf(1.f + __expf(-x)); }
DEVI float softplus_f(float x) { return fmaxf(x, 0.f) + log1pf(__expf(-fabsf(x))); }
DEVI float4 ld4(const float* p) { return *(const float4*)p; }
DEVI void st4(float* p, float4 v) { *(float4*)p = v; }


struct TI { int tid, lane, wave, gw, gtid; };
DEVI TI fresh_ti(int wave_id) { int l; asm volatile("v_mbcnt_lo_u32_b32 %0, -1, 0\n\tv_mbcnt_hi_u32_b32 %0, -1, %0" : "=v"(l)); TI r; r.lane = l; r.wave = wave_id; r.tid = wave_id * 64 + l; r.gw = blockIdx.x * 8 + wave_id; r.gtid = blockIdx.x * 512 + r.tid; return r; }
#define PHASE_IDS() const TI ti_ = fresh_ti(wave_id); const int tid = ti_.tid, lane = ti_.lane, wave = ti_.wave, gw = ti_.gw, gtid = ti_.gtid; (void)tid; (void)lane; (void)wave; (void)gw; (void)gtid
DEVI float bf2f(unsigned short v) { return __uint_as_float((unsigned)v << 16); }

#define XB_TMO      128
#define XB_XCNT(j)  (256  + 64 * (j))
#define XB_XSUB(j)  (1280 + 64 * (j))
#define XB_XGEN(j)  (2304 + 64 * (j))
#define XB_TOP      3328
#define XB_TOPGEN   3392
#define XCD_BAR_WORDS 3456
#define XB_SPIN_CAP (1u << 18)
DEVI unsigned xb_ld(unsigned* p)              { return __hip_atomic_load(p, __ATOMIC_RELAXED, __HIP_MEMORY_SCOPE_AGENT); }
DEVI unsigned xb_add(unsigned* p, unsigned v) { return __hip_atomic_fetch_add(p, v, __ATOMIC_RELAXED, __HIP_MEMORY_SCOPE_AGENT); }
DEVI unsigned xb_xcc_id() { return (unsigned)__builtin_amdgcn_s_getreg((3 << 11) | 20) & 0xFu; }
#define XB_SPIN(cond, bar) do { unsigned _sp = 0; while (cond) { __builtin_amdgcn_s_sleep(1); \
    if ((++_sp & 255u) == 0u) { if (xb_ld(&(bar)[XB_TMO])) break; if (_sp > XB_SPIN_CAP) { atomicAdd(&(bar)[XB_TMO], 1u); break; } } } } while (0)
struct XcdBarrier { unsigned* bar; unsigned x; volatile __attribute__((address_space(3))) unsigned* st; };
DEVI XcdBarrier xcd_barrier_post(unsigned* bar, volatile __attribute__((address_space(3))) unsigned* st, bool leader) {
    XcdBarrier b; b.bar = bar; b.x = xb_xcc_id(); b.st = st;
    if (leader) (void)xb_add(&bar[XB_XCNT(b.x)], 1u);
    return b;
}
DEVI void xcd_barrier_complete(unsigned* bar, unsigned x, unsigned& nloc, unsigned& nx) {
    const unsigned G = gridDim.x * gridDim.y * gridDim.z;
    unsigned sum, cnt, mine, sp = 0u;
    for (;;) {
        sum = 0u; cnt = 0u; mine = 0u;
#pragma unroll
        for (unsigned j = 0; j < 16; ++j) { const unsigned c = xb_ld(&bar[XB_XCNT(j)]); sum += c; cnt += (c > 0u) ? 1u : 0u; mine = (j == x) ? c : mine; }
        if (sum == G) break;
        __builtin_amdgcn_s_sleep(1);
        if ((++sp & 255u) == 0u) { if (xb_ld(&bar[XB_TMO])) break; if (sp > XB_SPIN_CAP) { atomicAdd(&bar[XB_TMO], 1u); break; } }
    }
    nloc = mine > 0u ? mine : 1u; nx = cnt > 0u ? cnt : 1u;
}
DEVI void xcd_barrier(const XcdBarrier& b, bool leader) {
    asm volatile("s_waitcnt vmcnt(0)" ::: "memory");
    __syncthreads();
    if (leader) {
        unsigned* bar = b.bar;
        __builtin_amdgcn_s_waitcnt(0);
        unsigned nloc = b.st[0], nx = b.st[1];
        if (nloc == 0u) { xcd_barrier_complete(bar, b.x, nloc, nx); b.st[0] = nloc; b.st[1] = nx; }
        const unsigned old = xb_add(&bar[XB_XSUB(b.x)], 1u);
        const unsigned gen = old / nloc;
        if (old + 1u == (gen + 1u) * nloc) {
            __builtin_amdgcn_fence(__ATOMIC_RELEASE, "agent");
            asm volatile("s_waitcnt vmcnt(0)" ::: "memory");
            const unsigned og = xb_add(&bar[XB_TOP], 1u);
            const unsigned tg = og / nx;
            if (og + 1u == (tg + 1u) * nx) xb_add(&bar[XB_TOPGEN], 1u);
            else XB_SPIN(xb_ld(&bar[XB_TOPGEN]) == tg, bar);
            __builtin_amdgcn_fence(__ATOMIC_ACQUIRE, "agent");
            xb_add(&bar[XB_XGEN(b.x)], 1u);
            asm volatile("s_waitcnt vmcnt(0)" ::: "memory");
        } else {
            XB_SPIN(xb_ld(&bar[XB_XGEN(b.x)]) == gen, bar);
            __builtin_amdgcn_fence(__ATOMIC_ACQUIRE, "agent");
            asm volatile("s_waitcnt vmcnt(0)" ::: "memory");
        }
    }
    __syncthreads();
}

namespace g8 {
#define G8_LAS __attribute__((address_space(3)))
typedef unsigned short bf16_t;
typedef short bf16x8 __attribute__((ext_vector_type(8)));
typedef float f32x4 __attribute__((ext_vector_type(4)));
typedef float f32x2 __attribute__((ext_vector_type(2)));
typedef unsigned u32x4 __attribute__((ext_vector_type(4)));
typedef unsigned u32x2 __attribute__((ext_vector_type(2)));
constexpr int BM = 256, BK = 64, HALF = 128, HTB = HALF * BK * 2, STAGE_BYTES = 8 * HTB;

DEVI int lds_byte(int r, int c) { const int st = (r >> 4) * 2 + (c >> 5), rr = r & 15, cc = c & 31, ob = rr * 64 + cc * 2; return st * 1024 + (ob ^ (((ob >> 9) & 1) << 5)); }
DEVI void stage_rc(int b, int& R, int& C) { const int st = b / 1024, sb = b % 1024, swz = sb ^ (((sb >> 9) & 1) << 5); R = (st >> 1) * 16 + swz / 64; C = (st & 1) * 32 + (swz % 64) / 2; }
DEVI int perm32(int rho) { const int n = rho >> 4, i = rho & 15; return 8 * (i >> 2) + 4 * n + (i & 3); }
typedef int v8i __attribute__((ext_vector_type(8)));
typedef int v4i __attribute__((ext_vector_type(4)));
DEVI v8i cat8(bf16x8 lo, bf16x8 hi) { const v4i a = __builtin_bit_cast(v4i, lo), b = __builtin_bit_cast(v4i, hi); return (v8i){a[0], a[1], a[2], a[3], b[0], b[1], b[2], b[3]}; }
DEVI unsigned pk4_fp8(float a, float b, float c, float d) { int w = 0; w = __builtin_amdgcn_cvt_pk_fp8_f32(a, b, w, false); w = __builtin_amdgcn_cvt_pk_fp8_f32(c, d, w, true); return (unsigned)w; }
typedef __bf16 bf16x2v __attribute__((ext_vector_type(2)));
DEVI unsigned cvt_pk_bf16(float lo, float hi) { const f32x2 v = {lo, hi}; const bf16x2v b = __builtin_convertvector(v, bf16x2v); return __builtin_bit_cast(unsigned, b); }

struct Unit {
    const int* alist;
    int acnt;
    int aoff;
    int arow0;
    unsigned boff;
    int orow0, ocol0;
    int e;
};


struct EpiSwiglu {
    static constexpr bool PERM = true;
    unsigned char* O; const float* bias; const float* rsa;
    DEVI void operator()(const f32x4 (&acc)[2][2][4][2], const Unit& u, int wr, int wc, int fr_, int fq_) const {
        int fr = fr_, fq = fq_; asm volatile("" : "+v"(fr), "+v"(fq));
        const int row0 = u.orow0 + wr * 64 + fr, col0 = u.ocol0 + wc * 32 + 8 * fq;
        const float* bp = bias + (size_t)u.e * 2048 + col0;
        f32x4 bv[2][2];
#pragma unroll
        for (int bj = 0; bj < 2; ++bj)
#pragma unroll
            for (int n = 0; n < 2; ++n) bv[bj][n] = *(const f32x4*)(bp + bj * HALF + 4 * n);
        float rsv[2][4];
#pragma unroll
        for (int ai = 0; ai < 2; ++ai)
#pragma unroll
            for (int m = 0; m < 4; ++m) { const int lr = wr * 64 + fr + ai * HALF + m * 16; rsv[ai][m] = rsa[u.aoff + min(lr, u.acnt - 1)]; }
        asm volatile("" : "+v"(rsv[0][0]), "+v"(rsv[0][1]), "+v"(rsv[0][2]), "+v"(rsv[0][3]), "+v"(rsv[1][0]), "+v"(rsv[1][1]), "+v"(rsv[1][2]), "+v"(rsv[1][3]));
#pragma unroll
        for (int ai = 0; ai < 2; ++ai)
#pragma unroll
            for (int m = 0; m < 4; ++m) { const int lr = wr * 64 + fr + ai * HALF + m * 16;
                const float rs = (lr < u.acnt) ? rsv[ai][m] * 0.03125f : 0.f;
                unsigned char* rowp = O + (size_t)(row0 + ai * HALF + m * 16) * 1024 + (col0 >> 1);
                float xg[8], xl[8], t[8];
#pragma unroll
                for (int bj = 0; bj < 2; ++bj)
#pragma unroll
                    for (int n = 0; n < 2; ++n) { const f32x4 v = acc[ai][bj][m][n] * rs + bv[bj][n]; const int q = bj * 4 + n * 2;
                        xg[q] = fminf(v[0], 7.f); xl[q] = fminf(fmaxf(v[1], -7.f), 7.f) + 1.f; xg[q + 1] = fminf(v[2], 7.f); xl[q + 1] = fminf(fmaxf(v[3], -7.f), 7.f) + 1.f; }
#pragma unroll
                for (int q = 0; q < 8; ++q) t[q] = __builtin_amdgcn_exp2f(xg[q] * -2.4554669595930157f);
#pragma unroll
                for (int q = 0; q < 8; ++q) t[q] = __builtin_amdgcn_rcpf(1.f + t[q]);
#pragma unroll
                for (int q = 0; q < 8; ++q) t[q] = (4.f * xg[q]) * t[q] * xl[q];
                *(unsigned*)(rowp) = pk4_fp8(t[0], t[1], t[2], t[3]);
                *(unsigned*)(rowp + HALF / 2) = pk4_fp8(t[4], t[5], t[6], t[7]); }
    }
};
struct EpiBf16 {
    static constexpr bool PERM = true;
    bf16_t* O; int ldc; const float* bias; int bias_stride; float scale;
    DEVI void operator()(const f32x4 (&acc)[2][2][4][2], const Unit& u, int wr, int wc, int fr_, int fq_) const {
        int fr = fr_, fq = fq_; asm volatile("" : "+v"(fr), "+v"(fq));
        const int row0 = u.orow0 + wr * 64 + fr, col0 = u.ocol0 + wc * 32 + 8 * fq;
        f32x4 bv[2][2];
#pragma unroll
        for (int bj = 0; bj < 2; ++bj)
#pragma unroll
            for (int n = 0; n < 2; ++n) bv[bj][n] = bias ? *(const f32x4*)(bias + (size_t)u.e * bias_stride + col0 + bj * HALF + 4 * n) : (f32x4){0.f, 0.f, 0.f, 0.f};
#pragma unroll
        for (int ai = 0; ai < 2; ++ai)
#pragma unroll
            for (int m = 0; m < 4; ++m) { bf16_t* rowp = O + (size_t)(row0 + ai * HALF + m * 16) * ldc + col0;
#pragma unroll
                for (int bj = 0; bj < 2; ++bj) { const f32x4 v0 = acc[ai][bj][m][0] * scale + bv[bj][0], v1 = acc[ai][bj][m][1] * scale + bv[bj][1];
                    u32x4 w; w.x = cvt_pk_bf16(v0[0], v0[1]); w.y = cvt_pk_bf16(v0[2], v0[3]); w.z = cvt_pk_bf16(v1[0], v1[1]); w.w = cvt_pk_bf16(v1[2], v1[3]);
                    *(u32x4*)(rowp + bj * HALF) = w; } }
    }
};

struct EpiFp8 {
    static constexpr bool PERM = true;
    unsigned char* O; const float* bias; float scale;
    DEVI void operator()(const f32x4 (&acc)[2][2][4][2], const Unit& u, int wr, int wc, int fr_, int fq_) const {
        int fr = fr_, fq = fq_; asm volatile("" : "+v"(fr), "+v"(fq));
        const int row0 = u.orow0 + wr * 64 + fr, col0 = u.ocol0 + wc * 32 + 8 * fq;
        f32x4 bv[2][2];
#pragma unroll
        for (int bj = 0; bj < 2; ++bj)
#pragma unroll
            for (int n = 0; n < 2; ++n) bv[bj][n] = *(const f32x4*)(bias + (size_t)u.e * 1024 + col0 + bj * HALF + 4 * n) * 16.f;
        const float sc = scale * 16.f;
#pragma unroll
        for (int ai = 0; ai < 2; ++ai)
#pragma unroll
            for (int m = 0; m < 4; ++m) { unsigned char* rowp = O + (size_t)(row0 + ai * HALF + m * 16) * 1024 + col0;
#pragma unroll
                for (int bj = 0; bj < 2; ++bj) { const f32x4 v0 = acc[ai][bj][m][0] * sc + bv[bj][0], v1 = acc[ai][bj][m][1] * sc + bv[bj][1];
                    u32x2 w; w.x = pk4_fp8(v0[0], v0[1], v0[2], v0[3]); w.y = pk4_fp8(v1[0], v1[1], v1[2], v1[3]);
                    *(u32x2*)(rowp + bj * HALF) = w; } }
    }
};
struct EpiBf16Dual {
    static constexpr bool PERM = true;
    bf16_t* O0; int ldc0; const float* bias0; bf16_t* O1; int ldc1;
    DEVI void operator()(const f32x4 (&acc)[2][2][4][2], const Unit& u, int wr, int wc, int fr_, int fq_) const {
        int fr = fr_, fq = fq_; asm volatile("" : "+v"(fr), "+v"(fq));
        const int row0 = u.orow0 + wr * 64 + fr, col0 = u.ocol0 + wc * 32 + 8 * fq;
        bf16_t* O = u.e ? O1 : O0; const int ldc = u.e ? ldc1 : ldc0; const float* bias = u.e ? nullptr : bias0;
        f32x4 bv[2][2];
#pragma unroll
        for (int bj = 0; bj < 2; ++bj)
#pragma unroll
            for (int n = 0; n < 2; ++n) bv[bj][n] = bias ? *(const f32x4*)(bias + col0 + bj * HALF + 4 * n) : (f32x4){0.f, 0.f, 0.f, 0.f};
#pragma unroll
        for (int ai = 0; ai < 2; ++ai)
#pragma unroll
            for (int m = 0; m < 4; ++m) { bf16_t* rowp = O + (size_t)(row0 + ai * HALF + m * 16) * ldc + col0;
#pragma unroll
                for (int bj = 0; bj < 2; ++bj) { const f32x4 v0 = acc[ai][bj][m][0] + bv[bj][0], v1 = acc[ai][bj][m][1] + bv[bj][1];
                    u32x4 w; w.x = cvt_pk_bf16(v0[0], v0[1]); w.y = cvt_pk_bf16(v0[2], v0[3]); w.z = cvt_pk_bf16(v1[0], v1[1]); w.w = cvt_pk_bf16(v1[2], v1[3]);
                    *(u32x4*)(rowp + bj * HALF) = w; } }
    }
};

struct EpiH1 {
    static constexpr bool PERM = false;
    const float* bias; const float* res; bf16_t* HB; float* SSQ;
    DEVI void operator()(const f32x4 (&acc)[2][2][4][2], const Unit& u, int wr, int wc, int fr_, int fq_) const {
        int fr = fr_, fq = fq_; asm volatile("" : "+v"(fr), "+v"(fq));
        const int row0 = u.orow0 + wr * 64 + fr, col0 = u.ocol0 + wc * 32 + 4 * fq;
        f32x4 bv[2][2];
#pragma unroll
        for (int bj = 0; bj < 2; ++bj)
#pragma unroll
            for (int n = 0; n < 2; ++n) bv[bj][n] = *(const f32x4*)(bias + col0 + bj * HALF + n * 16);
#pragma unroll
        for (int ai = 0; ai < 2; ++ai)
#pragma unroll
            for (int m = 0; m < 4; ++m) { const int row = row0 + ai * HALF + m * 16; const size_t off = (size_t)row * 1024 + col0;
#pragma unroll
                for (int bj = 0; bj < 2; ++bj) { float sq = 0.f;
#pragma unroll
                    for (int n = 0; n < 2; ++n) { const f32x4 h = acc[ai][bj][m][n] + bv[bj][n] + *(const f32x4*)(res + off + bj * HALF + n * 16);
                        sq += h[0] * h[0] + h[1] * h[1] + h[2] * h[2] + h[3] * h[3];
                        u32x2 w; w.x = cvt_pk_bf16(h[0], h[1]); w.y = cvt_pk_bf16(h[2], h[3]);
                        *(u32x2*)(HB + off + bj * HALF + n * 16) = w; }
                    sq += xshfl(sq, 16, fq * 16 + fr); sq += xshfl(sq, 32, fq * 16 + fr);
                    if (fq == 0) SSQ[(size_t)row * 32 + (u.ocol0 >> 8) * 8 + wc * 2 + bj] = sq; }
                if (m & 1) asm volatile("" ::: "memory"); }
    }
};
struct EpiH2 {
    static constexpr bool PERM = false;
    const bf16_t* res; bf16_t* HB; unsigned char* X8;
    DEVI void operator()(const f32x4 (&acc)[2][2][4][2], const Unit& u, int wr, int wc, int fr_, int fq_) const {
        int fr = fr_, fq = fq_; asm volatile("" : "+v"(fr), "+v"(fq));
        const int row0 = u.orow0 + wr * 64 + fr, col0 = u.ocol0 + wc * 32 + 4 * fq;
#pragma unroll
        for (int ai = 0; ai < 2; ++ai)
#pragma unroll
            for (int m = 0; m < 4; ++m) { const size_t off = (size_t)(row0 + ai * HALF + m * 16) * 1024 + col0;
#pragma unroll
                for (int bj = 0; bj < 2; ++bj)
#pragma unroll
                    for (int n = 0; n < 2; ++n) { const u32x2 r = *(const u32x2*)(res + off + bj * HALF + n * 16);
                        f32x4 h = acc[ai][bj][m][n];
                        h[0] += __uint_as_float(r.x << 16); h[1] += __uint_as_float(r.x & 0xffff0000u); h[2] += __uint_as_float(r.y << 16); h[3] += __uint_as_float(r.y & 0xffff0000u);
                        u32x2 w; w.x = cvt_pk_bf16(h[0], h[1]); w.y = cvt_pk_bf16(h[2], h[3]);
                        *(u32x2*)(HB + off + bj * HALF + n * 16) = w;
                        *(unsigned*)(X8 + off + bj * HALF + n * 16) = pk4_fp8(h[0], h[1], h[2], h[3]); }
                if (m & 1) asm volatile("" ::: "memory"); }
    }
};

template <class Epi, class Sched, bool FP8 = false>
DEVI void gemm_phase(G8_LAS unsigned char* lds, const void* A, const void* Bbase, int RP  , int ashift, const Sched& S, const Epi& E, int tid_) {
    int tid = tid_; asm volatile("" : "+v"(tid));
    const int wid = __builtin_amdgcn_readfirstlane(tid >> 6), lane = tid & 63, wr = wid >> 2, wc = wid & 3, fr = lane & 15, fq = lane >> 4;
    const int nt = RP / 128;
    unsigned voffB[2];
#pragma unroll
    for (int i = 0; i < 2; ++i) { int Rl, Cl; stage_rc(tid * 16 + i * 8192, Rl, Cl); const int Rb = Epi::PERM ? ((Rl & ~31) + perm32(Rl & 31)) : Rl;
        voffB[i] = (unsigned)(Rb * RP + Cl * 2); }
    const unsigned kstep = 128u;
    const unsigned hstep = (unsigned)(HALF * RP);
    const __amdgpu_buffer_rsrc_t rsA = __builtin_amdgcn_make_buffer_rsrc(const_cast<void*>(A), 0, 0x7fffffff, 0x00020000), rsB = __builtin_amdgcn_make_buffer_rsrc(const_cast<void*>(Bbase), 0, 0x7fffffff, 0x00020000);
    const unsigned ldsw = (unsigned)wid * 1024u;
    const int aoff = lds_byte(wr * 64 + fr, fq * 8), boff = lds_byte(wc * 32 + fr, fq * 8);
#define G8_AOFF(dst, u) do { int _t = tid; asm volatile("" : "+v"(_t)); int _R[2], _C[2]; _Pragma("unroll") for (int _i = 0; _i < 2; ++_i) stage_rc(_t * 16 + _i * 8192, _R[_i], _C[_i]); \
        if ((u).alist) { int _v[2][2];     \
            _Pragma("unroll") for (int _h = 0; _h < 2; ++_h) _Pragma("unroll") for (int _i = 0; _i < 2; ++_i) _v[_h][_i] = (u).alist[min(_h * HALF + _R[_i], (u).acnt - 1)]; \
            asm volatile("" : "+v"(_v[0][0]), "+v"(_v[0][1]), "+v"(_v[1][0]), "+v"(_v[1][1])); \
            _Pragma("unroll") for (int _h = 0; _h < 2; ++_h) _Pragma("unroll") for (int _i = 0; _i < 2; ++_i) dst[_h][_i] = (unsigned)((_v[_h][_i] >> ashift) * RP + _C[_i] * 2); } \
        else { _Pragma("unroll") for (int _h = 0; _h < 2; ++_h) _Pragma("unroll") for (int _i = 0; _i < 2; ++_i) dst[_h][_i] = (unsigned)(((u).arow0 + _h * HALF + _R[_i]) * RP + _C[_i] * 2); } } while (0)
#define G8_SA(b, h) (((b) * 2 + (h)) * HTB)
#define G8_SB(b, h) ((4 + (b) * 2 + (h)) * HTB)
#define G8_STAGE(bufoff, rsrc, soff, voff) do { _Pragma("unroll") for (int _i = 0; _i < 2; ++_i) \
        __builtin_amdgcn_raw_ptr_buffer_load_lds(rsrc, (G8_LAS unsigned*)(lds + (bufoff) + ldsw + _i * 8192), 16, (voff)[_i], (soff), 0, 0); } while (0)
#define G8_LDA(dst, b, h) do { if constexpr (FP8) { _Pragma("unroll") for (int m = 0; m < 4; ++m) { const v4i _lo = *(const G8_LAS v4i*)(lds + G8_SA(b, h) + aoff + m * 2048), _hi = *(const G8_LAS v4i*)(lds + G8_SA(b, h) + aoff + m * 2048 + 1024); dst##8[m] = __builtin_shufflevector(_lo, _hi, 0, 1, 2, 3, 4, 5, 6, 7); } } \
        else { _Pragma("unroll") for (int m = 0; m < 4; ++m) _Pragma("unroll") for (int k = 0; k < 2; ++k) dst[m][k] = *(const G8_LAS bf16x8*)(lds + G8_SA(b, h) + aoff + m * 2048 + k * 1024); } } while (0)
#define G8_LDB(dst, b, h) do { if constexpr (FP8) { _Pragma("unroll") for (int n = 0; n < 2; ++n) { const v4i _lo = *(const G8_LAS v4i*)(lds + G8_SB(b, h) + boff + n * 2048), _hi = *(const G8_LAS v4i*)(lds + G8_SB(b, h) + boff + n * 2048 + 1024); dst##8[n] = __builtin_shufflevector(_lo, _hi, 0, 1, 2, 3, 4, 5, 6, 7); } } \
        else { _Pragma("unroll") for (int n = 0; n < 2; ++n) _Pragma("unroll") for (int k = 0; k < 2; ++k) dst[n][k] = *(const G8_LAS bf16x8*)(lds + G8_SB(b, h) + boff + n * 2048 + k * 1024); } } while (0)
#define G8_MMA(ai, bj, At, Bt) do { __builtin_amdgcn_s_setprio(1); _Pragma("unroll") for (int m = 0; m < 4; ++m) _Pragma("unroll") for (int n = 0; n < 2; ++n) { \
        if constexpr (FP8) asm volatile("v_mfma_f32_16x16x128_f8f6f4 %0, %1, %2, %0" : "+v"(acc[ai][bj][m][n]) : "v"(Bt##8[n]), "v"(At##8[m])); \
        else { _Pragma("unroll") for (int k = 0; k < 2; ++k) asm volatile("v_mfma_f32_16x16x32_bf16 %0, %1, %2, %0" : "+v"(acc[ai][bj][m][n]) : "v"(Bt[n][k]), "v"(At[FP8 ? 0 : m][k])); } } __builtin_amdgcn_s_setprio(0); } while (0)
#define G8_WAIT_V(n) asm volatile("s_waitcnt vmcnt(" #n ")" ::: "memory")
#define G8_WAIT_L(n) asm volatile("s_waitcnt lgkmcnt(" #n ")" ::: "memory")
#define G8_BAR __builtin_amdgcn_s_barrier()
#define G8_SCHED __builtin_amdgcn_sched_barrier(0)
    Unit cur, nxt, nn; int ui = 0;
    if (!S.next(0, cur)) return;
    f32x4 acc[2][2][4][2];
#pragma unroll
    for (int a = 0; a < 2; ++a)
#pragma unroll
        for (int b = 0; b < 2; ++b)
#pragma unroll
            for (int m = 0; m < 4; ++m)
#pragma unroll
                for (int n = 0; n < 2; ++n) acc[a][b][m][n] = (f32x4){0.f, 0.f, 0.f, 0.f};
    bf16x8 At[FP8 ? 1 : 4][2], B0[2][2], B1[2][2];
    v8i At8[FP8 ? 4 : 1], B08[2], B18[2];
    unsigned cv[2][2], nv[2][2], fv[2][2];
    G8_AOFF(cv, cur);
    bool has_next = S.next(1, nxt);
    if (has_next) { G8_AOFF(nv, nxt); } else {
#pragma unroll
        for (int h = 0; h < 2; ++h)
#pragma unroll
            for (int i = 0; i < 2; ++i) nv[h][i] = cv[h][i]; }
    unsigned cB = cur.boff, nB = has_next ? nxt.boff : cB;
    G8_STAGE(G8_SB(0, 0), rsB, cB, voffB); G8_STAGE(G8_SB(0, 1), rsB, cB + hstep, voffB); G8_STAGE(G8_SA(0, 0), rsA, 0u, cv[0]); G8_STAGE(G8_SA(0, 1), rsA, 0u, cv[1]);
    if (wr == 1) G8_BAR;
    G8_WAIT_V(2); G8_BAR;
    G8_STAGE(G8_SB(1, 0), rsB, cB + kstep, voffB); G8_STAGE(G8_SA(1, 0), rsA, kstep, cv[0]); G8_STAGE(G8_SB(1, 1), rsB, cB + hstep + kstep, voffB);
    G8_WAIT_V(6); G8_BAR;
    for (;;) {
#pragma unroll 1
        for (int t = 0; t < nt; t += 2) {
            const bool last = (t == nt - 2);
            const unsigned k1 = (unsigned)(t + 1) * kstep;
            const unsigned k2 = last ? 0u : (unsigned)(t + 2) * kstep;
            const unsigned b2 = last ? nB : cB + (unsigned)(t + 2) * kstep, b3 = b2 + kstep;
            G8_LDB(B0, 0, 0); G8_LDB(B1, 0, 1); G8_SCHED; G8_LDA(At, 0, 0); G8_STAGE(G8_SA(1, 1), rsA, k1, cv[1]);
            G8_WAIT_V(8); G8_WAIT_L(0); G8_BAR; G8_MMA(0, 0, At, B0); G8_MMA(0, 1, At, B1); G8_BAR; G8_SCHED;
            G8_LDA(At, 0, 1); G8_STAGE(G8_SB(0, 0), rsB, b2, voffB); G8_STAGE(G8_SB(0, 1), rsB, b2 + hstep, voffB); { const unsigned sv_[2] = {last ? nv[0][0] : cv[0][0], last ? nv[0][1] : cv[0][1]}; G8_STAGE(G8_SA(0, 0), rsA, k2, sv_); }
            G8_WAIT_V(8); G8_WAIT_L(0); G8_BAR; G8_MMA(1, 0, At, B0); G8_MMA(1, 1, At, B1); G8_BAR; G8_SCHED;
            G8_LDB(B0, 1, 0); G8_LDB(B1, 1, 1); G8_SCHED; G8_LDA(At, 1, 0); { const unsigned sv_[2] = {last ? nv[1][0] : cv[1][0], last ? nv[1][1] : cv[1][1]}; G8_STAGE(G8_SA(0, 1), rsA, k2, sv_); }
            G8_WAIT_V(8); G8_WAIT_L(0); G8_BAR; G8_MMA(0, 0, At, B0); G8_MMA(0, 1, At, B1); G8_BAR; G8_SCHED;
            G8_LDA(At, 1, 1); G8_STAGE(G8_SB(1, 0), rsB, b3, voffB); G8_STAGE(G8_SB(1, 1), rsB, b3 + hstep, voffB); { const unsigned sv_[2] = {last ? nv[0][0] : cv[0][0], last ? nv[0][1] : cv[0][1]}; G8_STAGE(G8_SA(1, 0), rsA, k2 + kstep, sv_); }
            G8_WAIT_V(8); G8_WAIT_L(0); G8_BAR; G8_MMA(1, 0, At, B0); G8_MMA(1, 1, At, B1); G8_BAR; G8_SCHED;
        }
        asm volatile("s_nop 15\n\ts_nop 7" ::: "memory");
        if (wr == 0) G8_BAR;
        const bool has_nn = has_next && S.next(ui + 2, nn);
        if (has_nn) { G8_AOFF(fv, nn); }
        E(acc, cur, wr, wc, fr, fq);
        if (!has_next) break;
#pragma unroll
        for (int a = 0; a < 2; ++a)
#pragma unroll
            for (int b = 0; b < 2; ++b)
#pragma unroll
                for (int m = 0; m < 4; ++m)
#pragma unroll
                    for (int n = 0; n < 2; ++n) acc[a][b][m][n] = (f32x4){0.f, 0.f, 0.f, 0.f};
        cur = nxt; cB = nB; ++ui;
#pragma unroll
        for (int h = 0; h < 2; ++h)
#pragma unroll
            for (int i = 0; i < 2; ++i) { cv[h][i] = nv[h][i]; nv[h][i] = has_nn ? fv[h][i] : nv[h][i]; }
        has_next = has_nn; if (has_nn) { nxt = nn; nB = nn.boff; }
        if (wr == 1) G8_BAR;
    }
    G8_WAIT_V(0);
    G8_BAR;
#undef G8_AOFF
#undef G8_SA
#undef G8_SB
#undef G8_STAGE
#undef G8_LDA
#undef G8_LDB
#undef G8_MMA
#undef G8_WAIT_V
#undef G8_WAIT_L
#undef G8_BAR
#undef G8_SCHED
}

struct MoeSched {
    int nct, RP;
    const G8_LAS int* ut; const G8_LAS int* tp; const G8_LAS int* cnt;
    const int* list;
    const char* Bt; unsigned bt_estride;
    DEVI bool next(int i, Unit& u) const {
        if (i >= 32) return false;
        const int v = __builtin_amdgcn_readfirstlane(ut[i]);
        if (v < 0) return false;
        const int e = v & 255, rtg = (v >> 8) & 0xffff, ct = v >> 24;
        const int rt = rtg - __builtin_amdgcn_readfirstlane(tp[e]);
        u.e = e; u.orow0 = rtg * 256; u.ocol0 = ct * 256;
        u.boff = (unsigned)e * bt_estride + (unsigned)(ct * 256 * RP);
        if (list) { u.aoff = e * NTOK + rt * 256; u.alist = list + u.aoff; u.acnt = min(256, __builtin_amdgcn_readfirstlane(cnt[e]) - rt * 256); u.arow0 = 0; }
        else { u.alist = nullptr; u.acnt = 0; u.aoff = 0; u.arow0 = rtg * 256; }
        return true;
    }
};
DEVI void moe_units(G8_LAS int* ut, const G8_LAS int* tp, int nct, int G, int vcu, int tid) {
    if (tid < 32) {
        const int L = tid * G + vcu, total = tp[32] * nct; int v = -1;
        if (L < total) { const int rtg = L / nct, ct = L - rtg * nct; int e = 0;
            for (int k = 1; k < 32; ++k) e += (rtg >= tp[k]) ? 1 : 0;
            v = e | (rtg << 8) | (ct << 24); }
        ut[tid] = v;
    }
}
struct DenseSched {
    int G, c, RP, nM0, nN0; const char* Bt0; int nM1, nN1, arow1; const char* Bt1;
    DEVI bool next(int i, Unit& u) const {
        const int nwg = nM0 * nN0, L = i * G + c;
        u.alist = nullptr; u.acnt = 0; u.aoff = 0;
        if (L < nwg) {
            int wgid = L; { const int q = nwg / 8, r = nwg % 8, xcd = wgid % 8, off = wgid / 8; wgid = (xcd < r ? xcd * (q + 1) : r * (q + 1) + (xcd - r) * q) + off; }
            const int nig = 8 * nN0, gid = wgid / nig, fm = gid * 8, gsz = (nM0 - fm) < 8 ? (nM0 - fm) : 8;
            const int pm = fm + ((wgid % nig) % gsz), pn = (wgid % nig) / gsz;
            u.e = 0; u.arow0 = pm * 256; u.orow0 = pm * 256; u.ocol0 = pn * 256; u.boff = (unsigned)(pn * 256 * RP); return true;
        }
        const int l = L - nwg; if (l >= nM1 * nN1) return false;
        const int pm = l / nN1, pn = l - pm * nN1;
        u.e = 1; u.arow0 = arow1 + pm * 256; u.orow0 = pm * 256; u.ocol0 = pn * 256; u.boff = (unsigned)(Bt1 - Bt0) + (unsigned)(pn * 256 * RP); return true;
    }
};
}

DEVI unsigned f2bf(float f) { unsigned u = __builtin_bit_cast(unsigned, f); return (u + 0x7fffu + ((u >> 16) & 1u)) >> 16; }
DEVI unsigned pk2(float lo, float hi) { return f2bf(lo) | (f2bf(hi) << 16); }
typedef unsigned v4u __attribute__((ext_vector_type(4)));
DEVI void t8_load(const float* W, int N, int item, int ipe  , int lane, float4 (&v)[16]) {
    const int e = item / ipe, q = item - e * ipe, nblk = N / 64, kb = q / nblk, nb = q - kb * nblk;
    const float* src = W + (size_t)e * 1024 * N + (size_t)(64 * kb + (lane >> 4)) * N + 64 * nb + 4 * (lane & 15);
#pragma unroll
    for (int i = 0; i < 16; ++i) v[i] = *(const float4*)(src + (size_t)(4 * i) * N);
}
DEVI void t8_lds_write(const float4 (&v)[16], __attribute__((address_space(3))) float* scr, int lane) {
    const int kr = lane >> 4, c4 = lane & 15;
#pragma unroll
    for (int i = 0; i < 16; ++i) { __attribute__((address_space(3))) float* d = scr + (4 * i + kr) * 65 + 4 * c4; d[0] = v[i].x; d[1] = v[i].y; d[2] = v[i].z; d[3] = v[i].w; }
    asm volatile("s_waitcnt lgkmcnt(0)" ::: "memory");
}
DEVI void t8_pack_store(unsigned char* WT, int N, int item, int ipe, int lane, const __attribute__((address_space(3))) float* scr, const float* ks) {
    const int e = item / ipe, q = item - e * ipe, nblk = N / 64, kb = q / nblk, nb = q - kb * nblk, k0 = 64 * kb, n0 = 64 * nb;
    const int c = lane & 7, ns = lane >> 3;
    float kf[8];
#pragma unroll
    for (int q2 = 0; q2 < 8; ++q2) kf[q2] = 32.f * (ks ? ks[k0 + 8 * c + q2] : 1.f);
    unsigned char* dst = WT + (size_t)e * N * 1024 + (size_t)n0 * 1024 + k0 + 8 * c;
#pragma unroll
    for (int j = 0; j < 8; ++j) { const int n = ns + 8 * j; const __attribute__((address_space(3))) float* s = scr + (8 * c) * 65 + n;
        uint2 o; o.x = g8::pk4_fp8(kf[0] * s[0 * 65], kf[1] * s[1 * 65], kf[2] * s[2 * 65], kf[3] * s[3 * 65]); o.y = g8::pk4_fp8(kf[4] * s[4 * 65], kf[5] * s[5 * 65], kf[6] * s[6 * 65], kf[7] * s[7 * 65]);
        *(uint2*)(dst + (size_t)n * 1024) = o; }
    asm volatile("s_waitcnt lgkmcnt(0)" ::: "memory");
}
DEVI void t8_run(const float* W, int N, unsigned char* WT, const float* ks, int first, int end, int stride, int lane, __attribute__((address_space(3))) float* scr) {
    const int ipe = 16 * (N / 64);
    float4 v[16];
    int it = first;
    if (it < end) t8_load(W, N, it, ipe, lane, v);
    while (it < end) {
        t8_lds_write(v, scr, lane);
        const int nx = it + stride;
        if (nx < end) t8_load(W, N, nx, ipe, lane, v);
        t8_pack_store(WT, N, it, ipe, lane, scr, ks);
        it = nx;
    }
}
DEVI void transpose_item(const float* W, int K, int N, unsigned short* WT, __attribute__((address_space(3))) float* scr, int item, int lane, int ncols = 0, const float* ks = nullptr) {
    const int nblk = (ncols ? ncols : N) / 64, kb = item / nblk, nb = item % nblk, k0 = 64 * kb, n0 = 64 * nb;
    const int kr = lane >> 4, c4 = lane & 15;
    float4 v[16];
#pragma unroll
    for (int i = 0; i < 16; ++i) v[i] = *(const float4*)(W + (size_t)(k0 + 4 * i + kr) * N + n0 + 4 * c4);
#pragma unroll
    for (int i = 0; i < 16; ++i) { __attribute__((address_space(3))) float* d = scr + (4 * i + kr) * 65 + 4 * c4; d[0] = v[i].x; d[1] = v[i].y; d[2] = v[i].z; d[3] = v[i].w; }
    asm volatile("s_waitcnt lgkmcnt(0)" ::: "memory");
    const int c = lane & 7, ns = lane >> 3;
    float kf[8];
#pragma unroll
    for (int q = 0; q < 8; ++q) kf[q] = ks ? ks[k0 + 8 * c + q] : 1.f;
#pragma unroll
    for (int j = 0; j < 8; ++j) { const int n = ns + 8 * j; const __attribute__((address_space(3))) float* s = scr + (8 * c) * 65 + n;
        v4u o; o.x = pk2(kf[0] * s[0 * 65], kf[1] * s[1 * 65]); o.y = pk2(kf[2] * s[2 * 65], kf[3] * s[3 * 65]); o.z = pk2(kf[4] * s[4 * 65], kf[5] * s[5 * 65]); o.w = pk2(kf[6] * s[6 * 65], kf[7] * s[7 * 65]);
        *(v4u*)(WT + (size_t)(n0 + n) * K + k0 + 8 * c) = o; }
    asm volatile("s_waitcnt lgkmcnt(0)" ::: "memory");
}

#define LAS3 __attribute__((address_space(3)))

typedef float f32x16 __attribute__((ext_vector_type(16)));
typedef short bf16x8_t __attribute__((ext_vector_type(8)));
typedef float f32x2_t __attribute__((ext_vector_type(2)));
typedef __bf16 bf16x2_t __attribute__((ext_vector_type(2)));
typedef unsigned u32x4_t __attribute__((ext_vector_type(4)));
typedef unsigned u32x2_t __attribute__((ext_vector_type(2)));
#define MFMA32(a, b, c) __builtin_amdgcn_mfma_f32_32x32x16_bf16((a), (b), (c), 0, 0, 0)
DEVI unsigned cvtpk(float lo, float hi) { f32x2_t v = {lo, hi}; bf16x2_t b = __builtin_convertvector(v, bf16x2_t); return __builtin_bit_cast(unsigned, b); }
DEVI int crow(int reg, int hi) { return (reg & 3) + 8 * (reg >> 2) + 4 * hi; }
DEVI bf16x8_t pack_step(const f32x16& x, int s) {
    u32x4_t p; p[0] = cvtpk(x[8 * s], x[8 * s + 1]); p[1] = cvtpk(x[8 * s + 2], x[8 * s + 3]); p[2] = cvtpk(x[8 * s + 4], x[8 * s + 5]); p[3] = cvtpk(x[8 * s + 6], x[8 * s + 7]);
    return __builtin_bit_cast(bf16x8_t, p);
}
DEVI int t5_bucket(int d) { return d < 16 ? d : min(31, 16 + (int)(log2f((float)d * 0.0625f) * (16.f / 3.f))); }

DEVI void swa_item(int item, const unsigned short* PROJB, unsigned short* MIXB, const float* relb, const float* sinks, LAS3 unsigned char* L, int tid_) {
    int tid = tid_; asm volatile("" : "+v"(tid));
    const int kv = item & 1, qb = (item >> 1) & 63, b = item >> 7;
    const int lane = tid & 63, w = __builtin_amdgcn_readfirstlane(tid >> 6), hi = lane >> 5, r32 = lane & 31;
    LAS3 unsigned char* KL = L; LAS3 unsigned char* VT = L + 36864; LAS3 float* BT = (LAS3 float*)(L + 36864 + 33280);
    const long tok0 = (long)b * SEQ + (long)(qb - 1) * 128;
#pragma unroll
    for (int i = 0; i < 4; ++i) { const int ci = tid + 512 * i, row = ci >> 3, ch = ci & 7; const bool ok = (qb > 0) || (row >= 128);
        u32x4_t v = {0u, 0u, 0u, 0u}; if (ok) v = *(const u32x4_t*)(PROJB + (size_t)(tok0 + row) * PJ + PJ_K + kv * 64 + ch * 8);
        *(LAS3 u32x4_t*)(KL + row * 144 + ch * 16) = v; }
#pragma unroll
    for (int i = 0; i < 2; ++i) { const int it = tid + 512 * i, rp = it >> 3, ch = it & 7; const bool ok = (qb > 0) || (rp >= 64);
        u32x4_t v0 = {0u, 0u, 0u, 0u}, v1 = {0u, 0u, 0u, 0u};
        if (ok) { const unsigned short* vp = PROJB + (size_t)(tok0 + 2 * rp) * PJ + PJ_V + kv * 64 + ch * 8; v0 = *(const u32x4_t*)vp; v1 = *(const u32x4_t*)(vp + PJ); }
#pragma unroll
        for (int e = 0; e < 8; ++e) { const unsigned a = (e & 1) ? (v0[e >> 1] >> 16) : (v0[e >> 1] & 0xffffu), c = (e & 1) ? (v1[e >> 1] & 0xffff0000u) : (v1[e >> 1] << 16);
            *(LAS3 unsigned*)(VT + (ch * 8 + e) * 520 + rp * 4) = a | c; } }
    { const int hql = tid >> 7, d = tid & 127; BT[tid] = relb[t5_bucket(d) * 8 + kv * 4 + hql]; }
    __syncthreads();
    const int hql = w >> 1, hq = kv * 4 + hql, qhalf = w & 1;
    const float sink = sinks[hq];
#pragma unroll 1
    for (int qi = 0; qi < 2; ++qi) {
        const int m = 2 * qhalf + qi, qf0 = 128 + 32 * m;
        const size_t qrow0 = (size_t)b * SEQ + (size_t)qb * 128 + 32 * m;
        const unsigned short* qp = PROJB + (qrow0 + r32) * PJ + PJ_Q + hq * 64 + 8 * hi;
        bf16x8_t qf[4];
#pragma unroll
        for (int ks = 0; ks < 4; ++ks) qf[ks] = *(const bf16x8_t*)(qp + 16 * ks);
        f32x16 S[5];
#pragma unroll
        for (int kk = 0; kk < 5; ++kk) {
#pragma unroll
            for (int r = 0; r < 16; ++r) S[kk][r] = 0.f;
#pragma unroll
            for (int ks = 0; ks < 4; ++ks) { const bf16x8_t a = *(const LAS3 bf16x8_t*)(KL + (32 * (m + kk) + r32) * 144 + (16 * ks + 8 * hi) * 2); S[kk] = MFMA32(a, qf[ks], S[kk]); }
        }
        float mx = sink;
#pragma unroll
        for (int kk = 0; kk < 5; ++kk)
#pragma unroll
            for (int r = 0; r < 16; ++r) { const int kf = 32 * (m + kk) + crow(r, hi), dist = qf0 + r32 - kf; const bool ok = (dist >= 0) && (dist < 128) && ((qb > 0) || (kf >= 128));
                const float sc = ok ? S[kk][r] * 0.125f + BT[hql * 128 + (dist & 127)] : -INFINITY; S[kk][r] = sc; mx = fmaxf(mx, sc); }
        mx = fmaxf(mx, xshfl(mx, 32, lane));
        float sum = 0.f;
#pragma unroll
        for (int kk = 0; kk < 5; ++kk)
#pragma unroll
            for (int r = 0; r < 16; ++r) { const float pe = __expf(S[kk][r] - mx); S[kk][r] = pe; sum += pe; }
        sum += xshfl(sum, 32, lane); sum += __expf(sink - mx);
        const float linv = 1.f / sum;
        f32x16 O[2];
#pragma unroll
        for (int db = 0; db < 2; ++db)
#pragma unroll
            for (int r = 0; r < 16; ++r) O[db][r] = 0.f;
#pragma unroll
        for (int kk = 0; kk < 5; ++kk)
#pragma unroll
            for (int s2 = 0; s2 < 2; ++s2) { const bf16x8_t pa = pack_step(S[kk], s2); const int kbase = 32 * (m + kk) + 16 * s2 + 4 * hi;
#pragma unroll
                for (int db = 0; db < 2; ++db) { LAS3 unsigned char* vp = VT + (32 * db + r32) * 520 + kbase * 2;
                    const u32x2_t lo = *(const LAS3 u32x2_t*)vp, hi2 = *(const LAS3 u32x2_t*)(vp + 16);
                    const u32x4_t vv = {lo[0], lo[1], hi2[0], hi2[1]};
                    O[db] = MFMA32(pa, __builtin_bit_cast(bf16x8_t, vv), O[db]); } }
#pragma unroll
        for (int r = 0; r < 16; ++r) { const int q = crow(r, hi); const float li = bperm(linv, q);
            unsigned short* op = MIXB + (qrow0 + q) * 1024 + 512 + hq * 64 + r32;
            op[0] = (unsigned short)(cvtpk(O[0][r] * li, 0.f) & 0xffffu); op[32] = (unsigned short)(cvtpk(O[1][r] * li, 0.f) & 0xffffu); }
    }
    __syncthreads();
}

DEVI void xattn_item(int item, const unsigned short* QCB, const unsigned short* KVMB, const float* SSQ, unsigned short* OCB, LAS3 unsigned char* L, int tid_) {
    int tid = tid_; asm volatile("" : "+v"(tid));
    const int qblk = item & 31, hd = (item >> 5) & 3, b = item >> 7;
    const int lane = tid & 63, w = __builtin_amdgcn_readfirstlane(tid >> 6), hi = lane >> 5, r32 = lane & 31;
    LAS3 unsigned char* KL = L; LAS3 unsigned char* VT = L + 69632;
    const unsigned short* kvb = KVMB + (size_t)b * MEMLEN * 1024 + hd * 128;
#pragma unroll
    for (int i = 0; i < 8; ++i) { const int ci = tid + 512 * i, row = ci >> 4, ch = ci & 15;
        *(LAS3 u32x4_t*)(KL + row * 272 + ch * 16) = *(const u32x4_t*)(kvb + (size_t)row * 1024 + ch * 8); }
#pragma unroll
    for (int i = 0; i < 4; ++i) { const int it = tid + 512 * i, rp = it >> 4, ch = it & 15;
        const unsigned short* vp = kvb + (size_t)(2 * rp) * 1024 + 512 + ch * 8; const u32x4_t v0 = *(const u32x4_t*)vp, v1 = *(const u32x4_t*)(vp + 1024);
#pragma unroll
        for (int e = 0; e < 8; ++e) { const unsigned a = (e & 1) ? (v0[e >> 1] >> 16) : (v0[e >> 1] & 0xffffu), c = (e & 1) ? (v1[e >> 1] & 0xffff0000u) : (v1[e >> 1] << 16);
            *(LAS3 unsigned*)(VT + (ch * 8 + e) * 520 + rp * 4) = a | c; } }
    __syncthreads();
    const size_t qrow0 = (size_t)b * SEQ + (size_t)qblk * 256 + 32 * w;
    const unsigned short* qp = QCB + (qrow0 + r32) * 512 + hd * 128 + 8 * hi;
    f32x16 S[8];
    {
        bf16x8_t qf[8];
#pragma unroll
        for (int ks = 0; ks < 8; ++ks) qf[ks] = *(const bf16x8_t*)(qp + 16 * ks);
#pragma unroll
        for (int kk = 0; kk < 8; ++kk) {
#pragma unroll
            for (int r = 0; r < 16; ++r) S[kk][r] = 0.f;
#pragma unroll
            for (int ks = 0; ks < 8; ++ks) { const bf16x8_t a = *(const LAS3 bf16x8_t*)(KL + (32 * kk + r32) * 272 + (16 * ks + 8 * hi) * 2); S[kk] = MFMA32(a, qf[ks], S[kk]); }
        }
    }
    float sc = 0.08838834764831845f;
    {
        const float* sp = SSQ + (qrow0 + r32) * 32; float t = 0.f;
#pragma unroll
        for (int i = 0; i < 8; ++i) { const float4 v = ld4(sp + 4 * i); t += (v.x + v.y) + (v.z + v.w); }
        sc *= rsqrtf(t * (1.f / 1024.f) + EPS);
    }
    float mx = -INFINITY;
#pragma unroll
    for (int kk = 0; kk < 8; ++kk)
#pragma unroll
        for (int r = 0; r < 16; ++r) mx = fmaxf(mx, S[kk][r]);
    mx = fmaxf(mx, xshfl(mx, 32, lane));
    float sum = 0.f;
#pragma unroll
    for (int kk = 0; kk < 8; ++kk)
#pragma unroll
        for (int r = 0; r < 16; ++r) { const float pe = __expf((S[kk][r] - mx) * sc); S[kk][r] = pe; sum += pe; }
    sum += xshfl(sum, 32, lane);
    const float linv = 1.f / sum;
    f32x16 O[4];
#pragma unroll
    for (int db = 0; db < 4; ++db)
#pragma unroll
        for (int r = 0; r < 16; ++r) O[db][r] = 0.f;
#pragma unroll
    for (int kk = 0; kk < 8; ++kk)
#pragma unroll
        for (int s2 = 0; s2 < 2; ++s2) { const bf16x8_t pa = pack_step(S[kk], s2); const int kbase = 32 * kk + 16 * s2 + 4 * hi;
#pragma unroll
            for (int db = 0; db < 4; ++db) { LAS3 unsigned char* vp = VT + (32 * db + r32) * 520 + kbase * 2;
                const u32x2_t lo = *(const LAS3 u32x2_t*)vp, hi2 = *(const LAS3 u32x2_t*)(vp + 16);
                const u32x4_t vv = {lo[0], lo[1], hi2[0], hi2[1]};
                O[db] = MFMA32(pa, __builtin_bit_cast(bf16x8_t, vv), O[db]); } }
#pragma unroll
    for (int r = 0; r < 16; ++r) { const int q = crow(r, hi); const float li = bperm(linv, q);
        unsigned short* op = OCB + (qrow0 + q) * 512 + hd * 128 + r32;
#pragma unroll
        for (int db = 0; db < 4; ++db) op[32 * db] = (unsigned short)(cvtpk(O[db][r] * li, 0.f) & 0xffffu); }
    __syncthreads();
}


DEVI void ssd_s1_item(int item, const unsigned short* PROJB, const float* DTRAW, const float* convw, const float* convb, const float* dtbias, const float* alog,
                      unsigned short* XC, float* DT, float* ACS, float* CD, float* ST, LAS3 unsigned char* L, int tid_) {
    int tid = tid_; asm volatile("" : "+v"(tid));
    const int g = item & 1, c = (item >> 1) & 63, b = item >> 7;
    const int lane = tid & 63, w = __builtin_amdgcn_readfirstlane(tid >> 6), hi = lane >> 5, r32 = lane & 31;
    LAS3 unsigned char* XwT = L; LAS3 unsigned char* BT = L + 69632;
    LAS3 float* dts = (LAS3 float*)(L + 104448); LAS3 float* acs = dts + 512; LAS3 float* wts = acs + 512;
    const size_t tok0 = (size_t)b * SEQ + (size_t)c * 128;
    if (w < 4) {
        const int h = 4 * g + w; const float ah = -__expf(alog[h]), db = dtbias[h];
        const float d0 = softplus_f(DTRAW[(tok0 + 2 * lane) * 8 + h] + db), d1 = softplus_f(DTRAW[(tok0 + 2 * lane + 1) * 8 + h] + db);
        const float a0 = d0 * ah, a1 = d1 * ah;
        float sc = a0 + a1;
#pragma unroll
        for (int o = 1; o < 64; o <<= 1) { const float v = bperm(sc, lane - o); if (lane >= o) sc += v; }
        const float ex = sc - (a0 + a1), c0 = ex + a0, c1 = ex + a0 + a1, cend = bperm(sc, 63);
        dts[w * 128 + 2 * lane] = d0; dts[w * 128 + 2 * lane + 1] = d1; acs[w * 128 + 2 * lane] = c0; acs[w * 128 + 2 * lane + 1] = c1;
        wts[w * 128 + 2 * lane] = __expf(cend - c0) * d0; wts[w * 128 + 2 * lane + 1] = __expf(cend - c1) * d1;
        DT[(tok0 + 2 * lane) * 8 + h] = d0; DT[(tok0 + 2 * lane + 1) * 8 + h] = d1; ACS[(tok0 + 2 * lane) * 8 + h] = c0; ACS[(tok0 + 2 * lane + 1) * 8 + h] = c1;
        if (lane == 0) CD[((size_t)b * 64 + c) * 8 + h] = __expf(cend);
    }
    __syncthreads();
    {
        const int cg = lane, ch = cg < 32 ? g * 256 + cg * 8 : (cg < 48 ? 512 + g * 128 + (cg - 32) * 8 : 768 + g * 128 + (cg - 48) * 8);
        float wk[4][8], bb[8];
#pragma unroll
        for (int k = 0; k < 4; ++k) { const float4 a = ld4(convw + k * CONVCH + ch), d = ld4(convw + k * CONVCH + ch + 4); wk[k][0] = a.x; wk[k][1] = a.y; wk[k][2] = a.z; wk[k][3] = a.w; wk[k][4] = d.x; wk[k][5] = d.y; wk[k][6] = d.z; wk[k][7] = d.w; }
        { const float4 a = ld4(convb + ch), d = ld4(convb + ch + 4); bb[0] = a.x; bb[1] = a.y; bb[2] = a.z; bb[3] = a.w; bb[4] = d.x; bb[5] = d.y; bb[6] = d.z; bb[7] = d.w; }
        const int s0 = w * 16;
        const unsigned short* src = PROJB + (tok0 + s0) * PJ + PJ_XBC + ch;
        u32x4_t rw[19];
#pragma unroll
        for (int i = 0; i < 19; ++i) { const bool ok = (c > 0) || (s0 + i - 3 >= 0); rw[i] = (u32x4_t){0u, 0u, 0u, 0u}; if (ok) rw[i] = *(const u32x4_t*)(src + (ptrdiff_t)(i - 3) * PJ); }
        const int hl = cg >> 3;
#pragma unroll
        for (int i2 = 0; i2 < 8; ++i2) {
            float y[2][8];
#pragma unroll
            for (int q = 0; q < 2; ++q) {
                const int i = 2 * i2 + q;
#pragma unroll
                for (int e = 0; e < 8; ++e) { float a = bb[e];
#pragma unroll
                    for (int k = 0; k < 4; ++k) { const unsigned wd = rw[i + k][e >> 1]; a += wk[k][e] * __uint_as_float((e & 1) ? (wd & 0xffff0000u) : (wd << 16)); }
                    y[q][e] = silu_f(a); }
                u32x4_t o; o[0] = cvtpk(y[q][0], y[q][1]); o[1] = cvtpk(y[q][2], y[q][3]); o[2] = cvtpk(y[q][4], y[q][5]); o[3] = cvtpk(y[q][6], y[q][7]);
                *(u32x4_t*)(XC + (tok0 + s0 + i) * 1024 + ch) = o;
            }
            const int s = s0 + 2 * i2;
            if (cg < 32) { const float w0 = wts[hl * 128 + s], w1 = wts[hl * 128 + s + 1];
#pragma unroll
                for (int e = 0; e < 8; ++e) *(LAS3 unsigned*)(XwT + hl * 17408 + ((cg & 7) * 8 + e) * 272 + ((((s >> 3) ^ (cg & 7)) & 15) << 4) + (s & 7) * 2) = cvtpk(y[0][e] * w0, y[1][e] * w1); }
            else if (cg < 48) {
#pragma unroll
                for (int e = 0; e < 8; ++e) *(LAS3 unsigned*)(BT + ((cg - 32) * 8 + e) * 272 + ((((s >> 3) ^ ((cg - 32) & 7)) & 15) << 4) + (s & 7) * 2) = cvtpk(y[0][e], y[1][e]); }
        }
    }
    __syncthreads();
    {
        const int pb = w >> 2, nb = w & 3;
#pragma unroll 1
        for (int hl = 0; hl < 4; ++hl) {
            f32x16 acc;
#pragma unroll
            for (int r = 0; r < 16; ++r) acc[r] = 0.f;
#pragma unroll
            for (int ks = 0; ks < 8; ++ks) { const bf16x8_t a = *(const LAS3 bf16x8_t*)(XwT + hl * 17408 + (32 * pb + r32) * 272 + (((2 * ks + hi) ^ ((r32 >> 3) + 4 * pb)) & 15) * 16);
                const bf16x8_t bq = *(const LAS3 bf16x8_t*)(BT + (32 * nb + r32) * 272 + (((2 * ks + hi) ^ (((r32 >> 3) + 4 * nb) & 7)) & 15) * 16); acc = MFMA32(a, bq, acc); }
            float* sp = ST + (((size_t)b * 64 + c) * 8 + 4 * g + hl) * 8192 + 32 * nb + r32;
#pragma unroll
            for (int r = 0; r < 16; ++r) sp[(32 * pb + crow(r, hi)) * 128] = acc[r];
        }
    }
    __syncthreads();
}

DEVI void ssd_s3_item(int item, const unsigned short* XC, const float* DT, const float* ACS, const unsigned short* HIN, const unsigned short* PROJB, const float* dskip, const float* gssm,
                      float* YPRE, unsigned short* MIXB, LAS3 unsigned char* L, int tid_) {
    int tid = tid_; asm volatile("" : "+v"(tid));
    const int g = item & 1, c = (item >> 1) & 63, b = item >> 7;
    const int lane = tid & 63, w = __builtin_amdgcn_readfirstlane(tid >> 6), hi = lane >> 5, r32 = lane & 31;
    LAS3 unsigned char* Cs = L; LAS3 unsigned char* BM = L + 34816; LAS3 unsigned char* XT = L + 69632; LAS3 unsigned char* HN = L + 87040;
    LAS3 float* dts = (LAS3 float*)(L + 104448); LAS3 float* acs = dts + 512; LAS3 float* rowsq = acs + 512;
    const size_t tok0 = (size_t)b * SEQ + (size_t)c * 128;
#pragma unroll
    for (int i = 0; i < 4; ++i) { const int ci = tid + 512 * i, row = ci >> 4, chk = ci & 15;
        *(LAS3 u32x4_t*)(Cs + row * 272 + chk * 16) = *(const u32x4_t*)(XC + (tok0 + row) * 1024 + 768 + g * 128 + chk * 8);
        *(LAS3 u32x4_t*)(BM + row * 272 + chk * 16) = *(const u32x4_t*)(XC + (tok0 + row) * 1024 + 512 + g * 128 + chk * 8); }
    { const int t = tid >> 2, hl = tid & 3; dts[hl * 128 + t] = DT[(tok0 + t) * 8 + 4 * g + hl]; acs[hl * 128 + t] = ACS[(tok0 + t) * 8 + 4 * g + hl]; }
    __syncthreads();
    const int lb = w >> 1;
    f32x16 CB[2];
#pragma unroll
    for (int j = 0; j < 2; ++j) {
#pragma unroll
        for (int r = 0; r < 16; ++r) CB[j][r] = 0.f;
        const int sb = 2 * (w & 1) + j;
        if (sb <= lb) {
#pragma unroll
            for (int ks = 0; ks < 8; ++ks) { const bf16x8_t a = *(const LAS3 bf16x8_t*)(Cs + (32 * lb + r32) * 272 + (16 * ks + 8 * hi) * 2);
                const bf16x8_t bq = *(const LAS3 bf16x8_t*)(BM + (32 * sb + r32) * 272 + (16 * ks + 8 * hi) * 2); CB[j] = MFMA32(a, bq, CB[j]); }
        }
    }
    __syncthreads();
    const int pb = w & 1;
    LAS3 unsigned char* ZS = L + 110592;
    float sq[16];
#pragma unroll
    for (int r = 0; r < 16; ++r) sq[r] = 0.f;
#pragma unroll 1
    for (int hl = 0; hl < 4; ++hl) {
        const int h = 4 * g + hl;
        {
            const int sp = tid >> 3, chk = tid & 7;
            const unsigned short* xp = XC + (tok0 + 2 * sp) * 1024 + h * 64 + chk * 8; const u32x4_t v0 = *(const u32x4_t*)xp, v1 = *(const u32x4_t*)(xp + 1024);
#pragma unroll
            for (int e = 0; e < 8; ++e) { const unsigned a = (e & 1) ? (v0[e >> 1] >> 16) : (v0[e >> 1] & 0xffffu), d = (e & 1) ? (v1[e >> 1] & 0xffff0000u) : (v1[e >> 1] << 16);
                *(LAS3 unsigned*)(XT + (chk * 8 + e) * 272 + ((((sp >> 2) ^ chk) & 15) << 4) + (sp & 3) * 4) = a | d; }
            const unsigned short* hp = HIN + (((size_t)b * 64 + c) * 8 + h) * 8192;
#pragma unroll
            for (int i = 0; i < 2; ++i) { const int ci = tid + 512 * i, row = ci >> 4, ck = ci & 15; *(LAS3 u32x4_t*)(HN + row * 272 + ck * 16) = *(const u32x4_t*)(hp + row * 128 + ck * 8); }
#pragma unroll
            for (int i = 0; i < 2; ++i) { const int ci = tid + 512 * i, row = ci >> 3, ck = ci & 7; *(LAS3 u32x4_t*)(ZS + row * 144 + ck * 16) = *(const u32x4_t*)(PROJB + (tok0 + row) * PJ + PJ_Z + h * 64 + ck * 8); }
        }
#pragma unroll
        for (int j = 0; j < 2; ++j) { const int sb = 2 * (w & 1) + j;
            if (sb <= lb) { const int s = 32 * sb + r32; const float as = acs[hl * 128 + s], ds = dts[hl * 128 + s];
#pragma unroll
                for (int r = 0; r < 16; ++r) { const int l = 32 * lb + crow(r, hi); const float ev = CB[j][r] * __expf(acs[hl * 128 + l] - as) * ds; const float v = (s <= l) ? ev : 0.f;
                    *(LAS3 unsigned short*)(BM + l * 272 + s * 2) = (unsigned short)(cvtpk(v, 0.f) & 0xffffu); } } }
        __syncthreads();
        f32x16 acc;
#pragma unroll
        for (int r = 0; r < 16; ++r) acc[r] = 0.f;
#pragma unroll
        for (int ks = 0; ks < 8; ++ks) { const bf16x8_t a = *(const LAS3 bf16x8_t*)(Cs + (32 * lb + r32) * 272 + (16 * ks + 8 * hi) * 2);
            const bf16x8_t bq = *(const LAS3 bf16x8_t*)(HN + (32 * pb + r32) * 272 + (16 * ks + 8 * hi) * 2); acc = MFMA32(a, bq, acc); }
#pragma unroll
        for (int r = 0; r < 16; ++r) acc[r] *= __expf(acs[hl * 128 + 32 * lb + crow(r, hi)]);
#pragma unroll
        for (int ks = 0; ks < 8; ++ks) if (ks < 2 * (lb + 1)) { const bf16x8_t a = *(const LAS3 bf16x8_t*)(BM + (32 * lb + r32) * 272 + (16 * ks + 8 * hi) * 2);
            const bf16x8_t bq = *(const LAS3 bf16x8_t*)(XT + (32 * pb + r32) * 272 + (((2 * ks + hi) ^ ((r32 >> 3) + 4 * pb)) & 15) * 16); acc = MFMA32(a, bq, acc); }
        const float dsk = dskip[h]; const int pc = 32 * pb + r32;
        unsigned short* yp = (unsigned short*)YPRE + tok0 * 512 + h * 64 + pc;
#pragma unroll
        for (int r = 0; r < 16; ++r) { const int l = 32 * lb + crow(r, hi);
            const float xv = bf2f(*(const LAS3 unsigned short*)(XT + pc * 272 + ((((l >> 3) ^ (pc >> 3)) & 15) << 4) + (l & 7) * 2)), z = bf2f(*(const LAS3 unsigned short*)(ZS + l * 144 + pc * 2));
            const float y = (acc[r] + dsk * xv) * silu_f(z); yp[l * 512] = (unsigned short)(cvtpk(y, 0.f) & 0xffffu); sq[r] += y * y; }
        __syncthreads();
    }
#pragma unroll
    for (int r = 0; r < 16; ++r) { float v = sq[r];
#pragma unroll
        for (int o = 1; o < 32; o <<= 1) v += xshfl(v, o, lane);
        if (r32 == 0) rowsq[(32 * lb + crow(r, hi)) * 2 + pb] = v; }
    __syncthreads();
#pragma unroll 1
    for (int hl = 0; hl < 4; ++hl) { const int col = (4 * g + hl) * 64 + 32 * pb + r32; const float gs = gssm[col];
#pragma unroll
        for (int r = 0; r < 16; ++r) { const int l = 32 * lb + crow(r, hi); const float rs = rsqrtf((rowsq[l * 2] + rowsq[l * 2 + 1]) * (1.f / 256.f) + EPS);
            MIXB[(tok0 + l) * 1024 + col] = (unsigned short)(cvtpk(bf2f(((const unsigned short*)YPRE)[(tok0 + l) * 512 + col]) * rs * gs, 0.f) & 0xffffu); } }
    __syncthreads();
}

__global__ void __launch_bounds__(512, 2) mk_fwd(Params p) {
    extern __shared__ __attribute__((aligned(16))) unsigned char lds[];
    const int NGW = gridDim.x * 8, NGT = gridDim.x * 512, G = gridDim.x;
    unsigned char* ws = p.ws;
    unsigned* ctl = (unsigned*)(ws + WS_CTL);
    unsigned short* H2B = (unsigned short*)(ws + WS_H1);
    float* DT = (float*)(ws + WS_DT); float* DTRAW = (float*)(ws + WS_DTRAW); float* GATE = (float*)(ws + WS_GATE); float* BIASP = (float*)(ws + WS_BIASP);
    typedef unsigned short bf;
    bf* XN = (bf*)(ws + WS_XN); bf* PROJB = (bf*)(ws + WS_BIG); bf* YB = (bf*)(ws + WS_YB); bf* MIXB = (bf*)(ws + WS_MIXB); bf* QCB = (bf*)(ws + WS_QCB); bf* OCB = (bf*)(ws + WS_OCB);
    bf* KVMB = (bf*)(ws + WS_KVMB);
    bf* XC = (bf*)(ws + WS_XC); float* ACS = (float*)(ws + WS_ACS); float* CD = (float*)(ws + WS_CD); float* ST = (float*)(ws + WS_ST); bf* HIN = (bf*)(ws + WS_HIN);
    unsigned char* Y8 = ws + WS_YB;
    unsigned char* W1T8 = ws + WS_W1T; unsigned char* W2T8 = ws + WS_W2T; unsigned char* XN8 = ws + WS_QCB; unsigned char* ACT8 = ws + WS_ACTB;
    bf* WINT = (bf*)(ws + WS_WINT); bf* WOUTT = (bf*)(ws + WS_WOUTT); bf* WQT = (bf*)(ws + WS_WQT); bf* WKVT = (bf*)(ws + WS_WKVT); bf* WOT = (bf*)(ws + WS_WOT);
    int* LIST = (int*)(ws + WS_LIST); int* SLOT = (int*)(ws + WS_SLOT); float* RSA = (float*)(ws + WS_RSA); float* SSQ1 = (float*)(ws + WS_SSQ1); int* CNTB = (int*)(ws + WS_CNTB); float* RSROW = (float*)(ws + WS_RSROW);
    LAS3 unsigned char* ldsp = (LAS3 unsigned char*)lds;
    LAS3 int* TP = (LAS3 int*)(ldsp + LDS_MISC); LAS3 int* CNTL = TP + 64;
    const float* x = p.in[I_X];
    const int vcu = (G % 8 == 0) ? (blockIdx.x % 8) * (G / 8) + blockIdx.x / 8 : blockIdx.x;
    const int wave_id = __builtin_amdgcn_readfirstlane(threadIdx.x >> 6);
    if (threadIdx.x < 2) ((LAS3 unsigned*)(ldsp + LDS_MISC + 512))[threadIdx.x] = 0u;
    __syncthreads();
    const XcdBarrier xbar = xcd_barrier_post(ctl + 4096, (volatile LAS3 unsigned*)(ldsp + LDS_MISC + 512), threadIdx.x == 0);
#define GRID_BAR() do { const TI tb_ = fresh_ti(wave_id); xcd_barrier(xbar, tb_.tid == 0); } while (0)

    PH_BEGIN(0)
    {
        PHASE_IDS();
        LAS3 float* wdt = (LAS3 float*)ldsp;
        for (int i = tid; i < 1024 * 2; i += 512) { const int k = i >> 1, hh = i & 1; { const float4 t4 = ld4(p.in[I_WIN] + (size_t)k * IN_COLS + COL_DT + hh * 4); *(LAS3 g8::f32x4*)(wdt + hh * 4096 + (((k >> 8) * 4 + (k & 3)) * 64 + ((k & 255) >> 2)) * 4) = (g8::f32x4){t4.x, t4.y, t4.z, t4.w}; } }
        for (int i = gtid; i < PJ; i += NGT) BIASP[i] = i < PJ_Q ? 0.f : p.in[I_BQKV][i - PJ_Q];
        __syncthreads();
        {
            auto rowptr = [&](int r) -> const float* { return r >= NTOK ? p.in[I_MEM] + (size_t)(r - NTOK) * DM : x + (size_t)r * DM; };
            float4 vn[4];
            if (gw < NTOK + NMEM) {
#pragma unroll
                for (int j = 0; j < 4; ++j) vn[j] = ld4(rowptr(gw) + 4 * (lane + 64 * j)); }
            for (int r = gw; r < NTOK + NMEM; r += NGW) {
                const bool ismem = r >= NTOK;
                const float* g = ismem ? p.in[I_GMEM] : p.in[I_GMIX];
                float4 v[4]; float ss = 0.f;
#pragma unroll
                for (int j = 0; j < 4; ++j) { v[j] = vn[j]; ss += v[j].x * v[j].x + v[j].y * v[j].y + v[j].z * v[j].z + v[j].w * v[j].w; }
                if (r + NGW < NTOK + NMEM) {
#pragma unroll
                    for (int j = 0; j < 4; ++j) vn[j] = ld4(rowptr(r + NGW) + 4 * (lane + 64 * j)); }
                const float rs = rsqrtf(wave_sum(ss, lane) * (1.f / 1024.f) + EPS);
                float dacc[8];
#pragma unroll
                for (int h = 0; h < 8; ++h) dacc[h] = 0.f;
#pragma unroll
                for (int j = 0; j < 4; ++j) { const int c = 4 * (lane + 64 * j); const float4 gv = ld4(g + c);
                    v[j] = make_float4(v[j].x * rs * gv.x, v[j].y * rs * gv.y, v[j].z * rs * gv.z, v[j].w * rs * gv.w);
                    *(uint2*)(XN + (size_t)r * DM + c) = make_uint2(cvtpk(v[j].x, v[j].y), cvtpk(v[j].z, v[j].w));
                    if (!ismem) { const float uu[4] = {v[j].x, v[j].y, v[j].z, v[j].w};
#pragma unroll
                        for (int q = 0; q < 4; ++q) { const g8::f32x4 w0 = *(const LAS3 g8::f32x4*)(wdt + ((j * 4 + q) * 64 + lane) * 4), w1 = *(const LAS3 g8::f32x4*)(wdt + 4096 + ((j * 4 + q) * 64 + lane) * 4);
                            dacc[0] += uu[q] * w0.x; dacc[1] += uu[q] * w0.y; dacc[2] += uu[q] * w0.z; dacc[3] += uu[q] * w0.w;
                            dacc[4] += uu[q] * w1.x; dacc[5] += uu[q] * w1.y; dacc[6] += uu[q] * w1.z; dacc[7] += uu[q] * w1.w; } }
                }
                if (!ismem) {
#pragma unroll
                    for (int h = 0; h < 8; ++h) dacc[h] = wave_sum(dacc[h], lane);
                    if (lane == 0) { st4(DTRAW + (size_t)r * 8, make_float4(dacc[0], dacc[1], dacc[2], dacc[3])); st4(DTRAW + (size_t)r * 8 + 4, make_float4(dacc[4], dacc[5], dacc[6], dacc[7])); }
                }
            }
        }
        __syncthreads();
        LAS3 float* scr = (LAS3 float*)(ldsp + wave * 16640);
        constexpr int IT1 = 16 * (2048 / 64), IT2 = 16 * (1024 / 64);
        constexpr int IA = 16 * (1536 / 64), IB = 16 * (768 / 64), IO = 16 * 16, IQ = 16 * 8, IKV = 16 * 16, IWO = 8 * 16;
        constexpr int NSM = IA + IB + IO + IQ + IKV + IWO;
        for (int it = gw; it < NSM; it += NGW) {
            int r = it;
            if (r < IA) { transpose_item(p.in[I_WIN], 1024, IN_COLS, WINT, scr, r, lane, 1536); continue; } r -= IA;
            if (r < IB) { transpose_item(p.in[I_WIN] + COL_Q, 1024, IN_COLS, WINT + (size_t)1536 * 1024, scr, r, lane, 768); continue; } r -= IB;
            if (r < IO) { transpose_item(p.in[I_WOUT], 1024, 1024, WOUTT, scr, r, lane); continue; } r -= IO;
            if (r < IQ) { transpose_item(p.in[I_WQ], 1024, 512, WQT, scr, r, lane, 0, p.in[I_GCROSS]); continue; } r -= IQ;
            if (r < IKV) { transpose_item(p.in[I_WKV], 1024, 1024, WKVT, scr, r, lane); continue; } r -= IKV;
            transpose_item(p.in[I_WO], 512, 1024, WOT, scr, r, lane);
        }
        t8_run(p.in[I_W1], 2048, W1T8, p.in[I_GFFN], W1_P1_ITEMS + gw, NEXP * IT1, NGW, lane, scr);
    }
    GRID_BAR();
    PH_END()
    PH_BEGIN(1)
    {
        g8::DenseSched S{G, (int)blockIdx.x, 2048, NTOK / 256, PJ / 256, (const char*)WINT, NMEM / 256, 4, NTOK, (const char*)WKVT};
        g8::EpiBf16Dual E{PROJB, PJ, BIASP, KVMB, 1024};
        { PHASE_IDS(); g8::gemm_phase(ldsp, XN, WINT, 2048, 0, S, E, tid); }
    }
    if (blockIdx.x >= 72) {
        PHASE_IDS(); LAS3 float* scr = (LAS3 float*)(ldsp + wave * 16640);
        t8_run(p.in[I_W1], 2048, W1T8, p.in[I_GFFN], (blockIdx.x - 72) * 8 + wave, W1_P1_ITEMS, (G - 72) * 8, lane, scr);
    }
    GRID_BAR();
    PH_END()
    PH_BEGIN(2)
    {
    PHASE_IDS();
    for (int item = blockIdx.x; item < BATCH * 64 * 2; item += G)
        ssd_s1_item(item, PROJB, DTRAW, p.in[I_CONVW], p.in[I_CONVB], p.in[I_DTB], p.in[I_ALOG], XC, DT, ACS, CD, ST, ldsp, tid);
    }
    GRID_BAR();
    PH_END()
    PH_BEGIN(3)
    {
    PHASE_IDS();
    for (int item = blockIdx.x; item < BATCH * 64 * 2; item += G) swa_item(item, PROJB, MIXB, p.in[I_RELB], p.in[I_SINK], ldsp, tid);
    {
        for (int el = gtid; el < BATCH * 8 * 8192; el += NGT) {
            const int bh = el >> 13, pn = el & 8191, b = bh >> 3, h = bh & 7;
            float st = 0.f;
#pragma unroll 8
            for (int c = 0; c < 64; ++c) { const size_t idx = (((size_t)b * 64 + c) * 8 + h) * 8192 + pn;
                HIN[idx] = (bf)(cvtpk(st, 0.f) & 0xffffu); st = st * CD[((size_t)b * 64 + c) * 8 + h] + ST[idx]; }
        }
    }
    }
    GRID_BAR();
    PH_END()
    PH_BEGIN(4)
    {
    PHASE_IDS();
    for (int item = blockIdx.x; item < BATCH * 64 * 2; item += G)
        ssd_s3_item(item, XC, DT, ACS, HIN, PROJB, p.in[I_DSKIP], p.in[I_GSSM], ST, MIXB, ldsp, tid);
    }
    GRID_BAR();
    PH_END()
    PH_BEGIN(5)
    {
        g8::DenseSched S{G, (int)blockIdx.x, 2048, NTOK / 256, 4, (const char*)WOUTT, 0, 1, 0, nullptr};
        g8::EpiH1 E{p.in[I_BOUT], x, XN, SSQ1};
        { PHASE_IDS(); g8::gemm_phase(ldsp, MIXB, WOUTT, 2048, 0, S, E, tid); }
    }
    GRID_BAR();
    PH_END()
    PH_BEGIN(6)
    {
        g8::DenseSched S{G, (int)blockIdx.x, 2048, NTOK / 256, 2, (const char*)WQT, 0, 1, 0, nullptr};
        g8::EpiBf16Dual E{QCB, 512, nullptr, nullptr, 0};
        { PHASE_IDS(); g8::gemm_phase(ldsp, XN, WQT, 2048, 0, S, E, tid); }
    }
    if (blockIdx.x >= 128) {
        PHASE_IDS(); LAS3 float* scr = (LAS3 float*)(ldsp + wave * 16640);
        t8_run(p.in[I_W2], 1024, W2T8, nullptr, (blockIdx.x - 128) * 8 + wave, W2_P7_ITEMS, (G - 128) * 8, lane, scr);
    }
    GRID_BAR();
    PH_END()
    PH_BEGIN(7)
    {
    PHASE_IDS();
    for (int item = blockIdx.x; item < BATCH * 4 * 32; item += G) xattn_item(item, QCB, KVMB, SSQ1, OCB, ldsp, tid);
    }
    GRID_BAR();
    PH_END()
    PH_BEGIN(8)
    {
        g8::DenseSched S{G, (int)blockIdx.x, 1024, NTOK / 256, 4, (const char*)WOT, 0, 1, 0, nullptr};
        g8::EpiH2 E{XN, H2B, XN8};
        { PHASE_IDS(); g8::gemm_phase(ldsp, OCB, WOT, 1024, 0, S, E, tid); }
    }
    GRID_BAR();
    PH_END()
    PH_BEGIN(9)
    {
    PHASE_IDS();
    LAS3 float* PL = (LAS3 float*)ldsp;
    LAS3 float* SQ = (LAS3 float*)(ldsp + 33792);
    LAS3 unsigned* LC = (LAS3 unsigned*)(ldsp + 34816);
    if (tid < 32) LC[tid] = 0u;
    __syncthreads();
    const int hi = lane >> 5, r32 = lane & 31, tl = wave >> 2, kq = wave & 3;
    for (int rb = blockIdx.x; rb < NTOK / 64; rb += G) {
        const int row0 = rb * 64 + tl * 32;
        const unsigned short* hrow = H2B + (size_t)(row0 + r32) * DM + kq * 256 + 4 * hi;
        const float* gq = p.in[I_GFFN] + kq * 256 + 4 * hi;
        const float* wq = p.in[I_WR] + (size_t)(kq * 256 + 4 * hi) * 32 + r32;
        f32x16 acc;
#pragma unroll
        for (int r = 0; r < 16; ++r) acc[r] = 0.f;
        float ssq = 0.f;
#pragma unroll 1
        for (int mb = 0; mb < 32; mb += 8) {
            uint2 av[8]; float bv[8][4];
#pragma unroll
            for (int m = 0; m < 8; ++m) { av[m] = *(const uint2*)(hrow + 8 * (mb + m));
#pragma unroll
                for (int t = 0; t < 4; ++t) bv[m][t] = wq[(size_t)(8 * (mb + m) + t) * 32]; }
#pragma unroll
            for (int m = 0; m < 8; ++m) { const float4 gv = ld4(gq + 8 * (mb + m));
                float4 a = make_float4(__uint_as_float(av[m].x << 16), __uint_as_float(av[m].x & 0xffff0000u), __uint_as_float(av[m].y << 16), __uint_as_float(av[m].y & 0xffff0000u));
                ssq += a.x * a.x + a.y * a.y + a.z * a.z + a.w * a.w;
                a.x *= gv.x; a.y *= gv.y; a.z *= gv.z; a.w *= gv.w;
                acc = __builtin_amdgcn_mfma_f32_32x32x2f32(a.x, bv[m][0], acc, 0, 0, 0); acc = __builtin_amdgcn_mfma_f32_32x32x2f32(a.y, bv[m][1], acc, 0, 0, 0);
                acc = __builtin_amdgcn_mfma_f32_32x32x2f32(a.z, bv[m][2], acc, 0, 0, 0); acc = __builtin_amdgcn_mfma_f32_32x32x2f32(a.w, bv[m][3], acc, 0, 0, 0); }
        }
        ssq += xshfl(ssq, 32, lane);
        if (hi == 0) SQ[(tl * 4 + kq) * 32 + r32] = ssq;
#pragma unroll
        for (int r = 0; r < 16; ++r) PL[((tl * 4 + kq) * 32 + crow(r, hi)) * 33 + r32] = acc[r];
        __syncthreads();
        int sel[4] = {0, 0, 0, 0}, ls[4] = {0, 0, 0, 0}; float gt[4] = {0.f, 0.f, 0.f, 0.f}, rs = 0.f;
        const int i = 8 * kq + (lane & 7), row = row0 + i;
        if (lane < 8) {
            rs = rsqrtf((SQ[(tl * 4 + 0) * 32 + i] + SQ[(tl * 4 + 1) * 32 + i] + SQ[(tl * 4 + 2) * 32 + i] + SQ[(tl * 4 + 3) * 32 + i]) * (1.f / 1024.f) + EPS);
            float l[32];
#pragma unroll
            for (int e = 0; e < 32; ++e) l[e] = (PL[((tl * 4 + 0) * 32 + i) * 33 + e] + PL[((tl * 4 + 1) * 32 + i) * 33 + e] + PL[((tl * 4 + 2) * 32 + i) * 33 + e] + PL[((tl * 4 + 3) * 32 + i) * 33 + e]) * rs + p.in[I_BR][e];
            float val[4];
#pragma unroll
            for (int k = 0; k < 4; ++k) {
                float best = -INFINITY; int bi = 0;
#pragma unroll
                for (int e = 0; e < 32; ++e) if (l[e] > best) { best = l[e]; bi = e; }
                sel[k] = bi; val[k] = best;
#pragma unroll
                for (int e = 0; e < 32; ++e) l[e] = (e == bi) ? -INFINITY : l[e];
            }
            float den = 0.f;
#pragma unroll
            for (int k = 0; k < 4; ++k) { gt[k] = __expf(val[k] - val[0]); den += gt[k]; }
#pragma unroll
            for (int k = 0; k < 4; ++k) { gt[k] /= den; ls[k] = (int)__hip_atomic_fetch_add(&LC[sel[k]], 1u, __ATOMIC_RELAXED, __HIP_MEMORY_SCOPE_WORKGROUP); }
        }
        if (lane < 8) {
#pragma unroll
            for (int k = 0; k < 4; ++k) { const int a = row * 4 + k; SLOT[a] = (sel[k] << 16) | ls[k]; GATE[a] = gt[k]; }
            RSROW[row] = rs;
        }
        __syncthreads();
    }
    if (tid < 32) CNTB[blockIdx.x * 32 + tid] = (int)LC[tid];
    }
    GRID_BAR();
    PH_END()
    {
    PHASE_IDS();
    LAS3 int* PT = (LAS3 int*)ldsp;
    {
        const int e = tid & 31, part = tid >> 5; int tot = 0, base = 0;
        for (int bb = part; bb < G; bb += 16) { const int c = CNTB[bb * 32 + e]; tot += c; base += (bb < (int)blockIdx.x) ? c : 0; }
        PT[(part * 32 + e) * 2] = tot; PT[(part * 32 + e) * 2 + 1] = base;
    }
    __syncthreads();
    LAS3 unsigned* GB = (LAS3 unsigned*)(ldsp + 8192);
    if (tid < 64) {
        int c = 0, base = 0;
        if (tid < 32) {
#pragma unroll
            for (int q = 0; q < 16; ++q) { c += PT[(q * 32 + tid) * 2]; base += PT[(q * 32 + tid) * 2 + 1]; }
            GB[tid] = (unsigned)base; }
        int tl = (c + 255) >> 8, incl = tl;
#pragma unroll
        for (int o = 1; o < 32; o <<= 1) { const int v = bperm_i(incl, lane - o); if (lane >= o) incl += v; }
        if (tid < 32) { CNTL[tid] = c; TP[tid] = incl - tl; }
        if (tid == 31) TP[32] = incl;
    }
    __syncthreads();
    for (int rb = blockIdx.x; rb < NTOK / 64; rb += G)
        if (tid < 256) { const int a = rb * 256 + tid; const int v = SLOT[a], e = v >> 16; const unsigned slot = GB[e] + (unsigned)(v & 0xffff);
            LIST[e * NTOK + slot] = a; RSA[e * NTOK + slot] = RSROW[a >> 2]; SLOT[a] = (e << 16) | (int)slot; }
    g8::moe_units(TP + 136, TP, 8, G, vcu, tid); g8::moe_units(TP + 168, TP, 4, G, vcu, tid);
    }
    GRID_BAR();
    PH_BEGIN(10)
    {
        g8::MoeSched S{8, 1024, TP + 136, TP, CNTL, LIST, (const char*)W1T8, 2048u * 1024u};
        g8::EpiSwiglu E{ACT8, p.in[I_B1], RSA};
        { PHASE_IDS(); g8::gemm_phase<g8::EpiSwiglu, g8::MoeSched, true>(ldsp, XN8, W1T8, 1024, 2, S, E, tid); }
    }
    {
        PHASE_IDS(); LAS3 float* scr = (LAS3 float*)(ldsp + wave * 16640);
        const int total = TP[32] * 8, maxu = (total + G - 1) / G, tlast = total - (maxu - 1) * G;
        const int nidle = G - tlast;
        if (nidle >= 64) { if (vcu >= tlast) t8_run(p.in[I_W2], 1024, W2T8, nullptr, W2_P7_ITEMS + (vcu - tlast) * 8 + wave, NEXP * 256, nidle * 8, lane, scr); }
        else t8_run(p.in[I_W2], 1024, W2T8, nullptr, W2_P7_ITEMS + vcu * 8 + wave, NEXP * 256, G * 8, lane, scr);
    }
    GRID_BAR();
    PH_END()
    PH_BEGIN(11)
    {
        g8::MoeSched S{4, 1024, TP + 168, TP, CNTL, nullptr, (const char*)W2T8, 1024u * 1024u};
        g8::EpiFp8 E{Y8, p.in[I_B2], 0.0078125f};
        { PHASE_IDS(); g8::gemm_phase<g8::EpiFp8, g8::MoeSched, true>(ldsp, ACT8, W2T8, 1024, 0, S, E, tid); }
    }
    GRID_BAR();
    PH_END()
    PH_BEGIN(12)
    {
    PHASE_IDS();
    {
        uint2 hn[4]; int sln[4]; float gkn[4];
        if (gw < NTOK) {
#pragma unroll
            for (int k = 0; k < 4; ++k) { sln[k] = SLOT[gw * 4 + k]; gkn[k] = GATE[gw * 4 + k] * 0.0625f; }
#pragma unroll
            for (int j = 0; j < 4; ++j) hn[j] = *(const uint2*)(H2B + (size_t)gw * DM + 4 * (lane + 64 * j)); }
        for (int row = gw; row < NTOK; row += NGW) {
            float4 v[4]; float ss = 0.f; float gk[4]; unsigned y[4][4];
#pragma unroll
            for (int k = 0; k < 4; ++k) { const int yrow = TP[sln[k] >> 16] * 256 + (sln[k] & 0xffff); gk[k] = gkn[k];
#pragma unroll
                for (int j = 0; j < 4; ++j) y[k][j] = *(const unsigned*)(Y8 + (size_t)yrow * 1024 + 4 * (lane + 64 * j)); }
#pragma unroll
            for (int j = 0; j < 4; ++j) v[j] = make_float4(__uint_as_float(hn[j].x << 16), __uint_as_float(hn[j].x & 0xffff0000u), __uint_as_float(hn[j].y << 16), __uint_as_float(hn[j].y & 0xffff0000u));
            if (row + NGW < NTOK) {
#pragma unroll
                for (int k = 0; k < 4; ++k) { sln[k] = SLOT[(row + NGW) * 4 + k]; gkn[k] = GATE[(row + NGW) * 4 + k] * 0.0625f; }
#pragma unroll
                for (int j = 0; j < 4; ++j) hn[j] = *(const uint2*)(H2B + (size_t)(row + NGW) * DM + 4 * (lane + 64 * j)); }
#pragma unroll
            for (int j = 0; j < 4; ++j) { float4 a = v[j];
#pragma unroll
                for (int k = 0; k < 4; ++k) { const g8::f32x2 lo = __builtin_amdgcn_cvt_pk_f32_fp8((int)y[k][j], false), hi2 = __builtin_amdgcn_cvt_pk_f32_fp8((int)y[k][j], true);
                    a.x += gk[k] * lo[0]; a.y += gk[k] * lo[1]; a.z += gk[k] * hi2[0]; a.w += gk[k] * hi2[1]; }
                v[j] = a; ss += a.x * a.x + a.y * a.y + a.z * a.z + a.w * a.w; }
            const float rs = rsqrtf(wave_sum(ss, lane) * (1.f / 1024.f) + EPS);
#pragma unroll
            for (int j = 0; j < 4; ++j) { const int c = 4 * (lane + 64 * j); const float4 gv = ld4(p.in[I_GFIN] + c);
                st4(p.out + (size_t)row * DM + c, make_float4(v[j].x * rs * gv.x, v[j].y * rs * gv.y, v[j].z * rs * gv.z, v[j].w * rs * gv.w)); }
        }
    }
    }
    PH_END()
}

constexpr int LDS_BYTES = 147456;

extern "C" void kernel_launch(void* const* d_in, const int* in_sizes, int n_in, void* d_out, int out_size, void* d_ws, size_t ws_size, hipStream_t stream) {
    static int grid = 0;
    if (grid == 0) {
        if (n_in != N_IN || ws_size < WS_END) { fprintf(stderr, "kernel_launch: unexpected n_in %d / ws_size %zu (need %zu)\n", n_in, ws_size, (size_t)WS_END); grid = -1; return; }
        int dev = 0, cus = 0, per_cu = 0;
        (void)hipGetDevice(&dev);
        (void)hipDeviceGetAttribute(&cus, hipDeviceAttributeMultiprocessorCount, dev);
        (void)hipFuncSetAttribute((const void*)mk_fwd, hipFuncAttributeMaxDynamicSharedMemorySize, LDS_BYTES);
        (void)hipOccupancyMaxActiveBlocksPerMultiprocessor(&per_cu, (const void*)mk_fwd, 512, LDS_BYTES);
        if (per_cu < 1) { fprintf(stderr, "kernel_launch: occupancy query says %d blocks per CU\n", per_cu); per_cu = 1; }
        if (per_cu > 1) per_cu = 1;
        grid = cus * per_cu;
    }
    if (grid < 0) return;
    (void)hipMemsetAsync((char*)d_ws + WS_CTL, 0, 1 * MiB, stream);
    Params p{};
    for (int i = 0; i < N_IN; ++i) p.in[i] = (const float*)d_in[i];
    p.out = (float*)d_out; p.ws = (unsigned char*)d_ws; p.rep_mask = REP_MASK;
    void* args[] = {&p};
    hipError_t e = hipLaunchCooperativeKernel((const void*)mk_fwd, dim3(grid), dim3(512), args, LDS_BYTES, stream);
    if (e != hipSuccess) fprintf(stderr, "cooperative launch failed: %s (grid %d)\n", hipGetErrorString(e), grid);
}
```

```cpp
#include <hip/hip_runtime.h>
#include <cstdio>
#include <cstdint>

#define DEVI __device__ __forceinline__

constexpr int BATCH = 2, SEQ = 8192, NTOK = BATCH * SEQ, DM = 1024, MEMLEN = 256, NMEM = BATCH * MEMLEN;
constexpr int SSM_H = 8, SSM_P = 64, SSM_W = 512, SSM_N = 128, CONVCH = 1024;
constexpr int IN_COLS = 2312, COL_Z = 0, COL_XBC = 512, COL_DT = 1536, COL_Q = 1544, COL_K = 2056, COL_V = 2184;
constexpr int NEXP = 32, TOPK = 4, DFF = 1024, NASSIGN = NTOK * TOPK;
constexpr float EPS = 1e-5f;

enum { I_X = 0, I_MEM, I_GMIX, I_WIN, I_BQKV, I_CONVW, I_CONVB, I_DTB, I_ALOG, I_DSKIP, I_GSSM, I_SINK, I_RELB, I_WOUT, I_BOUT,
       I_GCROSS, I_GMEM, I_WQ, I_WKV, I_WO, I_GFFN, I_WR, I_BR, I_W1, I_B1, I_W2, I_B2, I_GFIN, N_IN };

constexpr size_t MiB = 1u << 20;
constexpr size_t WS_CTL = 0;
constexpr size_t WS_XN = 1 * MiB;
constexpr size_t WS_BIG = WS_XN + 34 * MiB;
constexpr size_t WS_XBC = WS_BIG + 144 * MiB;
constexpr size_t WS_MIXB = WS_XBC + 64 * MiB;
constexpr size_t WS_H1 = WS_MIXB + 32 * MiB;
constexpr size_t WS_H2 = WS_H1 + 64 * MiB;
constexpr size_t WS_YSSM = WS_H2 + 64 * MiB;
constexpr size_t WS_QCB = WS_YSSM + 32 * MiB;
constexpr size_t WS_OCB = WS_QCB + 16 * MiB;
constexpr size_t WS_ACTB = WS_OCB + 16 * MiB;
constexpr size_t WS_W1T = WS_ACTB + 144 * MiB;
constexpr size_t WS_W2T = WS_W1T + 128 * MiB;
constexpr size_t WS_WINT = WS_W2T + 64 * MiB;
constexpr size_t WS_WOUTT = WS_WINT + 5 * MiB;
constexpr size_t WS_WQT = WS_WOUTT + 2 * MiB;
constexpr size_t WS_WKVT = WS_WQT + 1 * MiB;
constexpr size_t WS_WOT = WS_WKVT + 2 * MiB;
constexpr size_t WS_SMALL = WS_WOT + 1 * MiB;
constexpr size_t WS_DT = WS_SMALL;
constexpr size_t WS_DTRAW = WS_DT + 512 * 1024;
constexpr size_t WS_KVMB = WS_DTRAW + 512 * 1024;
constexpr size_t WS_GATE = WS_KVMB + 1 * MiB;
constexpr size_t WS_SLOT = WS_GATE + 512 * 1024;
constexpr size_t WS_BIASP = WS_SLOT + 256 * 1024;
constexpr size_t WS_LIST = WS_GATE + 1 * MiB;
constexpr size_t WS_RSA = WS_LIST + 2 * MiB;
constexpr size_t WS_CNTB = WS_RSA + 2 * MiB;
constexpr size_t WS_RSROW = WS_CNTB + 64 * 1024;
constexpr size_t WS_SSQ1 = WS_RSROW + 64 * 1024;
constexpr size_t WS_ACS = WS_SSQ1 + 2 * MiB;
constexpr size_t WS_CD = WS_ACS + 512 * 1024;
constexpr size_t WS_END = WS_CD + 64 * 1024;
constexpr size_t WS_XC = WS_XBC;
constexpr size_t WS_ST = WS_YSSM;
constexpr size_t WS_HIN = WS_H2;
constexpr size_t WS_YB = WS_BIG;
constexpr int NROWS_MAX = NASSIGN + NEXP * 256;
constexpr int PJ = 2304, PJ_Z = 0, PJ_XBC = 512, PJ_Q = 1536, PJ_K = 2048, PJ_V = 2176;
constexpr int W1_P1_ITEMS = 14720;
constexpr int W2_P7_ITEMS = 5120;
constexpr int LDS_MISC = 146432;
constexpr int CW_CNT = 64;
#ifndef REP_MASK
#define REP_MASK 0
#endif
#ifndef RUNTIME_REP
#define RUNTIME_REP 1
#endif
#if RUNTIME_REP
#define PH_BEGIN(i) for (int rep_ = 0; rep_ <= ((p.rep_mask >> (i)) & 1); ++rep_) {
#else
#define PH_BEGIN(i) { constexpr int rep_ = 0; (void)rep_;
#endif
#define PH_END() }

struct Params { const float* in[N_IN]; float* out; unsigned char* ws; int rep_mask; int pad; };

DEVI float bperm(float v, int srclane) { return __int_as_float(__builtin_amdgcn_ds_bpermute(srclane << 2, __float_as_int(v))); }
DEVI int bperm_i(int v, int srclane) { return __builtin_amdgcn_ds_bpermute(srclane << 2, v); }
DEVI float xshfl(float v, int mask, int lane) { return bperm(v, lane ^ mask); }
DEVI float wave_sum(float v, int lane) {
#pragma unroll
    for (int o = 32; o > 0; o >>= 1) v += xshfl(v, o, lane);
    return v;
}
DEVI float wave_max(float v, int lane) {
#pragma unroll
    for (int o = 32; o > 0; o >>= 1) v = fmaxf(v, xshfl(v, o, lane));
    return v;
}
DEVI float silu_f(float x) { return x * __builtin_amdgcn_rcpf(1.f + __expf(-x)); }
DEVI float softplus_f(float x) { return fmaxf(x, 0.f) + log1pf(__expf(-fabsf(x))); }
DEVI float4 ld4(const float* p) { return *(const float4*)p; }
DEVI void st4(float* p, float4 v) { *(float4*)p = v; }


struct TI { int tid, lane, wave, gw, gtid; };
DEVI TI fresh_ti(int wave_id) { int l; asm volatile("v_mbcnt_lo_u32_b32 %0, -1, 0\n\tv_mbcnt_hi_u32_b32 %0, -1, %0" : "=v"(l)); TI r; r.lane = l; r.wave = wave_id; r.tid = wave_id * 64 + l; r.gw = blockIdx.x * 8 + wave_id; r.gtid = blockIdx.x * 512 + r.tid; return r; }
#define PHASE_IDS() const TI ti_ = fresh_ti(wave_id); const int tid = ti_.tid, lane = ti_.lane, wave = ti_.wave, gw = ti_.gw, gtid = ti_.gtid; (void)tid; (void)lane; (void)wave; (void)gw; (void)gtid
DEVI float bf2f(unsigned short v) { return __uint_as_float((unsigned)v << 16); }

#define XB_TMO      128
#define XB_XCNT(j)  (256  + 64 * (j))
#define XB_XSUB(j)  (1280 + 64 * (j))
#define XB_XGEN(j)  (2304 + 64 * (j))
#define XB_TOP      3328
#define XB_TOPGEN   3392
#define XCD_BAR_WORDS 3456
#define XB_SPIN_CAP (1u << 18)
DEVI unsigned xb_ld(unsigned* p)              { return __hip_atomic_load(p, __ATOMIC_RELAXED, __HIP_MEMORY_SCOPE_AGENT); }
DEVI unsigned xb_add(unsigned* p, unsigned v) { return __hip_atomic_fetch_add(p, v, __ATOMIC_RELAXED, __HIP_MEMORY_SCOPE_AGENT); }
DEVI unsigned xb_xcc_id() { return (unsigned)__builtin_amdgcn_s_getreg((3 << 11) | 20) & 0xFu; }
#define XB_SPIN(cond, bar) do { unsigned _sp = 0; while (cond) { __builtin_amdgcn_s_sleep(1); \
    if ((++_sp & 255u) == 0u) { if (xb_ld(&(bar)[XB_TMO])) break; if (_sp > XB_SPIN_CAP) { atomicAdd(&(bar)[XB_TMO], 1u); break; } } } } while (0)
struct XcdBarrier { unsigned* bar; unsigned x; volatile __attribute__((address_space(3))) unsigned* st; };
DEVI XcdBarrier xcd_barrier_post(unsigned* bar, volatile __attribute__((address_space(3))) unsigned* st, bool leader) {
    XcdBarrier b; b.bar = bar; b.x = xb_xcc_id(); b.st = st;
    if (leader) (void)xb_add(&bar[XB_XCNT(b.x)], 1u);
    return b;
}
DEVI void xcd_barrier_complete(unsigned* bar, unsigned x, unsigned& nloc, unsigned& nx) {
    const unsigned G = gridDim.x * gridDim.y * gridDim.z;
    unsigned sum, cnt, mine, sp = 0u;
    for (;;) {
        sum = 0u; cnt = 0u; mine = 0u;
#pragma unroll
        for (unsigned j = 0; j < 16; ++j) { const unsigned c = xb_ld(&bar[XB_XCNT(j)]); sum += c; cnt += (c > 0u) ? 1u : 0u; mine = (j == x) ? c : mine; }
        if (sum == G) break;
        __builtin_amdgcn_s_sleep(1);
        if ((++sp & 255u) == 0u) { if (xb_ld(&bar[XB_TMO])) break; if (sp > XB_SPIN_CAP) { atomicAdd(&bar[XB_TMO], 1u); break; } }
    }
    nloc = mine > 0u ? mine : 1u; nx = cnt > 0u ? cnt : 1u;
}
DEVI void xcd_barrier(const XcdBarrier& b, bool leader) {
    asm volatile("s_waitcnt vmcnt(0)" ::: "memory");
    __syncthreads();
    if (leader) {
        unsigned* bar = b.bar;
        __builtin_amdgcn_s_waitcnt(0);
        unsigned nloc = b.st[0], nx = b.st[1];
        if (nloc == 0u) { xcd_barrier_complete(bar, b.x, nloc, nx); b.st[0] = nloc; b.st[1] = nx; }
        const unsigned old = xb_add(&bar[XB_XSUB(b.x)], 1u);
        const unsigned gen = old / nloc;
        if (old + 1u == (gen + 1u) * nloc) {
            __builtin_amdgcn_fence(__ATOMIC_RELEASE, "agent");
            asm volatile("s_waitcnt vmcnt(0)" ::: "memory");
            const unsigned og = xb_add(&bar[XB_TOP], 1u);
            const unsigned tg = og / nx;
            if (og + 1u == (tg + 1u) * nx) xb_add(&bar[XB_TOPGEN], 1u);
            else XB_SPIN(xb_ld(&bar[XB_TOPGEN]) == tg, bar);
            __builtin_amdgcn_fence(__ATOMIC_ACQUIRE, "agent");
            xb_add(&bar[XB_XGEN(b.x)], 1u);
            asm volatile("s_waitcnt vmcnt(0)" ::: "memory");
        } else {
            XB_SPIN(xb_ld(&bar[XB_XGEN(b.x)]) == gen, bar);
            __builtin_amdgcn_fence(__ATOMIC_ACQUIRE, "agent");
            asm volatile("s_waitcnt vmcnt(0)" ::: "memory");
        }
    }
    __syncthreads();
}

namespace g8 {
#define G8_LAS __attribute__((address_space(3)))
typedef unsigned short bf16_t;
typedef short bf16x8 __attribute__((ext_vector_type(8)));
typedef float f32x4 __attribute__((ext_vector_type(4)));
typedef float f32x2 __attribute__((ext_vector_type(2)));
typedef unsigned u32x4 __attribute__((ext_vector_type(4)));
typedef unsigned u32x2 __attribute__((ext_vector_type(2)));
constexpr int BM = 256, BK = 64, HALF = 128, HTB = HALF * BK * 2, STAGE_BYTES = 8 * HTB;

DEVI int lds_byte(int r, int c) { const int st = (r >> 4) * 2 + (c >> 5), rr = r & 15, cc = c & 31, ob = rr * 64 + cc * 2; return st * 1024 + (ob ^ (((ob >> 9) & 1) << 5)); }
DEVI void stage_rc(int b, int& R, int& C) { const int st = b / 1024, sb = b % 1024, swz = sb ^ (((sb >> 9) & 1) << 5); R = (st >> 1) * 16 + swz / 64; C = (st & 1) * 32 + (swz % 64) / 2; }
DEVI int perm32(int rho) { const int n = rho >> 4, i = rho & 15; return 8 * (i >> 2) + 4 * n + (i & 3); }
typedef int v8i __attribute__((ext_vector_type(8)));
typedef int v4i __attribute__((ext_vector_type(4)));
DEVI v8i cat8(bf16x8 lo, bf16x8 hi) { const v4i a = __builtin_bit_cast(v4i, lo), b = __builtin_bit_cast(v4i, hi); return (v8i){a[0], a[1], a[2], a[3], b[0], b[1], b[2], b[3]}; }
DEVI unsigned pk4_fp8(float a, float b, float c, float d) { int w = 0; w = __builtin_amdgcn_cvt_pk_fp8_f32(a, b, w, false); w = __builtin_amdgcn_cvt_pk_fp8_f32(c, d, w, true); return (unsigned)w; }
typedef __bf16 bf16x2v __attribute__((ext_vector_type(2)));
DEVI unsigned cvt_pk_bf16(float lo, float hi) { const f32x2 v = {lo, hi}; const bf16x2v b = __builtin_convertvector(v, bf16x2v); return __builtin_bit_cast(unsigned, b); }

struct Unit {
    const int* alist;
    int acnt;
    int aoff;
    int arow0;
    unsigned boff;
    int orow0, ocol0;
    int e;
};


struct EpiSwiglu {
    static constexpr bool PERM = true;
    unsigned char* O; const float* bias; const float* rsa;
    DEVI void operator()(const f32x4 (&acc)[2][2][4][2], const Unit& u, int wr, int wc, int fr_, int fq_) const {
        int fr = fr_, fq = fq_; asm volatile("" : "+v"(fr), "+v"(fq));
        const int row0 = u.orow0 + wr * 64 + fr, col0 = u.ocol0 + wc * 32 + 8 * fq;
        const float* bp = bias + (size_t)u.e * 2048 + col0;
        f32x4 bv[2][2];
#pragma unroll
        for (int bj = 0; bj < 2; ++bj)
#pragma unroll
            for (int n = 0; n < 2; ++n) bv[bj][n] = *(const f32x4*)(bp + bj * HALF + 4 * n);
        float rsv[2][4];
#pragma unroll
        for (int ai = 0; ai < 2; ++ai)
#pragma unroll
            for (int m = 0; m < 4; ++m) { const int lr = wr * 64 + fr + ai * HALF + m * 16; rsv[ai][m] = rsa[u.aoff + min(lr, u.acnt - 1)]; }
        asm volatile("" : "+v"(rsv[0][0]), "+v"(rsv[0][1]), "+v"(rsv[0][2]), "+v"(rsv[0][3]), "+v"(rsv[1][0]), "+v"(rsv[1][1]), "+v"(rsv[1][2]), "+v"(rsv[1][3]));
#pragma unroll
        for (int ai = 0; ai < 2; ++ai)
#pragma unroll
            for (int m = 0; m < 4; ++m) { const int lr = wr * 64 + fr + ai * HALF + m * 16;
                const float rs = (lr < u.acnt) ? rsv[ai][m] * 0.03125f : 0.f;
                unsigned char* rowp = O + (size_t)(row0 + ai * HALF + m * 16) * 1024 + (col0 >> 1);
                float xg[8], xl[8], t[8];
#pragma unroll
                for (int bj = 0; bj < 2; ++bj)
#pragma unroll
                    for (int n = 0; n < 2; ++n) { const f32x4 v = acc[ai][bj][m][n] * rs + bv[bj][n]; const int q = bj * 4 + n * 2;
                        xg[q] = fminf(v[0], 7.f); xl[q] = fminf(fmaxf(v[1], -7.f), 7.f) + 1.f; xg[q + 1] = fminf(v[2], 7.f); xl[q + 1] = fminf(fmaxf(v[3], -7.f), 7.f) + 1.f; }
#pragma unroll
                for (int q = 0; q < 8; ++q) t[q] = __builtin_amdgcn_exp2f(xg[q] * -2.4554669595930157f);
#pragma unroll
                for (int q = 0; q < 8; ++q) t[q] = __builtin_amdgcn_rcpf(1.f + t[q]);
#pragma unroll
                for (int q = 0; q < 8; ++q) t[q] = (4.f * xg[q]) * t[q] * xl[q];
                *(unsigned*)(rowp) = pk4_fp8(t[0], t[1], t[2], t[3]);
                *(unsigned*)(rowp + HALF / 2) = pk4_fp8(t[4], t[5], t[6], t[7]); }
    }
};
struct EpiBf16 {
    static constexpr bool PERM = true;
    bf16_t* O; int ldc; const float* bias; int bias_stride; float scale;
    DEVI void operator()(const f32x4 (&acc)[2][2][4][2], const Unit& u, int wr, int wc, int fr_, int fq_) const {
        int fr = fr_, fq = fq_; asm volatile("" : "+v"(fr), "+v"(fq));
        const int row0 = u.orow0 + wr * 64 + fr, col0 = u.ocol0 + wc * 32 + 8 * fq;
        f32x4 bv[2][2];
#pragma unroll
        for (int bj = 0; bj < 2; ++bj)
#pragma unroll
            for (int n = 0; n < 2; ++n) bv[bj][n] = bias ? *(const f32x4*)(bias + (size_t)u.e * bias_stride + col0 + bj * HALF + 4 * n) : (f32x4){0.f, 0.f, 0.f, 0.f};
#pragma unroll
        for (int ai = 0; ai < 2; ++ai)
#pragma unroll
            for (int m = 0; m < 4; ++m) { bf16_t* rowp = O + (size_t)(row0 + ai * HALF + m * 16) * ldc + col0;
#pragma unroll
                for (int bj = 0; bj < 2; ++bj) { const f32x4 v0 = acc[ai][bj][m][0] * scale + bv[bj][0], v1 = acc[ai][bj][m][1] * scale + bv[bj][1];
                    u32x4 w; w.x = cvt_pk_bf16(v0[0], v0[1]); w.y = cvt_pk_bf16(v0[2], v0[3]); w.z = cvt_pk_bf16(v1[0], v1[1]); w.w = cvt_pk_bf16(v1[2], v1[3]);
                    *(u32x4*)(rowp + bj * HALF) = w; } }
    }
};

struct EpiFp8 {
    static constexpr bool PERM = true;
    unsigned char* O; const float* bias; float scale;
    DEVI void operator()(const f32x4 (&acc)[2][2][4][2], const Unit& u, int wr, int wc, int fr_, int fq_) const {
        int fr = fr_, fq = fq_; asm volatile("" : "+v"(fr), "+v"(fq));
        const int row0 = u.orow0 + wr * 64 + fr, col0 = u.ocol0 + wc * 32 + 8 * fq;
        f32x4 bv[2][2];
#pragma unroll
        for (int bj = 0; bj < 2; ++bj)
#pragma unroll
            for (int n = 0; n < 2; ++n) bv[bj][n] = *(const f32x4*)(bias + (size_t)u.e * 1024 + col0 + bj * HALF + 4 * n) * 16.f;
        const float sc = scale * 16.f;
#pragma unroll
        for (int ai = 0; ai < 2; ++ai)
#pragma unroll
            for (int m = 0; m < 4; ++m) { unsigned char* rowp = O + (size_t)(row0 + ai * HALF + m * 16) * 1024 + col0;
#pragma unroll
                for (int bj = 0; bj < 2; ++bj) { const f32x4 v0 = acc[ai][bj][m][0] * sc + bv[bj][0], v1 = acc[ai][bj][m][1] * sc + bv[bj][1];
                    u32x2 w; w.x = pk4_fp8(v0[0], v0[1], v0[2], v0[3]); w.y = pk4_fp8(v1[0], v1[1], v1[2], v1[3]);
                    *(u32x2*)(rowp + bj * HALF) = w; } }
    }
};
struct EpiBf16Dual {
    static constexpr bool PERM = true;
    bf16_t* O0; int ldc0; const float* bias0; bf16_t* O1; int ldc1;
    DEVI void operator()(const f32x4 (&acc)[2][2][4][2], const Unit& u, int wr, int wc, int fr_, int fq_) const {
        int fr = fr_, fq = fq_; asm volatile("" : "+v"(fr), "+v"(fq));
        const int row0 = u.orow0 + wr * 64 + fr, col0 = u.ocol0 + wc * 32 + 8 * fq;
        bf16_t* O = u.e ? O1 : O0; const int ldc = u.e ? ldc1 : ldc0; const float* bias = u.e ? nullptr : bias0;
        f32x4 bv[2][2];
#pragma unroll
        for (int bj = 0; bj < 2; ++bj)
#pragma unroll
            for (int n = 0; n < 2; ++n) bv[bj][n] = bias ? *(const f32x4*)(bias + col0 + bj * HALF + 4 * n) : (f32x4){0.f, 0.f, 0.f, 0.f};
#pragma unroll
        for (int ai = 0; ai < 2; ++ai)
#pragma unroll
            for (int m = 0; m < 4; ++m) { bf16_t* rowp = O + (size_t)(row0 + ai * HALF + m * 16) * ldc + col0;
#pragma unroll
                for (int bj = 0; bj < 2; ++bj) { const f32x4 v0 = acc[ai][bj][m][0] + bv[bj][0], v1 = acc[ai][bj][m][1] + bv[bj][1];
                    u32x4 w; w.x = cvt_pk_bf16(v0[0], v0[1]); w.y = cvt_pk_bf16(v0[2], v0[3]); w.z = cvt_pk_bf16(v1[0], v1[1]); w.w = cvt_pk_bf16(v1[2], v1[3]);
                    *(u32x4*)(rowp + bj * HALF) = w; } }
    }
};

struct EpiH1 {
    static constexpr bool PERM = false;
    const float* bias; const float* res; bf16_t* HB; float* SSQ;
    DEVI void operator()(const f32x4 (&acc)[2][2][4][2], const Unit& u, int wr, int wc, int fr_, int fq_) const {
        int fr = fr_, fq = fq_; asm volatile("" : "+v"(fr), "+v"(fq));
        const int row0 = u.orow0 + wr * 64 + fr, col0 = u.ocol0 + wc * 32 + 4 * fq;
        f32x4 bv[2][2];
#pragma unroll
        for (int bj = 0; bj < 2; ++bj)
#pragma unroll
            for (int n = 0; n < 2; ++n) bv[bj][n] = *(const f32x4*)(bias + col0 + bj * HALF + n * 16);
#pragma unroll
        for (int ai = 0; ai < 2; ++ai)
#pragma unroll
            for (int m = 0; m < 4; ++m) { const int row = row0 + ai * HALF + m * 16; const size_t off = (size_t)row * 1024 + col0;
#pragma unroll
                for (int bj = 0; bj < 2; ++bj) { float sq = 0.f;
#pragma unroll
                    for (int n = 0; n < 2; ++n) { const f32x4 h = acc[ai][bj][m][n] + bv[bj][n] + *(const f32x4*)(res + off + bj * HALF + n * 16);
                        sq += h[0] * h[0] + h[1] * h[1] + h[2] * h[2] + h[3] * h[3];
                        u32x2 w; w.x = cvt_pk_bf16(h[0], h[1]); w.y = cvt_pk_bf16(h[2], h[3]);
                        *(u32x2*)(HB + off + bj * HALF + n * 16) = w; }
                    sq += xshfl(sq, 16, fq * 16 + fr); sq += xshfl(sq, 32, fq * 16 + fr);
                    if (fq == 0) SSQ[(size_t)row * 32 + (u.ocol0 >> 8) * 8 + wc * 2 + bj] = sq; }
                if (m & 1) asm volatile("" ::: "memory"); }
    }
};
struct EpiH2 {
    static constexpr bool PERM = false;
    const bf16_t* res; bf16_t* HB; unsigned char* X8;
    DEVI void operator()(const f32x4 (&acc)[2][2][4][2], const Unit& u, int wr, int wc, int fr_, int fq_) const {
        int fr = fr_, fq = fq_; asm volatile("" : "+v"(fr), "+v"(fq));
        const int row0 = u.orow0 + wr * 64 + fr, col0 = u.ocol0 + wc * 32 + 4 * fq;
#pragma unroll
        for (int ai = 0; ai < 2; ++ai)
#pragma unroll
            for (int m = 0; m < 4; ++m) { const size_t off = (size_t)(row0 + ai * HALF + m * 16) * 1024 + col0;
#pragma unroll
                for (int bj = 0; bj < 2; ++bj)
#pragma unroll
                    for (int n = 0; n < 2; ++n) { const u32x2 r = *(const u32x2*)(res + off + bj * HALF + n * 16);
                        f32x4 h = acc[ai][bj][m][n];
                        h[0] += __uint_as_float(r.x << 16); h[1] += __uint_as_float(r.x & 0xffff0000u); h[2] += __uint_as_float(r.y << 16); h[3] += __uint_as_float(r.y & 0xffff0000u);
                        u32x2 w; w.x = cvt_pk_bf16(h[0], h[1]); w.y = cvt_pk_bf16(h[2], h[3]);
                        *(u32x2*)(HB + off + bj * HALF + n * 16) = w;
                        *(unsigned*)(X8 + off + bj * HALF + n * 16) = pk4_fp8(h[0], h[1], h[2], h[3]); }
                if (m & 1) asm volatile("" ::: "memory"); }
    }
};

template <class Epi, class Sched, bool FP8 = false>
DEVI void gemm_phase(G8_LAS unsigned char* lds, const void* A, const void* Bbase, int RP  , int ashift, const Sched& S, const Epi& E, int tid_) {
    int tid = tid_; asm volatile("" : "+v"(tid));
    const int wid = __builtin_amdgcn_readfirstlane(tid >> 6), lane = tid & 63, wr = wid >> 2, wc = wid & 3, fr = lane & 15, fq = lane >> 4;
    const int nt = RP / 128;
    unsigned voffB[2];
#pragma unroll
    for (int i = 0; i < 2; ++i) { int Rl, Cl; stage_rc(tid * 16 + i * 8192, Rl, Cl); const int Rb = Epi::PERM ? ((Rl & ~31) + perm32(Rl & 31)) : Rl;
        voffB[i] = (unsigned)(Rb * RP + Cl * 2); }
    const unsigned kstep = 128u;
    const unsigned hstep = (unsigned)(HALF * RP);
    const __amdgpu_buffer_rsrc_t rsA = __builtin_amdgcn_make_buffer_rsrc(const_cast<void*>(A), 0, 0x7fffffff, 0x00020000), rsB = __builtin_amdgcn_make_buffer_rsrc(const_cast<void*>(Bbase), 0, 0x7fffffff, 0x00020000);
    const unsigned ldsw = (unsigned)wid * 1024u;
    const int aoff = lds_byte(wr * 64 + fr, fq * 8), boff = lds_byte(wc * 32 + fr, fq * 8);
#define G8_AOFF(dst, u) do { int _t = tid; asm volatile("" : "+v"(_t)); int _R[2], _C[2]; _Pragma("unroll") for (int _i = 0; _i < 2; ++_i) stage_rc(_t * 16 + _i * 8192, _R[_i], _C[_i]); \
        if ((u).alist) { int _v[2][2];     \
            _Pragma("unroll") for (int _h = 0; _h < 2; ++_h) _Pragma("unroll") for (int _i = 0; _i < 2; ++_i) _v[_h][_i] = (u).alist[min(_h * HALF + _R[_i], (u).acnt - 1)]; \
            asm volatile("" : "+v"(_v[0][0]), "+v"(_v[0][1]), "+v"(_v[1][0]), "+v"(_v[1][1])); \
            _Pragma("unroll") for (int _h = 0; _h < 2; ++_h) _Pragma("unroll") for (int _i = 0; _i < 2; ++_i) dst[_h][_i] = (unsigned)((_v[_h][_i] >> ashift) * RP + _C[_i] * 2); } \
        else { _Pragma("unroll") for (int _h = 0; _h < 2; ++_h) _Pragma("unroll") for (int _i = 0; _i < 2; ++_i) dst[_h][_i] = (unsigned)(((u).arow0 + _h * HALF + _R[_i]) * RP + _C[_i] * 2); } } while (0)
#define G8_SA(b, h) (((b) * 2 + (h)) * HTB)
#define G8_SB(b, h) ((4 + (b) * 2 + (h)) * HTB)
#define G8_STAGE(bufoff, rsrc, soff, voff) do { _Pragma("unroll") for (int _i = 0; _i < 2; ++_i) \
        __builtin_amdgcn_raw_ptr_buffer_load_lds(rsrc, (G8_LAS unsigned*)(lds + (bufoff) + ldsw + _i * 8192), 16, (voff)[_i], (soff), 0, 0); } while (0)
#define G8_LDA(dst, b, h) do { if constexpr (FP8) { _Pragma("unroll") for (int m = 0; m < 4; ++m) { const v4i _lo = *(const G8_LAS v4i*)(lds + G8_SA(b, h) + aoff + m * 2048), _hi = *(const G8_LAS v4i*)(lds + G8_SA(b, h) + aoff + m * 2048 + 1024); dst##8[m] = __builtin_shufflevector(_lo, _hi, 0, 1, 2, 3, 4, 5, 6, 7); } } \
        else { _Pragma("unroll") for (int m = 0; m < 4; ++m) _Pragma("unroll") for (int k = 0; k < 2; ++k) dst[m][k] = *(const G8_LAS bf16x8*)(lds + G8_SA(b, h) + aoff + m * 2048 + k * 1024); } } while (0)
#define G8_LDB(dst, b, h) do { if constexpr (FP8) { _Pragma("unroll") for (int n = 0; n < 2; ++n) { const v4i _lo = *(const G8_LAS v4i*)(lds + G8_SB(b, h) + boff + n * 2048), _hi = *(const G8_LAS v4i*)(lds + G8_SB(b, h) + boff + n * 2048 + 1024); dst##8[n] = __builtin_shufflevector(_lo, _hi, 0, 1, 2, 3, 4, 5, 6, 7); } } \
        else { _Pragma("unroll") for (int n = 0; n < 2; ++n) _Pragma("unroll") for (int k = 0; k < 2; ++k) dst[n][k] = *(const G8_LAS bf16x8*)(lds + G8_SB(b, h) + boff + n * 2048 + k * 1024); } } while (0)
#define G8_MMA(ai, bj, At, Bt) do { __builtin_amdgcn_s_setprio(1); _Pragma("unroll") for (int m = 0; m < 4; ++m) _Pragma("unroll") for (int n = 0; n < 2; ++n) { \
        if constexpr (FP8) asm volatile("v_mfma_f32_16x16x128_f8f6f4 %0, %1, %2, %0" : "+v"(acc[ai][bj][m][n]) : "v"(Bt##8[n]), "v"(At##8[m])); \
        else { _Pragma("unroll") for (int k = 0; k < 2; ++k) asm volatile("v_mfma_f32_16x16x32_bf16 %0, %1, %2, %0" : "+v"(acc[ai][bj][m][n]) : "v"(Bt[n][k]), "v"(At[FP8 ? 0 : m][k])); } } __builtin_amdgcn_s_setprio(0); } while (0)
#define G8_WAIT_V(n) asm volatile("s_waitcnt vmcnt(" #n ")" ::: "memory")
#define G8_WAIT_L(n) asm volatile("s_waitcnt lgkmcnt(" #n ")" ::: "memory")
#define G8_BAR __builtin_amdgcn_s_barrier()
#define G8_SCHED __builtin_amdgcn_sched_barrier(0)
    Unit cur, nxt, nn; int ui = 0;
    if (!S.next(0, cur)) return;
    f32x4 acc[2][2][4][2];
#pragma unroll
    for (int a = 0; a < 2; ++a)
#pragma unroll
        for (int b = 0; b < 2; ++b)
#pragma unroll
            for (int m = 0; m < 4; ++m)
#pragma unroll
                for (int n = 0; n < 2; ++n) acc[a][b][m][n] = (f32x4){0.f, 0.f, 0.f, 0.f};
    bf16x8 At[FP8 ? 1 : 4][2], B0[2][2], B1[2][2];
    v8i At8[FP8 ? 4 : 1], B08[2], B18[2];
    unsigned cv[2][2], nv[2][2], fv[2][2];
    G8_AOFF(cv, cur);
    bool has_next = S.next(1, nxt);
    if (has_next) { G8_AOFF(nv, nxt); } else {
#pragma unroll
        for (int h = 0; h < 2; ++h)
#pragma unroll
            for (int i = 0; i < 2; ++i) nv[h][i] = cv[h][i]; }
    unsigned cB = cur.boff, nB = has_next ? nxt.boff : cB;
    G8_STAGE(G8_SB(0, 0), rsB, cB, voffB); G8_STAGE(G8_SB(0, 1), rsB, cB + hstep, voffB); G8_STAGE(G8_SA(0, 0), rsA, 0u, cv[0]); G8_STAGE(G8_SA(0, 1), rsA, 0u, cv[1]);
    if (wr == 1) G8_BAR;
    G8_WAIT_V(2); G8_BAR;
    G8_STAGE(G8_SB(1, 0), rsB, cB + kstep, voffB); G8_STAGE(G8_SA(1, 0), rsA, kstep, cv[0]); G8_STAGE(G8_SB(1, 1), rsB, cB + hstep + kstep, voffB);
    G8_WAIT_V(6); G8_BAR;
    for (;;) {
#pragma unroll 1
        for (int t = 0; t < nt; t += 2) {
            const bool last = (t == nt - 2);
            const unsigned k1 = (unsigned)(t + 1) * kstep;
            const unsigned k2 = last ? 0u : (unsigned)(t + 2) * kstep;
            const unsigned b2 = last ? nB : cB + (unsigned)(t + 2) * kstep, b3 = b2 + kstep;
            G8_LDB(B0, 0, 0); G8_LDB(B1, 0, 1); G8_SCHED; G8_LDA(At, 0, 0); G8_STAGE(G8_SA(1, 1), rsA, k1, cv[1]);
            G8_WAIT_V(8); G8_WAIT_L(0); G8_BAR; G8_MMA(0, 0, At, B0); G8_MMA(0, 1, At, B1); G8_BAR; G8_SCHED;
            G8_LDA(At, 0, 1); G8_STAGE(G8_SB(0, 0), rsB, b2, voffB); G8_STAGE(G8_SB(0, 1), rsB, b2 + hstep, voffB); { const unsigned sv_[2] = {last ? nv[0][0] : cv[0][0], last ? nv[0][1] : cv[0][1]}; G8_STAGE(G8_SA(0, 0), rsA, k2, sv_); }
            G8_WAIT_V(8); G8_WAIT_L(0); G8_BAR; G8_MMA(1, 0, At, B0); G8_MMA(1, 1, At, B1); G8_BAR; G8_SCHED;
            G8_LDB(B0, 1, 0); G8_LDB(B1, 1, 1); G8_SCHED; G8_LDA(At, 1, 0); { const unsigned sv_[2] = {last ? nv[1][0] : cv[1][0], last ? nv[1][1] : cv[1][1]}; G8_STAGE(G8_SA(0, 1), rsA, k2, sv_); }
            G8_WAIT_V(8); G8_WAIT_L(0); G8_BAR; G8_MMA(0, 0, At, B0); G8_MMA(0, 1, At, B1); G8_BAR; G8_SCHED;
            G8_LDA(At, 1, 1); G8_STAGE(G8_SB(1, 0), rsB, b3, voffB); G8_STAGE(G8_SB(1, 1), rsB, b3 + hstep, voffB); { const unsigned sv_[2] = {last ? nv[0][0] : cv[0][0], last ? nv[0][1] : cv[0][1]}; G8_STAGE(G8_SA(1, 0), rsA, k2 + kstep, sv_); }
            G8_WAIT_V(8); G8_WAIT_L(0); G8_BAR; G8_MMA(1, 0, At, B0); G8_MMA(1, 1, At, B1); G8_BAR; G8_SCHED;
        }
        asm volatile("s_nop 15\n\ts_nop 7" ::: "memory");
        if (wr == 0) G8_BAR;
        const bool has_nn = has_next && S.next(ui + 2, nn);
        if (has_nn) { G8_AOFF(fv, nn); }
        E(acc, cur, wr, wc, fr, fq);
        if (!has_next) break;
#pragma unroll
        for (int a = 0; a < 2; ++a)
#pragma unroll
            for (int b = 0; b < 2; ++b)
#pragma unroll
                for (int m = 0; m < 4; ++m)
#pragma unroll
                    for (int n = 0; n < 2; ++n) acc[a][b][m][n] = (f32x4){0.f, 0.f, 0.f, 0.f};
        cur = nxt; cB = nB; ++ui;
#pragma unroll
        for (int h = 0; h < 2; ++h)
#pragma unroll
            for (int i = 0; i < 2; ++i) { cv[h][i] = nv[h][i]; nv[h][i] = has_nn ? fv[h][i] : nv[h][i]; }
        has_next = has_nn; if (has_nn) { nxt = nn; nB = nn.boff; }
        if (wr == 1) G8_BAR;
    }
    G8_WAIT_V(0);
    G8_BAR;
#undef G8_AOFF
#undef G8_SA
#undef G8_SB
#undef G8_STAGE
#undef G8_LDA
#undef G8_LDB
#undef G8_MMA
#undef G8_WAIT_V
#undef G8_WAIT_L
#undef G8_BAR
#undef G8_SCHED
}

struct MoeSched {
    int nct, RP;
    const G8_LAS int* ut; const G8_LAS int* tp; const G8_LAS int* cnt;
    const int* list;
    const char* Bt; unsigned bt_estride;
    DEVI bool next(int i, Unit& u) const {
        if (i >= 32) return false;
        const int v = __builtin_amdgcn_readfirstlane(ut[i]);
        if (v < 0) return false;
        const int e = v & 255, rtg = (v >> 8) & 0xffff, ct = v >> 24;
        const int rt = rtg - __builtin_amdgcn_readfirstlane(tp[e]);
        u.e = e; u.orow0 = rtg * 256; u.ocol0 = ct * 256;
        u.boff = (unsigned)e * bt_estride + (unsigned)(ct * 256 * RP);
        if (list) { u.aoff = e * NTOK + rt * 256; u.alist = list + u.aoff; u.acnt = min(256, __builtin_amdgcn_readfirstlane(cnt[e]) - rt * 256); u.arow0 = 0; }
        else { u.alist = nullptr; u.acnt = 0; u.aoff = 0; u.arow0 = rtg * 256; }
        return true;
    }
};
DEVI void moe_units(G8_LAS int* ut, const G8_LAS int* tp, int nct, int G, int vcu, int tid) {
    if (tid < 32) {
        const int L = tid * G + vcu, total = tp[32] * nct; int v = -1;
        if (L < total) { const int rtg = L / nct, ct = L - rtg * nct; int e = 0;
            for (int k = 1; k < 32; ++k) e += (rtg >= tp[k]) ? 1 : 0;
            v = e | (rtg << 8) | (ct << 24); }
        ut[tid] = v;
    }
}
struct DenseSched {
    int G, c, RP, nM0, nN0; const char* Bt0; int nM1, nN1, arow1; const char* Bt1;
    DEVI bool next(int i, Unit& u) const {
        const int nwg = nM0 * nN0, L = i * G + c;
        u.alist = nullptr; u.acnt = 0; u.aoff = 0;
        if (L < nwg) {
            int wgid = L; { const int q = nwg / 8, r = nwg % 8, xcd = wgid % 8, off = wgid / 8; wgid = (xcd < r ? xcd * (q + 1) : r * (q + 1) + (xcd - r) * q) + off; }
            const int nig = 8 * nN0, gid = wgid / nig, fm = gid * 8, gsz = (nM0 - fm) < 8 ? (nM0 - fm) : 8;
            const int pm = fm + ((wgid % nig) % gsz), pn = (wgid % nig) / gsz;
            u.e = 0; u.arow0 = pm * 256; u.orow0 = pm * 256; u.ocol0 = pn * 256; u.boff = (unsigned)(pn * 256 * RP); return true;
        }
        const int l = L - nwg; if (l >= nM1 * nN1) return false;
        const int pm = l / nN1, pn = l - pm * nN1;
        u.e = 1; u.arow0 = arow1 + pm * 256; u.orow0 = pm * 256; u.ocol0 = pn * 256; u.boff = (unsigned)(Bt1 - Bt0) + (unsigned)(pn * 256 * RP); return true;
    }
};
}

DEVI unsigned f2bf(float f) { unsigned u = __builtin_bit_cast(unsigned, f); return (u + 0x7fffu + ((u >> 16) & 1u)) >> 16; }
DEVI unsigned pk2(float lo, float hi) { return f2bf(lo) | (f2bf(hi) << 16); }
typedef unsigned v4u __attribute__((ext_vector_type(4)));
DEVI void t8_load(const float* W, int N, int item, int ipe  , int lane, float4 (&v)[16]) {
    const int e = item / ipe, q = item - e * ipe, nblk = N / 64, kb = q / nblk, nb = q - kb * nblk;
    const float* src = W + (size_t)e * 1024 * N + (size_t)(64 * kb + (lane >> 4)) * N + 64 * nb + 4 * (lane & 15);
#pragma unroll
    for (int i = 0; i < 16; ++i) v[i] = *(const float4*)(src + (size_t)(4 * i) * N);
}
DEVI void t8_lds_write(const float4 (&v)[16], __attribute__((address_space(3))) float* scr, int lane) {
    const int kr = lane >> 4, c4 = lane & 15;
#pragma unroll
    for (int i = 0; i < 16; ++i) { __attribute__((address_space(3))) float* d = scr + (4 * i + kr) * 65 + 4 * c4; d[0] = v[i].x; d[1] = v[i].y; d[2] = v[i].z; d[3] = v[i].w; }
    asm volatile("s_waitcnt lgkmcnt(0)" ::: "memory");
}
DEVI void t8_pack_store(unsigned char* WT, int N, int item, int ipe, int lane, const __attribute__((address_space(3))) float* scr, const float* ks) {
    const int e = item / ipe, q = item - e * ipe, nblk = N / 64, kb = q / nblk, nb = q - kb * nblk, k0 = 64 * kb, n0 = 64 * nb;
    const int c = lane & 7, ns = lane >> 3;
    float kf[8];
#pragma unroll
    for (int q2 = 0; q2 < 8; ++q2) kf[q2] = 32.f * (ks ? ks[k0 + 8 * c + q2] : 1.f);
    unsigned char* dst = WT + (size_t)e * N * 1024 + (size_t)n0 * 1024 + k0 + 8 * c;
#pragma unroll
    for (int j = 0; j < 8; ++j) { const int n = ns + 8 * j; const __attribute__((address_space(3))) float* s = scr + (8 * c) * 65 + n;
        uint2 o; o.x = g8::pk4_fp8(kf[0] * s[0 * 65], kf[1] * s[1 * 65], kf[2] * s[2 * 65], kf[3] * s[3 * 65]); o.y = g8::pk4_fp8(kf[4] * s[4 * 65], kf[5] * s[5 * 65], kf[6] * s[6 * 65], kf[7] * s[7 * 65]);
        *(uint2*)(dst + (size_t)n * 1024) = o; }
    asm volatile("s_waitcnt lgkmcnt(0)" ::: "memory");
}
DEVI void t8_run(const float* W, int N, unsigned char* WT, const float* ks, int first, int end, int stride, int lane, __attribute__((address_space(3))) float* scr) {
    const int ipe = 16 * (N / 64);
    float4 v[16];
    int it = first;
    if (it < end) t8_load(W, N, it, ipe, lane, v);
    while (it < end) {
        t8_lds_write(v, scr, lane);
        const int nx = it + stride;
        if (nx < end) t8_load(W, N, nx, ipe, lane, v);
        t8_pack_store(WT, N, it, ipe, lane, scr, ks);
        it = nx;
    }
}
DEVI void transpose_item(const float* W, int K, int N, unsigned short* WT, __attribute__((address_space(3))) float* scr, int item, int lane, int ncols = 0, const float* ks = nullptr) {
    const int nblk = (ncols ? ncols : N) / 64, kb = item / nblk, nb = item % nblk, k0 = 64 * kb, n0 = 64 * nb;
    const int kr = lane >> 4, c4 = lane & 15;
    float4 v[16];
#pragma unroll
    for (int i = 0; i < 16; ++i) v[i] = *(const float4*)(W + (size_t)(k0 + 4 * i + kr) * N + n0 + 4 * c4);
#pragma unroll
    for (int i = 0; i < 16; ++i) { __attribute__((address_space(3))) float* d = scr + (4 * i + kr) * 65 + 4 * c4; d[0] = v[i].x; d[1] = v[i].y; d[2] = v[i].z; d[3] = v[i].w; }
    asm volatile("s_waitcnt lgkmcnt(0)" ::: "memory");
    const int c = lane & 7, ns = lane >> 3;
    float kf[8];
#pragma unroll
    for (int q = 0; q < 8; ++q) kf[q] = ks ? ks[k0 + 8 * c + q] : 1.f;
#pragma unroll
    for (int j = 0; j < 8; ++j) { const int n = ns + 8 * j; const __attribute__((address_space(3))) float* s = scr + (8 * c) * 65 + n;
        v4u o; o.x = pk2(kf[0] * s[0 * 65], kf[1] * s[1 * 65]); o.y = pk2(kf[2] * s[2 * 65], kf[3] * s[3 * 65]); o.z = pk2(kf[4] * s[4 * 65], kf[5] * s[5 * 65]); o.w = pk2(kf[6] * s[6 * 65], kf[7] * s[7 * 65]);
        *(v4u*)(WT + (size_t)(n0 + n) * K + k0 + 8 * c) = o; }
    asm volatile("s_waitcnt lgkmcnt(0)" ::: "memory");
}

#define LAS3 __attribute__((address_space(3)))

typedef float f32x16 __attribute__((ext_vector_type(16)));
typedef short bf16x8_t __attribute__((ext_vector_type(8)));
typedef float f32x2_t __attribute__((ext_vector_type(2)));
typedef __bf16 bf16x2_t __attribute__((ext_vector_type(2)));
typedef unsigned u32x4_t __attribute__((ext_vector_type(4)));
typedef unsigned u32x2_t __attribute__((ext_vector_type(2)));
#define MFMA32(a, b, c) __builtin_amdgcn_mfma_f32_32x32x16_bf16((a), (b), (c), 0, 0, 0)
DEVI unsigned cvtpk(float lo, float hi) { f32x2_t v = {lo, hi}; bf16x2_t b = __builtin_convertvector(v, bf16x2_t); return __builtin_bit_cast(unsigned, b); }
DEVI int crow(int reg, int hi) { return (reg & 3) + 8 * (reg >> 2) + 4 * hi; }
DEVI bf16x8_t pack_step(const f32x16& x, int s) {
    u32x4_t p; p[0] = cvtpk(x[8 * s], x[8 * s + 1]); p[1] = cvtpk(x[8 * s + 2], x[8 * s + 3]); p[2] = cvtpk(x[8 * s + 4], x[8 * s + 5]); p[3] = cvtpk(x[8 * s + 6], x[8 * s + 7]);
    return __builtin_bit_cast(bf16x8_t, p);
}
DEVI int t5_bucket(int d) { return d < 16 ? d : min(31, 16 + (int)(log2f((float)d * 0.0625f) * (16.f / 3.f))); }

DEVI void swa_item(int item, const unsigned short* PROJB, unsigned short* MIXB, const float* relb, const float* sinks, LAS3 unsigned char* L, int tid_) {
    int tid = tid_; asm volatile("" : "+v"(tid));
    const int kv = item & 1, qb = (item >> 1) & 63, b = item >> 7;
    const int lane = tid & 63, w = __builtin_amdgcn_readfirstlane(tid >> 6), hi = lane >> 5, r32 = lane & 31;
    LAS3 unsigned char* KL = L; LAS3 unsigned char* VT = L + 36864; LAS3 float* BT = (LAS3 float*)(L + 36864 + 33280);
    const long tok0 = (long)b * SEQ + (long)(qb - 1) * 128;
#pragma unroll
    for (int i = 0; i < 4; ++i) { const int ci = tid + 512 * i, row = ci >> 3, ch = ci & 7; const bool ok = (qb > 0) || (row >= 128);
        u32x4_t v = {0u, 0u, 0u, 0u}; if (ok) v = *(const u32x4_t*)(PROJB + (size_t)(tok0 + row) * PJ + PJ_K + kv * 64 + ch * 8);
        *(LAS3 u32x4_t*)(KL + row * 144 + ch * 16) = v; }
#pragma unroll
    for (int i = 0; i < 2; ++i) { const int it = tid + 512 * i, rp = it >> 3, ch = it & 7; const bool ok = (qb > 0) || (rp >= 64);
        u32x4_t v0 = {0u, 0u, 0u, 0u}, v1 = {0u, 0u, 0u, 0u};
        if (ok) { const unsigned short* vp = PROJB + (size_t)(tok0 + 2 * rp) * PJ + PJ_V + kv * 64 + ch * 8; v0 = *(const u32x4_t*)vp; v1 = *(const u32x4_t*)(vp + PJ); }
#pragma unroll
        for (int e = 0; e < 8; ++e) { const unsigned a = (e & 1) ? (v0[e >> 1] >> 16) : (v0[e >> 1] & 0xffffu), c = (e & 1) ? (v1[e >> 1] & 0xffff0000u) : (v1[e >> 1] << 16);
            *(LAS3 unsigned*)(VT + (ch * 8 + e) * 520 + rp * 4) = a | c; } }
    { const int hql = tid >> 7, d = tid & 127; BT[tid] = relb[t5_bucket(d) * 8 + kv * 4 + hql]; }
    __syncthreads();
    const int hql = w >> 1, hq = kv * 4 + hql, qhalf = w & 1;
    const float sink = sinks[hq];
#pragma unroll 1
    for (int qi = 0; qi < 2; ++qi) {
        const int m = 2 * qhalf + qi, qf0 = 128 + 32 * m;
        const size_t qrow0 = (size_t)b * SEQ + (size_t)qb * 128 + 32 * m;
        const unsigned short* qp = PROJB + (qrow0 + r32) * PJ + PJ_Q + hq * 64 + 8 * hi;
        bf16x8_t qf[4];
#pragma unroll
        for (int ks = 0; ks < 4; ++ks) qf[ks] = *(const bf16x8_t*)(qp + 16 * ks);
        f32x16 S[5];
#pragma unroll
        for (int kk = 0; kk < 5; ++kk) {
#pragma unroll
            for (int r = 0; r < 16; ++r) S[kk][r] = 0.f;
#pragma unroll
            for (int ks = 0; ks < 4; ++ks) { const bf16x8_t a = *(const LAS3 bf16x8_t*)(KL + (32 * (m + kk) + r32) * 144 + (16 * ks + 8 * hi) * 2); S[kk] = MFMA32(a, qf[ks], S[kk]); }
        }
        float mx = sink;
#pragma unroll
        for (int kk = 0; kk < 5; ++kk)
#pragma unroll
            for (int r = 0; r < 16; ++r) { const int kf = 32 * (m + kk) + crow(r, hi), dist = qf0 + r32 - kf; const bool ok = (dist >= 0) && (dist < 128) && ((qb > 0) || (kf >= 128));
                const float sc = ok ? S[kk][r] * 0.125f + BT[hql * 128 + (dist & 127)] : -INFINITY; S[kk][r] = sc; mx = fmaxf(mx, sc); }
        mx = fmaxf(mx, xshfl(mx, 32, lane));
        float sum = 0.f;
#pragma unroll
        for (int kk = 0; kk < 5; ++kk)
#pragma unroll
            for (int r = 0; r < 16; ++r) { const float pe = __expf(S[kk][r] - mx); S[kk][r] = pe; sum += pe; }
        sum += xshfl(sum, 32, lane); sum += __expf(sink - mx);
        const float linv = 1.f / sum;
        f32x16 O[2];
#pragma unroll
        for (int db = 0; db < 2; ++db)
#pragma unroll
            for (int r = 0; r < 16; ++r) O[db][r] = 0.f;
#pragma unroll
        for (int kk = 0; kk < 5; ++kk)
#pragma unroll
            for (int s2 = 0; s2 < 2; ++s2) { const bf16x8_t pa = pack_step(S[kk], s2); const int kbase = 32 * (m + kk) + 16 * s2 + 4 * hi;
#pragma unroll
                for (int db = 0; db < 2; ++db) { LAS3 unsigned char* vp = VT + (32 * db + r32) * 520 + kbase * 2;
                    const u32x2_t lo = *(const LAS3 u32x2_t*)vp, hi2 = *(const LAS3 u32x2_t*)(vp + 16);
                    const u32x4_t vv = {lo[0], lo[1], hi2[0], hi2[1]};
                    O[db] = MFMA32(pa, __builtin_bit_cast(bf16x8_t, vv), O[db]); } }
#pragma unroll
        for (int r = 0; r < 16; ++r) { const int q = crow(r, hi); const float li = bperm(linv, q);
            unsigned short* op = MIXB + (qrow0 + q) * 1024 + 512 + hq * 64 + r32;
            op[0] = (unsigned short)(cvtpk(O[0][r] * li, 0.f) & 0xffffu); op[32] = (unsigned short)(cvtpk(O[1][r] * li, 0.f) & 0xffffu); }
    }
    __syncthreads();
}

DEVI void xattn_item(int item, const unsigned short* QCB, const unsigned short* KVMB, const float* SSQ, unsigned short* OCB, LAS3 unsigned char* L, int tid_) {
    int tid = tid_; asm volatile("" : "+v"(tid));
    const int qblk = item & 31, hd = (item >> 5) & 3, b = item >> 7;
    const int lane = tid & 63, w = __builtin_amdgcn_readfirstlane(tid >> 6), hi = lane >> 5, r32 = lane & 31;
    LAS3 unsigned char* KL = L; LAS3 unsigned char* VT = L + 69632;
    const unsigned short* kvb = KVMB + (size_t)b * MEMLEN * 1024 + hd * 128;
#pragma unroll
    for (int i = 0; i < 8; ++i) { const int ci = tid + 512 * i, row = ci >> 4, ch = ci & 15;
        *(LAS3 u32x4_t*)(KL + row * 272 + ch * 16) = *(const u32x4_t*)(kvb + (size_t)row * 1024 + ch * 8); }
#pragma unroll
    for (int i = 0; i < 4; ++i) { const int it = tid + 512 * i, rp = it >> 4, ch = it & 15;
        const unsigned short* vp = kvb + (size_t)(2 * rp) * 1024 + 512 + ch * 8; const u32x4_t v0 = *(const u32x4_t*)vp, v1 = *(const u32x4_t*)(vp + 1024);
#pragma unroll
        for (int e = 0; e < 8; ++e) { const unsigned a = (e & 1) ? (v0[e >> 1] >> 16) : (v0[e >> 1] & 0xffffu), c = (e & 1) ? (v1[e >> 1] & 0xffff0000u) : (v1[e >> 1] << 16);
            *(LAS3 unsigned*)(VT + (ch * 8 + e) * 520 + rp * 4) = a | c; } }
    __syncthreads();
    const size_t qrow0 = (size_t)b * SEQ + (size_t)qblk * 256 + 32 * w;
    const unsigned short* qp = QCB + (qrow0 + r32) * 512 + hd * 128 + 8 * hi;
    f32x16 S[8];
    {
        bf16x8_t qf[8];
#pragma unroll
        for (int ks = 0; ks < 8; ++ks) qf[ks] = *(const bf16x8_t*)(qp + 16 * ks);
#pragma unroll
        for (int kk = 0; kk < 8; ++kk) {
#pragma unroll
            for (int r = 0; r < 16; ++r) S[kk][r] = 0.f;
#pragma unroll
            for (int ks = 0; ks < 8; ++ks) { const bf16x8_t a = *(const LAS3 bf16x8_t*)(KL + (32 * kk + r32) * 272 + (16 * ks + 8 * hi) * 2); S[kk] = MFMA32(a, qf[ks], S[kk]); }
        }
    }
    float sc = 0.08838834764831845f;
    {
        const float* sp = SSQ + (qrow0 + r32) * 32; float t = 0.f;
#pragma unroll
        for (int i = 0; i < 8; ++i) { const float4 v = ld4(sp + 4 * i); t += (v.x + v.y) + (v.z + v.w); }
        sc *= rsqrtf(t * (1.f / 1024.f) + EPS);
    }
    float mx = -INFINITY;
#pragma unroll
    for (int kk = 0; kk < 8; ++kk)
#pragma unroll
        for (int r = 0; r < 16; ++r) mx = fmaxf(mx, S[kk][r]);
    mx = fmaxf(mx, xshfl(mx, 32, lane));
    float sum = 0.f;
#pragma unroll
    for (int kk = 0; kk < 8; ++kk)
#pragma unroll
        for (int r = 0; r < 16; ++r) { const float pe = __expf((S[kk][r] - mx) * sc); S[kk][r] = pe; sum += pe; }
    sum += xshfl(sum, 32, lane);
    const float linv = 1.f / sum;
    f32x16 O[4];
#pragma unroll
    for (int db = 0; db < 4; ++db)
#pragma unroll
        for (int r = 0; r < 16; ++r) O[db][r] = 0.f;
#pragma unroll
    for (int kk = 0; kk < 8; ++kk)
#pragma unroll
        for (int s2 = 0; s2 < 2; ++s2) { const bf16x8_t pa = pack_step(S[kk], s2); const int kbase = 32 * kk + 16 * s2 + 4 * hi;
#pragma unroll
            for (int db = 0; db < 4; ++db) { LAS3 unsigned char* vp = VT + (32 * db + r32) * 520 + kbase * 2;
                const u32x2_t lo = *(const LAS3 u32x2_t*)vp, hi2 = *(const LAS3 u32x2_t*)(vp + 16);
                const u32x4_t vv = {lo[0], lo[1], hi2[0], hi2[1]};
                O[db] = MFMA32(pa, __builtin_bit_cast(bf16x8_t, vv), O[db]); } }
#pragma unroll
    for (int r = 0; r < 16; ++r) { const int q = crow(r, hi); const float li = bperm(linv, q);
        unsigned short* op = OCB + (qrow0 + q) * 512 + hd * 128 + r32;
#pragma unroll
        for (int db = 0; db < 4; ++db) op[32 * db] = (unsigned short)(cvtpk(O[db][r] * li, 0.f) & 0xffffu); }
    __syncthreads();
}


DEVI void ssd_s1_item(int item, const unsigned short* PROJB, const float* DTRAW, const float* convw, const float* convb, const float* dtbias, const float* alog,
                      unsigned short* XC, float* DT, float* ACS, float* CD, float* ST, LAS3 unsigned char* L, int tid_) {
    int tid = tid_; asm volatile("" : "+v"(tid));
    const int g = item & 1, c = (item >> 1) & 63, b = item >> 7;
    const int lane = tid & 63, w = __builtin_amdgcn_readfirstlane(tid >> 6), hi = lane >> 5, r32 = lane & 31;
    LAS3 unsigned char* XwT = L; LAS3 unsigned char* BT = L + 69632;
    LAS3 float* dts = (LAS3 float*)(L + 104448); LAS3 float* acs = dts + 512; LAS3 float* wts = acs + 512;
    const size_t tok0 = (size_t)b * SEQ + (size_t)c * 128;
    if (w < 4) {
        const int h = 4 * g + w; const float ah = -__expf(alog[h]), db = dtbias[h];
        const float d0 = softplus_f(DTRAW[(tok0 + 2 * lane) * 8 + h] + db), d1 = softplus_f(DTRAW[(tok0 + 2 * lane + 1) * 8 + h] + db);
        const float a0 = d0 * ah, a1 = d1 * ah;
        float sc = a0 + a1;
#pragma unroll
        for (int o = 1; o < 64; o <<= 1) { const float v = bperm(sc, lane - o); if (lane >= o) sc += v; }
        const float ex = sc - (a0 + a1), c0 = ex + a0, c1 = ex + a0 + a1, cend = bperm(sc, 63);
        dts[w * 128 + 2 * lane] = d0; dts[w * 128 + 2 * lane + 1] = d1; acs[w * 128 + 2 * lane] = c0; acs[w * 128 + 2 * lane + 1] = c1;
        wts[w * 128 + 2 * lane] = __expf(cend - c0) * d0; wts[w * 128 + 2 * lane + 1] = __expf(cend - c1) * d1;
        DT[(tok0 + 2 * lane) * 8 + h] = d0; DT[(tok0 + 2 * lane + 1) * 8 + h] = d1; ACS[(tok0 + 2 * lane) * 8 + h] = c0; ACS[(tok0 + 2 * lane + 1) * 8 + h] = c1;
        if (lane == 0) CD[((size_t)b * 64 + c) * 8 + h] = __expf(cend);
    }
    __syncthreads();
    {
        const int cg = lane, ch = cg < 32 ? g * 256 + cg * 8 : (cg < 48 ? 512 + g * 128 + (cg - 32) * 8 : 768 + g * 128 + (cg - 48) * 8);
        float wk[4][8], bb[8];
#pragma unroll
        for (int k = 0; k < 4; ++k) { const float4 a = ld4(convw + k * CONVCH + ch), d = ld4(convw + k * CONVCH + ch + 4); wk[k][0] = a.x; wk[k][1] = a.y; wk[k][2] = a.z; wk[k][3] = a.w; wk[k][4] = d.x; wk[k][5] = d.y; wk[k][6] = d.z; wk[k][7] = d.w; }
        { const float4 a = ld4(convb + ch), d = ld4(convb + ch + 4); bb[0] = a.x; bb[1] = a.y; bb[2] = a.z; bb[3] = a.w; bb[4] = d.x; bb[5] = d.y; bb[6] = d.z; bb[7] = d.w; }
        const int s0 = w * 16;
        const unsigned short* src = PROJB + (tok0 + s0) * PJ + PJ_XBC + ch;
        u32x4_t rw[19];
#pragma unroll
        for (int i = 0; i < 19; ++i) { const bool ok = (c > 0) || (s0 + i - 3 >= 0); rw[i] = (u32x4_t){0u, 0u, 0u, 0u}; if (ok) rw[i] = *(const u32x4_t*)(src + (ptrdiff_t)(i - 3) * PJ); }
        const int hl = cg >> 3;
#pragma unroll
        for (int i2 = 0; i2 < 8; ++i2) {
            float y[2][8];
#pragma unroll
            for (int q = 0; q < 2; ++q) {
                const int i = 2 * i2 + q;
#pragma unroll
                for (int e = 0; e < 8; ++e) { float a = bb[e];
#pragma unroll
                    for (int k = 0; k < 4; ++k) { const unsigned wd = rw[i + k][e >> 1]; a += wk[k][e] * __uint_as_float((e & 1) ? (wd & 0xffff0000u) : (wd << 16)); }
                    y[q][e] = silu_f(a); }
                u32x4_t o; o[0] = cvtpk(y[q][0], y[q][1]); o[1] = cvtpk(y[q][2], y[q][3]); o[2] = cvtpk(y[q][4], y[q][5]); o[3] = cvtpk(y[q][6], y[q][7]);
                *(u32x4_t*)(XC + (tok0 + s0 + i) * 1024 + ch) = o;
            }
            const int s = s0 + 2 * i2;
            if (cg < 32) { const float w0 = wts[hl * 128 + s], w1 = wts[hl * 128 + s + 1];
#pragma unroll
                for (int e = 0; e < 8; ++e) *(LAS3 unsigned*)(XwT + hl * 17408 + ((cg & 7) * 8 + e) * 272 + ((((s >> 3) ^ (cg & 7)) & 15) << 4) + (s & 7) * 2) = cvtpk(y[0][e] * w0, y[1][e] * w1); }
            else if (cg < 48) {
#pragma unroll
                for (int e = 0; e < 8; ++e) *(LAS3 unsigned*)(BT + ((cg - 32) * 8 + e) * 272 + ((((s >> 3) ^ ((cg - 32) & 7)) & 15) << 4) + (s & 7) * 2) = cvtpk(y[0][e], y[1][e]); }
        }
    }
    __syncthreads();
    {
        const int pb = w >> 2, nb = w & 3;
#pragma unroll 1
        for (int hl = 0; hl < 4; ++hl) {
            f32x16 acc;
#pragma unroll
            for (int r = 0; r < 16; ++r) acc[r] = 0.f;
#pragma unroll
            for (int ks = 0; ks < 8; ++ks) { const bf16x8_t a = *(const LAS3 bf16x8_t*)(XwT + hl * 17408 + (32 * pb + r32) * 272 + (((2 * ks + hi) ^ ((r32 >> 3) + 4 * pb)) & 15) * 16);
                const bf16x8_t bq = *(const LAS3 bf16x8_t*)(BT + (32 * nb + r32) * 272 + (((2 * ks + hi) ^ (((r32 >> 3) + 4 * nb) & 7)) & 15) * 16); acc = MFMA32(a, bq, acc); }
            float* sp = ST + (((size_t)b * 64 + c) * 8 + 4 * g + hl) * 8192 + 32 * nb + r32;
#pragma unroll
            for (int r = 0; r < 16; ++r) sp[(32 * pb + crow(r, hi)) * 128] = acc[r];
        }
    }
    __syncthreads();
}

DEVI void ssd_s3_item(int item, const unsigned short* XC, const float* DT, const float* ACS, const unsigned short* HIN, const unsigned short* PROJB, const float* dskip, const float* gssm,
                      float* YPRE, unsigned short* MIXB, LAS3 unsigned char* L, int tid_) {
    int tid = tid_; asm volatile("" : "+v"(tid));
    const int g = item & 1, c = (item >> 1) & 63, b = item >> 7;
    const int lane = tid & 63, w = __builtin_amdgcn_readfirstlane(tid >> 6), hi = lane >> 5, r32 = lane & 31;
    LAS3 unsigned char* Cs = L; LAS3 unsigned char* BM = L + 34816; LAS3 unsigned char* XT = L + 69632; LAS3 unsigned char* HN = L + 87040;
    LAS3 float* dts = (LAS3 float*)(L + 104448); LAS3 float* acs = dts + 512; LAS3 float* rowsq = acs + 512;
    const size_t tok0 = (size_t)b * SEQ + (size_t)c * 128;
#pragma unroll
    for (int i = 0; i < 4; ++i) { const int ci = tid + 512 * i, row = ci >> 4, chk = ci & 15;
        *(LAS3 u32x4_t*)(Cs + row * 272 + chk * 16) = *(const u32x4_t*)(XC + (tok0 + row) * 1024 + 768 + g * 128 + chk * 8);
        *(LAS3 u32x4_t*)(BM + row * 272 + chk * 16) = *(const u32x4_t*)(XC + (tok0 + row) * 1024 + 512 + g * 128 + chk * 8); }
    { const int t = tid >> 2, hl = tid & 3; dts[hl * 128 + t] = DT[(tok0 + t) * 8 + 4 * g + hl]; acs[hl * 128 + t] = ACS[(tok0 + t) * 8 + 4 * g + hl]; }
    __syncthreads();
    const int lb = w >> 1;
    f32x16 CB[2];
#pragma unroll
    for (int j = 0; j < 2; ++j) {
#pragma unroll
        for (int r = 0; r < 16; ++r) CB[j][r] = 0.f;
        const int sb = 2 * (w & 1) + j;
        if (sb <= lb) {
#pragma unroll
            for (int ks = 0; ks < 8; ++ks) { const bf16x8_t a = *(const LAS3 bf16x8_t*)(Cs + (32 * lb + r32) * 272 + (16 * ks + 8 * hi) * 2);
                const bf16x8_t bq = *(const LAS3 bf16x8_t*)(BM + (32 * sb + r32) * 272 + (16 * ks + 8 * hi) * 2); CB[j] = MFMA32(a, bq, CB[j]); }
        }
    }
    __syncthreads();
    const int pb = w & 1;
    LAS3 unsigned char* ZS = L + 110592;
    float sq[16];
#pragma unroll
    for (int r = 0; r < 16; ++r) sq[r] = 0.f;
#pragma unroll 1
    for (int hl = 0; hl < 4; ++hl) {
        const int h = 4 * g + hl;
        {
            const int sp = tid >> 3, chk = tid & 7;
            const unsigned short* xp = XC + (tok0 + 2 * sp) * 1024 + h * 64 + chk * 8; const u32x4_t v0 = *(const u32x4_t*)xp, v1 = *(const u32x4_t*)(xp + 1024);
#pragma unroll
            for (int e = 0; e < 8; ++e) { const unsigned a = (e & 1) ? (v0[e >> 1] >> 16) : (v0[e >> 1] & 0xffffu), d = (e & 1) ? (v1[e >> 1] & 0xffff0000u) : (v1[e >> 1] << 16);
                *(LAS3 unsigned*)(XT + (chk * 8 + e) * 272 + ((((sp >> 2) ^ chk) & 15) << 4) + (sp & 3) * 4) = a | d; }
            const unsigned short* hp = HIN + (((size_t)b * 64 + c) * 8 + h) * 8192;
#pragma unroll
            for (int i = 0; i < 2; ++i) { const int ci = tid + 512 * i, row = ci >> 4, ck = ci & 15; *(LAS3 u32x4_t*)(HN + row * 272 + ck * 16) = *(const u32x4_t*)(hp + row * 128 + ck * 8); }
#pragma unroll
            for (int i = 0; i < 2; ++i) { const int ci = tid + 512 * i, row = ci >> 3, ck = ci & 7; *(LAS3 u32x4_t*)(ZS + row * 144 + ck * 16) = *(const u32x4_t*)(PROJB + (tok0 + row) * PJ + PJ_Z + h * 64 + ck * 8); }
        }
#pragma unroll
        for (int j = 0; j < 2; ++j) { const int sb = 2 * (w & 1) + j;
            if (sb <= lb) { const int s = 32 * sb + r32; const float as = acs[hl * 128 + s], ds = dts[hl * 128 + s];
#pragma unroll
                for (int r = 0; r < 16; ++r) { const int l = 32 * lb + crow(r, hi); const float ev = CB[j][r] * __expf(acs[hl * 128 + l] - as) * ds; const float v = (s <= l) ? ev : 0.f;
                    *(LAS3 unsigned short*)(BM + l * 272 + s * 2) = (unsigned short)(cvtpk(v, 0.f) & 0xffffu); } } }
        __syncthreads();
        f32x16 acc;
#pragma unroll
        for (int r = 0; r < 16; ++r) acc[r] = 0.f;
#pragma unroll
        for (int ks = 0; ks < 8; ++ks) { const bf16x8_t a = *(const LAS3 bf16x8_t*)(Cs + (32 * lb + r32) * 272 + (16 * ks + 8 * hi) * 2);
            const bf16x8_t bq = *(const LAS3 bf16x8_t*)(HN + (32 * pb + r32) * 272 + (16 * ks + 8 * hi) * 2); acc = MFMA32(a, bq, acc); }
#pragma unroll
        for (int r = 0; r < 16; ++r) acc[r] *= __expf(acs[hl * 128 + 32 * lb + crow(r, hi)]);
#pragma unroll
        for (int ks = 0; ks < 8; ++ks) if (ks < 2 * (lb + 1)) { const bf16x8_t a = *(const LAS3 bf16x8_t*)(BM + (32 * lb + r32) * 272 + (16 * ks + 8 * hi) * 2);
            const bf16x8_t bq = *(const LAS3 bf16x8_t*)(XT + (32 * pb + r32) * 272 + (((2 * ks + hi) ^ ((r32 >> 3) + 4 * pb)) & 15) * 16); acc = MFMA32(a, bq, acc); }
        const float dsk = dskip[h]; const int pc = 32 * pb + r32;
        unsigned short* yp = (unsigned short*)YPRE + tok0 * 512 + h * 64 + pc;
#pragma unroll
        for (int r = 0; r < 16; ++r) { const int l = 32 * lb + crow(r, hi);
            const float xv = bf2f(*(const LAS3 unsigned short*)(XT + pc * 272 + ((((l >> 3) ^ (pc >> 3)) & 15) << 4) + (l & 7) * 2)), z = bf2f(*(const LAS3 unsigned short*)(ZS + l * 144 + pc * 2));
            const float y = (acc[r] + dsk * xv) * silu_f(z); yp[l * 512] = (unsigned short)(cvtpk(y, 0.f) & 0xffffu); sq[r] += y * y; }
        __syncthreads();
    }
#pragma unroll
    for (int r = 0; r < 16; ++r) { float v = sq[r];
#pragma unroll
        for (int o = 1; o < 32; o <<= 1) v += xshfl(v, o, lane);
        if (r32 == 0) rowsq[(32 * lb + crow(r, hi)) * 2 + pb] = v; }
    __syncthreads();
#pragma unroll 1
    for (int hl = 0; hl < 4; ++hl) { const int col = (4 * g + hl) * 64 + 32 * pb + r32; const float gs = gssm[col];
#pragma unroll
        for (int r = 0; r < 16; ++r) { const int l = 32 * lb + crow(r, hi); const float rs = rsqrtf((rowsq[l * 2] + rowsq[l * 2 + 1]) * (1.f / 256.f) + EPS);
            MIXB[(tok0 + l) * 1024 + col] = (unsigned short)(cvtpk(bf2f(((const unsigned short*)YPRE)[(tok0 + l) * 512 + col]) * rs * gs, 0.f) & 0xffffu); } }
    __syncthreads();
}

__global__ void __launch_bounds__(512, 2) mk_fwd(Params p) {
    extern __shared__ __attribute__((aligned(16))) unsigned char lds[];
    const int NGW = gridDim.x * 8, NGT = gridDim.x * 512, G = gridDim.x;
    unsigned char* ws = p.ws;
    unsigned* ctl = (unsigned*)(ws + WS_CTL);
    unsigned short* H2B = (unsigned short*)(ws + WS_H1);
    float* DT = (float*)(ws + WS_DT); float* DTRAW = (float*)(ws + WS_DTRAW); float* GATE = (float*)(ws + WS_GATE); float* BIASP = (float*)(ws + WS_BIASP);
    typedef unsigned short bf;
    bf* XN = (bf*)(ws + WS_XN); bf* PROJB = (bf*)(ws + WS_BIG); bf* YB = (bf*)(ws + WS_YB); bf* MIXB = (bf*)(ws + WS_MIXB); bf* QCB = (bf*)(ws + WS_QCB); bf* OCB = (bf*)(ws + WS_OCB);
    bf* KVMB = (bf*)(ws + WS_KVMB);
    bf* XC = (bf*)(ws + WS_XC); float* ACS = (float*)(ws + WS_ACS); float* CD = (float*)(ws + WS_CD); float* ST = (float*)(ws + WS_ST); bf* HIN = (bf*)(ws + WS_HIN);
    unsigned char* Y8 = ws + WS_YB;
    unsigned char* W1T8 = ws + WS_W1T; unsigned char* W2T8 = ws + WS_W2T; unsigned char* XN8 = ws + WS_QCB; unsigned char* ACT8 = ws + WS_ACTB;
    bf* WINT = (bf*)(ws + WS_WINT); bf* WOUTT = (bf*)(ws + WS_WOUTT); bf* WQT = (bf*)(ws + WS_WQT); bf* WKVT = (bf*)(ws + WS_WKVT); bf* WOT = (bf*)(ws + WS_WOT);
    int* LIST = (int*)(ws + WS_LIST); int* SLOT = (int*)(ws + WS_SLOT); float* RSA = (float*)(ws + WS_RSA); float* SSQ1 = (float*)(ws + WS_SSQ1); int* CNTB = (int*)(ws + WS_CNTB); float* RSROW = (float*)(ws + WS_RSROW);
    LAS3 unsigned char* ldsp = (LAS3 unsigned char*)lds;
    LAS3 int* TP = (LAS3 int*)(ldsp + LDS_MISC); LAS3 int* CNTL = TP + 64;
    const float* x = p.in[I_X];
    const int vcu = (G % 8 == 0) ? (blockIdx.x % 8) * (G / 8) + blockIdx.x / 8 : blockIdx.x;
    const int wave_id = __builtin_amdgcn_readfirstlane(threadIdx.x >> 6);
    if (threadIdx.x < 2) ((LAS3 unsigned*)(ldsp + LDS_MISC + 512))[threadIdx.x] = 0u;
    __syncthreads();
    const XcdBarrier xbar = xcd_barrier_post(ctl + 4096, (volatile LAS3 unsigned*)(ldsp + LDS_MISC + 512), threadIdx.x == 0);
#define GRID_BAR() do { const TI tb_ = fresh_ti(wave_id); xcd_barrier(xbar, tb_.tid == 0); } while (0)

    PH_BEGIN(0)
    {
        PHASE_IDS();
        LAS3 float* wdt = (LAS3 float*)ldsp;
        for (int i = tid; i < 1024 * 2; i += 512) { const int k = i >> 1, hh = i & 1; { const float4 t4 = ld4(p.in[I_WIN] + (size_t)k * IN_COLS + COL_DT + hh * 4); *(LAS3 g8::f32x4*)(wdt + hh * 4096 + (((k >> 8) * 4 + (k & 3)) * 64 + ((k & 255) >> 2)) * 4) = (g8::f32x4){t4.x, t4.y, t4.z, t4.w}; } }
        for (int i = gtid; i < PJ; i += NGT) BIASP[i] = i < PJ_Q ? 0.f : p.in[I_BQKV][i - PJ_Q];
        __syncthreads();
        {
            auto rowptr = [&](int r) -> const float* { return r >= NTOK ? p.in[I_MEM] + (size_t)(r - NTOK) * DM : x + (size_t)r * DM; };
            float4 vn[4];
            if (gw < NTOK + NMEM) {
#pragma unroll
                for (int j = 0; j < 4; ++j) vn[j] = ld4(rowptr(gw) + 4 * (lane + 64 * j)); }
            for (int r = gw; r < NTOK + NMEM; r += NGW) {
                const bool ismem = r >= NTOK;
                const float* g = ismem ? p.in[I_GMEM] : p.in[I_GMIX];
                float4 v[4]; float ss = 0.f;
#pragma unroll
                for (int j = 0; j < 4; ++j) { v[j] = vn[j]; ss += v[j].x * v[j].x + v[j].y * v[j].y + v[j].z * v[j].z + v[j].w * v[j].w; }
                if (r + NGW < NTOK + NMEM) {
#pragma unroll
                    for (int j = 0; j < 4; ++j) vn[j] = ld4(rowptr(r + NGW) + 4 * (lane + 64 * j)); }
                const float rs = rsqrtf(wave_sum(ss, lane) * (1.f / 1024.f) + EPS);
                float dacc[8];
#pragma unroll
                for (int h = 0; h < 8; ++h) dacc[h] = 0.f;
#pragma unroll
                for (int j = 0; j < 4; ++j) { const int c = 4 * (lane + 64 * j); const float4 gv = ld4(g + c);
                    v[j] = make_float4(v[j].x * rs * gv.x, v[j].y * rs * gv.y, v[j].z * rs * gv.z, v[j].w * rs * gv.w);
                    *(uint2*)(XN + (size_t)r * DM + c) = make_uint2(cvtpk(v[j].x, v[j].y), cvtpk(v[j].z, v[j].w));
                    if (!ismem) { const float uu[4] = {v[j].x, v[j].y, v[j].z, v[j].w};
#pragma unroll
                        for (int q = 0; q < 4; ++q) { const g8::f32x4 w0 = *(const LAS3 g8::f32x4*)(wdt + ((j * 4 + q) * 64 + lane) * 4), w1 = *(const LAS3 g8::f32x4*)(wdt + 4096 + ((j * 4 + q) * 64 + lane) * 4);
                            dacc[0] += uu[q] * w0.x; dacc[1] += uu[q] * w0.y; dacc[2] += uu[q] * w0.z; dacc[3] += uu[q] * w0.w;
                            dacc[4] += uu[q] * w1.x; dacc[5] += uu[q] * w1.y; dacc[6] += uu[q] * w1.z; dacc[7] += uu[q] * w1.w; } }
                }
                if (!ismem) {
#pragma unroll
                    for (int h = 0; h < 8; ++h) dacc[h] = wave_sum(dacc[h], lane);
                    if (lane == 0) { st4(DTRAW + (size_t)r * 8, make_float4(dacc[0], dacc[1], dacc[2], dacc[3])); st4(DTRAW + (size_t)r * 8 + 4, make_float4(dacc[4], dacc[5], dacc[6], dacc[7])); }
                }
            }
        }
        __syncthreads();
        LAS3 float* scr = (LAS3 float*)(ldsp + wave * 16640);
        constexpr int IT1 = 16 * (2048 / 64), IT2 = 16 * (1024 / 64);
        constexpr int IA = 16 * (1536 / 64), IB = 16 * (768 / 64), IO = 16 * 16, IQ = 16 * 8, IKV = 16 * 16, IWO = 8 * 16;
        constexpr int NSM = IA + IB + IO + IQ + IKV + IWO;
        for (int it = gw; it < NSM; it += NGW) {
            int r = it;
            if (r < IA) { transpose_item(p.in[I_WIN], 1024, IN_COLS, WINT, scr, r, lane, 1536); continue; } r -= IA;
            if (r < IB) { transpose_item(p.in[I_WIN] + COL_Q, 1024, IN_COLS, WINT + (size_t)1536 * 1024, scr, r, lane, 768); continue; } r -= IB;
            if (r < IO) { transpose_item(p.in[I_WOUT], 1024, 1024, WOUTT, scr, r, lane); continue; } r -= IO;
            if (r < IQ) { transpose_item(p.in[I_WQ], 1024, 512, WQT, scr, r, lane, 0, p.in[I_GCROSS]); continue; } r -= IQ;
            if (r < IKV) { transpose_item(p.in[I_WKV], 1024, 1024, WKVT, scr, r, lane); continue; } r -= IKV;
            transpose_item(p.in[I_WO], 512, 1024, WOT, scr, r, lane);
        }
        t8_run(p.in[I_W1], 2048, W1T8, p.in[I_GFFN], W1_P1_ITEMS + gw, NEXP * IT1, NGW, lane, scr);
    }
    GRID_BAR();
    PH_END()
    PH_BEGIN(1)
    {
        g8::DenseSched S{G, (int)blockIdx.x, 2048, NTOK / 256, PJ / 256, (const char*)WINT, NMEM / 256, 4, NTOK, (const char*)WKVT};
        g8::EpiBf16Dual E{PROJB, PJ, BIASP, KVMB, 1024};
        { PHASE_IDS(); g8::gemm_phase(ldsp, XN, WINT, 2048, 0, S, E, tid); }
    }
    if (blockIdx.x >= 72) {
        PHASE_IDS(); LAS3 float* scr = (LAS3 float*)(ldsp + wave * 16640);
        t8_run(p.in[I_W1], 2048, W1T8, p.in[I_GFFN], (blockIdx.x - 72) * 8 + wave, W1_P1_ITEMS, (G - 72) * 8, lane, scr);
    }
    GRID_BAR();
    PH_END()
    PH_BEGIN(2)
    {
    PHASE_IDS();
    for (int item = blockIdx.x; item < BATCH * 64 * 2; item += G)
        ssd_s1_item(item, PROJB, DTRAW, p.in[I_CONVW], p.in[I_CONVB], p.in[I_DTB], p.in[I_ALOG], XC, DT, ACS, CD, ST, ldsp, tid);
    }
    GRID_BAR();
    PH_END()
    PH_BEGIN(3)
    {
    PHASE_IDS();
    for (int item = blockIdx.x; item < BATCH * 64 * 2; item += G) swa_item(item, PROJB, MIXB, p.in[I_RELB], p.in[I_SINK], ldsp, tid);
    {
        for (int el = gtid; el < BATCH * 8 * 8192; el += NGT) {
            const int bh = el >> 13, pn = el & 8191, b = bh >> 3, h = bh & 7;
            float st = 0.f;
#pragma unroll 1
            for (int c0 = 0; c0 < 64; c0 += 32) {
                float sv[32], dv[32];
#pragma unroll
                for (int q = 0; q < 32; ++q) { const size_t bc = (size_t)b * 64 + c0 + q; sv[q] = ST[(bc * 8 + h) * 8192 + pn]; dv[q] = CD[bc * 8 + h]; }
#pragma unroll
                for (int q = 0; q < 32; ++q) { const size_t idx = (((size_t)b * 64 + c0 + q) * 8 + h) * 8192 + pn;
                    HIN[idx] = (bf)(cvtpk(st, 0.f) & 0xffffu); st = st * dv[q] + sv[q]; }
            }
        }
    }
    }
    GRID_BAR();
    PH_END()
    PH_BEGIN(4)
    {
    PHASE_IDS();
    for (int item = blockIdx.x; item < BATCH * 64 * 2; item += G)
        ssd_s3_item(item, XC, DT, ACS, HIN, PROJB, p.in[I_DSKIP], p.in[I_GSSM], ST, MIXB, ldsp, tid);
    }
    GRID_BAR();
    PH_END()
    PH_BEGIN(5)
    {
        g8::DenseSched S{G, (int)blockIdx.x, 2048, NTOK / 256, 4, (const char*)WOUTT, 0, 1, 0, nullptr};
        g8::EpiH1 E{p.in[I_BOUT], x, XN, SSQ1};
        { PHASE_IDS(); g8::gemm_phase(ldsp, MIXB, WOUTT, 2048, 0, S, E, tid); }
    }
    GRID_BAR();
    PH_END()
    PH_BEGIN(6)
    {
        g8::DenseSched S{G, (int)blockIdx.x, 2048, NTOK / 256, 2, (const char*)WQT, 0, 1, 0, nullptr};
        g8::EpiBf16Dual E{QCB, 512, nullptr, nullptr, 0};
        { PHASE_IDS(); g8::gemm_phase(ldsp, XN, WQT, 2048, 0, S, E, tid); }
    }
    if (blockIdx.x >= 128) {
        PHASE_IDS(); LAS3 float* scr = (LAS3 float*)(ldsp + wave * 16640);
        t8_run(p.in[I_W2], 1024, W2T8, nullptr, (blockIdx.x - 128) * 8 + wave, W2_P7_ITEMS, (G - 128) * 8, lane, scr);
    }
    GRID_BAR();
    PH_END()
    PH_BEGIN(7)
    {
    PHASE_IDS();
    for (int item = blockIdx.x; item < BATCH * 4 * 32; item += G) xattn_item(item, QCB, KVMB, SSQ1, OCB, ldsp, tid);
    }
    GRID_BAR();
    PH_END()
    PH_BEGIN(8)
    {
        g8::DenseSched S{G, (int)blockIdx.x, 1024, NTOK / 256, 4, (const char*)WOT, 0, 1, 0, nullptr};
        g8::EpiH2 E{XN, H2B, XN8};
        { PHASE_IDS(); g8::gemm_phase(ldsp, OCB, WOT, 1024, 0, S, E, tid); }
    }
    GRID_BAR();
    PH_END()
    PH_BEGIN(9)
    {
    PHASE_IDS();
    LAS3 float* PL = (LAS3 float*)ldsp;
    LAS3 float* SQ = (LAS3 float*)(ldsp + 33792);
    LAS3 unsigned* LC = (LAS3 unsigned*)(ldsp + 34816);
    if (tid < 32) LC[tid] = 0u;
    __syncthreads();
    const int hi = lane >> 5, r32 = lane & 31, tl = wave >> 2, kq = wave & 3;
    for (int rb = blockIdx.x; rb < NTOK / 64; rb += G) {
        const int row0 = rb * 64 + tl * 32;
        const unsigned short* hrow = H2B + (size_t)(row0 + r32) * DM + kq * 256 + 4 * hi;
        const float* gq = p.in[I_GFFN] + kq * 256 + 4 * hi;
        const float* wq = p.in[I_WR] + (size_t)(kq * 256 + 4 * hi) * 32 + r32;
        f32x16 acc;
#pragma unroll
        for (int r = 0; r < 16; ++r) acc[r] = 0.f;
        float ssq = 0.f;
#pragma unroll 1
        for (int mb = 0; mb < 32; mb += 8) {
            uint2 av[8]; float bv[8][4];
#pragma unroll
            for (int m = 0; m < 8; ++m) { av[m] = *(const uint2*)(hrow + 8 * (mb + m));
#pragma unroll
                for (int t = 0; t < 4; ++t) bv[m][t] = wq[(size_t)(8 * (mb + m) + t) * 32]; }
#pragma unroll
            for (int m = 0; m < 8; ++m) { const float4 gv = ld4(gq + 8 * (mb + m));
                float4 a = make_float4(__uint_as_float(av[m].x << 16), __uint_as_float(av[m].x & 0xffff0000u), __uint_as_float(av[m].y << 16), __uint_as_float(av[m].y & 0xffff0000u));
                ssq += a.x * a.x + a.y * a.y + a.z * a.z + a.w * a.w;
                a.x *= gv.x; a.y *= gv.y; a.z *= gv.z; a.w *= gv.w;
                acc = __builtin_amdgcn_mfma_f32_32x32x2f32(a.x, bv[m][0], acc, 0, 0, 0); acc = __builtin_amdgcn_mfma_f32_32x32x2f32(a.y, bv[m][1], acc, 0, 0, 0);
                acc = __builtin_amdgcn_mfma_f32_32x32x2f32(a.z, bv[m][2], acc, 0, 0, 0); acc = __builtin_amdgcn_mfma_f32_32x32x2f32(a.w, bv[m][3], acc, 0, 0, 0); }
        }
        ssq += xshfl(ssq, 32, lane);
        if (hi == 0) SQ[(tl * 4 + kq) * 32 + r32] = ssq;
#pragma unroll
        for (int r = 0; r < 16; ++r) PL[((tl * 4 + kq) * 32 + crow(r, hi)) * 33 + r32] = acc[r];
        __syncthreads();
        int sel[4] = {0, 0, 0, 0}, ls[4] = {0, 0, 0, 0}; float gt[4] = {0.f, 0.f, 0.f, 0.f}, rs = 0.f;
        const int i = 8 * kq + (lane & 7), row = row0 + i;
        if (lane < 8) {
            rs = rsqrtf((SQ[(tl * 4 + 0) * 32 + i] + SQ[(tl * 4 + 1) * 32 + i] + SQ[(tl * 4 + 2) * 32 + i] + SQ[(tl * 4 + 3) * 32 + i]) * (1.f / 1024.f) + EPS);
            float l[32];
#pragma unroll
            for (int e = 0; e < 32; ++e) l[e] = (PL[((tl * 4 + 0) * 32 + i) * 33 + e] + PL[((tl * 4 + 1) * 32 + i) * 33 + e] + PL[((tl * 4 + 2) * 32 + i) * 33 + e] + PL[((tl * 4 + 3) * 32 + i) * 33 + e]) * rs + p.in[I_BR][e];
            float val[4];
#pragma unroll
            for (int k = 0; k < 4; ++k) {
                float best = -INFINITY; int bi = 0;
#pragma unroll
                for (int e = 0; e < 32; ++e) if (l[e] > best) { best = l[e]; bi = e; }
                sel[k] = bi; val[k] = best;
#pragma unroll
                for (int e = 0; e < 32; ++e) l[e] = (e == bi) ? -INFINITY : l[e];
            }
            float den = 0.f;
#pragma unroll
            for (int k = 0; k < 4; ++k) { gt[k] = __expf(val[k] - val[0]); den += gt[k]; }
#pragma unroll
            for (int k = 0; k < 4; ++k) { gt[k] /= den; ls[k] = (int)__hip_atomic_fetch_add(&LC[sel[k]], 1u, __ATOMIC_RELAXED, __HIP_MEMORY_SCOPE_WORKGROUP); }
        }
        if (lane < 8) {
#pragma unroll
            for (int k = 0; k < 4; ++k) { const int a = row * 4 + k; SLOT[a] = (sel[k] << 16) | ls[k]; GATE[a] = gt[k]; }
            RSROW[row] = rs;
        }
        __syncthreads();
    }
    if (tid < 32) CNTB[blockIdx.x * 32 + tid] = (int)LC[tid];
    }
    GRID_BAR();
    PH_END()
    {
    PHASE_IDS();
    LAS3 int* PT = (LAS3 int*)ldsp;
    {
        const int e = tid & 31, part = tid >> 5; int tot = 0, base = 0;
        for (int bb = part; bb < G; bb += 16) { const int c = CNTB[bb * 32 + e]; tot += c; base += (bb < (int)blockIdx.x) ? c : 0; }
        PT[(part * 32 + e) * 2] = tot; PT[(part * 32 + e) * 2 + 1] = base;
    }
    __syncthreads();
    LAS3 unsigned* GB = (LAS3 unsigned*)(ldsp + 8192);
    if (tid < 64) {
        int c = 0, base = 0;
        if (tid < 32) {
#pragma unroll
            for (int q = 0; q < 16; ++q) { c += PT[(q * 32 + tid) * 2]; base += PT[(q * 32 + tid) * 2 + 1]; }
            GB[tid] = (unsigned)base; }
        int tl = (c + 255) >> 8, incl = tl;
#pragma unroll
        for (int o = 1; o < 32; o <<= 1) { const int v = bperm_i(incl, lane - o); if (lane >= o) incl += v; }
        if (tid < 32) { CNTL[tid] = c; TP[tid] = incl - tl; }
        if (tid == 31) TP[32] = incl;
    }
    __syncthreads();
    for (int rb = blockIdx.x; rb < NTOK / 64; rb += G)
        if (tid < 256) { const int a = rb * 256 + tid; const int v = SLOT[a], e = v >> 16; const unsigned slot = GB[e] + (unsigned)(v & 0xffff);
            LIST[e * NTOK + slot] = a; RSA[e * NTOK + slot] = RSROW[a >> 2]; SLOT[a] = (e << 16) | (int)slot; }
    g8::moe_units(TP + 136, TP, 8, G, vcu, tid); g8::moe_units(TP + 168, TP, 4, G, vcu, tid);
    }
    GRID_BAR();
    PH_BEGIN(10)
    {
        g8::MoeSched S{8, 1024, TP + 136, TP, CNTL, LIST, (const char*)W1T8, 2048u * 1024u};
        g8::EpiSwiglu E{ACT8, p.in[I_B1], RSA};
        { PHASE_IDS(); g8::gemm_phase<g8::EpiSwiglu, g8::MoeSched, true>(ldsp, XN8, W1T8, 1024, 2, S, E, tid); }
    }
    {
        PHASE_IDS(); LAS3 float* scr = (LAS3 float*)(ldsp + wave * 16640);
        const int total = TP[32] * 8, maxu = (total + G - 1) / G, tlast = total - (maxu - 1) * G;
        const int nidle = G - tlast;
        if (nidle >= 64) { if (vcu >= tlast) t8_run(p.in[I_W2], 1024, W2T8, nullptr, W2_P7_ITEMS + (vcu - tlast) * 8 + wave, NEXP * 256, nidle * 8, lane, scr); }
        else t8_run(p.in[I_W2], 1024, W2T8, nullptr, W2_P7_ITEMS + vcu * 8 + wave, NEXP * 256, G * 8, lane, scr);
    }
    GRID_BAR();
    PH_END()
    PH_BEGIN(11)
    {
        g8::MoeSched S{4, 1024, TP + 168, TP, CNTL, nullptr, (const char*)W2T8, 1024u * 1024u};
        g8::EpiFp8 E{Y8, p.in[I_B2], 0.0078125f};
        { PHASE_IDS(); g8::gemm_phase<g8::EpiFp8, g8::MoeSched, true>(ldsp, ACT8, W2T8, 1024, 0, S, E, tid); }
    }
    GRID_BAR();
    PH_END()
    PH_BEGIN(12)
    {
    PHASE_IDS();
    {
        uint2 hn[4]; int sln[4]; float gkn[4];
        if (gw < NTOK) {
#pragma unroll
            for (int k = 0; k < 4; ++k) { sln[k] = SLOT[gw * 4 + k]; gkn[k] = GATE[gw * 4 + k] * 0.0625f; }
#pragma unroll
            for (int j = 0; j < 4; ++j) hn[j] = *(const uint2*)(H2B + (size_t)gw * DM + 4 * (lane + 64 * j)); }
        for (int row = gw; row < NTOK; row += NGW) {
            float4 v[4]; float ss = 0.f; float gk[4]; unsigned y[4][4];
#pragma unroll
            for (int k = 0; k < 4; ++k) { const int yrow = TP[sln[k] >> 16] * 256 + (sln[k] & 0xffff); gk[k] = gkn[k];
#pragma unroll
                for (int j = 0; j < 4; ++j) y[k][j] = *(const unsigned*)(Y8 + (size_t)yrow * 1024 + 4 * (lane + 64 * j)); }
#pragma unroll
            for (int j = 0; j < 4; ++j) v[j] = make_float4(__uint_as_float(hn[j].x << 16), __uint_as_float(hn[j].x & 0xffff0000u), __uint_as_float(hn[j].y << 16), __uint_as_float(hn[j].y & 0xffff0000u));
            if (row + NGW < NTOK) {
#pragma unroll
                for (int k = 0; k < 4; ++k) { sln[k] = SLOT[(row + NGW) * 4 + k]; gkn[k] = GATE[(row + NGW) * 4 + k] * 0.0625f; }
#pragma unroll
                for (int j = 0; j < 4; ++j) hn[j] = *(const uint2*)(H2B + (size_t)(row + NGW) * DM + 4 * (lane + 64 * j)); }
#pragma unroll
            for (int j = 0; j < 4; ++j) { float4 a = v[j];
#pragma unroll
                for (int k = 0; k < 4; ++k) { const g8::f32x2 lo = __builtin_amdgcn_cvt_pk_f32_fp8((int)y[k][j], false), hi2 = __builtin_amdgcn_cvt_pk_f32_fp8((int)y[k][j], true);
                    a.x += gk[k] * lo[0]; a.y += gk[k] * lo[1]; a.z += gk[k] * hi2[0]; a.w += gk[k] * hi2[1]; }
                v[j] = a; ss += a.x * a.x + a.y * a.y + a.z * a.z + a.w * a.w; }
            const float rs = rsqrtf(wave_sum(ss, lane) * (1.f / 1024.f) + EPS);
#pragma unroll
            for (int j = 0; j < 4; ++j) { const int c = 4 * (lane + 64 * j); const float4 gv = ld4(p.in[I_GFIN] + c);
                st4(p.out + (size_t)row * DM + c, make_float4(v[j].x * rs * gv.x, v[j].y * rs * gv.y, v[j].z * rs * gv.z, v[j].w * rs * gv.w)); }
        }
    }
    }
    PH_END()
}

constexpr int LDS_BYTES = 147456;

extern "C" void kernel_launch(void* const* d_in, const int* in_sizes, int n_in, void* d_out, int out_size, void* d_ws, size_t ws_size, hipStream_t stream) {
    static int grid = 0;
    if (grid == 0) {
        if (n_in != N_IN || ws_size < WS_END) { fprintf(stderr, "kernel_launch: unexpected n_in %d / ws_size %zu (need %zu)\n", n_in, ws_size, (size_t)WS_END); grid = -1; return; }
        int dev = 0, cus = 0, per_cu = 0;
        (void)hipGetDevice(&dev);
        (void)hipDeviceGetAttribute(&cus, hipDeviceAttributeMultiprocessorCount, dev);
        (void)hipFuncSetAttribute((const void*)mk_fwd, hipFuncAttributeMaxDynamicSharedMemorySize, LDS_BYTES);
        (void)hipOccupancyMaxActiveBlocksPerMultiprocessor(&per_cu, (const void*)mk_fwd, 512, LDS_BYTES);
        if (per_cu < 1) { fprintf(stderr, "kernel_launch: occupancy query says %d blocks per CU\n", per_cu); per_cu = 1; }
        if (per_cu > 1) per_cu = 1;
        grid = cus * per_cu;
    }
    if (grid < 0) return;
    (void)hipMemsetAsync((char*)d_ws + WS_CTL, 0, 1 * MiB, stream);
    Params p{};
    for (int i = 0; i < N_IN; ++i) p.in[i] = (const float*)d_in[i];
    p.out = (float*)d_out; p.ws = (unsigned char*)d_ws; p.rep_mask = REP_MASK;
    void* args[] = {&p};
    hipError_t e = hipLaunchCooperativeKernel((const void*)mk_fwd, dim3(grid), dim3(512), args, LDS_BYTES, stream);
    if (e != hipSuccess) fprintf(stderr, "cooperative launch failed: %s (grid %d)\n", hipGetErrorString(e), grid);
}
```

```cpp
#include <hip/hip_runtime.h>
#include <cstdio>
#include <cstdint>

#define DEVI __device__ __forceinline__

constexpr int BATCH = 2, SEQ = 8192, NTOK = BATCH * SEQ, DM = 1024, MEMLEN = 256, NMEM = BATCH * MEMLEN;
constexpr int SSM_H = 8, SSM_P = 64, SSM_W = 512, SSM_N = 128, CONVCH = 1024;
constexpr int IN_COLS = 2312, COL_Z = 0, COL_XBC = 512, COL_DT = 1536, COL_Q = 1544, COL_K = 2056, COL_V = 2184;
constexpr int NEXP = 32, TOPK = 4, DFF = 1024, NASSIGN = NTOK * TOPK;
constexpr float EPS = 1e-5f;

enum { I_X = 0, I_MEM, I_GMIX, I_WIN, I_BQKV, I_CONVW, I_CONVB, I_DTB, I_ALOG, I_DSKIP, I_GSSM, I_SINK, I_RELB, I_WOUT, I_BOUT,
       I_GCROSS, I_GMEM, I_WQ, I_WKV, I_WO, I_GFFN, I_WR, I_BR, I_W1, I_B1, I_W2, I_B2, I_GFIN, N_IN };

constexpr size_t MiB = 1u << 20;
constexpr size_t WS_CTL = 0;
constexpr size_t WS_XN = 1 * MiB;
constexpr size_t WS_BIG = WS_XN + 34 * MiB;
constexpr size_t WS_XBC = WS_BIG + 144 * MiB;
constexpr size_t WS_MIXB = WS_XBC + 64 * MiB;
constexpr size_t WS_H1 = WS_MIXB + 32 * MiB;
constexpr size_t WS_H2 = WS_H1 + 64 * MiB;
constexpr size_t WS_YSSM = WS_H2 + 64 * MiB;
constexpr size_t WS_QCB = WS_YSSM + 32 * MiB;
constexpr size_t WS_OCB = WS_QCB + 16 * MiB;
constexpr size_t WS_ACTB = WS_OCB + 16 * MiB;
constexpr size_t WS_W1T = WS_ACTB + 144 * MiB;
constexpr size_t WS_W2T = WS_W1T + 128 * MiB;
constexpr size_t WS_WINT = WS_W2T + 64 * MiB;
constexpr size_t WS_WOUTT = WS_WINT + 5 * MiB;
constexpr size_t WS_WQT = WS_WOUTT + 2 * MiB;
constexpr size_t WS_WKVT = WS_WQT + 1 * MiB;
constexpr size_t WS_WOT = WS_WKVT + 2 * MiB;
constexpr size_t WS_SMALL = WS_WOT + 1 * MiB;
constexpr size_t WS_DT = WS_SMALL;
constexpr size_t WS_DTRAW = WS_DT + 512 * 1024;
constexpr size_t WS_KVMB = WS_DTRAW + 512 * 1024;
constexpr size_t WS_GATE = WS_KVMB + 1 * MiB;
constexpr size_t WS_SLOT = WS_GATE + 512 * 1024;
constexpr size_t WS_BIASP = WS_SLOT + 256 * 1024;
constexpr size_t WS_LIST = WS_GATE + 1 * MiB;
constexpr size_t WS_RSA = WS_LIST + 2 * MiB;
constexpr size_t WS_CNTB = WS_RSA + 2 * MiB;
constexpr size_t WS_RSROW = WS_CNTB + 64 * 1024;
constexpr size_t WS_SSQ1 = WS_RSROW + 64 * 1024;
constexpr size_t WS_ACS = WS_SSQ1 + 2 * MiB;
constexpr size_t WS_CD = WS_ACS + 512 * 1024;
constexpr size_t WS_END = WS_CD + 64 * 1024;
constexpr size_t WS_XC = WS_XBC;
constexpr size_t WS_ST = WS_YSSM;
constexpr size_t WS_HIN = WS_H2;
constexpr size_t WS_YB = WS_BIG;
constexpr int NROWS_MAX = NASSIGN + NEXP * 256;
constexpr int PJ = 2304, PJ_Z = 0, PJ_XBC = 512, PJ_Q = 1536, PJ_K = 2048, PJ_V = 2176;
constexpr int W1_P1_ITEMS = 14720;
constexpr int W2_P7_ITEMS = 5120;
constexpr int LDS_MISC = 146432;
constexpr int CW_CNT = 64;
#ifndef REP_MASK
#define REP_MASK 0
#endif
#ifndef RUNTIME_REP
#define RUNTIME_REP 1
#endif
#if RUNTIME_REP
#define PH_BEGIN(i) for (int rep_ = 0; rep_ <= ((p.rep_mask >> (i)) & 1); ++rep_) {
#else
#define PH_BEGIN(i) { constexpr int rep_ = 0; (void)rep_;
#endif
#define PH_END() }

struct Params { const float* in[N_IN]; float* out; unsigned char* ws; int rep_mask; int pad; };

DEVI float bperm(float v, int srclane) { return __int_as_float(__builtin_amdgcn_ds_bpermute(srclane << 2, __float_as_int(v))); }
DEVI int bperm_i(int v, int srclane) { return __builtin_amdgcn_ds_bpermute(srclane << 2, v); }
DEVI float xshfl(float v, int mask, int lane) { return bperm(v, lane ^ mask); }
DEVI float wave_sum(float v, int lane) {
#pragma unroll
    for (int o = 32; o > 0; o >>= 1) v += xshfl(v, o, lane);
    return v;
}
DEVI float wave_max(float v, int lane) {
#pragma unroll
    for (int o = 32; o > 0; o >>= 1) v = fmaxf(v, xshfl(v, o, lane));
    return v;
}
DEVI float silu_f(float x) { return x * __builtin_amdgcn_rcpf(1.f + __expf(-x)); }
DEVI float softplus_f(float x) { return fmaxf(x, 0.f) + log1pf(__expf(-fabsf(x))); }
DEVI float4 ld4(const float* p) { return *(const float4*)p; }
DEVI void st4(float* p, float4 v) { *(float4*)p = v; }


struct TI { int tid, lane, wave, gw, gtid; };
DEVI TI fresh_ti(int wave_id) { int l; asm volatile("v_mbcnt_lo_u32_b32 %0, -1, 0\n\tv_mbcnt_hi_u32_b32 %0, -1, %0" : "=v"(l)); TI r; r.lane = l; r.wave = wave_id; r.tid = wave_id * 64 + l; r.gw = blockIdx.x * 8 + wave_id; r.gtid = blockIdx.x * 512 + r.tid; return r; }
#define PHASE_IDS() const TI ti_ = fresh_ti(wave_id); const int tid = ti_.tid, lane = ti_.lane, wave = ti_.wave, gw = ti_.gw, gtid = ti_.gtid; (void)tid; (void)lane; (void)wave; (void)gw; (void)gtid
DEVI float bf2f(unsigned short v) { return __uint_as_float((unsigned)v << 16); }

#define XB_TMO      128
#define XB_XCNT(j)  (256  + 64 * (j))
#define XB_XSUB(j)  (1280 + 64 * (j))
#define XB_XGEN(j)  (2304 + 64 * (j))
#define XB_TOP      3328
#define XB_TOPGEN   3392
#define XCD_BAR_WORDS 3456
#define XB_SPIN_CAP (1u << 18)
DEVI unsigned xb_ld(unsigned* p)              { return __hip_atomic_load(p, __ATOMIC_RELAXED, __HIP_MEMORY_SCOPE_AGENT); }
DEVI unsigned xb_add(unsigned* p, unsigned v) { return __hip_atomic_fetch_add(p, v, __ATOMIC_RELAXED, __HIP_MEMORY_SCOPE_AGENT); }
DEVI unsigned xb_xcc_id() { return (unsigned)__builtin_amdgcn_s_getreg((3 << 11) | 20) & 0xFu; }
#define XB_SPIN(cond, bar) do { unsigned _sp = 0; while (cond) { __builtin_amdgcn_s_sleep(1); \
    if ((++_sp & 255u) == 0u) { if (xb_ld(&(bar)[XB_TMO])) break; if (_sp > XB_SPIN_CAP) { atomicAdd(&(bar)[XB_TMO], 1u); break; } } } } while (0)
struct XcdBarrier { unsigned* bar; unsigned x; volatile __attribute__((address_space(3))) unsigned* st; };
DEVI XcdBarrier xcd_barrier_post(unsigned* bar, volatile __attribute__((address_space(3))) unsigned* st, bool leader) {
    XcdBarrier b; b.bar = bar; b.x = xb_xcc_id(); b.st = st;
    if (leader) (void)xb_add(&bar[XB_XCNT(b.x)], 1u);
    return b;
}
DEVI void xcd_barrier_complete(unsigned* bar, unsigned x, unsigned& nloc, unsigned& nx) {
    const unsigned G = gridDim.x * gridDim.y * gridDim.z;
    unsigned sum, cnt, mine, sp = 0u;
    for (;;) {
        sum = 0u; cnt = 0u; mine = 0u;
#pragma unroll
        for (unsigned j = 0; j < 16; ++j) { const unsigned c = xb_ld(&bar[XB_XCNT(j)]); sum += c; cnt += (c > 0u) ? 1u : 0u; mine = (j == x) ? c : mine; }
        if (sum == G) break;
        __builtin_amdgcn_s_sleep(1);
        if ((++sp & 255u) == 0u) { if (xb_ld(&bar[XB_TMO])) break; if (sp > XB_SPIN_CAP) { atomicAdd(&bar[XB_TMO], 1u); break; } }
    }
    nloc = mine > 0u ? mine : 1u; nx = cnt > 0u ? cnt : 1u;
}
DEVI void xcd_barrier(const XcdBarrier& b, bool leader) {
    asm volatile("s_waitcnt vmcnt(0)" ::: "memory");
    __syncthreads();
    if (leader) {
        unsigned* bar = b.bar;
        __builtin_amdgcn_s_waitcnt(0);
        unsigned nloc = b.st[0], nx = b.st[1];
        if (nloc == 0u) { xcd_barrier_complete(bar, b.x, nloc, nx); b.st[0] = nloc; b.st[1] = nx; }
        const unsigned old = xb_add(&bar[XB_XSUB(b.x)], 1u);
        const unsigned gen = old / nloc;
        if (old + 1u == (gen + 1u) * nloc) {
            __builtin_amdgcn_fence(__ATOMIC_RELEASE, "agent");
            asm volatile("s_waitcnt vmcnt(0)" ::: "memory");
            const unsigned og = xb_add(&bar[XB_TOP], 1u);
            const unsigned tg = og / nx;
            if (og + 1u == (tg + 1u) * nx) xb_add(&bar[XB_TOPGEN], 1u);
            else XB_SPIN(xb_ld(&bar[XB_TOPGEN]) == tg, bar);
            __builtin_amdgcn_fence(__ATOMIC_ACQUIRE, "agent");
            xb_add(&bar[XB_XGEN(b.x)], 1u);
            asm volatile("s_waitcnt vmcnt(0)" ::: "memory");
        } else {
            XB_SPIN(xb_ld(&bar[XB_XGEN(b.x)]) == gen, bar);
            __builtin_amdgcn_fence(__ATOMIC_ACQUIRE, "agent");
            asm volatile("s_waitcnt vmcnt(0)" ::: "memory");
        }
    }
    __syncthreads();
}

namespace g8 {
#define G8_LAS __attribute__((address_space(3)))
typedef unsigned short bf16_t;
typedef short bf16x8 __attribute__((ext_vector_type(8)));
typedef float f32x4 __attribute__((ext_vector_type(4)));
typedef float f32x2 __attribute__((ext_vector_type(2)));
typedef unsigned u32x4 __attribute__((ext_vector_type(4)));
typedef unsigned u32x2 __attribute__((ext_vector_type(2)));
constexpr int BM = 256, BK = 64, HALF = 128, HTB = HALF * BK * 2, STAGE_BYTES = 8 * HTB;

DEVI int lds_byte(int r, int c) { const int st = (r >> 4) * 2 + (c >> 5), rr = r & 15, cc = c & 31, ob = rr * 64 + cc * 2; return st * 1024 + (ob ^ (((ob >> 9) & 1) << 5)); }
DEVI void stage_rc(int b, int& R, int& C) { const int st = b / 1024, sb = b % 1024, swz = sb ^ (((sb >> 9) & 1) << 5); R = (st >> 1) * 16 + swz / 64; C = (st & 1) * 32 + (swz % 64) / 2; }
DEVI int perm32(int rho) { const int n = rho >> 4, i = rho & 15; return 8 * (i >> 2) + 4 * n + (i & 3); }
typedef int v8i __attribute__((ext_vector_type(8)));
typedef int v4i __attribute__((ext_vector_type(4)));
DEVI v8i cat8(bf16x8 lo, bf16x8 hi) { const v4i a = __builtin_bit_cast(v4i, lo), b = __builtin_bit_cast(v4i, hi); return (v8i){a[0], a[1], a[2], a[3], b[0], b[1], b[2], b[3]}; }
DEVI unsigned pk4_fp8(float a, float b, float c, float d) { int w = 0; w = __builtin_amdgcn_cvt_pk_fp8_f32(a, b, w, false); w = __builtin_amdgcn_cvt_pk_fp8_f32(c, d, w, true); return (unsigned)w; }
typedef __bf16 bf16x2v __attribute__((ext_vector_type(2)));
DEVI unsigned cvt_pk_bf16(float lo, float hi) { const f32x2 v = {lo, hi}; const bf16x2v b = __builtin_convertvector(v, bf16x2v); return __builtin_bit_cast(unsigned, b); }

struct Unit {
    const int* alist;
    int acnt;
    int aoff;
    int arow0;
    unsigned boff;
    int orow0, ocol0;
    int e;
};


struct EpiSwiglu {
    static constexpr bool PERM = true;
    unsigned char* O; const float* bias; const float* rsa;
    DEVI void operator()(const f32x4 (&acc)[2][2][4][2], const Unit& u, int wr, int wc, int fr_, int fq_) const {
        int fr = fr_, fq = fq_; asm volatile("" : "+v"(fr), "+v"(fq));
        const int row0 = u.orow0 + wr * 64 + fr, col0 = u.ocol0 + wc * 32 + 8 * fq;
        const float* bp = bias + (size_t)u.e * 2048 + col0;
        f32x4 bv[2][2];
#pragma unroll
        for (int bj = 0; bj < 2; ++bj)
#pragma unroll
            for (int n = 0; n < 2; ++n) bv[bj][n] = *(const f32x4*)(bp + bj * HALF + 4 * n);
        float rsv[2][4];
#pragma unroll
        for (int ai = 0; ai < 2; ++ai)
#pragma unroll
            for (int m = 0; m < 4; ++m) { const int lr = wr * 64 + fr + ai * HALF + m * 16; rsv[ai][m] = rsa[u.aoff + min(lr, u.acnt - 1)]; }
        asm volatile("" : "+v"(rsv[0][0]), "+v"(rsv[0][1]), "+v"(rsv[0][2]), "+v"(rsv[0][3]), "+v"(rsv[1][0]), "+v"(rsv[1][1]), "+v"(rsv[1][2]), "+v"(rsv[1][3]));
#pragma unroll
        for (int ai = 0; ai < 2; ++ai)
#pragma unroll
            for (int m = 0; m < 4; ++m) { const int lr = wr * 64 + fr + ai * HALF + m * 16;
                const float rs = (lr < u.acnt) ? rsv[ai][m] * 0.03125f : 0.f;
                unsigned char* rowp = O + (size_t)(row0 + ai * HALF + m * 16) * 1024 + (col0 >> 1);
                float xg[8], xl[8], t[8];
#pragma unroll
                for (int bj = 0; bj < 2; ++bj)
#pragma unroll
                    for (int n = 0; n < 2; ++n) { const f32x4 v = acc[ai][bj][m][n] * rs + bv[bj][n]; const int q = bj * 4 + n * 2;
                        xg[q] = fminf(v[0], 7.f); xl[q] = fminf(fmaxf(v[1], -7.f), 7.f) + 1.f; xg[q + 1] = fminf(v[2], 7.f); xl[q + 1] = fminf(fmaxf(v[3], -7.f), 7.f) + 1.f; }
#pragma unroll
                for (int q = 0; q < 8; ++q) t[q] = __builtin_amdgcn_exp2f(xg[q] * -2.4554669595930157f);
#pragma unroll
                for (int q = 0; q < 8; ++q) t[q] = __builtin_amdgcn_rcpf(1.f + t[q]);
#pragma unroll
                for (int q = 0; q < 8; ++q) t[q] = (4.f * xg[q]) * t[q] * xl[q];
                *(unsigned*)(rowp) = pk4_fp8(t[0], t[1], t[2], t[3]);
                *(unsigned*)(rowp + HALF / 2) = pk4_fp8(t[4], t[5], t[6], t[7]); }
    }
};
struct EpiBf16 {
    static constexpr bool PERM = true;
    bf16_t* O; int ldc; const float* bias; int bias_stride; float scale;
    DEVI void operator()(const f32x4 (&acc)[2][2][4][2], const Unit& u, int wr, int wc, int fr_, int fq_) const {
        int fr = fr_, fq = fq_; asm volatile("" : "+v"(fr), "+v"(fq));
        const int row0 = u.orow0 + wr * 64 + fr, col0 = u.ocol0 + wc * 32 + 8 * fq;
        f32x4 bv[2][2];
#pragma unroll
        for (int bj = 0; bj < 2; ++bj)
#pragma unroll
            for (int n = 0; n < 2; ++n) bv[bj][n] = bias ? *(const f32x4*)(bias + (size_t)u.e * bias_stride + col0 + bj * HALF + 4 * n) : (f32x4){0.f, 0.f, 0.f, 0.f};
#pragma unroll
        for (int ai = 0; ai < 2; ++ai)
#pragma unroll
            for (int m = 0; m < 4; ++m) { bf16_t* rowp = O + (size_t)(row0 + ai * HALF + m * 16) * ldc + col0;
#pragma unroll
                for (int bj = 0; bj < 2; ++bj) { const f32x4 v0 = acc[ai][bj][m][0] * scale + bv[bj][0], v1 = acc[ai][bj][m][1] * scale + bv[bj][1];
                    u32x4 w; w.x = cvt_pk_bf16(v0[0], v0[1]); w.y = cvt_pk_bf16(v0[2], v0[3]); w.z = cvt_pk_bf16(v1[0], v1[1]); w.w = cvt_pk_bf16(v1[2], v1[3]);
                    *(u32x4*)(rowp + bj * HALF) = w; } }
    }
};

struct EpiFp8 {
    static constexpr bool PERM = true;
    unsigned char* O; const float* bias; float scale;
    DEVI void operator()(const f32x4 (&acc)[2][2][4][2], const Unit& u, int wr, int wc, int fr_, int fq_) const {
        int fr = fr_, fq = fq_; asm volatile("" : "+v"(fr), "+v"(fq));
        const int row0 = u.orow0 + wr * 64 + fr, col0 = u.ocol0 + wc * 32 + 8 * fq;
        f32x4 bv[2][2];
#pragma unroll
        for (int bj = 0; bj < 2; ++bj)
#pragma unroll
            for (int n = 0; n < 2; ++n) bv[bj][n] = *(const f32x4*)(bias + (size_t)u.e * 1024 + col0 + bj * HALF + 4 * n) * 16.f;
        const float sc = scale * 16.f;
#pragma unroll
        for (int ai = 0; ai < 2; ++ai)
#pragma unroll
            for (int m = 0; m < 4; ++m) { unsigned char* rowp = O + (size_t)(row0 + ai * HALF + m * 16) * 1024 + col0;
#pragma unroll
                for (int bj = 0; bj < 2; ++bj) { const f32x4 v0 = acc[ai][bj][m][0] * sc + bv[bj][0], v1 = acc[ai][bj][m][1] * sc + bv[bj][1];
                    u32x2 w; w.x = pk4_fp8(v0[0], v0[1], v0[2], v0[3]); w.y = pk4_fp8(v1[0], v1[1], v1[2], v1[3]);
                    *(u32x2*)(rowp + bj * HALF) = w; } }
    }
};
struct EpiBf16Dual {
    static constexpr bool PERM = true;
    bf16_t* O0; int ldc0; const float* bias0; bf16_t* O1; int ldc1;
    DEVI void operator()(const f32x4 (&acc)[2][2][4][2], const Unit& u, int wr, int wc, int fr_, int fq_) const {
        int fr = fr_, fq = fq_; asm volatile("" : "+v"(fr), "+v"(fq));
        const int row0 = u.orow0 + wr * 64 + fr, col0 = u.ocol0 + wc * 32 + 8 * fq;
        bf16_t* O = u.e ? O1 : O0; const int ldc = u.e ? ldc1 : ldc0; const float* bias = u.e ? nullptr : bias0;
        f32x4 bv[2][2];
#pragma unroll
        for (int bj = 0; bj < 2; ++bj)
#pragma unroll
            for (int n = 0; n < 2; ++n) bv[bj][n] = bias ? *(const f32x4*)(bias + col0 + bj * HALF + 4 * n) : (f32x4){0.f, 0.f, 0.f, 0.f};
#pragma unroll
        for (int ai = 0; ai < 2; ++ai)
#pragma unroll
            for (int m = 0; m < 4; ++m) { bf16_t* rowp = O + (size_t)(row0 + ai * HALF + m * 16) * ldc + col0;
#pragma unroll
                for (int bj = 0; bj < 2; ++bj) { const f32x4 v0 = acc[ai][bj][m][0] + bv[bj][0], v1 = acc[ai][bj][m][1] + bv[bj][1];
                    u32x4 w; w.x = cvt_pk_bf16(v0[0], v0[1]); w.y = cvt_pk_bf16(v0[2], v0[3]); w.z = cvt_pk_bf16(v1[0], v1[1]); w.w = cvt_pk_bf16(v1[2], v1[3]);
                    *(u32x4*)(rowp + bj * HALF) = w; } }
    }
};

struct EpiH1 {
    static constexpr bool PERM = false;
    const float* bias; const float* res; bf16_t* HB; float* SSQ;
    DEVI void operator()(const f32x4 (&acc)[2][2][4][2], const Unit& u, int wr, int wc, int fr_, int fq_) const {
        int fr = fr_, fq = fq_; asm volatile("" : "+v"(fr), "+v"(fq));
        const int row0 = u.orow0 + wr * 64 + fr, col0 = u.ocol0 + wc * 32 + 4 * fq;
        f32x4 bv[2][2];
#pragma unroll
        for (int bj = 0; bj < 2; ++bj)
#pragma unroll
            for (int n = 0; n < 2; ++n) bv[bj][n] = *(const f32x4*)(bias + col0 + bj * HALF + n * 16);
#pragma unroll
        for (int ai = 0; ai < 2; ++ai)
#pragma unroll
            for (int m = 0; m < 4; ++m) { const int row = row0 + ai * HALF + m * 16; const size_t off = (size_t)row * 1024 + col0;
#pragma unroll
                for (int bj = 0; bj < 2; ++bj) { float sq = 0.f;
#pragma unroll
                    for (int n = 0; n < 2; ++n) { const f32x4 h = acc[ai][bj][m][n] + bv[bj][n] + *(const f32x4*)(res + off + bj * HALF + n * 16);
                        sq += h[0] * h[0] + h[1] * h[1] + h[2] * h[2] + h[3] * h[3];
                        u32x2 w; w.x = cvt_pk_bf16(h[0], h[1]); w.y = cvt_pk_bf16(h[2], h[3]);
                        *(u32x2*)(HB + off + bj * HALF + n * 16) = w; }
                    sq += xshfl(sq, 16, fq * 16 + fr); sq += xshfl(sq, 32, fq * 16 + fr);
                    if (fq == 0) SSQ[(size_t)row * 32 + (u.ocol0 >> 8) * 8 + wc * 2 + bj] = sq; }
                if (m & 1) asm volatile("" ::: "memory"); }
    }
};
struct EpiH2 {
    static constexpr bool PERM = false;
    const bf16_t* res; bf16_t* HB; unsigned char* X8;
    DEVI void operator()(const f32x4 (&acc)[2][2][4][2], const Unit& u, int wr, int wc, int fr_, int fq_) const {
        int fr = fr_, fq = fq_; asm volatile("" : "+v"(fr), "+v"(fq));
        const int row0 = u.orow0 + wr * 64 + fr, col0 = u.ocol0 + wc * 32 + 4 * fq;
#pragma unroll
        for (int ai = 0; ai < 2; ++ai)
#pragma unroll
            for (int m = 0; m < 4; ++m) { const size_t off = (size_t)(row0 + ai * HALF + m * 16) * 1024 + col0;
#pragma unroll
                for (int bj = 0; bj < 2; ++bj)
#pragma unroll
                    for (int n = 0; n < 2; ++n) { const u32x2 r = *(const u32x2*)(res + off + bj * HALF + n * 16);
                        f32x4 h = acc[ai][bj][m][n];
                        h[0] += __uint_as_float(r.x << 16); h[1] += __uint_as_float(r.x & 0xffff0000u); h[2] += __uint_as_float(r.y << 16); h[3] += __uint_as_float(r.y & 0xffff0000u);
                        u32x2 w; w.x = cvt_pk_bf16(h[0], h[1]); w.y = cvt_pk_bf16(h[2], h[3]);
                        *(u32x2*)(HB + off + bj * HALF + n * 16) = w;
                        *(unsigned*)(X8 + off + bj * HALF + n * 16) = pk4_fp8(h[0], h[1], h[2], h[3]); }
                if (m & 1) asm volatile("" ::: "memory"); }
    }
};

template <class Epi, class Sched, bool FP8 = false>
DEVI void gemm_phase(G8_LAS unsigned char* lds, const void* A, const void* Bbase, int RP  , int ashift, const Sched& S, const Epi& E, int tid_) {
    int tid = tid_; asm volatile("" : "+v"(tid));
    const int wid = __builtin_amdgcn_readfirstlane(tid >> 6), lane = tid & 63, wr = wid >> 2, wc = wid & 3, fr = lane & 15, fq = lane >> 4;
    const int nt = RP / 128;
    unsigned voffB[2];
#pragma unroll
    for (int i = 0; i < 2; ++i) { int Rl, Cl; stage_rc(tid * 16 + i * 8192, Rl, Cl); const int Rb = Epi::PERM ? ((Rl & ~31) + perm32(Rl & 31)) : Rl;
        voffB[i] = (unsigned)(Rb * RP + Cl * 2); }
    const unsigned kstep = 128u;
    const unsigned hstep = (unsigned)(HALF * RP);
    const __amdgpu_buffer_rsrc_t rsA = __builtin_amdgcn_make_buffer_rsrc(const_cast<void*>(A), 0, 0x7fffffff, 0x00020000), rsB = __builtin_amdgcn_make_buffer_rsrc(const_cast<void*>(Bbase), 0, 0x7fffffff, 0x00020000);
    const unsigned ldsw = (unsigned)wid * 1024u;
    const int aoff = lds_byte(wr * 64 + fr, fq * 8), boff = lds_byte(wc * 32 + fr, fq * 8);
#define G8_AOFF(dst, u) do { int _t = tid; asm volatile("" : "+v"(_t)); int _R[2], _C[2]; _Pragma("unroll") for (int _i = 0; _i < 2; ++_i) stage_rc(_t * 16 + _i * 8192, _R[_i], _C[_i]); \
        if ((u).alist) { int _v[2][2];     \
            _Pragma("unroll") for (int _h = 0; _h < 2; ++_h) _Pragma("unroll") for (int _i = 0; _i < 2; ++_i) _v[_h][_i] = (u).alist[min(_h * HALF + _R[_i], (u).acnt - 1)]; \
            asm volatile("" : "+v"(_v[0][0]), "+v"(_v[0][1]), "+v"(_v[1][0]), "+v"(_v[1][1])); \
            _Pragma("unroll") for (int _h = 0; _h < 2; ++_h) _Pragma("unroll") for (int _i = 0; _i < 2; ++_i) dst[_h][_i] = (unsigned)((_v[_h][_i] >> ashift) * RP + _C[_i] * 2); } \
        else { _Pragma("unroll") for (int _h = 0; _h < 2; ++_h) _Pragma("unroll") for (int _i = 0; _i < 2; ++_i) dst[_h][_i] = (unsigned)(((u).arow0 + _h * HALF + _R[_i]) * RP + _C[_i] * 2); } } while (0)
#define G8_SA(b, h) (((b) * 2 + (h)) * HTB)
#define G8_SB(b, h) ((4 + (b) * 2 + (h)) * HTB)
#define G8_STAGE(bufoff, rsrc, soff, voff) do { _Pragma("unroll") for (int _i = 0; _i < 2; ++_i) \
        __builtin_amdgcn_raw_ptr_buffer_load_lds(rsrc, (G8_LAS unsigned*)(lds + (bufoff) + ldsw + _i * 8192), 16, (voff)[_i], (soff), 0, 0); } while (0)
#define G8_LDA(dst, b, h) do { if constexpr (FP8) { _Pragma("unroll") for (int m = 0; m < 4; ++m) { const v4i _lo = *(const G8_LAS v4i*)(lds + G8_SA(b, h) + aoff + m * 2048), _hi = *(const G8_LAS v4i*)(lds + G8_SA(b, h) + aoff + m * 2048 + 1024); dst##8[m] = __builtin_shufflevector(_lo, _hi, 0, 1, 2, 3, 4, 5, 6, 7); } } \
        else { _Pragma("unroll") for (int m = 0; m < 4; ++m) _Pragma("unroll") for (int k = 0; k < 2; ++k) dst[m][k] = *(const G8_LAS bf16x8*)(lds + G8_SA(b, h) + aoff + m * 2048 + k * 1024); } } while (0)
#define G8_LDB(dst, b, h) do { if constexpr (FP8) { _Pragma("unroll") for (int n = 0; n < 2; ++n) { const v4i _lo = *(const G8_LAS v4i*)(lds + G8_SB(b, h) + boff + n * 2048), _hi = *(const G8_LAS v4i*)(lds + G8_SB(b, h) + boff + n * 2048 + 1024); dst##8[n] = __builtin_shufflevector(_lo, _hi, 0, 1, 2, 3, 4, 5, 6, 7); } } \
        else { _Pragma("unroll") for (int n = 0; n < 2; ++n) _Pragma("unroll") for (int k = 0; k < 2; ++k) dst[n][k] = *(const G8_LAS bf16x8*)(lds + G8_SB(b, h) + boff + n * 2048 + k * 1024); } } while (0)
#define G8_MMA(ai, bj, At, Bt) do { __builtin_amdgcn_s_setprio(1); _Pragma("unroll") for (int m = 0; m < 4; ++m) _Pragma("unroll") for (int n = 0; n < 2; ++n) { \
        if constexpr (FP8) asm volatile("v_mfma_f32_16x16x128_f8f6f4 %0, %1, %2, %0" : "+v"(acc[ai][bj][m][n]) : "v"(Bt##8[n]), "v"(At##8[m])); \
        else { _Pragma("unroll") for (int k = 0; k < 2; ++k) asm volatile("v_mfma_f32_16x16x32_bf16 %0, %1, %2, %0" : "+v"(acc[ai][bj][m][n]) : "v"(Bt[n][k]), "v"(At[FP8 ? 0 : m][k])); } } __builtin_amdgcn_s_setprio(0); } while (0)
#define G8_WAIT_V(n) asm volatile("s_waitcnt vmcnt(" #n ")" ::: "memory")
#define G8_WAIT_L(n) asm volatile("s_waitcnt lgkmcnt(" #n ")" ::: "memory")
#define G8_BAR __builtin_amdgcn_s_barrier()
#define G8_SCHED __builtin_amdgcn_sched_barrier(0)
    Unit cur, nxt, nn; int ui = 0;
    if (!S.next(0, cur)) return;
    f32x4 acc[2][2][4][2];
#pragma unroll
    for (int a = 0; a < 2; ++a)
#pragma unroll
        for (int b = 0; b < 2; ++b)
#pragma unroll
            for (int m = 0; m < 4; ++m)
#pragma unroll
                for (int n = 0; n < 2; ++n) acc[a][b][m][n] = (f32x4){0.f, 0.f, 0.f, 0.f};
    bf16x8 At[FP8 ? 1 : 4][2], B0[2][2], B1[2][2];
    v8i At8[FP8 ? 4 : 1], B08[2], B18[2];
    unsigned cv[2][2], nv[2][2], fv[2][2];
    G8_AOFF(cv, cur);
    bool has_next = S.next(1, nxt);
    if (has_next) { G8_AOFF(nv, nxt); } else {
#pragma unroll
        for (int h = 0; h < 2; ++h)
#pragma unroll
            for (int i = 0; i < 2; ++i) nv[h][i] = cv[h][i]; }
    unsigned cB = cur.boff, nB = has_next ? nxt.boff : cB;
    G8_STAGE(G8_SB(0, 0), rsB, cB, voffB); G8_STAGE(G8_SB(0, 1), rsB, cB + hstep, voffB); G8_STAGE(G8_SA(0, 0), rsA, 0u, cv[0]); G8_STAGE(G8_SA(0, 1), rsA, 0u, cv[1]);
    if (wr == 1) G8_BAR;
    G8_WAIT_V(2); G8_BAR;
    G8_STAGE(G8_SB(1, 0), rsB, cB + kstep, voffB); G8_STAGE(G8_SA(1, 0), rsA, kstep, cv[0]); G8_STAGE(G8_SB(1, 1), rsB, cB + hstep + kstep, voffB);
    G8_WAIT_V(6); G8_BAR;
    for (;;) {
#pragma unroll 1
        for (int t = 0; t < nt; t += 2) {
            const bool last = (t == nt - 2);
            const unsigned k1 = (unsigned)(t + 1) * kstep;
            const unsigned k2 = last ? 0u : (unsigned)(t + 2) * kstep;
            const unsigned b2 = last ? nB : cB + (unsigned)(t + 2) * kstep, b3 = b2 + kstep;
            G8_LDB(B0, 0, 0); G8_LDB(B1, 0, 1); G8_SCHED; G8_LDA(At, 0, 0); G8_STAGE(G8_SA(1, 1), rsA, k1, cv[1]);
            G8_WAIT_V(8); G8_WAIT_L(0); G8_BAR; G8_MMA(0, 0, At, B0); G8_MMA(0, 1, At, B1); G8_BAR; G8_SCHED;
            G8_LDA(At, 0, 1); G8_STAGE(G8_SB(0, 0), rsB, b2, voffB); G8_STAGE(G8_SB(0, 1), rsB, b2 + hstep, voffB); { const unsigned sv_[2] = {last ? nv[0][0] : cv[0][0], last ? nv[0][1] : cv[0][1]}; G8_STAGE(G8_SA(0, 0), rsA, k2, sv_); }
            G8_WAIT_V(8); G8_WAIT_L(0); G8_BAR; G8_MMA(1, 0, At, B0); G8_MMA(1, 1, At, B1); G8_BAR; G8_SCHED;
            G8_LDB(B0, 1, 0); G8_LDB(B1, 1, 1); G8_SCHED; G8_LDA(At, 1, 0); { const unsigned sv_[2] = {last ? nv[1][0] : cv[1][0], last ? nv[1][1] : cv[1][1]}; G8_STAGE(G8_SA(0, 1), rsA, k2, sv_); }
            G8_WAIT_V(8); G8_WAIT_L(0); G8_BAR; G8_MMA(0, 0, At, B0); G8_MMA(0, 1, At, B1); G8_BAR; G8_SCHED;
            G8_LDA(At, 1, 1); G8_STAGE(G8_SB(1, 0), rsB, b3, voffB); G8_STAGE(G8_SB(1, 1), rsB, b3 + hstep, voffB); { const unsigned sv_[2] = {last ? nv[0][0] : cv[0][0], last ? nv[0][1] : cv[0][1]}; G8_STAGE(G8_SA(1, 0), rsA, k2 + kstep, sv_); }
            G8_WAIT_V(8); G8_WAIT_L(0); G8_BAR; G8_MMA(1, 0, At, B0); G8_MMA(1, 1, At, B1); G8_BAR; G8_SCHED;
        }
        asm volatile("s_nop 15\n\ts_nop 7" ::: "memory");
        if (wr == 0) G8_BAR;
        const bool has_nn = has_next && S.next(ui + 2, nn);
        if (has_nn) { G8_AOFF(fv, nn); }
        E(acc, cur, wr, wc, fr, fq);
        if (!has_next) break;
#pragma unroll
        for (int a = 0; a < 2; ++a)
#pragma unroll
            for (int b = 0; b < 2; ++b)
#pragma unroll
                for (int m = 0; m < 4; ++m)
#pragma unroll
                    for (int n = 0; n < 2; ++n) acc[a][b][m][n] = (f32x4){0.f, 0.f, 0.f, 0.f};
        cur = nxt; cB = nB; ++ui;
#pragma unroll
        for (int h = 0; h < 2; ++h)
#pragma unroll
            for (int i = 0; i < 2; ++i) { cv[h][i] = nv[h][i]; nv[h][i] = has_nn ? fv[h][i] : nv[h][i]; }
        has_next = has_nn; if (has_nn) { nxt = nn; nB = nn.boff; }
        if (wr == 1) G8_BAR;
    }
    G8_WAIT_V(0);
    G8_BAR;
#undef G8_AOFF
#undef G8_SA
#undef G8_SB
#undef G8_STAGE
#undef G8_LDA
#undef G8_LDB
#undef G8_MMA
#undef G8_WAIT_V
#undef G8_WAIT_L
#undef G8_BAR
#undef G8_SCHED
}

struct MoeSched {
    int nct, RP;
    const G8_LAS int* ut; const G8_LAS int* tp; const G8_LAS int* cnt;
    const int* list;
    const char* Bt; unsigned bt_estride;
    DEVI bool next(int i, Unit& u) const {
        if (i >= 32) return false;
        const int v = __builtin_amdgcn_readfirstlane(ut[i]);
        if (v < 0) return false;
        const int e = v & 255, rtg = (v >> 8) & 0xffff, ct = v >> 24;
        const int rt = rtg - __builtin_amdgcn_readfirstlane(tp[e]);
        u.e = e; u.orow0 = rtg * 256; u.ocol0 = ct * 256;
        u.boff = (unsigned)e * bt_estride + (unsigned)(ct * 256 * RP);
        if (list) { u.aoff = e * NTOK + rt * 256; u.alist = list + u.aoff; u.acnt = min(256, __builtin_amdgcn_readfirstlane(cnt[e]) - rt * 256); u.arow0 = 0; }
        else { u.alist = nullptr; u.acnt = 0; u.aoff = 0; u.arow0 = rtg * 256; }
        return true;
    }
};
DEVI void moe_units(G8_LAS int* ut, const G8_LAS int* tp, int nct, int G, int vcu, int tid) {
    if (tid < 32) {
        const int L = tid * G + vcu, total = tp[32] * nct; int v = -1;
        if (L < total) { const int rtg = L / nct, ct = L - rtg * nct; int e = 0;
            for (int k = 1; k < 32; ++k) e += (rtg >= tp[k]) ? 1 : 0;
            v = e | (rtg << 8) | (ct << 24); }
        ut[tid] = v;
    }
}
struct DenseSched {
    int G, c, RP, nM0, nN0; const char* Bt0; int nM1, nN1, arow1; const char* Bt1;
    DEVI bool next(int i, Unit& u) const {
        const int nwg = nM0 * nN0, L = i * G + c;
        u.alist = nullptr; u.acnt = 0; u.aoff = 0;
        if (L < nwg) {
            int wgid = L; { const int q = nwg / 8, r = nwg % 8, xcd = wgid % 8, off = wgid / 8; wgid = (xcd < r ? xcd * (q + 1) : r * (q + 1) + (xcd - r) * q) + off; }
            const int nig = 8 * nN0, gid = wgid / nig, fm = gid * 8, gsz = (nM0 - fm) < 8 ? (nM0 - fm) : 8;
            const int pm = fm + ((wgid % nig) % gsz), pn = (wgid % nig) / gsz;
            u.e = 0; u.arow0 = pm * 256; u.orow0 = pm * 256; u.ocol0 = pn * 256; u.boff = (unsigned)(pn * 256 * RP); return true;
        }
        const int l = L - nwg; if (l >= nM1 * nN1) return false;
        const int pm = l / nN1, pn = l - pm * nN1;
        u.e = 1; u.arow0 = arow1 + pm * 256; u.orow0 = pm * 256; u.ocol0 = pn * 256; u.boff = (unsigned)(Bt1 - Bt0) + (unsigned)(pn * 256 * RP); return true;
    }
};
}

DEVI unsigned f2bf(float f) { unsigned u = __builtin_bit_cast(unsigned, f); return (u + 0x7fffu + ((u >> 16) & 1u)) >> 16; }
DEVI unsigned pk2(float lo, float hi) { return f2bf(lo) | (f2bf(hi) << 16); }
typedef unsigned v4u __attribute__((ext_vector_type(4)));
DEVI void t8_load(const float* W, int N, int item, int ipe  , int lane, float4 (&v)[16]) {
    const int e = item / ipe, q = item - e * ipe, nblk = N / 64, kb = q / nblk, nb = q - kb * nblk;
    const float* src = W + (size_t)e * 1024 * N + (size_t)(64 * kb + (lane >> 4)) * N + 64 * nb + 4 * (lane & 15);
#pragma unroll
    for (int i = 0; i < 16; ++i) v[i] = *(const float4*)(src + (size_t)(4 * i) * N);
}
DEVI void t8_lds_write(const float4 (&v)[16], __attribute__((address_space(3))) float* scr, int lane) {
    const int kr = lane >> 4, c4 = lane & 15;
#pragma unroll
    for (int i = 0; i < 16; ++i) { __attribute__((address_space(3))) float* d = scr + (4 * i + kr) * 65 + 4 * c4; d[0] = v[i].x; d[1] = v[i].y; d[2] = v[i].z; d[3] = v[i].w; }
    asm volatile("s_waitcnt lgkmcnt(0)" ::: "memory");
}
DEVI void t8_pack_store(unsigned char* WT, int N, int item, int ipe, int lane, const __attribute__((address_space(3))) float* scr, const float* ks) {
    const int e = item / ipe, q = item - e * ipe, nblk = N / 64, kb = q / nblk, nb = q - kb * nblk, k0 = 64 * kb, n0 = 64 * nb;
    const int c = lane & 7, ns = lane >> 3;
    float kf[8];
#pragma unroll
    for (int q2 = 0; q2 < 8; ++q2) kf[q2] = 32.f * (ks ? ks[k0 + 8 * c + q2] : 1.f);
    unsigned char* dst = WT + (size_t)e * N * 1024 + (size_t)n0 * 1024 + k0 + 8 * c;
#pragma unroll
    for (int j = 0; j < 8; ++j) { const int n = ns + 8 * j; const __attribute__((address_space(3))) float* s = scr + (8 * c) * 65 + n;
        uint2 o; o.x = g8::pk4_fp8(kf[0] * s[0 * 65], kf[1] * s[1 * 65], kf[2] * s[2 * 65], kf[3] * s[3 * 65]); o.y = g8::pk4_fp8(kf[4] * s[4 * 65], kf[5] * s[5 * 65], kf[6] * s[6 * 65], kf[7] * s[7 * 65]);
        *(uint2*)(dst + (size_t)n * 1024) = o; }
    asm volatile("s_waitcnt lgkmcnt(0)" ::: "memory");
}
DEVI void t8_run(const float* W, int N, unsigned char* WT, const float* ks, int first, int end, int stride, int lane, __attribute__((address_space(3))) float* scr) {
    const int ipe = 16 * (N / 64);
    float4 v[16];
    int it = first;
    if (it < end) t8_load(W, N, it, ipe, lane, v);
    while (it < end) {
        t8_lds_write(v, scr, lane);
        const int nx = it + stride;
        if (nx < end) t8_load(W, N, nx, ipe, lane, v);
        t8_pack_store(WT, N, it, ipe, lane, scr, ks);
        it = nx;
    }
}
DEVI void transpose_item(const float* W, int K, int N, unsigned short* WT, __attribute__((address_space(3))) float* scr, int item, int lane, int ncols = 0, const float* ks = nullptr) {
    const int nblk = (ncols ? ncols : N) / 64, kb = item / nblk, nb = item % nblk, k0 = 64 * kb, n0 = 64 * nb;
    const int kr = lane >> 4, c4 = lane & 15;
    float4 v[16];
#pragma unroll
    for (int i = 0; i < 16; ++i) v[i] = *(const float4*)(W + (size_t)(k0 + 4 * i + kr) * N + n0 + 4 * c4);
#pragma unroll
    for (int i = 0; i < 16; ++i) { __attribute__((address_space(3))) float* d = scr + (4 * i + kr) * 65 + 4 * c4; d[0] = v[i].x; d[1] = v[i].y; d[2] = v[i].z; d[3] = v[i].w; }
    asm volatile("s_waitcnt lgkmcnt(0)" ::: "memory");
    const int c = lane & 7, ns = lane >> 3;
    float kf[8];
#pragma unroll
    for (int q = 0; q < 8; ++q) kf[q] = ks ? ks[k0 + 8 * c + q] : 1.f;
#pragma unroll
    for (int j = 0; j < 8; ++j) { const int n = ns + 8 * j; const __attribute__((address_space(3))) float* s = scr + (8 * c) * 65 + n;
        v4u o; o.x = pk2(kf[0] * s[0 * 65], kf[1] * s[1 * 65]); o.y = pk2(kf[2] * s[2 * 65], kf[3] * s[3 * 65]); o.z = pk2(kf[4] * s[4 * 65], kf[5] * s[5 * 65]); o.w = pk2(kf[6] * s[6 * 65], kf[7] * s[7 * 65]);
        *(v4u*)(WT + (size_t)(n0 + n) * K + k0 + 8 * c) = o; }
    asm volatile("s_waitcnt lgkmcnt(0)" ::: "memory");
}

#define LAS3 __attribute__((address_space(3)))

typedef float f32x16 __attribute__((ext_vector_type(16)));
typedef short bf16x8_t __attribute__((ext_vector_type(8)));
typedef float f32x2_t __attribute__((ext_vector_type(2)));
typedef __bf16 bf16x2_t __attribute__((ext_vector_type(2)));
typedef unsigned u32x4_t __attribute__((ext_vector_type(4)));
typedef unsigned u32x2_t __attribute__((ext_vector_type(2)));
#define MFMA32(a, b, c) __builtin_amdgcn_mfma_f32_32x32x16_bf16((a), (b), (c), 0, 0, 0)
DEVI unsigned cvtpk(float lo, float hi) { f32x2_t v = {lo, hi}; bf16x2_t b = __builtin_convertvector(v, bf16x2_t); return __builtin_bit_cast(unsigned, b); }
DEVI int crow(int reg, int hi) { return (reg & 3) + 8 * (reg >> 2) + 4 * hi; }
DEVI bf16x8_t pack_step(const f32x16& x, int s) {
    u32x4_t p; p[0] = cvtpk(x[8 * s], x[8 * s + 1]); p[1] = cvtpk(x[8 * s + 2], x[8 * s + 3]); p[2] = cvtpk(x[8 * s + 4], x[8 * s + 5]); p[3] = cvtpk(x[8 * s + 6], x[8 * s + 7]);
    return __builtin_bit_cast(bf16x8_t, p);
}
DEVI int t5_bucket(int d) { return d < 16 ? d : min(31, 16 + (int)(log2f((float)d * 0.0625f) * (16.f / 3.f))); }

DEVI void swa_item(int item, const unsigned short* PROJB, unsigned short* MIXB, const float* relb, const float* sinks, LAS3 unsigned char* L, int tid_) {
    int tid = tid_; asm volatile("" : "+v"(tid));
    const int kv = item & 1, qb = (item >> 1) & 63, b = item >> 7;
    const int lane = tid & 63, w = __builtin_amdgcn_readfirstlane(tid >> 6), hi = lane >> 5, r32 = lane & 31;
    LAS3 unsigned char* KL = L; LAS3 unsigned char* VT = L + 36864; LAS3 float* BT = (LAS3 float*)(L + 36864 + 33280);
    const long tok0 = (long)b * SEQ + (long)(qb - 1) * 128;
#pragma unroll
    for (int i = 0; i < 4; ++i) { const int ci = tid + 512 * i, row = ci >> 3, ch = ci & 7; const bool ok = (qb > 0) || (row >= 128);
        u32x4_t v = {0u, 0u, 0u, 0u}; if (ok) v = *(const u32x4_t*)(PROJB + (size_t)(tok0 + row) * PJ + PJ_K + kv * 64 + ch * 8);
        *(LAS3 u32x4_t*)(KL + row * 144 + ch * 16) = v; }
#pragma unroll
    for (int i = 0; i < 2; ++i) { const int it = tid + 512 * i, rp = it >> 3, ch = it & 7; const bool ok = (qb > 0) || (rp >= 64);
        u32x4_t v0 = {0u, 0u, 0u, 0u}, v1 = {0u, 0u, 0u, 0u};
        if (ok) { const unsigned short* vp = PROJB + (size_t)(tok0 + 2 * rp) * PJ + PJ_V + kv * 64 + ch * 8; v0 = *(const u32x4_t*)vp; v1 = *(const u32x4_t*)(vp + PJ); }
#pragma unroll
        for (int e = 0; e < 8; ++e) { const unsigned a = (e & 1) ? (v0[e >> 1] >> 16) : (v0[e >> 1] & 0xffffu), c = (e & 1) ? (v1[e >> 1] & 0xffff0000u) : (v1[e >> 1] << 16);
            *(LAS3 unsigned*)(VT + (ch * 8 + e) * 520 + rp * 4) = a | c; } }
    { const int hql = tid >> 7, d = tid & 127; BT[tid] = relb[t5_bucket(d) * 8 + kv * 4 + hql]; }
    __syncthreads();
    const int hql = w >> 1, hq = kv * 4 + hql, qhalf = w & 1;
    const float sink = sinks[hq];
#pragma unroll 1
    for (int qi = 0; qi < 2; ++qi) {
        const int m = 2 * qhalf + qi, qf0 = 128 + 32 * m;
        const size_t qrow0 = (size_t)b * SEQ + (size_t)qb * 128 + 32 * m;
        const unsigned short* qp = PROJB + (qrow0 + r32) * PJ + PJ_Q + hq * 64 + 8 * hi;
        bf16x8_t qf[4];
#pragma unroll
        for (int ks = 0; ks < 4; ++ks) qf[ks] = *(const bf16x8_t*)(qp + 16 * ks);
        f32x16 S[5];
#pragma unroll
        for (int kk = 0; kk < 5; ++kk) {
#pragma unroll
            for (int r = 0; r < 16; ++r) S[kk][r] = 0.f;
#pragma unroll
            for (int ks = 0; ks < 4; ++ks) { const bf16x8_t a = *(const LAS3 bf16x8_t*)(KL + (32 * (m + kk) + r32) * 144 + (16 * ks + 8 * hi) * 2); S[kk] = MFMA32(a, qf[ks], S[kk]); }
        }
        float mx = sink;
#pragma unroll
        for (int kk = 0; kk < 5; ++kk)
#pragma unroll
            for (int r = 0; r < 16; ++r) { const int kf = 32 * (m + kk) + crow(r, hi), dist = qf0 + r32 - kf; const bool ok = (dist >= 0) && (dist < 128) && ((qb > 0) || (kf >= 128));
                const float sc = ok ? S[kk][r] * 0.125f + BT[hql * 128 + (dist & 127)] : -INFINITY; S[kk][r] = sc; mx = fmaxf(mx, sc); }
        mx = fmaxf(mx, xshfl(mx, 32, lane));
        float sum = 0.f;
#pragma unroll
        for (int kk = 0; kk < 5; ++kk)
#pragma unroll
            for (int r = 0; r < 16; ++r) { const float pe = __expf(S[kk][r] - mx); S[kk][r] = pe; sum += pe; }
        sum += xshfl(sum, 32, lane); sum += __expf(sink - mx);
        const float linv = 1.f / sum;
        f32x16 O[2];
#pragma unroll
        for (int db = 0; db < 2; ++db)
#pragma unroll
            for (int r = 0; r < 16; ++r) O[db][r] = 0.f;
#pragma unroll
        for (int kk = 0; kk < 5; ++kk)
#pragma unroll
            for (int s2 = 0; s2 < 2; ++s2) { const bf16x8_t pa = pack_step(S[kk], s2); const int kbase = 32 * (m + kk) + 16 * s2 + 4 * hi;
#pragma unroll
                for (int db = 0; db < 2; ++db) { LAS3 unsigned char* vp = VT + (32 * db + r32) * 520 + kbase * 2;
                    const u32x2_t lo = *(const LAS3 u32x2_t*)vp, hi2 = *(const LAS3 u32x2_t*)(vp + 16);
                    const u32x4_t vv = {lo[0], lo[1], hi2[0], hi2[1]};
                    O[db] = MFMA32(pa, __builtin_bit_cast(bf16x8_t, vv), O[db]); } }
#pragma unroll
        for (int r = 0; r < 16; ++r) { const int q = crow(r, hi); const float li = bperm(linv, q);
            unsigned short* op = MIXB + (qrow0 + q) * 1024 + 512 + hq * 64 + r32;
            op[0] = (unsigned short)(cvtpk(O[0][r] * li, 0.f) & 0xffffu); op[32] = (unsigned short)(cvtpk(O[1][r] * li, 0.f) & 0xffffu); }
    }
    __syncthreads();
}

DEVI void xattn_item(int item, const unsigned short* QCB, const unsigned short* KVMB, const float* SSQ, unsigned short* OCB, LAS3 unsigned char* L, int tid_) {
    int tid = tid_; asm volatile("" : "+v"(tid));
    const int qblk = item & 31, hd = (item >> 5) & 3, b = item >> 7;
    const int lane = tid & 63, w = __builtin_amdgcn_readfirstlane(tid >> 6), hi = lane >> 5, r32 = lane & 31;
    LAS3 unsigned char* KL = L; LAS3 unsigned char* VT = L + 69632;
    const unsigned short* kvb = KVMB + (size_t)b * MEMLEN * 1024 + hd * 128;
#pragma unroll
    for (int i = 0; i < 8; ++i) { const int ci = tid + 512 * i, row = ci >> 4, ch = ci & 15;
        *(LAS3 u32x4_t*)(KL + row * 272 + ch * 16) = *(const u32x4_t*)(kvb + (size_t)row * 1024 + ch * 8); }
#pragma unroll
    for (int i = 0; i < 4; ++i) { const int it = tid + 512 * i, rp = it >> 4, ch = it & 15;
        const unsigned short* vp = kvb + (size_t)(2 * rp) * 1024 + 512 + ch * 8; const u32x4_t v0 = *(const u32x4_t*)vp, v1 = *(const u32x4_t*)(vp + 1024);
#pragma unroll
        for (int e = 0; e < 8; ++e) { const unsigned a = (e & 1) ? (v0[e >> 1] >> 16) : (v0[e >> 1] & 0xffffu), c = (e & 1) ? (v1[e >> 1] & 0xffff0000u) : (v1[e >> 1] << 16);
            *(LAS3 unsigned*)(VT + (ch * 8 + e) * 520 + rp * 4) = a | c; } }
    __syncthreads();
    const size_t qrow0 = (size_t)b * SEQ + (size_t)qblk * 256 + 32 * w;
    const unsigned short* qp = QCB + (qrow0 + r32) * 512 + hd * 128 + 8 * hi;
    f32x16 S[8];
    {
        bf16x8_t qf[8];
#pragma unroll
        for (int ks = 0; ks < 8; ++ks) qf[ks] = *(const bf16x8_t*)(qp + 16 * ks);
#pragma unroll
        for (int kk = 0; kk < 8; ++kk) {
#pragma unroll
            for (int r = 0; r < 16; ++r) S[kk][r] = 0.f;
#pragma unroll
            for (int ks = 0; ks < 8; ++ks) { const bf16x8_t a = *(const LAS3 bf16x8_t*)(KL + (32 * kk + r32) * 272 + (16 * ks + 8 * hi) * 2); S[kk] = MFMA32(a, qf[ks], S[kk]); }
        }
    }
    float sc = 0.08838834764831845f;
    {
        const float* sp = SSQ + (qrow0 + r32) * 32; float t = 0.f;
#pragma unroll
        for (int i = 0; i < 8; ++i) { const float4 v = ld4(sp + 4 * i); t += (v.x + v.y) + (v.z + v.w); }
        sc *= rsqrtf(t * (1.f / 1024.f) + EPS);
    }
    float mx = -INFINITY;
#pragma unroll
    for (int kk = 0; kk < 8; ++kk)
#pragma unroll
        for (int r = 0; r < 16; ++r) mx = fmaxf(mx, S[kk][r]);
    mx = fmaxf(mx, xshfl(mx, 32, lane));
    float sum = 0.f;
#pragma unroll
    for (int kk = 0; kk < 8; ++kk)
#pragma unroll
        for (int r = 0; r < 16; ++r) { const float pe = __expf((S[kk][r] - mx) * sc); S[kk][r] = pe; sum += pe; }
    sum += xshfl(sum, 32, lane);
    const float linv = 1.f / sum;
    f32x16 O[4];
#pragma unroll
    for (int db = 0; db < 4; ++db)
#pragma unroll
        for (int r = 0; r < 16; ++r) O[db][r] = 0.f;
#pragma unroll
    for (int kk = 0; kk < 8; ++kk)
#pragma unroll
        for (int s2 = 0; s2 < 2; ++s2) { const bf16x8_t pa = pack_step(S[kk], s2); const int kbase = 32 * kk + 16 * s2 + 4 * hi;
#pragma unroll
            for (int db = 0; db < 4; ++db) { LAS3 unsigned char* vp = VT + (32 * db + r32) * 520 + kbase * 2;
                const u32x2_t lo = *(const LAS3 u32x2_t*)vp, hi2 = *(const LAS3 u32x2_t*)(vp + 16);
                const u32x4_t vv = {lo[0], lo[1], hi2[0], hi2[1]};
                O[db] = MFMA32(pa, __builtin_bit_cast(bf16x8_t, vv), O[db]); } }
#pragma unroll
    for (int r = 0; r < 16; ++r) { const int q = crow(r, hi); const float li = bperm(linv, q);
        unsigned short* op = OCB + (qrow0 + q) * 512 + hd * 128 + r32;
#pragma unroll
        for (int db = 0; db < 4; ++db) op[32 * db] = (unsigned short)(cvtpk(O[db][r] * li, 0.f) & 0xffffu); }
    __syncthreads();
}


DEVI void ssd_s1_item(int item, const unsigned short* PROJB, const float* DTRAW, const float* convw, const float* convb, const float* dtbias, const float* alog,
                      unsigned short* XC, float* DT, float* ACS, float* CD, float* ST, LAS3 unsigned char* L, int tid_) {
    int tid = tid_; asm volatile("" : "+v"(tid));
    const int g = item & 1, c = (item >> 1) & 63, b = item >> 7;
    const int lane = tid & 63, w = __builtin_amdgcn_readfirstlane(tid >> 6), hi = lane >> 5, r32 = lane & 31;
    LAS3 unsigned char* XwT = L; LAS3 unsigned char* BT = L + 69632;
    LAS3 float* dts = (LAS3 float*)(L + 104448); LAS3 float* acs = dts + 512; LAS3 float* wts = acs + 512;
    const size_t tok0 = (size_t)b * SEQ + (size_t)c * 128;
    if (w < 4) {
        const int h = 4 * g + w; const float ah = -__expf(alog[h]), db = dtbias[h];
        const float d0 = softplus_f(DTRAW[(tok0 + 2 * lane) * 8 + h] + db), d1 = softplus_f(DTRAW[(tok0 + 2 * lane + 1) * 8 + h] + db);
        const float a0 = d0 * ah, a1 = d1 * ah;
        float sc = a0 + a1;
#pragma unroll
        for (int o = 1; o < 64; o <<= 1) { const float v = bperm(sc, lane - o); if (lane >= o) sc += v; }
        const float ex = sc - (a0 + a1), c0 = ex + a0, c1 = ex + a0 + a1, cend = bperm(sc, 63);
        dts[w * 128 + 2 * lane] = d0; dts[w * 128 + 2 * lane + 1] = d1; acs[w * 128 + 2 * lane] = c0; acs[w * 128 + 2 * lane + 1] = c1;
        wts[w * 128 + 2 * lane] = __expf(cend - c0) * d0; wts[w * 128 + 2 * lane + 1] = __expf(cend - c1) * d1;
        DT[(tok0 + 2 * lane) * 8 + h] = d0; DT[(tok0 + 2 * lane + 1) * 8 + h] = d1; ACS[(tok0 + 2 * lane) * 8 + h] = c0; ACS[(tok0 + 2 * lane + 1) * 8 + h] = c1;
        if (lane == 0) CD[((size_t)b * 64 + c) * 8 + h] = __expf(cend);
    }
    __syncthreads();
    {
        const int cg = lane, ch = cg < 32 ? g * 256 + cg * 8 : (cg < 48 ? 512 + g * 128 + (cg - 32) * 8 : 768 + g * 128 + (cg - 48) * 8);
        float wk[4][8], bb[8];
#pragma unroll
        for (int k = 0; k < 4; ++k) { const float4 a = ld4(convw + k * CONVCH + ch), d = ld4(convw + k * CONVCH + ch + 4); wk[k][0] = a.x; wk[k][1] = a.y; wk[k][2] = a.z; wk[k][3] = a.w; wk[k][4] = d.x; wk[k][5] = d.y; wk[k][6] = d.z; wk[k][7] = d.w; }
        { const float4 a = ld4(convb + ch), d = ld4(convb + ch + 4); bb[0] = a.x; bb[1] = a.y; bb[2] = a.z; bb[3] = a.w; bb[4] = d.x; bb[5] = d.y; bb[6] = d.z; bb[7] = d.w; }
        const int s0 = w * 16;
        const unsigned short* src = PROJB + (tok0 + s0) * PJ + PJ_XBC + ch;
        u32x4_t rw[19];
#pragma unroll
        for (int i = 0; i < 19; ++i) { const bool ok = (c > 0) || (s0 + i - 3 >= 0); rw[i] = (u32x4_t){0u, 0u, 0u, 0u}; if (ok) rw[i] = *(const u32x4_t*)(src + (ptrdiff_t)(i - 3) * PJ); }
        const int hl = cg >> 3;
#pragma unroll
        for (int i2 = 0; i2 < 8; ++i2) {
            float y[2][8];
#pragma unroll
            for (int q = 0; q < 2; ++q) {
                const int i = 2 * i2 + q;
#pragma unroll
                for (int e = 0; e < 8; ++e) { float a = bb[e];
#pragma unroll
                    for (int k = 0; k < 4; ++k) { const unsigned wd = rw[i + k][e >> 1]; a += wk[k][e] * __uint_as_float((e & 1) ? (wd & 0xffff0000u) : (wd << 16)); }
                    y[q][e] = silu_f(a); }
                u32x4_t o; o[0] = cvtpk(y[q][0], y[q][1]); o[1] = cvtpk(y[q][2], y[q][3]); o[2] = cvtpk(y[q][4], y[q][5]); o[3] = cvtpk(y[q][6], y[q][7]);
                *(u32x4_t*)(XC + (tok0 + s0 + i) * 1024 + ch) = o;
            }
            const int s = s0 + 2 * i2;
            if (cg < 32) { const float w0 = wts[hl * 128 + s], w1 = wts[hl * 128 + s + 1];
#pragma unroll
                for (int e = 0; e < 8; ++e) *(LAS3 unsigned*)(XwT + hl * 17408 + ((cg & 7) * 8 + e) * 272 + ((((s >> 3) ^ (cg & 7)) & 15) << 4) + (s & 7) * 2) = cvtpk(y[0][e] * w0, y[1][e] * w1); }
            else if (cg < 48) {
#pragma unroll
                for (int e = 0; e < 8; ++e) *(LAS3 unsigned*)(BT + ((cg - 32) * 8 + e) * 272 + ((((s >> 3) ^ ((cg - 32) & 7)) & 15) << 4) + (s & 7) * 2) = cvtpk(y[0][e], y[1][e]); }
        }
    }
    __syncthreads();
    {
        const int pb = w >> 2, nb = w & 3;
#pragma unroll 1
        for (int hl = 0; hl < 4; ++hl) {
            f32x16 acc;
#pragma unroll
            for (int r = 0; r < 16; ++r) acc[r] = 0.f;
#pragma unroll
            for (int ks = 0; ks < 8; ++ks) { const bf16x8_t a = *(const LAS3 bf16x8_t*)(XwT + hl * 17408 + (32 * pb + r32) * 272 + (((2 * ks + hi) ^ ((r32 >> 3) + 4 * pb)) & 15) * 16);
                const bf16x8_t bq = *(const LAS3 bf16x8_t*)(BT + (32 * nb + r32) * 272 + (((2 * ks + hi) ^ (((r32 >> 3) + 4 * nb) & 7)) & 15) * 16); acc = MFMA32(a, bq, acc); }
            float* sp = ST + (((size_t)b * 64 + c) * 8 + 4 * g + hl) * 8192 + 32 * nb + r32;
#pragma unroll
            for (int r = 0; r < 16; ++r) sp[(32 * pb + crow(r, hi)) * 128] = acc[r];
        }
    }
    __syncthreads();
}

DEVI void ssd_s3_item(int item, const unsigned short* XC, const float* DT, const float* ACS, const unsigned short* HIN, const unsigned short* PROJB, const float* dskip, const float* gssm,
                      float* YPRE, unsigned short* MIXB, LAS3 unsigned char* L, int tid_) {
    int tid = tid_; asm volatile("" : "+v"(tid));
    const int g = item & 1, c = (item >> 1) & 63, b = item >> 7;
    const int lane = tid & 63, w = __builtin_amdgcn_readfirstlane(tid >> 6), hi = lane >> 5, r32 = lane & 31;
    LAS3 unsigned char* Cs = L; LAS3 unsigned char* BM = L + 34816; LAS3 unsigned char* XT = L + 69632; LAS3 unsigned char* HN = L + 87040;
    LAS3 float* dts = (LAS3 float*)(L + 104448); LAS3 float* acs = dts + 512; LAS3 float* rowsq = acs + 512;
    const size_t tok0 = (size_t)b * SEQ + (size_t)c * 128;
#pragma unroll
    for (int i = 0; i < 4; ++i) { const int ci = tid + 512 * i, row = ci >> 4, chk = ci & 15;
        *(LAS3 u32x4_t*)(Cs + row * 272 + chk * 16) = *(const u32x4_t*)(XC + (tok0 + row) * 1024 + 768 + g * 128 + chk * 8);
        *(LAS3 u32x4_t*)(BM + row * 272 + chk * 16) = *(const u32x4_t*)(XC + (tok0 + row) * 1024 + 512 + g * 128 + chk * 8); }
    { const int t = tid >> 2, hl = tid & 3; dts[hl * 128 + t] = DT[(tok0 + t) * 8 + 4 * g + hl]; acs[hl * 128 + t] = ACS[(tok0 + t) * 8 + 4 * g + hl]; }
    __syncthreads();
    const int lb = w >> 1;
    f32x16 CB[2];
#pragma unroll
    for (int j = 0; j < 2; ++j) {
#pragma unroll
        for (int r = 0; r < 16; ++r) CB[j][r] = 0.f;
        const int sb = 2 * (w & 1) + j;
        if (sb <= lb) {
#pragma unroll
            for (int ks = 0; ks < 8; ++ks) { const bf16x8_t a = *(const LAS3 bf16x8_t*)(Cs + (32 * lb + r32) * 272 + (16 * ks + 8 * hi) * 2);
                const bf16x8_t bq = *(const LAS3 bf16x8_t*)(BM + (32 * sb + r32) * 272 + (16 * ks + 8 * hi) * 2); CB[j] = MFMA32(a, bq, CB[j]); }
        }
    }
    __syncthreads();
    const int pb = w & 1;
    LAS3 unsigned char* ZS = L + 110592;
    float sq[16];
#pragma unroll
    for (int r = 0; r < 16; ++r) sq[r] = 0.f;
#pragma unroll 1
    for (int hl = 0; hl < 4; ++hl) {
        const int h = 4 * g + hl;
        {
            const int sp = tid >> 3, chk = tid & 7;
            const unsigned short* xp = XC + (tok0 + 2 * sp) * 1024 + h * 64 + chk * 8; const u32x4_t v0 = *(const u32x4_t*)xp, v1 = *(const u32x4_t*)(xp + 1024);
#pragma unroll
            for (int e = 0; e < 8; ++e) { const unsigned a = (e & 1) ? (v0[e >> 1] >> 16) : (v0[e >> 1] & 0xffffu), d = (e & 1) ? (v1[e >> 1] & 0xffff0000u) : (v1[e >> 1] << 16);
                *(LAS3 unsigned*)(XT + (chk * 8 + e) * 272 + ((((sp >> 2) ^ chk) & 15) << 4) + (sp & 3) * 4) = a | d; }
            const unsigned short* hp = HIN + (((size_t)b * 64 + c) * 8 + h) * 8192;
#pragma unroll
            for (int i = 0; i < 2; ++i) { const int ci = tid + 512 * i, row = ci >> 4, ck = ci & 15; *(LAS3 u32x4_t*)(HN + row * 272 + ck * 16) = *(const u32x4_t*)(hp + row * 128 + ck * 8); }
#pragma unroll
            for (int i = 0; i < 2; ++i) { const int ci = tid + 512 * i, row = ci >> 3, ck = ci & 7; *(LAS3 u32x4_t*)(ZS + row * 144 + ck * 16) = *(const u32x4_t*)(PROJB + (tok0 + row) * PJ + PJ_Z + h * 64 + ck * 8); }
        }
#pragma unroll
        for (int j = 0; j < 2; ++j) { const int sb = 2 * (w & 1) + j;
            if (sb <= lb) { const int s = 32 * sb + r32; const float as = acs[hl * 128 + s], ds = dts[hl * 128 + s];
#pragma unroll
                for (int r = 0; r < 16; ++r) { const int l = 32 * lb + crow(r, hi); const float ev = CB[j][r] * __expf(acs[hl * 128 + l] - as) * ds; const float v = (s <= l) ? ev : 0.f;
                    *(LAS3 unsigned short*)(BM + l * 272 + s * 2) = (unsigned short)(cvtpk(v, 0.f) & 0xffffu); } } }
        __syncthreads();
        f32x16 acc;
#pragma unroll
        for (int r = 0; r < 16; ++r) acc[r] = 0.f;
#pragma unroll
        for (int ks = 0; ks < 8; ++ks) { const bf16x8_t a = *(const LAS3 bf16x8_t*)(Cs + (32 * lb + r32) * 272 + (16 * ks + 8 * hi) * 2);
            const bf16x8_t bq = *(const LAS3 bf16x8_t*)(HN + (32 * pb + r32) * 272 + (16 * ks + 8 * hi) * 2); acc = MFMA32(a, bq, acc); }
#pragma unroll
        for (int r = 0; r < 16; ++r) acc[r] *= __expf(acs[hl * 128 + 32 * lb + crow(r, hi)]);
#pragma unroll
        for (int ks = 0; ks < 8; ++ks) if (ks < 2 * (lb + 1)) { const bf16x8_t a = *(const LAS3 bf16x8_t*)(BM + (32 * lb + r32) * 272 + (16 * ks + 8 * hi) * 2);
            const bf16x8_t bq = *(const LAS3 bf16x8_t*)(XT + (32 * pb + r32) * 272 + (((2 * ks + hi) ^ ((r32 >> 3) + 4 * pb)) & 15) * 16); acc = MFMA32(a, bq, acc); }
        const float dsk = dskip[h]; const int pc = 32 * pb + r32;
        unsigned short* yp = (unsigned short*)YPRE + tok0 * 512 + h * 64 + pc;
#pragma unroll
        for (int r = 0; r < 16; ++r) { const int l = 32 * lb + crow(r, hi);
            const float xv = bf2f(*(const LAS3 unsigned short*)(XT + pc * 272 + ((((l >> 3) ^ (pc >> 3)) & 15) << 4) + (l & 7) * 2)), z = bf2f(*(const LAS3 unsigned short*)(ZS + l * 144 + pc * 2));
            const float y = (acc[r] + dsk * xv) * silu_f(z); yp[l * 512] = (unsigned short)(cvtpk(y, 0.f) & 0xffffu); sq[r] += y * y; }
        __syncthreads();
    }
#pragma unroll
    for (int r = 0; r < 16; ++r) { float v = sq[r];
#pragma unroll
        for (int o = 1; o < 32; o <<= 1) v += xshfl(v, o, lane);
        if (r32 == 0) rowsq[(32 * lb + crow(r, hi)) * 2 + pb] = v; }
    __syncthreads();
#pragma unroll 1
    for (int hl = 0; hl < 4; ++hl) { const int col = (4 * g + hl) * 64 + 32 * pb + r32; const float gs = gssm[col];
#pragma unroll
        for (int r = 0; r < 16; ++r) { const int l = 32 * lb + crow(r, hi); const float rs = rsqrtf((rowsq[l * 2] + rowsq[l * 2 + 1]) * (1.f / 256.f) + EPS);
            MIXB[(tok0 + l) * 1024 + col] = (unsigned short)(cvtpk(bf2f(((const unsigned short*)YPRE)[(tok0 + l) * 512 + col]) * rs * gs, 0.f) & 0xffffu); } }
    __syncthreads();
}

__global__ void __launch_bounds__(512, 2) mk_fwd(Params p) {
    extern __shared__ __attribute__((aligned(16))) unsigned char lds[];
    const int NGW = gridDim.x * 8, NGT = gridDim.x * 512, G = gridDim.x;
    unsigned char* ws = p.ws;
    unsigned* ctl = (unsigned*)(ws + WS_CTL);
    unsigned short* H2B = (unsigned short*)(ws + WS_H1);
    float* DT = (float*)(ws + WS_DT); float* DTRAW = (float*)(ws + WS_DTRAW); float* GATE = (float*)(ws + WS_GATE); float* BIASP = (float*)(ws + WS_BIASP);
    typedef unsigned short bf;
    bf* XN = (bf*)(ws + WS_XN); bf* PROJB = (bf*)(ws + WS_BIG); bf* YB = (bf*)(ws + WS_YB); bf* MIXB = (bf*)(ws + WS_MIXB); bf* QCB = (bf*)(ws + WS_QCB); bf* OCB = (bf*)(ws + WS_OCB);
    bf* KVMB = (bf*)(ws + WS_KVMB);
    bf* XC = (bf*)(ws + WS_XC); float* ACS = (float*)(ws + WS_ACS); float* CD = (float*)(ws + WS_CD); float* ST = (float*)(ws + WS_ST); bf* HIN = (bf*)(ws + WS_HIN);
    unsigned char* Y8 = ws + WS_YB;
    unsigned char* W1T8 = ws + WS_W1T; unsigned char* W2T8 = ws + WS_W2T; unsigned char* XN8 = ws + WS_QCB; unsigned char* ACT8 = ws + WS_ACTB;
    bf* WINT = (bf*)(ws + WS_WINT); bf* WOUTT = (bf*)(ws + WS_WOUTT); bf* WQT = (bf*)(ws + WS_WQT); bf* WKVT = (bf*)(ws + WS_WKVT); bf* WOT = (bf*)(ws + WS_WOT);
    int* LIST = (int*)(ws + WS_LIST); int* SLOT = (int*)(ws + WS_SLOT); float* RSA = (float*)(ws + WS_RSA); float* SSQ1 = (float*)(ws + WS_SSQ1); int* CNTB = (int*)(ws + WS_CNTB); float* RSROW = (float*)(ws + WS_RSROW);
    LAS3 unsigned char* ldsp = (LAS3 unsigned char*)lds;
    LAS3 int* TP = (LAS3 int*)(ldsp + LDS_MISC); LAS3 int* CNTL = TP + 64;
    const float* x = p.in[I_X];
    const int vcu = (G % 8 == 0) ? (blockIdx.x % 8) * (G / 8) + blockIdx.x / 8 : blockIdx.x;
    const int wave_id = __builtin_amdgcn_readfirstlane(threadIdx.x >> 6);
    if (threadIdx.x < 2) ((LAS3 unsigned*)(ldsp + LDS_MISC + 512))[threadIdx.x] = 0u;
    __syncthreads();
    const XcdBarrier xbar = xcd_barrier_post(ctl + 4096, (volatile LAS3 unsigned*)(ldsp + LDS_MISC + 512), threadIdx.x == 0);
#define GRID_BAR() do { const TI tb_ = fresh_ti(wave_id); xcd_barrier(xbar, tb_.tid == 0); } while (0)

    PH_BEGIN(0)
    {
        PHASE_IDS();
        LAS3 float* wdt = (LAS3 float*)ldsp;
        for (int i = tid; i < 1024 * 2; i += 512) { const int k = i >> 1, hh = i & 1; { const float4 t4 = ld4(p.in[I_WIN] + (size_t)k * IN_COLS + COL_DT + hh * 4); *(LAS3 g8::f32x4*)(wdt + hh * 4096 + (((k >> 8) * 4 + (k & 3)) * 64 + ((k & 255) >> 2)) * 4) = (g8::f32x4){t4.x, t4.y, t4.z, t4.w}; } }
        for (int i = gtid; i < PJ; i += NGT) BIASP[i] = i < PJ_Q ? 0.f : p.in[I_BQKV][i - PJ_Q];
        __syncthreads();
        {
            auto rowptr = [&](int r) -> const float* { return r >= NTOK ? p.in[I_MEM] + (size_t)(r - NTOK) * DM : x + (size_t)r * DM; };
            float4 vn[4];
            if (gw < NTOK + NMEM) {
#pragma unroll
                for (int j = 0; j < 4; ++j) vn[j] = ld4(rowptr(gw) + 4 * (lane + 64 * j)); }
            for (int r = gw; r < NTOK + NMEM; r += NGW) {
                const bool ismem = r >= NTOK;
                const float* g = ismem ? p.in[I_GMEM] : p.in[I_GMIX];
                float4 v[4]; float ss = 0.f;
#pragma unroll
                for (int j = 0; j < 4; ++j) { v[j] = vn[j]; ss += v[j].x * v[j].x + v[j].y * v[j].y + v[j].z * v[j].z + v[j].w * v[j].w; }
                if (r + NGW < NTOK + NMEM) {
#pragma unroll
                    for (int j = 0; j < 4; ++j) vn[j] = ld4(rowptr(r + NGW) + 4 * (lane + 64 * j)); }
                const float rs = rsqrtf(wave_sum(ss, lane) * (1.f / 1024.f) + EPS);
                float dacc[8];
#pragma unroll
                for (int h = 0; h < 8; ++h) dacc[h] = 0.f;
#pragma unroll
                for (int j = 0; j < 4; ++j) { const int c = 4 * (lane + 64 * j); const float4 gv = ld4(g + c);
                    v[j] = make_float4(v[j].x * rs * gv.x, v[j].y * rs * gv.y, v[j].z * rs * gv.z, v[j].w * rs * gv.w);
                    *(uint2*)(XN + (size_t)r * DM + c) = make_uint2(cvtpk(v[j].x, v[j].y), cvtpk(v[j].z, v[j].w));
                    if (!ismem) { const float uu[4] = {v[j].x, v[j].y, v[j].z, v[j].w};
#pragma unroll
                        for (int q = 0; q < 4; ++q) { const g8::f32x4 w0 = *(const LAS3 g8::f32x4*)(wdt + ((j * 4 + q) * 64 + lane) * 4), w1 = *(const LAS3 g8::f32x4*)(wdt + 4096 + ((j * 4 + q) * 64 + lane) * 4);
                            dacc[0] += uu[q] * w0.x; dacc[1] += uu[q] * w0.y; dacc[2] += uu[q] * w0.z; dacc[3] += uu[q] * w0.w;
                            dacc[4] += uu[q] * w1.x; dacc[5] += uu[q] * w1.y; dacc[6] += uu[q] * w1.z; dacc[7] += uu[q] * w1.w; } }
                }
                if (!ismem) {
#pragma unroll
                    for (int h = 0; h < 8; ++h) dacc[h] = wave_sum(dacc[h], lane);
                    if (lane == 0) { st4(DTRAW + (size_t)r * 8, make_float4(dacc[0], dacc[1], dacc[2], dacc[3])); st4(DTRAW + (size_t)r * 8 + 4, make_float4(dacc[4], dacc[5], dacc[6], dacc[7])); }
                }
            }
        }
        __syncthreads();
        LAS3 float* scr = (LAS3 float*)(ldsp + wave * 16640);
        constexpr int IT1 = 16 * (2048 / 64), IT2 = 16 * (1024 / 64);
        constexpr int IA = 16 * (1536 / 64), IB = 16 * (768 / 64), IO = 16 * 16, IQ = 16 * 8, IKV = 16 * 16, IWO = 8 * 16;
        constexpr int NSM = IA + IB + IO + IQ + IKV + IWO;
        for (int it = gw; it < NSM; it += NGW) {
            int r = it;
            if (r < IA) { transpose_item(p.in[I_WIN], 1024, IN_COLS, WINT, scr, r, lane, 1536); continue; } r -= IA;
            if (r < IB) { transpose_item(p.in[I_WIN] + COL_Q, 1024, IN_COLS, WINT + (size_t)1536 * 1024, scr, r, lane, 768); continue; } r -= IB;
            if (r < IO) { transpose_item(p.in[I_WOUT], 1024, 1024, WOUTT, scr, r, lane); continue; } r -= IO;
            if (r < IQ) { transpose_item(p.in[I_WQ], 1024, 512, WQT, scr, r, lane, 0, p.in[I_GCROSS]); continue; } r -= IQ;
            if (r < IKV) { transpose_item(p.in[I_WKV], 1024, 1024, WKVT, scr, r, lane); continue; } r -= IKV;
            transpose_item(p.in[I_WO], 512, 1024, WOT, scr, r, lane);
        }
        t8_run(p.in[I_W1], 2048, W1T8, p.in[I_GFFN], W1_P1_ITEMS + gw, NEXP * IT1, NGW, lane, scr);
    }
    GRID_BAR();
    PH_END()
    PH_BEGIN(1)
    {
        g8::DenseSched S{G, (int)blockIdx.x, 2048, NTOK / 256, PJ / 256, (const char*)WINT, NMEM / 256, 4, NTOK, (const char*)WKVT};
        g8::EpiBf16Dual E{PROJB, PJ, BIASP, KVMB, 1024};
        { PHASE_IDS(); g8::gemm_phase(ldsp, XN, WINT, 2048, 0, S, E, tid); }
    }
    if (blockIdx.x >= 72) {
        PHASE_IDS(); LAS3 float* scr = (LAS3 float*)(ldsp + wave * 16640);
        t8_run(p.in[I_W1], 2048, W1T8, p.in[I_GFFN], (blockIdx.x - 72) * 8 + wave, W1_P1_ITEMS, (G - 72) * 8, lane, scr);
    }
    GRID_BAR();
    PH_END()
    PH_BEGIN(2)
    {
    PHASE_IDS();
    for (int item = blockIdx.x; item < BATCH * 64 * 2; item += G)
        ssd_s1_item(item, PROJB, DTRAW, p.in[I_CONVW], p.in[I_CONVB], p.in[I_DTB], p.in[I_ALOG], XC, DT, ACS, CD, ST, ldsp, tid);
    }
    GRID_BAR();
    PH_END()
    PH_BEGIN(3)
    {
    PHASE_IDS();
    for (int item = blockIdx.x; item < BATCH * 64 * 2; item += G) swa_item(item, PROJB, MIXB, p.in[I_RELB], p.in[I_SINK], ldsp, tid);
    {
        for (int el = gtid; el < BATCH * 8 * 8192; el += NGT) {
            const int bh = el >> 13, pn = el & 8191, b = bh >> 3, h = bh & 7;
            float st = 0.f;
#pragma unroll 1
            for (int c0 = 0; c0 < 64; c0 += 32) {
                float sv[32], dv[32];
#pragma unroll
                for (int q = 0; q < 32; ++q) { const size_t bc = (size_t)b * 64 + c0 + q; sv[q] = ST[(bc * 8 + h) * 8192 + pn]; dv[q] = CD[bc * 8 + h]; }
#pragma unroll
                for (int q = 0; q < 32; ++q) { const size_t idx = (((size_t)b * 64 + c0 + q) * 8 + h) * 8192 + pn;
                    HIN[idx] = (bf)(cvtpk(st, 0.f) & 0xffffu); st = st * dv[q] + sv[q]; }
            }
        }
    }
    }
    GRID_BAR();
    PH_END()
    PH_BEGIN(4)
    {
    PHASE_IDS();
    for (int item = blockIdx.x; item < BATCH * 64 * 2; item += G)
        ssd_s3_item(item, XC, DT, ACS, HIN, PROJB, p.in[I_DSKIP], p.in[I_GSSM], ST, MIXB, ldsp, tid);
    }
    GRID_BAR();
    PH_END()
    PH_BEGIN(5)
    {
        g8::DenseSched S{G, (int)blockIdx.x, 2048, NTOK / 256, 4, (const char*)WOUTT, 0, 1, 0, nullptr};
        g8::EpiH1 E{p.in[I_BOUT], x, XN, SSQ1};
        { PHASE_IDS(); g8::gemm_phase(ldsp, MIXB, WOUTT, 2048, 0, S, E, tid); }
    }
    GRID_BAR();
    PH_END()
    PH_BEGIN(6)
    {
        g8::DenseSched S{G, (int)blockIdx.x, 2048, NTOK / 256, 2, (const char*)WQT, 0, 1, 0, nullptr};
        g8::EpiBf16Dual E{QCB, 512, nullptr, nullptr, 0};
        { PHASE_IDS(); g8::gemm_phase(ldsp, XN, WQT, 2048, 0, S, E, tid); }
    }
    if (blockIdx.x >= 128) {
        PHASE_IDS(); LAS3 float* scr = (LAS3 float*)(ldsp + wave * 16640);
        t8_run(p.in[I_W2], 1024, W2T8, nullptr, (blockIdx.x - 128) * 8 + wave, W2_P7_ITEMS, (G - 128) * 8, lane, scr);
    }
    GRID_BAR();
    PH_END()
    PH_BEGIN(7)
    {
    PHASE_IDS();
    for (int item = blockIdx.x; item < BATCH * 4 * 32; item += G) xattn_item(item, QCB, KVMB, SSQ1, OCB, ldsp, tid);
    }
    GRID_BAR();
    PH_END()
    PH_BEGIN(8)
    {
        g8::DenseSched S{G, (int)blockIdx.x, 1024, NTOK / 256, 4, (const char*)WOT, 0, 1, 0, nullptr};
        g8::EpiH2 E{XN, H2B, XN8};
        { PHASE_IDS(); g8::gemm_phase(ldsp, OCB, WOT, 1024, 0, S, E, tid); }
    }
    GRID_BAR();
    PH_END()
    PH_BEGIN(9)
    {
    PHASE_IDS();
    LAS3 float* PL = (LAS3 float*)ldsp;
    LAS3 float* SQ = (LAS3 float*)(ldsp + 33792);
    LAS3 unsigned* LC = (LAS3 unsigned*)(ldsp + 34816);
    if (tid < 32) LC[tid] = 0u;
    __syncthreads();
    const int hi = lane >> 5, r32 = lane & 31, tl = wave >> 2, kq = wave & 3;
    for (int rb = blockIdx.x; rb < NTOK / 64; rb += G) {
        const int row0 = rb * 64 + tl * 32;
        const unsigned short* hrow = H2B + (size_t)(row0 + r32) * DM + kq * 256 + 4 * hi;
        const float* gq = p.in[I_GFFN] + kq * 256 + 4 * hi;
        const float* wq = p.in[I_WR] + (size_t)(kq * 256 + 4 * hi) * 32 + r32;
        f32x16 acc;
#pragma unroll
        for (int r = 0; r < 16; ++r) acc[r] = 0.f;
        float ssq = 0.f;
#pragma unroll 1
        for (int mb = 0; mb < 32; mb += 8) {
            uint2 av[8]; float bv[8][4];
#pragma unroll
            for (int m = 0; m < 8; ++m) { av[m] = *(const uint2*)(hrow + 8 * (mb + m));
#pragma unroll
                for (int t = 0; t < 4; ++t) bv[m][t] = wq[(size_t)(8 * (mb + m) + t) * 32]; }
#pragma unroll
            for (int m = 0; m < 8; ++m) { const float4 gv = ld4(gq + 8 * (mb + m));
                float4 a = make_float4(__uint_as_float(av[m].x << 16), __uint_as_float(av[m].x & 0xffff0000u), __uint_as_float(av[m].y << 16), __uint_as_float(av[m].y & 0xffff0000u));
                ssq += a.x * a.x + a.y * a.y + a.z * a.z + a.w * a.w;
                a.x *= gv.x; a.y *= gv.y; a.z *= gv.z; a.w *= gv.w;
                acc = __builtin_amdgcn_mfma_f32_32x32x2f32(a.x, bv[m][0], acc, 0, 0, 0); acc = __builtin_amdgcn_mfma_f32_32x32x2f32(a.y, bv[m][1], acc, 0, 0, 0);
                acc = __builtin_amdgcn_mfma_f32_32x32x2f32(a.z, bv[m][2], acc, 0, 0, 0); acc = __builtin_amdgcn_mfma_f32_32x32x2f32(a.w, bv[m][3], acc, 0, 0, 0); }
        }
        ssq += xshfl(ssq, 32, lane);
        if (hi == 0) SQ[(tl * 4 + kq) * 32 + r32] = ssq;
#pragma unroll
        for (int r = 0; r < 16; ++r) PL[((tl * 4 + kq) * 32 + crow(r, hi)) * 33 + r32] = acc[r];
        __syncthreads();
        int sel[4] = {0, 0, 0, 0}, ls[4] = {0, 0, 0, 0}; float gt[4] = {0.f, 0.f, 0.f, 0.f}, rs = 0.f;
        const int i = 8 * kq + (lane & 7), row = row0 + i;
        if (lane < 8) {
            rs = rsqrtf((SQ[(tl * 4 + 0) * 32 + i] + SQ[(tl * 4 + 1) * 32 + i] + SQ[(tl * 4 + 2) * 32 + i] + SQ[(tl * 4 + 3) * 32 + i]) * (1.f / 1024.f) + EPS);
            float l[32];
#pragma unroll
            for (int e = 0; e < 32; ++e) l[e] = (PL[((tl * 4 + 0) * 32 + i) * 33 + e] + PL[((tl * 4 + 1) * 32 + i) * 33 + e] + PL[((tl * 4 + 2) * 32 + i) * 33 + e] + PL[((tl * 4 + 3) * 32 + i) * 33 + e]) * rs + p.in[I_BR][e];
            float val[4];
#pragma unroll
            for (int k = 0; k < 4; ++k) {
                float best = -INFINITY; int bi = 0;
#pragma unroll
                for (int e = 0; e < 32; ++e) if (l[e] > best) { best = l[e]; bi = e; }
                sel[k] = bi; val[k] = best;
#pragma unroll
                for (int e = 0; e < 32; ++e) l[e] = (e == bi) ? -INFINITY : l[e];
            }
            float den = 0.f;
#pragma unroll
            for (int k = 0; k < 4; ++k) { gt[k] = __expf(val[k] - val[0]); den += gt[k]; }
#pragma unroll
            for (int k = 0; k < 4; ++k) { gt[k] /= den; ls[k] = (int)__hip_atomic_fetch_add(&LC[sel[k]], 1u, __ATOMIC_RELAXED, __HIP_MEMORY_SCOPE_WORKGROUP); }
        }
        if (lane < 8) {
#pragma unroll
            for (int k = 0; k < 4; ++k) { const int a = row * 4 + k; SLOT[a] = (sel[k] << 16) | ls[k]; GATE[a] = gt[k]; }
            RSROW[row] = rs;
        }
        __syncthreads();
    }
    if (tid < 32) CNTB[blockIdx.x * 32 + tid] = (int)LC[tid];
    }
    GRID_BAR();
    PH_END()
    {
    PHASE_IDS();
    LAS3 int* PT = (LAS3 int*)ldsp;
    {
        const int e = tid & 31, part = tid >> 5; int tot = 0, base = 0;
        for (int bb = part; bb < G; bb += 16) { const int c = CNTB[bb * 32 + e]; tot += c; base += (bb < (int)blockIdx.x) ? c : 0; }
        PT[(part * 32 + e) * 2] = tot; PT[(part * 32 + e) * 2 + 1] = base;
    }
    __syncthreads();
    LAS3 unsigned* GB = (LAS3 unsigned*)(ldsp + 8192);
    if (tid < 64) {
        int c = 0, base = 0;
        if (tid < 32) {
#pragma unroll
            for (int q = 0; q < 16; ++q) { c += PT[(q * 32 + tid) * 2]; base += PT[(q * 32 + tid) * 2 + 1]; }
            GB[tid] = (unsigned)base; }
        int tl = (c + 255) >> 8, incl = tl;
#pragma unroll
        for (int o = 1; o < 32; o <<= 1) { const int v = bperm_i(incl, lane - o); if (lane >= o) incl += v; }
        if (tid < 32) { CNTL[tid] = c; TP[tid] = incl - tl; }
        if (tid == 31) TP[32] = incl;
    }
    __syncthreads();
    for (int rb = blockIdx.x; rb < NTOK / 64; rb += G)
        if (tid < 256) { const int a = rb * 256 + tid; const int v = SLOT[a], e = v >> 16; const unsigned slot = GB[e] + (unsigned)(v & 0xffff);
            LIST[e * NTOK + slot] = a; RSA[e * NTOK + slot] = RSROW[a >> 2]; SLOT[a] = (e << 16) | (int)slot; }
    g8::moe_units(TP + 136, TP, 8, G, vcu, tid); g8::moe_units(TP + 168, TP, 4, G, vcu, tid);
    }
    GRID_BAR();
    PH_BEGIN(10)
    {
        g8::MoeSched S{8, 1024, TP + 136, TP, CNTL, LIST, (const char*)W1T8, 2048u * 1024u};
        g8::EpiSwiglu E{ACT8, p.in[I_B1], RSA};
        { PHASE_IDS(); g8::gemm_phase<g8::EpiSwiglu, g8::MoeSched, true>(ldsp, XN8, W1T8, 1024, 2, S, E, tid); }
    }
    {
        PHASE_IDS(); LAS3 float* scr = (LAS3 float*)(ldsp + wave * 16640);
        const int total = TP[32] * 8, maxu = (total + G - 1) / G, tlast = total - (maxu - 1) * G;
        const int nidle = G - tlast;
        if (nidle >= 64) { if (vcu >= tlast) t8_run(p.in[I_W2], 1024, W2T8, nullptr, W2_P7_ITEMS + (vcu - tlast) * 8 + wave, NEXP * 256, nidle * 8, lane, scr); }
        else t8_run(p.in[I_W2], 1024, W2T8, nullptr, W2_P7_ITEMS + vcu * 8 + wave, NEXP * 256, G * 8, lane, scr);
    }
    GRID_BAR();
    PH_END()
    PH_BEGIN(11)
    {
        g8::MoeSched S{4, 1024, TP + 168, TP, CNTL, nullptr, (const char*)W2T8, 1024u * 1024u};
        g8::EpiFp8 E{Y8, p.in[I_B2], 0.0078125f};
        { PHASE_IDS(); g8::gemm_phase<g8::EpiFp8, g8::MoeSched, true>(ldsp, ACT8, W2T8, 1024, 0, S, E, tid); }
    }
    GRID_BAR();
    PH_END()
    PH_BEGIN(12)
    {
    PHASE_IDS();
    {
        uint2 hn[4]; int sln[4]; float gkn[4];
        if (gw < NTOK) {
#pragma unroll
            for (int k = 0; k < 4; ++k) { sln[k] = SLOT[gw * 4 + k]; gkn[k] = GATE[gw * 4 + k] * 0.0625f; }
#pragma unroll
            for (int j = 0; j < 4; ++j) hn[j] = *(const uint2*)(H2B + (size_t)gw * DM + 4 * (lane + 64 * j)); }
        for (int row = gw; row < NTOK; row += NGW) {
            float4 v[4]; float ss = 0.f; float gk[4]; unsigned y[4][4];
#pragma unroll
            for (int k = 0; k < 4; ++k) { const int yrow = TP[sln[k] >> 16] * 256 + (sln[k] & 0xffff); gk[k] = gkn[k];
#pragma unroll
                for (int j = 0; j < 4; ++j) y[k][j] = *(const unsigned*)(Y8 + (size_t)yrow * 1024 + 4 * (lane + 64 * j)); }
#pragma unroll
            for (int j = 0; j < 4; ++j) v[j] = make_float4(__uint_as_float(hn[j].x << 16), __uint_as_float(hn[j].x & 0xffff0000u), __uint_as_float(hn[j].y << 16), __uint_as_float(hn[j].y & 0xffff0000u));
            if (row + NGW < NTOK) {
#pragma unroll
                for (int k = 0; k < 4; ++k) { sln[k] = SLOT[(row + NGW) * 4 + k]; gkn[k] = GATE[(row + NGW) * 4 + k] * 0.0625f; }
#pragma unroll
                for (int j = 0; j < 4; ++j) hn[j] = *(const uint2*)(H2B + (size_t)(row + NGW) * DM + 4 * (lane + 64 * j)); }
#pragma unroll
            for (int j = 0; j < 4; ++j) { float4 a = v[j];
#pragma unroll
                for (int k = 0; k < 4; ++k) { const g8::f32x2 lo = __builtin_amdgcn_cvt_pk_f32_fp8((int)y[k][j], false), hi2 = __builtin_amdgcn_cvt_pk_f32_fp8((int)y[k][j], true);
                    a.x += gk[k] * lo[0]; a.y += gk[k] * lo[1]; a.z += gk[k] * hi2[0]; a.w += gk[k] * hi2[1]; }
                v[j] = a; ss += a.x * a.x + a.y * a.y + a.z * a.z + a.w * a.w; }
            const float rs = rsqrtf(wave_sum(ss, lane) * (1.f / 1024.f) + EPS);
#pragma unroll
            for (int j = 0; j < 4; ++j) { const int c = 4 * (lane + 64 * j); const float4 gv = ld4(p.in[I_GFIN] + c);
                st4(p.out + (size_t)row * DM + c, make_float4(v[j].x * rs * gv.x, v[j].y * rs * gv.y, v[j].z * rs * gv.z, v[j].w * rs * gv.w)); }
        }
    }
    }
    PH_END()
}

constexpr int LDS_BYTES = 147456;

extern "C" void kernel_launch(void* const* d_in, const int* in_sizes, int n_in, void* d_out, int out_size, void* d_ws, size_t ws_size, hipStream_t stream) {
    static int grid = 0;
    if (grid == 0) {
        if (n_in != N_IN || ws_size < WS_END) { fprintf(stderr, "kernel_launch: unexpected n_in %d / ws_size %zu (need %zu)\n", n_in, ws_size, (size_t)WS_END); grid = -1; return; }
        int dev = 0, cus = 0, per_cu = 0;
        (void)hipGetDevice(&dev);
        (void)hipDeviceGetAttribute(&cus, hipDeviceAttributeMultiprocessorCount, dev);
        (void)hipFuncSetAttribute((const void*)mk_fwd, hipFuncAttributeMaxDynamicSharedMemorySize, LDS_BYTES);
        (void)hipOccupancyMaxActiveBlocksPerMultiprocessor(&per_cu, (const void*)mk_fwd, 512, LDS_BYTES);
        if (per_cu < 1) { fprintf(stderr, "kernel_launch: occupancy query says %d blocks per CU\n", per_cu); per_cu = 1; }
        if (per_cu > 1) per_cu = 1;
        grid = cus * per_cu;
    }
    if (grid < 0) return;
    (void)hipMemsetAsync((char*)d_ws + WS_CTL, 0, 32 * 1024, stream);
    Params p{};
    for (int i = 0; i < N_IN; ++i) p.in[i] = (const float*)d_in[i];
    p.out = (float*)d_out; p.ws = (unsigned char*)d_ws; p.rep_mask = REP_MASK;
    void* args[] = {&p};
    hipError_t e = hipLaunchCooperativeKernel((const void*)mk_fwd, dim3(grid), dim3(512), args, LDS_BYTES, stream);
    if (e != hipSuccess) fprintf(stderr, "cooperative launch failed: %s (grid %d)\n", hipGetErrorString(e), grid);
}
```
